# Optimizing an MI355X kernel written in HIP

```python
import jax
import jax.numpy as jnp
from jax import lax
import numpy as np


D_MODEL = 1024
BATCH = 16
SEQ = 2048
DEPTH = 2

N_MIXERS = 2
N_ATTN_LAYERS = (DEPTH + 1) // 2
N_MLSTM_LAYERS = DEPTH // 2

DIL_CONFIGS = ((128, 1), (512, 4), (2048, 16))
N_GROUPS = len(DIL_CONFIGS)
ATTN_HEADS = 8
ATTN_HEAD_DIM = 128
ATTN_WIDTH = ATTN_HEADS * ATTN_HEAD_DIM
ATTN_IN_WIDTH = N_GROUPS * 3 * ATTN_WIDTH
ROT_DIM = ATTN_HEAD_DIM // 4
ROPE_THETA = 500000.0
BLOCK = 128

MLSTM_HEADS = 8
MLSTM_QK_DIM = D_MODEL // 2 // MLSTM_HEADS
MLSTM_V_DIM = D_MODEL // MLSTM_HEADS
QK_WIDTH = MLSTM_HEADS * MLSTM_QK_DIM
MLSTM_IN_WIDTH = 2 * QK_WIDTH + 2 * D_MODEL + 2 * MLSTM_HEADS
MLSTM_CHUNK = 64
CONV_WIDTH = 4

D_FF = -(-8 * D_MODEL // (3 * 256)) * 256

RMS_EPS = 1e-6

kernel_name = 'hybrid_dilated_attn_mlstm'


def rms_norm(x, g):
    xf = x.astype(jnp.float32)
    y = xf * lax.rsqrt(jnp.mean(xf * xf, axis=-1, keepdims=True) + RMS_EPS)
    return y.astype(x.dtype) * g.astype(x.dtype)


def apply_partial_rope(t, positions):
    half = ROT_DIM // 2
    inv_freq = ROPE_THETA ** (-jnp.arange(half, dtype=jnp.float32) * 2.0 / ROT_DIM)
    ang = positions.astype(jnp.float32)[..., None] * inv_freq
    cos = jnp.cos(ang)[:, :, None, :]
    sin = jnp.sin(ang)[:, :, None, :]
    tf = t.astype(jnp.float32)
    x1 = tf[..., :half]
    x2 = tf[..., half:ROT_DIM]
    out = jnp.concatenate([x1 * cos - x2 * sin, x2 * cos + x1 * sin, tf[..., ROT_DIM:]], axis=-1)
    return out.astype(t.dtype)


def banded_window_attention(q, k, v, window):
    *lead, L, hd = q.shape
    nb = -(-L // BLOCK)
    Lp = nb * BLOCK
    pad = [(0, 0)] * len(lead) + [(0, Lp - L), (0, 0)]

    def blocks(t):
        return jnp.pad(t, pad).reshape(*lead, nb, BLOCK, hd)

    def with_prev(t):
        prev = jnp.concatenate([jnp.zeros_like(t[..., :1, :, :]), t[..., :-1, :, :]], axis=-3)
        return jnp.concatenate([prev, t], axis=-2)

    qb = blocks(q)
    kk = with_prev(blocks(k))
    vv = with_prev(blocks(v))
    s = jnp.einsum('...iqd,...ikd->...iqk', qb, kk).astype(jnp.float32)
    blk = jnp.arange(nb)[:, None, None]
    a = jnp.arange(BLOCK)[None, :, None]
    c = jnp.arange(2 * BLOCK)[None, None, :]
    dist = a + BLOCK - c
    valid = (dist >= 0) & (dist <= window) & ((blk - 1) * BLOCK + c >= 0)
    s = jnp.where(valid, s, -jnp.inf)
    m = jnp.max(s, axis=-1, keepdims=True)
    p = jnp.exp(s - m)
    den = jnp.sum(p, axis=-1, keepdims=True)
    o = jnp.einsum('...iqk,...ikd->...iqd', (p / den).astype(v.dtype), vv)
    lse = (m + jnp.log(den))[..., 0]
    o = o.reshape(*lead, Lp, hd)[..., :L, :]
    lse = lse.reshape(*lead, Lp)[..., :L]
    return o, lse


def dilated_window_attention(q, k, v, window, dilation):
    B, S, H, hd = q.shape
    L = S // dilation

    def to_sub(t):
        return t.reshape(B, L, dilation, H, hd).transpose(0, 2, 3, 1, 4)

    o, lse = banded_window_attention(to_sub(q), to_sub(k), to_sub(v), window // dilation)
    o = o.transpose(0, 3, 1, 2, 4).reshape(B, S, H, hd)
    lse = lse.transpose(0, 3, 1, 2).reshape(B, S, H)
    return o, lse


def dilated_attention_mixer(xn, positions, w_in, w_out):
    B, S, _ = xn.shape
    proj = (xn @ w_in).reshape(B, S, N_GROUPS, 3, ATTN_HEADS, ATTN_HEAD_DIM)
    scale = ATTN_HEAD_DIM ** -0.5
    outs = []
    lses = []
    for g, (window, dilation) in enumerate(DIL_CONFIGS):
        q = apply_partial_rope(proj[:, :, g, 0], positions) * scale
        k = apply_partial_rope(proj[:, :, g, 1], positions)
        v = proj[:, :, g, 2]
        o, lse = dilated_window_attention(q, k, v, window, dilation)
        outs.append(o)
        lses.append(lse)
    wts = jax.nn.softmax(jnp.stack(lses), axis=0)
    o = jnp.einsum('gbsh,gbshd->bshd', wts.astype(xn.dtype), jnp.stack(outs))
    return o.reshape(B, S, ATTN_WIDTH) @ w_out


def causal_depthwise_conv(t, w, b):
    out = lax.conv_general_dilated(
        t, w[:, None, :].astype(t.dtype), window_strides=(1,),
        padding=[(CONV_WIDTH - 1, 0)], dimension_numbers=('NWC', 'WIO', 'NWC'),
        feature_group_count=t.shape[-1])
    return out + b.astype(t.dtype)


def mlstm_chunk_step(carry, xs):
    C, n, m = carry
    q, k, v, ig, lf = xs
    L = q.shape[2]
    b = jnp.cumsum(lf, axis=-1)
    causal = jnp.tril(jnp.ones((L, L), dtype=bool))
    dmat = jnp.where(causal, b[..., :, None] - b[..., None, :] + ig[..., None, :], -jnp.inf)
    inter = b + m[..., None]
    m_t = jnp.maximum(inter, jnp.max(dmat, axis=-1))
    w_intra = jnp.exp(dmat - m_t[..., None])
    w_inter = jnp.exp(inter - m_t)
    sm = w_intra * jnp.einsum('bhtd,bhsd->bhts', q, k)
    num = jnp.einsum('bhts,bhsv->bhtv', sm, v) + w_inter[..., None] * jnp.einsum('bhtd,bhdv->bhtv', q, C)
    den = jnp.sum(sm, axis=-1) + w_inter * jnp.einsum('bhtd,bhd->bht', q, n)
    h = num / jnp.maximum(jnp.abs(den), jnp.exp(-m_t))[..., None]
    b_last = b[..., -1]
    decay = b_last[..., None] - b + ig
    m_new = jnp.maximum(b_last + m, jnp.max(decay, axis=-1))
    ws = jnp.exp(decay - m_new[..., None])
    carry_scale = jnp.exp(b_last + m - m_new)
    C_new = carry_scale[..., None, None] * C + jnp.einsum('bhs,bhsd,bhsv->bhdv', ws, k, v)
    n_new = carry_scale[..., None] * n + jnp.einsum('bhs,bhsd->bhd', ws, k)
    return (C_new, n_new, m_new), h


def mlstm_chunkwise(q, k, v, ig, lf):
    B, H, S, dk = q.shape
    dv = v.shape[-1]
    nc = S // MLSTM_CHUNK

    def to_chunks(t):
        return jnp.moveaxis(t.reshape(B, H, nc, MLSTM_CHUNK, *t.shape[3:]), 2, 0)

    init = (jnp.zeros((B, H, dk, dv), jnp.float32), jnp.zeros((B, H, dk), jnp.float32),
            jnp.zeros((B, H), jnp.float32))
    _, h = lax.scan(mlstm_chunk_step, init,
                    (to_chunks(q), to_chunks(k), to_chunks(v), to_chunks(ig), to_chunks(lf)))
    return jnp.moveaxis(h, 0, 2).reshape(B, H, S, dv)


def mlstm_mixer(xn, w_in, conv_w, conv_b, ig_bias, fg_bias, head_gain, w_out):
    B, S, _ = xn.shape
    proj = xn @ w_in
    qk_pre = proj[..., :2 * QK_WIDTH]
    v = proj[..., 2 * QK_WIDTH:2 * QK_WIDTH + D_MODEL]
    o_pre = proj[..., 2 * QK_WIDTH + D_MODEL:2 * QK_WIDTH + 2 * D_MODEL]
    gates = proj[..., 2 * QK_WIDTH + 2 * D_MODEL:].astype(jnp.float32)
    qk = jax.nn.silu(causal_depthwise_conv(qk_pre, conv_w, conv_b))
    ig = gates[..., :MLSTM_HEADS] + ig_bias.astype(jnp.float32)
    lf = jax.nn.log_sigmoid(gates[..., MLSTM_HEADS:] + fg_bias.astype(jnp.float32))

    def heads(t, d):
        return t.reshape(B, S, MLSTM_HEADS, d).transpose(0, 2, 1, 3).astype(jnp.float32)

    q = heads(qk[..., :QK_WIDTH], MLSTM_QK_DIM)
    k = heads(qk[..., QK_WIDTH:], MLSTM_QK_DIM) * (MLSTM_QK_DIM ** -0.5)
    vh = heads(v, MLSTM_V_DIM)
    h = mlstm_chunkwise(q, k, vh, ig.transpose(0, 2, 1), lf.transpose(0, 2, 1))
    h = h.transpose(0, 2, 1, 3)
    h = h * lax.rsqrt(jnp.mean(h * h, axis=-1, keepdims=True) + RMS_EPS)
    h = h.reshape(B, S, D_MODEL).astype(xn.dtype) * head_gain.astype(xn.dtype)
    return (h * jax.nn.sigmoid(o_pre)) @ w_out


def swiglu(xn, w_in, w_out):
    gu = xn @ w_in
    return (jax.nn.silu(gu[..., :D_FF]) * gu[..., D_FF:]) @ w_out


def setup_inputs(seed: int = 0) -> dict:
    key = jax.random.key(seed)
    ks = jax.random.split(key, 20)

    def dense(k, shape, fan_in):
        return jax.random.normal(k, shape, jnp.float32) * (fan_in ** -0.5)

    def gain(k, shape):
        return 1.0 + 0.05 * jax.random.normal(k, shape, jnp.float32)

    x = jax.random.normal(ks[0], (BATCH, SEQ, D_MODEL), jnp.float32)
    offset = jax.random.randint(ks[1], (BATCH, 1), 0, 4096, dtype=jnp.int32)
    positions = offset + jnp.arange(SEQ, dtype=jnp.int32)[None, :]
    return {
        'x': x,
        'positions': positions,
        'attn_norm': gain(ks[2], (N_ATTN_LAYERS, D_MODEL)),
        'attn_w_in': dense(ks[3], (N_ATTN_LAYERS, D_MODEL, ATTN_IN_WIDTH), D_MODEL),
        'attn_w_out': dense(ks[4], (N_ATTN_LAYERS, ATTN_WIDTH, D_MODEL), ATTN_WIDTH),
        'mlstm_norm': gain(ks[5], (N_MLSTM_LAYERS, D_MODEL)),
        'mlstm_w_in': dense(ks[6], (N_MLSTM_LAYERS, D_MODEL, MLSTM_IN_WIDTH), D_MODEL),
        'mlstm_conv_w': dense(ks[7], (N_MLSTM_LAYERS, CONV_WIDTH, 2 * QK_WIDTH), CONV_WIDTH),
        'mlstm_conv_b': 0.02 * jax.random.normal(ks[8], (N_MLSTM_LAYERS, 2 * QK_WIDTH), jnp.float32),
        'mlstm_ig_bias': 0.1 * jax.random.normal(ks[9], (N_MLSTM_LAYERS, MLSTM_HEADS), jnp.float32),
        'mlstm_fg_bias': 3.0 + 0.1 * jax.random.normal(ks[10], (N_MLSTM_LAYERS, MLSTM_HEADS), jnp.float32),
        'mlstm_head_gain': gain(ks[11], (N_MLSTM_LAYERS, D_MODEL)),
        'mlstm_w_out': dense(ks[12], (N_MLSTM_LAYERS, D_MODEL, D_MODEL), D_MODEL),
        'ffn_norm': gain(ks[13], (DEPTH, D_MODEL)),
        'ffn_w_in': dense(ks[14], (DEPTH, D_MODEL, 2 * D_FF), D_MODEL),
        'ffn_w_out': dense(ks[15], (DEPTH, D_FF, D_MODEL), D_FF),
        'final_norm': gain(ks[16], (D_MODEL,)),
    }


def reference(x, positions, attn_norm, attn_w_in, attn_w_out, mlstm_norm, mlstm_w_in,
              mlstm_conv_w, mlstm_conv_b, mlstm_ig_bias, mlstm_fg_bias, mlstm_head_gain,
              mlstm_w_out, ffn_norm, ffn_w_in, ffn_w_out, final_norm):
    h = x
    for i in range(DEPTH):
        j = i // N_MIXERS
        if i % N_MIXERS == 0:
            h = h + dilated_attention_mixer(rms_norm(h, attn_norm[j]), positions,
                                            attn_w_in[j], attn_w_out[j])
        else:
            h = h + mlstm_mixer(rms_norm(h, mlstm_norm[j]), mlstm_w_in[j], mlstm_conv_w[j],
                                mlstm_conv_b[j], mlstm_ig_bias[j], mlstm_fg_bias[j],
                                mlstm_head_gain[j], mlstm_w_out[j])
        h = h + swiglu(rms_norm(h, ffn_norm[i]), ffn_w_in[i], ffn_w_out[i])
    return rms_norm(h, final_norm)
```

```cpp
#include <hip/hip_runtime.h>
#include <hip/hip_cooperative_groups.h>
#include <cstdio>
#include <cstdint>
namespace cg = cooperative_groups;

constexpr float RMS_EPS = 1e-6f;
__device__ __forceinline__ float rs_from_ss(float ss) { return 1.0f / sqrtf(ss * (1.0f / 1024.0f) + RMS_EPS); }
__device__ __forceinline__ float silu_f(float x) { return x / (1.0f + __expf(-x)); }
__device__ __forceinline__ float sigmoid_f(float x) { return 1.0f / (1.0f + __expf(-x)); }

namespace pg8 {
#define PG8_LAS __attribute__((address_space(3)))
typedef unsigned short bf16_t;
typedef short bf16x8 __attribute__((ext_vector_type(8)));
typedef float f32x4 __attribute__((ext_vector_type(4)));
typedef unsigned u32x4 __attribute__((ext_vector_type(4)));
constexpr int BM = 256, BK = 64, HALF = 128, HTB = HALF * BK * 2  , STAGE_BYTES = 8 * HTB, NXCD = 8, WGM = 8;

__host__ __device__ __forceinline__ int lds_byte(int r, int c) { const int st = (r >> 4) * 2 + (c >> 5), rr = r & 15, cc = c & 31, ob = rr * 64 + cc * 2; return st * 1024 + (ob ^ (((ob >> 9) & 1) << 5)); }
__host__ __device__ __forceinline__ void stage_rc(int b, int& R, int& C) { const int st = b / 1024, sb = b % 1024, swz = sb ^ (((sb >> 9) & 1) << 5); R = (st >> 1) * 16 + swz / 64; C = (st & 1) * 32 + (swz % 64) / 2; }
__host__ __device__ __forceinline__ int perm32(int rho) { const int n = rho >> 4, i = rho & 15; return 8 * (i >> 2) + 4 * n + (i & 3); }

struct Unit { int pm, pn; };
struct Gemm { const bf16_t* A; const bf16_t* Bt; int M, N, K; };

struct StaticOrder {
    int nM, nN, nwg, G, c;
    __host__ __device__ void init(int M, int N, int G_, int c_) { nM = M / BM; nN = N / BM; nwg = nM * nN; G = G_; c = c_; }
    __host__ __device__ bool next(int i, Unit& u) const {
        const long L = (long)i * G + c; if (L >= nwg) return false;
        int wgid = (int)L; { const int q = nwg / NXCD, r = nwg % NXCD, xcd = wgid % NXCD, off = wgid / NXCD; wgid = (xcd < r ? xcd * (q + 1) : r * (q + 1) + (xcd - r) * q) + off; }
        const int nig = WGM * nN, gid = wgid / nig, fm = gid * WGM, gsz = (nM - fm) < WGM ? (nM - fm) : WGM;
        u.pm = fm + ((wgid % nig) % gsz); u.pn = (wgid % nig) / gsz; return true;
    }
    __device__ __forceinline__ void a_ready(const Unit&) const {}
    __device__ __forceinline__ void done(const Unit&) const {}
};
__device__ __forceinline__ unsigned cvt_pk_bf16(float lo, float hi) { unsigned r; asm volatile("v_cvt_pk_bf16_f32 %0, %1, %2" : "=v"(r) : "v"(lo), "v"(hi)); return r; }

struct EpiQKV {
    static constexpr bool PERM = true, AFTER_DRAIN = false;
    bf16_t* O; const float* ss; const float* cs;
    __device__ __forceinline__ void operator()(const f32x4 (&acc)[2][2][4][2], const Unit& u, int wr, int wc, int fr, int fq) const {
        const int row0 = u.pm * BM + wr * 64 + fr; const int colt = u.pn * BM;
        const int tsel = (colt % 3072) / 1024;
        const bool rope = (tsel < 2) && (wc == 0);
        const int col0 = colt + wc * 32 + 8 * fq;
        const float sgn = (fq < 2) ? -1.f : 1.f;
#pragma unroll
        for (int ai = 0; ai < 2; ++ai)
#pragma unroll
            for (int m = 0; m < 4; ++m) {
                const int row = row0 + ai * HALF + m * 16;
                const float rs = rs_from_ss(ss[row]);
                f32x4 c0 = {0.f, 0.f, 0.f, 0.f}, c1 = c0, s0 = c0, s1 = c0;
                if (rope) { const float* p = cs + (size_t)row * 32 + 8 * (fq & 1); c0 = *(const f32x4*)p; c1 = *(const f32x4*)(p + 4); s0 = *(const f32x4*)(p + 16); s1 = *(const f32x4*)(p + 20); }
                bf16_t* rowp = O + (size_t)row * 9216 + col0;
#pragma unroll
                for (int bj = 0; bj < 2; ++bj) {
                    f32x4 v0 = acc[ai][bj][m][0], v1 = acc[ai][bj][m][1];
                    if (rope) {
                        f32x4 o0, o1;
#pragma unroll
                        for (int e = 0; e < 4; ++e) { o0[e] = __shfl_xor(v0[e], 32); o1[e] = __shfl_xor(v1[e], 32); }
                        v0 = v0 * c0 + (o0 * s0) * sgn; v1 = v1 * c1 + (o1 * s1) * sgn;
                    }
                    v0 = v0 * rs; v1 = v1 * rs;
                    u32x4 wv; wv.x = cvt_pk_bf16(v0[0], v0[1]); wv.y = cvt_pk_bf16(v0[2], v0[3]); wv.z = cvt_pk_bf16(v1[0], v1[1]); wv.w = cvt_pk_bf16(v1[2], v1[3]);
                    *(u32x4*)(rowp + bj * HALF) = wv;
                }
            }
    }
};
struct EpiResid {
    static constexpr bool PERM = true, AFTER_DRAIN = false;
    const float* base; float* out; bf16_t* outb; float* ssn;
    __device__ __forceinline__ void operator()(const f32x4 (&acc)[2][2][4][2], const Unit& u, int wr, int wc, int fr, int fq) const {
        const int row0 = u.pm * BM + wr * 64 + fr; const int col0 = u.pn * BM + wc * 32 + 8 * fq;
#pragma unroll
        for (int ai = 0; ai < 2; ++ai)
#pragma unroll
            for (int m = 0; m < 4; ++m) {
                const int row = row0 + ai * HALF + m * 16; float sq = 0.f;
#pragma unroll
                for (int bj = 0; bj < 2; ++bj) {
                    const size_t off = (size_t)row * 1024 + col0 + bj * HALF;
                    const f32x4 r0 = *(const f32x4*)(base + off), r1 = *(const f32x4*)(base + off + 4);
                    const f32x4 v0 = acc[ai][bj][m][0] + r0, v1 = acc[ai][bj][m][1] + r1;
                    *(f32x4*)(out + off) = v0; *(f32x4*)(out + off + 4) = v1;
                    if (outb) { u32x4 wv; wv.x = cvt_pk_bf16(v0[0], v0[1]); wv.y = cvt_pk_bf16(v0[2], v0[3]); wv.z = cvt_pk_bf16(v1[0], v1[1]); wv.w = cvt_pk_bf16(v1[2], v1[3]); *(u32x4*)(outb + off) = wv; }
                    sq += (v0[0] * v0[0] + v0[1] * v0[1]) + (v0[2] * v0[2] + v0[3] * v0[3]) + (v1[0] * v1[0] + v1[1] * v1[1]) + (v1[2] * v1[2] + v1[3] * v1[3]);
                }
                sq += __shfl_xor(sq, 16); sq += __shfl_xor(sq, 32);
                if (fq == 0) atomicAdd(ssn + row, sq);
            }
    }
};
struct EpiSwiGLU {
    static constexpr bool PERM = true, AFTER_DRAIN = false;
    bf16_t* O; const float* ss;
    __device__ __forceinline__ void operator()(const f32x4 (&acc)[2][2][4][2], const Unit& u, int wr, int wc, int fr, int fq) const {
        const int row0 = u.pm * BM + wr * 64 + fr; const int col0 = u.pn * HALF + wc * 32 + 8 * fq;
#pragma unroll
        for (int ai = 0; ai < 2; ++ai)
#pragma unroll
            for (int m = 0; m < 4; ++m) {
                const int row = row0 + ai * HALF + m * 16;
                const float rs = rs_from_ss(ss[row]);
                float o[8];
#pragma unroll
                for (int n = 0; n < 2; ++n)
#pragma unroll
                    for (int e = 0; e < 4; ++e) { const float g = acc[ai][0][m][n][e] * rs, uu = acc[ai][1][m][n][e] * rs; o[4 * n + e] = silu_f(g) * uu; }
                u32x4 wv; wv.x = cvt_pk_bf16(o[0], o[1]); wv.y = cvt_pk_bf16(o[2], o[3]); wv.z = cvt_pk_bf16(o[4], o[5]); wv.w = cvt_pk_bf16(o[6], o[7]);
                *(u32x4*)(O + (size_t)row * 2816 + col0) = wv;
            }
    }
};
struct EpiMlstmIn {
    static constexpr bool PERM = true, AFTER_DRAIN = false;
    bf16_t* P2; bf16_t* OP; float* gates; const float* ss;
    __device__ __forceinline__ void operator()(const f32x4 (&acc)[2][2][4][2], const Unit& u, int wr, int wc, int fr, int fq) const {
        const int row0 = u.pm * BM + wr * 64 + fr;
#pragma unroll
        for (int ai = 0; ai < 2; ++ai)
#pragma unroll
            for (int m = 0; m < 4; ++m) {
                const int row = row0 + ai * HALF + m * 16;
                const float rs = rs_from_ss(ss[row]);
#pragma unroll
                for (int bj = 0; bj < 2; ++bj) {
                    const int cb = u.pn * BM + bj * HALF;
                    const f32x4 v0 = acc[ai][bj][m][0] * rs, v1 = acc[ai][bj][m][1] * rs;
                    const int cc = wc * 32 + 8 * fq;
                    if (cb < 3072) {
                        u32x4 wv; wv.x = cvt_pk_bf16(v0[0], v0[1]); wv.y = cvt_pk_bf16(v0[2], v0[3]); wv.z = cvt_pk_bf16(v1[0], v1[1]); wv.w = cvt_pk_bf16(v1[2], v1[3]);
                        bf16_t* dst = (cb < 2048) ? (P2 + (size_t)row * 2048 + cb + cc) : (OP + (size_t)row * 1024 + (cb - 2048) + cc);
                        *(u32x4*)dst = wv;
                    } else if (cb == 3072 && cc < 16) {
                        float* dst = gates + (size_t)row * 16 + cc;
                        *(f32x4*)dst = v0; *(f32x4*)(dst + 4) = v1;
                    }
                }
            }
    }
};

template <class Epi, class Sched, bool ALIGN_EPI = false, bool SP2 = false>
__device__ __forceinline__ void gemm_phase(PG8_LAS unsigned char* lds, const Gemm g, const Sched& S, const Epi& E) {
    const int tid = threadIdx.x, wid = __builtin_amdgcn_readfirstlane(tid >> 6), lane = tid & 63, wr = wid >> 2, wc = wid & 3, fr = lane & 15, fq = lane >> 4;
    const int K = g.K, nt = K / BK;
    unsigned voffA[2], voffB[2];
#pragma unroll
    for (int i = 0; i < 2; ++i) { int R, C; stage_rc(tid * 16 + i * 8192, R, C); const int Rb = Epi::PERM ? ((R & ~31) + perm32(R & 31)) : R;
        voffA[i] = (unsigned)(R * K + C) * 2u; voffB[i] = (unsigned)(Rb * K + C) * 2u; }
    const size_t kstep = (size_t)(BK * 2);
    const size_t hstep = (size_t)HALF * K * 2;
    const size_t tstep = 2 * hstep;
    const unsigned ldsw = (unsigned)wid * 1024u;
    const int aoff = lds_byte(wr * 64 + fr, fq * 8), boff = lds_byte(wc * 32 + fr, fq * 8);
#define PG8_SA(b, h) (((b) * 2 + (h)) * HTB)
#define PG8_SB(b, h) ((4 + (b) * 2 + (h)) * HTB)
#define PG8_STAGE(bufoff, gbase, voff) do { _Pragma("unroll") for (int _i = 0; _i < 2; ++_i) \
        __builtin_amdgcn_global_load_lds((const unsigned*)((const char*)(gbase) + (voff)[_i]), (PG8_LAS unsigned*)(lds + (bufoff) + ldsw + _i * 8192), 16, 0, 0); } while (0)
#define PG8_LDA(dst, b, h) do { _Pragma("unroll") for (int m = 0; m < 4; ++m) _Pragma("unroll") for (int k = 0; k < 2; ++k) dst[m][k] = *(const PG8_LAS bf16x8*)(lds + PG8_SA(b, h) + aoff + m * 2048 + k * 1024); } while (0)
#define PG8_LDB(dst, b, h) do { _Pragma("unroll") for (int n = 0; n < 2; ++n) _Pragma("unroll") for (int k = 0; k < 2; ++k) dst[n][k] = *(const PG8_LAS bf16x8*)(lds + PG8_SB(b, h) + boff + n * 2048 + k * 1024); } while (0)
#define PG8_MMA(ai, bj, At, Bt) do { __builtin_amdgcn_s_setprio(1); _Pragma("unroll") for (int m = 0; m < 4; ++m) _Pragma("unroll") for (int n = 0; n < 2; ++n) _Pragma("unroll") for (int k = 0; k < 2; ++k) \
        acc[ai][bj][m][n] = __builtin_amdgcn_mfma_f32_16x16x32_bf16(Bt[n][k], At[m][k], acc[ai][bj][m][n], 0, 0, 0); __builtin_amdgcn_s_setprio(0); } while (0)
#define PG8_WAIT_V(n) asm volatile("s_waitcnt vmcnt(" #n ")" ::: "memory")
#define PG8_WAIT_L(n) asm volatile("s_waitcnt lgkmcnt(" #n ")" ::: "memory")
#define PG8_BAR __builtin_amdgcn_s_barrier()
#define PG8_SCHED __builtin_amdgcn_sched_barrier(0)
    Unit cur, nxt; int ui = 0;
    if (!S.next(0, cur)) return;
    f32x4 acc[2][2][4][2];
#pragma unroll
    for (int a = 0; a < 2; ++a)
#pragma unroll
        for (int b = 0; b < 2; ++b)
#pragma unroll
            for (int m = 0; m < 4; ++m)
#pragma unroll
                for (int n = 0; n < 2; ++n) acc[a][b][m][n] = (f32x4){0.f, 0.f, 0.f, 0.f};
    bf16x8 At[4][2], B0[2][2], B1[2][2];
    const char* cA = (const char*)g.A + (size_t)cur.pm * tstep; const char* cB = (const char*)g.Bt + (size_t)cur.pn * tstep;
    S.a_ready(cur);
    if constexpr (SP2) {
        PG8_STAGE(PG8_SB(0, 0), cB, voffB); PG8_STAGE(PG8_SB(0, 1), cB + hstep, voffB); PG8_STAGE(PG8_SA(0, 0), cA, voffA); PG8_STAGE(PG8_SA(0, 1), cA + hstep, voffA);
        if (wr == 1) PG8_BAR;
        PG8_WAIT_V(2); PG8_BAR;
        PG8_STAGE(PG8_SB(1, 0), cB + kstep, voffB); PG8_STAGE(PG8_SA(1, 0), cA + kstep, voffA); PG8_STAGE(PG8_SB(1, 1), cB + hstep + kstep, voffB);
        PG8_WAIT_V(6); PG8_BAR;
    } else {
        PG8_STAGE(PG8_SB(0, 0), cB, voffB); PG8_STAGE(PG8_SA(0, 0), cA, voffA); PG8_STAGE(PG8_SB(0, 1), cB + hstep, voffB); PG8_STAGE(PG8_SA(0, 1), cA + hstep, voffA);
        if (wr == 1) PG8_BAR;
        PG8_WAIT_V(4); PG8_BAR;
        PG8_STAGE(PG8_SB(1, 0), cB + kstep, voffB); PG8_STAGE(PG8_SA(1, 0), cA + kstep, voffA); PG8_STAGE(PG8_SB(1, 1), cB + hstep + kstep, voffB);
        PG8_WAIT_V(6); PG8_BAR;
    }
    for (;;) {
        const bool has_next = S.next(ui + 1, nxt);
        const char* nA = has_next ? (const char*)g.A + (size_t)nxt.pm * tstep : cA; const char* nB = has_next ? (const char*)g.Bt + (size_t)nxt.pn * tstep : cB;
        for (int t = 0; t < nt; t += 2) {
            const bool last = (t == nt - 2);
            const char* a1 = cA + (size_t)(t + 1) * kstep;
            const char* a2 = last ? nA : cA + (size_t)(t + 2) * kstep; const char* b2 = last ? nB : cB + (size_t)(t + 2) * kstep;
            const char* a3 = a2 + kstep; const char* b3 = b2 + kstep;
            if (last && has_next) S.a_ready(nxt);
            if constexpr (SP2) {
            PG8_LDB(B0, 0, 0); PG8_LDB(B1, 0, 1); PG8_SCHED; PG8_LDA(At, 0, 0); PG8_STAGE(PG8_SA(1, 1), a1 + hstep, voffA);
            PG8_WAIT_V(8); PG8_WAIT_L(0); PG8_BAR; PG8_MMA(0, 0, At, B0); PG8_MMA(0, 1, At, B1); PG8_BAR; PG8_SCHED;
            PG8_LDA(At, 0, 1); PG8_STAGE(PG8_SB(0, 0), b2, voffB); PG8_STAGE(PG8_SB(0, 1), b2 + hstep, voffB); PG8_STAGE(PG8_SA(0, 0), a2, voffA);
            PG8_WAIT_V(8); PG8_WAIT_L(0); PG8_BAR; PG8_MMA(1, 0, At, B0); PG8_MMA(1, 1, At, B1); PG8_BAR; PG8_SCHED;
            PG8_LDB(B0, 1, 0); PG8_LDB(B1, 1, 1); PG8_SCHED; PG8_LDA(At, 1, 0); PG8_STAGE(PG8_SA(0, 1), a2 + hstep, voffA);
            PG8_WAIT_V(8); PG8_WAIT_L(0); PG8_BAR; PG8_MMA(0, 0, At, B0); PG8_MMA(0, 1, At, B1); PG8_BAR; PG8_SCHED;
            PG8_LDA(At, 1, 1); PG8_STAGE(PG8_SB(1, 0), b3, voffB); PG8_STAGE(PG8_SB(1, 1), b3 + hstep, voffB); PG8_STAGE(PG8_SA(1, 0), a3, voffA);
            PG8_WAIT_V(8); PG8_WAIT_L(0); PG8_BAR; PG8_MMA(1, 0, At, B0); PG8_MMA(1, 1, At, B1); PG8_BAR; PG8_SCHED;
            } else {
            PG8_LDB(B0, 0, 0); PG8_SCHED; PG8_LDA(At, 0, 0); PG8_STAGE(PG8_SA(1, 1), a1 + hstep, voffA);
            PG8_WAIT_L(8); PG8_BAR; PG8_WAIT_L(0); PG8_MMA(0, 0, At, B0); PG8_BAR; PG8_SCHED;
            PG8_LDB(B1, 0, 1); PG8_STAGE(PG8_SB(0, 0), b2, voffB);
            PG8_BAR; PG8_WAIT_L(0); PG8_MMA(0, 1, At, B1); PG8_BAR;
            PG8_LDA(At, 0, 1); PG8_STAGE(PG8_SA(0, 0), a2, voffA);
            PG8_BAR; PG8_WAIT_L(0); PG8_MMA(1, 0, At, B0); PG8_BAR; PG8_SCHED;
            PG8_STAGE(PG8_SB(0, 1), b2 + hstep, voffB);
            PG8_WAIT_V(6); PG8_BAR; PG8_MMA(1, 1, At, B1); PG8_BAR;
            PG8_LDB(B0, 1, 0); PG8_SCHED; PG8_LDA(At, 1, 0); PG8_STAGE(PG8_SA(0, 1), a2 + hstep, voffA);
            PG8_WAIT_L(8); PG8_BAR; PG8_WAIT_L(0); PG8_MMA(0, 0, At, B0); PG8_BAR; PG8_SCHED;
            PG8_LDB(B1, 1, 1); PG8_STAGE(PG8_SB(1, 0), b3, voffB);
            PG8_BAR; PG8_WAIT_L(0); PG8_MMA(0, 1, At, B1); PG8_BAR;
            PG8_LDA(At, 1, 1); PG8_STAGE(PG8_SA(1, 0), a3, voffA);
            PG8_BAR; PG8_WAIT_L(0); PG8_MMA(1, 0, At, B0); PG8_BAR; PG8_SCHED;
            PG8_STAGE(PG8_SB(1, 1), b3 + hstep, voffB);
            PG8_WAIT_V(6); PG8_BAR; PG8_MMA(1, 1, At, B1); PG8_BAR;
            }
        }
        if constexpr (ALIGN_EPI) { if (wr == 0) PG8_BAR; }
        if constexpr (!Epi::AFTER_DRAIN) { E(acc, cur, wr, wc, fr, fq); S.done(cur); }
        if (!has_next) break;
#pragma unroll
        for (int a = 0; a < 2; ++a)
#pragma unroll
            for (int b = 0; b < 2; ++b)
#pragma unroll
                for (int m = 0; m < 4; ++m)
#pragma unroll
                    for (int n = 0; n < 2; ++n) acc[a][b][m][n] = (f32x4){0.f, 0.f, 0.f, 0.f};
        cur = nxt; cA = nA; cB = nB; ++ui;
        if constexpr (ALIGN_EPI) { if (wr == 1) PG8_BAR; }
    }
    PG8_WAIT_V(0);
    if constexpr (!ALIGN_EPI) { if (wr == 0) PG8_BAR; }
    PG8_BAR;
    if constexpr (Epi::AFTER_DRAIN) { E.fused(acc, cur, wr, wc, fr, fq, lds, wid, lane); S.done(cur); }
#undef PG8_SA
#undef PG8_SB
#undef PG8_STAGE
#undef PG8_LDA
#undef PG8_LDB
#undef PG8_MMA
#undef PG8_WAIT_V
#undef PG8_WAIT_L
#undef PG8_BAR
#undef PG8_SCHED
}
}

constexpr int T_TOK = 32768, DM = 1024, SEQ = 2048, NB = 16, DFF = 2816, THALF = 16384;
constexpr int NWAVES = 8;
constexpr int LDS_BYTES = 147456;
constexpr size_t MiB = 1u << 20;
constexpr size_t WS_SS = 0;
constexpr size_t WS_MST = 1 * MiB;
constexpr size_t WS_NST = 1 * MiB + 65536;
constexpr size_t WS_WQKV = 4 * MiB;
constexpr size_t WS_WAO = 22 * MiB;
constexpr size_t WS_WFFIN = 24 * MiB;
constexpr size_t WS_WFFOUT = 46 * MiB;
constexpr size_t WS_WMIN = 57 * MiB;
constexpr size_t WS_WMOUT = 64 * MiB;
constexpr size_t WS_ROPE = 66 * MiB;
constexpr size_t WS_LSE = 70 * MiB;
constexpr size_t WS_GATES = 73 * MiB;
constexpr size_t WS_HB = 76 * MiB;
constexpr size_t WS_MX = 140 * MiB;
constexpr size_t WS_BIG = 204 * MiB;
constexpr size_t WS_H = WS_BIG;
constexpr size_t WS_ACT = WS_BIG + 128 * MiB;
constexpr size_t WS_END = 512 * MiB;
static_assert(WS_ACT + (size_t)T_TOK * DFF * 2 <= WS_END && WS_BIG + (size_t)THALF * 9216 * 2 <= WS_END, "d_ws map");

#define LAS __attribute__((address_space(3)))
typedef unsigned short bf16;
typedef unsigned u32x4 __attribute__((ext_vector_type(4)));
typedef unsigned u32x2 __attribute__((ext_vector_type(2)));
typedef float f32x4 __attribute__((ext_vector_type(4)));
typedef float f32x16 __attribute__((ext_vector_type(16)));
typedef short bf16x8 __attribute__((ext_vector_type(8)));
typedef short s16x4 __attribute__((ext_vector_type(4)));
typedef float f32x2_t __attribute__((ext_vector_type(2)));
typedef __bf16 bf16x2_t __attribute__((ext_vector_type(2)));
__device__ __forceinline__ unsigned pk2(float lo, float hi) { f32x2_t v = {lo, hi}; bf16x2_t b = __builtin_convertvector(v, bf16x2_t); return __builtin_bit_cast(unsigned, b); }
__device__ __forceinline__ float bf_lo(unsigned w) { return __uint_as_float(w << 16); }
__device__ __forceinline__ float bf_hi(unsigned w) { return __uint_as_float(w & 0xffff0000u); }
__device__ __forceinline__ float wave_sum(float v) {
#pragma unroll
    for (int o = 1; o < 64; o <<= 1) v += __shfl_xor(v, o);
    return v;
}
__device__ __forceinline__ float wave_max(float v) {
#pragma unroll
    for (int o = 1; o < 64; o <<= 1) v = fmaxf(v, __shfl_xor(v, o));
    return v;
}
#define MFMA16(a, b, c) __builtin_amdgcn_mfma_f32_16x16x32_bf16((a), (b), (c), 0, 0, 0)
#define MFMA32(a, b, c) __builtin_amdgcn_mfma_f32_32x32x16_bf16((a), (b), (c), 0, 0, 0)

struct Args {
    const float* x; const int* pos; const float* attn_norm; const float* attn_w_in; const float* attn_w_out; const float* mlstm_norm; const float* mlstm_w_in;
    const float* conv_w; const float* conv_b; const float* ig_bias; const float* fg_bias; const float* head_gain; const float* mlstm_w_out;
    const float* ffn_norm; const float* ffn_w_in; const float* ffn_w_out; const float* final_norm;
    float* out; unsigned char* ws; int ph_lo, ph_hi;
};

__device__ __forceinline__ void tr_item(const float* __restrict__ W, int K, int Nsrc, bf16* WT, int n0_dst, int n0_src, int k0, const float* __restrict__ gain, float scale, LAS float* scr, int lane) {
    const int nn = n0_src + (lane & 31); const bool ok = nn < Nsrc;
#pragma unroll 8
    for (int i = 0; i < 32; ++i) { const int kk = 2 * i + (lane >> 5); float v = ok ? W[(size_t)(k0 + kk) * Nsrc + nn] : 0.f; if (gain) v *= gain[k0 + kk]; scr[kk * 33 + (lane & 31)] = v * scale; }
    asm volatile("s_waitcnt lgkmcnt(0)" ::: "memory");
    const int c = lane & 7;
#pragma unroll
    for (int j = 0; j < 4; ++j) { const int n = (lane >> 3) + 8 * j; const LAS float* s = scr + (8 * c) * 33 + n;
        u32x4 o; o.x = pk2(s[0 * 33], s[1 * 33]); o.y = pk2(s[2 * 33], s[3 * 33]); o.z = pk2(s[4 * 33], s[5 * 33]); o.w = pk2(s[6 * 33], s[7 * 33]);
        *(u32x4*)(WT + (size_t)(n0_dst + n) * K + k0 + 8 * c) = o; }
    asm volatile("s_waitcnt lgkmcnt(0)" ::: "memory");
}
__device__ __forceinline__ void p0_prologue(const Args& A, LAS unsigned char* lds, int G, int bid) {
    const int tid = threadIdx.x, lane = tid & 63, wave = tid >> 6;
    LAS float* scr = (LAS float*)(lds + wave * 16384);
    const int gw = bid * NWAVES + wave, NGW = G * NWAVES;
    unsigned char* ws = A.ws;
    constexpr int I_QKV = 16 * 288, I_AO = 16 * 32, I_FFIN = 16 * 176, I_FFOUT = 44 * 32, I_MIN = 16 * 104, I_MOUT = 16 * 32;
    constexpr int NITEMS = I_QKV + I_AO + 2 * I_FFIN + 2 * I_FFOUT + I_MIN + I_MOUT;
    constexpr float QSCALE = 0.08838834764831845f * 1.4426950408889634f;
    for (int it = gw; it < NITEMS; it += NGW) {
        int r = it;
        if (r < I_QKV) { const int kb = r / 288, nb = r % 288, n0 = 32 * nb; const int tsel = (n0 % 3072) / 1024;
            tr_item(A.attn_w_in, 1024, 9216, (bf16*)(ws + WS_WQKV), n0, n0, 64 * kb, A.attn_norm, tsel == 0 ? QSCALE : 1.f, scr, lane); continue; } r -= I_QKV;
        if (r < I_AO) { const int kb = r / 32, nb = r % 32; tr_item(A.attn_w_out, 1024, 1024, (bf16*)(ws + WS_WAO), 32 * nb, 32 * nb, 64 * kb, nullptr, 1.f, scr, lane); continue; } r -= I_AO;
        if (r < 2 * I_FFIN) { const int l = r / I_FFIN; r -= l * I_FFIN; const int kb = r / 176, nb = r % 176, n0 = 32 * nb;
            const int pn = n0 >> 8, bj = (n0 >> 7) & 1, jj = n0 & 127; const int nsrc = (bj ? DFF : 0) + 128 * pn + jj;
            tr_item(A.ffn_w_in + (size_t)l * 1024 * 5632, 1024, 5632, (bf16*)(ws + WS_WFFIN) + (size_t)l * 5632 * 1024, n0, nsrc, 64 * kb, A.ffn_norm + l * 1024, 1.f, scr, lane); continue; } r -= 2 * I_FFIN;
        if (r < 2 * I_FFOUT) { const int l = r / I_FFOUT; r -= l * I_FFOUT; const int kb = r / 32, nb = r % 32;
            tr_item(A.ffn_w_out + (size_t)l * DFF * 1024, DFF, 1024, (bf16*)(ws + WS_WFFOUT) + (size_t)l * 1024 * DFF, 32 * nb, 32 * nb, 64 * kb, nullptr, 1.f, scr, lane); continue; } r -= 2 * I_FFOUT;
        if (r < I_MIN) { const int kb = r / 104, nb = r % 104; tr_item(A.mlstm_w_in, 1024, 3088, (bf16*)(ws + WS_WMIN), 32 * nb, 32 * nb, 64 * kb, A.mlstm_norm, 1.f, scr, lane); continue; } r -= I_MIN;
        { const int kb = r / 32, nb = r % 32; tr_item(A.mlstm_w_out, 1024, 1024, (bf16*)(ws + WS_WMOUT), 32 * nb, 32 * nb, 64 * kb, nullptr, 1.f, scr, lane); }
    }
    float* ss = (float*)(ws + WS_SS); bf16* hb = (bf16*)(ws + WS_HB);
    for (int m = gw; m < T_TOK; m += NGW) {
        const f32x4* xr = (const f32x4*)(A.x + (size_t)m * DM) + lane; f32x4 v[4]; float s = 0.f;
#pragma unroll
        for (int j = 0; j < 4; ++j) { v[j] = xr[64 * j]; s += (v[j].x * v[j].x + v[j].y * v[j].y) + (v[j].z * v[j].z + v[j].w * v[j].w); }
        s = wave_sum(s);
        u32x2* o8 = (u32x2*)(hb + (size_t)m * DM) + lane;
#pragma unroll
        for (int j = 0; j < 4; ++j) { u32x2 o; o.x = pk2(v[j].x, v[j].y); o.y = pk2(v[j].z, v[j].w); o8[64 * j] = o; }
        if (lane == 0) ss[m] = s;
    }
    const int gt = bid * 512 + tid, NGT = G * 512;
    for (int i = gt; i < 4 * T_TOK; i += NGT) ss[T_TOK + i] = 0.f;
    float* rope = (float*)(ws + WS_ROPE);
    for (int i = gt; i < T_TOK * 16; i += NGT) {
        const int t = i >> 4, f = i & 15;
        const float invf = (float)exp2(-(double)f * (18.931568569324174 / 16.0));
        const float ang = (float)A.pos[t] * invf;
        const double rev = (double)ang * 0.15915494309189535; const float fr = (float)(rev - rint(rev));
        rope[(size_t)t * 32 + f] = __builtin_amdgcn_cosf(fr); rope[(size_t)t * 32 + 16 + f] = __builtin_amdgcn_sinf(fr);
    }
}

__device__ __forceinline__ void attn_phase(LAS unsigned char* lds, const bf16* __restrict__ QKVh, bf16* __restrict__ Oh, float* __restrict__ lse, int half, int G, int bid) {
    const int tid = threadIdx.x, lane = tid & 63, w = __builtin_amdgcn_readfirstlane(tid >> 6), r = lane & 15, q4 = lane >> 4;
    LAS unsigned char* Ks = lds; LAS unsigned char* Vt = lds + 69632;
    for (int item = bid; item < 3072; item += G) {
        int idx = item; const int sub = idx & 15; idx >>= 4; const int h = idx & 7; idx >>= 3; const int b = idx & 7; const int g = idx >> 3;
        int dil, rr, blk;
        if (g == 0) { dil = 1; rr = 0; blk = sub; } else if (g == 1) { dil = 4; rr = sub >> 2; blk = sub & 3; } else { dil = 16; rr = sub; blk = 0; }
        const bool first = (blk == 0);
        const size_t rowstride = (size_t)dil * 9216;
        const bf16* base = QKVh + (size_t)(b * SEQ + rr) * 9216 + g * 3072 + h * 128;
        const int m0 = 128 * (blk - 1);
#pragma unroll
        for (int i = 0; i < 8; ++i) { const int chunk = tid + 512 * i, c = chunk >> 4, ch = chunk & 15;
            u32x4 v = {0u, 0u, 0u, 0u}; if (!(first && c < 128)) v = *(const u32x4*)(base + 1024 + (size_t)(m0 + c) * rowstride + 8 * ch);
            *(LAS u32x4*)(Ks + c * 272 + ch * 16) = v; }
#pragma unroll
        for (int i = 0; i < 4; ++i) { const int pc = tid + 512 * i, cp = pc & 127, ch = pc >> 7, c = 2 * cp;
            u32x4 v0 = {0u, 0u, 0u, 0u}, v1 = v0;
            if (!(first && c < 128)) { v0 = *(const u32x4*)(base + 2048 + (size_t)(m0 + c) * rowstride + 8 * ch); v1 = *(const u32x4*)(base + 2048 + (size_t)(m0 + c + 1) * rowstride + 8 * ch); }
#pragma unroll
            for (int e = 0; e < 4; ++e) {
                *(LAS unsigned*)(Vt + (8 * ch + 2 * e) * 528 + 4 * cp) = (v0[e] & 0xffffu) | (v1[e] << 16);
                *(LAS unsigned*)(Vt + (8 * ch + 2 * e + 1) * 528 + 4 * cp) = (v0[e] >> 16) | (v1[e] & 0xffff0000u); } }
        const int a0 = 16 * w, a = a0 + r;
        const bf16* qrow = base + (size_t)(128 * blk + a) * rowstride;
        bf16x8 qf[4];
#pragma unroll
        for (int st = 0; st < 4; ++st) qf[st] = *(const bf16x8*)(qrow + 32 * st + 8 * q4);
        __syncthreads();
        const int jlo = first ? 8 : 0;
        f32x4 S[9]; float mx = -INFINITY;
#pragma unroll
        for (int jj = 0; jj < 9; ++jj) { const int j = w + jj; S[jj] = (f32x4){0.f, 0.f, 0.f, 0.f};
            if (j >= jlo) {
#pragma unroll
                for (int st = 0; st < 4; ++st) { const bf16x8 kf = *(const LAS bf16x8*)(Ks + (16 * j + r) * 272 + (32 * st + 8 * q4) * 2); S[jj] = MFMA16(kf, qf[st], S[jj]); } }
#pragma unroll
            for (int i = 0; i < 4; ++i) { const int c = 16 * j + 4 * q4 + i; const bool valid = (c >= a) && (c <= a + 128) && (c >= 128 || !first);
                S[jj][i] = valid ? S[jj][i] : -INFINITY; mx = fmaxf(mx, S[jj][i]); } }
        mx = fmaxf(mx, __shfl_xor(mx, 16)); mx = fmaxf(mx, __shfl_xor(mx, 32));
        float den = 0.f;
#pragma unroll
        for (int jj = 0; jj < 9; ++jj)
#pragma unroll
            for (int i = 0; i < 4; ++i) { const float p = __builtin_amdgcn_exp2f(S[jj][i] - mx); S[jj][i] = p; den += p; }
        den += __shfl_xor(den, 16); den += __shfl_xor(den, 32);
        bf16x8 pf[5];
#pragma unroll
        for (int p = 0; p < 5; ++p) { u32x4 wv; wv.x = pk2(S[2 * p][0], S[2 * p][1]); wv.y = pk2(S[2 * p][2], S[2 * p][3]);
            if (2 * p + 1 < 9) { wv.z = pk2(S[(2 * p + 1) % 9][0], S[(2 * p + 1) % 9][1]); wv.w = pk2(S[(2 * p + 1) % 9][2], S[(2 * p + 1) % 9][3]); } else { wv.z = 0u; wv.w = 0u; }
            pf[p] = __builtin_bit_cast(bf16x8, wv); }
        f32x4 o[8];
#pragma unroll
        for (int db = 0; db < 8; ++db) o[db] = (f32x4){0.f, 0.f, 0.f, 0.f};
#pragma unroll
        for (int p = 0; p < 5; ++p) { const int j0 = w + 2 * p, j1 = (j0 + 1 > 15) ? 15 : j0 + 1;
            if (j0 + 1 >= jlo) {
#pragma unroll
                for (int db = 0; db < 8; ++db) {
                    const s16x4 lo = *(const LAS s16x4*)(Vt + (16 * db + r) * 528 + (16 * j0 + 4 * q4) * 2);
                    const s16x4 hi = *(const LAS s16x4*)(Vt + (16 * db + r) * 528 + (16 * j1 + 4 * q4) * 2);
                    const bf16x8 af = __builtin_shufflevector(lo, hi, 0, 1, 2, 3, 4, 5, 6, 7);
                    o[db] = MFMA16(af, pf[p], o[db]); } } }
        const float inv = 1.0f / den;
        const int tl = b * SEQ + (128 * blk + a) * dil + rr;
        bf16* orow = Oh + ((size_t)g * THALF + tl) * 1024 + h * 128 + 4 * q4;
#pragma unroll
        for (int db = 0; db < 8; ++db) { u32x2 wv; wv.x = pk2(o[db][0] * inv, o[db][1] * inv); wv.y = pk2(o[db][2] * inv, o[db][3] * inv); *(u32x2*)(orow + 16 * db) = wv; }
        if (q4 == 0) lse[((size_t)g * T_TOK + (size_t)half * THALF + tl) * 8 + h] = mx * 0.6931471805599453f + __logf(den);
        __syncthreads();
    }
}
__device__ __forceinline__ void merge_phase(const bf16* __restrict__ Oh, const float* __restrict__ lse, bf16* __restrict__ MX, int half, int G, int bid) {
    const int gt = bid * 512 + threadIdx.x, NGT = G * 512;
    for (int i = gt; i < THALF * 128; i += NGT) {
        const int tl = i >> 7, ch = i & 127, h = ch >> 4; const size_t tg = (size_t)half * THALF + tl;
        const float l0 = lse[((size_t)0 * T_TOK + tg) * 8 + h], l1 = lse[((size_t)1 * T_TOK + tg) * 8 + h], l2 = lse[((size_t)2 * T_TOK + tg) * 8 + h];
        const float mxl = fmaxf(l0, fmaxf(l1, l2)); float w0 = __expf(l0 - mxl), w1 = __expf(l1 - mxl), w2 = __expf(l2 - mxl); const float inv = 1.0f / (w0 + w1 + w2); w0 *= inv; w1 *= inv; w2 *= inv;
        const u32x4 a = *(const u32x4*)(Oh + ((size_t)0 * THALF + tl) * 1024 + 8 * ch), b = *(const u32x4*)(Oh + ((size_t)1 * THALF + tl) * 1024 + 8 * ch), c = *(const u32x4*)(Oh + ((size_t)2 * THALF + tl) * 1024 + 8 * ch);
        u32x4 o;
#pragma unroll
        for (int e = 0; e < 4; ++e) o[e] = pk2(w0 * bf_lo(a[e]) + w1 * bf_lo(b[e]) + w2 * bf_lo(c[e]), w0 * bf_hi(a[e]) + w1 * bf_hi(b[e]) + w2 * bf_hi(c[e]));
        *(u32x4*)(MX + tg * 1024 + 8 * ch) = o;
    }
}
__device__ __forceinline__ float logsigmoid_f(float x) { return fminf(x, 0.f) - __logf(1.0f + __expf(-fabsf(x))); }
__device__ __forceinline__ void mlstm_scan_phase(LAS unsigned char* lds, const bf16* __restrict__ P2, const float* __restrict__ gates, const float* __restrict__ convw, const float* __restrict__ convb,
                                                 const float* __restrict__ igb, const float* __restrict__ fgb, bf16* __restrict__ Cst, float* __restrict__ nst, float* __restrict__ mst, int G, int bid) {
    const int tid = threadIdx.x, lane = tid & 63, w = __builtin_amdgcn_readfirstlane(tid >> 6), r = lane & 15, q4 = lane >> 4;
    LAS unsigned char* kT = lds; LAS unsigned char* vT = lds + 9216;
    for (int item = bid; item < 256; item += G) {
        const int dvh = item & 1, h = (item >> 1) & 7, b = item >> 4;
        const int colk = 512 + h * 64 + 8 * w, colv = 1024 + h * 128 + 64 * dvh + 8 * w;
        float cw[4][8], cbv[8];
#pragma unroll
        for (int e = 0; e < 8; ++e) { cbv[e] = convb[colk + e];
#pragma unroll
            for (int j = 0; j < 4; ++j) cw[j][e] = convw[j * 1024 + colk + e]; }
        const float igb_h = igb[h], fgb_h = fgb[h];
        f32x4 acc[2]; acc[0] = (f32x4){0.f, 0.f, 0.f, 0.f}; acc[1] = acc[0];
        float nreg = 0.f, mcar = 0.f;
        u32x4 nk[4], nv; float ngi, ngf;
#define MSCAN_LOAD(c) do { const int sq_ = 64 * (c) + lane; const size_t t_ = (size_t)b * SEQ + sq_; \
            _Pragma("unroll") for (int j = 0; j < 4; ++j) { const int sj_ = sq_ - 3 + j; nk[j] = (u32x4){0u, 0u, 0u, 0u}; if (sj_ >= 0) nk[j] = *(const u32x4*)(P2 + ((size_t)b * SEQ + sj_) * 2048 + colk); } \
            nv = *(const u32x4*)(P2 + t_ * 2048 + colv); ngi = gates[t_ * 16 + h]; ngf = gates[t_ * 16 + 8 + h]; } while (0)
        MSCAN_LOAD(0);
        for (int c = 0; c < 32; ++c) {
            u32x4 ck[4]; ck[0] = nk[0]; ck[1] = nk[1]; ck[2] = nk[2]; ck[3] = nk[3]; const u32x4 cv = nv; const float gi = ngi, gf = ngf;
            if (c + 1 < 32) MSCAN_LOAD(c + 1);
            const float ig = gi + igb_h, lf = logsigmoid_f(gf + fgb_h);
            float bs = lf;
#pragma unroll
            for (int o = 1; o < 64; o <<= 1) { const float v = __shfl_up(bs, o); if (lane >= o) bs += v; }
            const float blast = __shfl(bs, 63);
            const float decay = blast - bs + ig;
            const float mloc = wave_max(decay);
            const float mnew = fmaxf(blast + mcar, mloc);
            const float wsv = __expf(decay - mnew), carry = __expf(blast + mcar - mnew);
            const size_t cid = (size_t)(b * 8 + h) * 32 + c;
#pragma unroll
            for (int nb = 0; nb < 2; ++nb)
#pragma unroll
                for (int i = 0; i < 4; ++i) { const int dv = 64 * dvh + 16 * (w & 3) + 4 * q4 + i, dk = 32 * (w >> 2) + 16 * nb + r;
                    Cst[(cid * 128 + dv) * 64 + dk] = (bf16)(pk2(acc[nb][i], 0.f) & 0xffffu); }
            if (dvh == 0 && tid < 64) nst[cid * 64 + tid] = nreg;
            if (dvh == 0 && tid == 0) mst[cid] = mcar;
#pragma unroll
            for (int e = 0; e < 4; ++e) {
                float x0 = cbv[2 * e], x1 = cbv[2 * e + 1];
#pragma unroll
                for (int j = 0; j < 4; ++j) { x0 += cw[j][2 * e] * bf_lo(ck[j][e]); x1 += cw[j][2 * e + 1] * bf_hi(ck[j][e]); }
                const unsigned pk = pk2(silu_f(x0) * 0.125f * wsv, silu_f(x1) * 0.125f * wsv);
                *(LAS bf16*)(kT + (8 * w + 2 * e) * 144 + 2 * lane) = (bf16)(pk & 0xffffu);
                *(LAS bf16*)(kT + (8 * w + 2 * e + 1) * 144 + 2 * lane) = (bf16)(pk >> 16);
                *(LAS bf16*)(vT + (8 * w + 2 * e) * 144 + 2 * lane) = (bf16)(cv[e] & 0xffffu);
                *(LAS bf16*)(vT + (8 * w + 2 * e + 1) * 144 + 2 * lane) = (bf16)(cv[e] >> 16);
            }
            __syncthreads();
            acc[0] = acc[0] * carry; acc[1] = acc[1] * carry;
#pragma unroll
            for (int st = 0; st < 2; ++st) {
                const bf16x8 af = *(const LAS bf16x8*)(vT + (16 * (w & 3) + r) * 144 + (32 * st + 8 * q4) * 2);
#pragma unroll
                for (int nb = 0; nb < 2; ++nb) { const bf16x8 bfr = *(const LAS bf16x8*)(kT + (32 * (w >> 2) + 16 * nb + r) * 144 + (32 * st + 8 * q4) * 2); acc[nb] = MFMA16(af, bfr, acc[nb]); }
            }
            if (tid < 64) { float s = 0.f;
#pragma unroll
                for (int j = 0; j < 8; ++j) { const u32x4 kk = *(const LAS u32x4*)(kT + tid * 144 + 16 * j);
#pragma unroll
                    for (int e = 0; e < 4; ++e) s += bf_lo(kk[e]) + bf_hi(kk[e]); }
                nreg = carry * nreg + s; }
            mcar = mnew;
            __syncthreads();
        }
#undef MSCAN_LOAD
    }
}
__device__ __forceinline__ void mlstm_out_phase(LAS unsigned char* lds, const bf16* __restrict__ P2, const bf16* __restrict__ OP, const float* __restrict__ gates, const float* __restrict__ convw, const float* __restrict__ convb,
                                                const float* __restrict__ igb, const float* __restrict__ fgb, const float* __restrict__ hgain, const bf16* __restrict__ Cst, const float* __restrict__ nst, const float* __restrict__ mst,
                                                bf16* __restrict__ MX, int G, int bid) {
    const int tid = threadIdx.x, lane = tid & 63, w = __builtin_amdgcn_readfirstlane(tid >> 6), r = lane & 31, h2 = lane >> 5;
    LAS unsigned char* Qs = lds; LAS unsigned char* Ks = lds + 9216; LAS unsigned char* vT = lds + 18432;
    LAS float* va = (LAS float*)(lds + 36864); LAS float* vb = va + 64; LAS float* vM = va + 128; LAS float* vn = va + 192; LAS float* part = va + 256;
    const int dvb = w & 3, tb = w >> 2;
    for (int item = bid; item < 4096; item += G) {
        const int c = item & 31, h = (item >> 5) & 7, b = item >> 8;
        const int s0 = 64 * c; const size_t t0 = (size_t)b * SEQ + s0;
        const float mc = mst[item];
        {
            const int colq = h * 64 + 8 * w, colk = 512 + colq;
            u32x4 rq[4], rk[4];
#pragma unroll
            for (int j = 0; j < 4; ++j) { const int sj = s0 + lane - 3 + j; rq[j] = (u32x4){0u, 0u, 0u, 0u}; rk[j] = rq[j];
                if (sj >= 0) { const bf16* p = P2 + ((size_t)b * SEQ + sj) * 2048; rq[j] = *(const u32x4*)(p + colq); rk[j] = *(const u32x4*)(p + colk); } }
            u32x4 oq, ok;
#pragma unroll
            for (int e = 0; e < 4; ++e) {
                float q0 = convb[colq + 2 * e], q1 = convb[colq + 2 * e + 1], k0 = convb[colk + 2 * e], k1 = convb[colk + 2 * e + 1];
#pragma unroll
                for (int j = 0; j < 4; ++j) { q0 += convw[j * 1024 + colq + 2 * e] * bf_lo(rq[j][e]); q1 += convw[j * 1024 + colq + 2 * e + 1] * bf_hi(rq[j][e]);
                    k0 += convw[j * 1024 + colk + 2 * e] * bf_lo(rk[j][e]); k1 += convw[j * 1024 + colk + 2 * e + 1] * bf_hi(rk[j][e]); }
                oq[e] = pk2(silu_f(q0), silu_f(q1)); ok[e] = pk2(silu_f(k0) * 0.125f, silu_f(k1) * 0.125f);
            }
            *(LAS u32x4*)(Qs + lane * 144 + 16 * w) = oq; *(LAS u32x4*)(Ks + lane * 144 + 16 * w) = ok;
            const bf16* pv = P2 + (t0 + lane) * 2048 + 1024 + h * 128;
#pragma unroll
            for (int hh = 0; hh < 2; ++hh) { const u32x4 v = *(const u32x4*)(pv + 64 * hh + 8 * w);
#pragma unroll
                for (int e = 0; e < 4; ++e) { *(LAS bf16*)(vT + (64 * hh + 8 * w + 2 * e) * 144 + 2 * lane) = (bf16)(v[e] & 0xffffu); *(LAS bf16*)(vT + (64 * hh + 8 * w + 2 * e + 1) * 144 + 2 * lane) = (bf16)(v[e] >> 16); } }
        }
        if (w == 0) {
            const float ig = gates[(t0 + lane) * 16 + h] + igb[h], lf = logsigmoid_f(gates[(t0 + lane) * 16 + 8 + h] + fgb[h]);
            float bs = lf;
#pragma unroll
            for (int o = 1; o < 64; o <<= 1) { const float v = __shfl_up(bs, o); if (lane >= o) bs += v; }
            const float av = ig - bs; float pm = av;
#pragma unroll
            for (int o = 1; o < 64; o <<= 1) { const float v = __shfl_up(pm, o); if (lane >= o) pm = fmaxf(pm, v); }
            va[lane] = av; vb[lane] = bs; vM[lane] = fmaxf(mc, pm); vn[lane] = nst[(size_t)item * 64 + lane];
        }
        __syncthreads();
        const int t = 32 * tb + r;
        const float Mt = vM[t], bt = vb[t];
        bf16x8 qf[4];
#pragma unroll
        for (int st = 0; st < 4; ++st) qf[st] = *(const LAS bf16x8*)(Qs + t * 144 + (16 * st + 8 * h2) * 2);
        float qn = 0.f;
#pragma unroll
        for (int j = 0; j < 4; ++j) { const u32x4 qq = *(const LAS u32x4*)(Qs + t * 144 + (32 * h2 + 8 * j) * 2);
#pragma unroll
            for (int e = 0; e < 4; ++e) qn += bf_lo(qq[e]) * vn[32 * h2 + 8 * j + 2 * e] + bf_hi(qq[e]) * vn[32 * h2 + 8 * j + 2 * e + 1]; }
        qn += __shfl_xor(qn, 32);
        f32x16 acc1, acc2;
#pragma unroll
        for (int i = 0; i < 16; ++i) { acc1[i] = 0.f; acc2[i] = 0.f; }
        float dsum = 0.f;
#pragma unroll
        for (int sb = 0; sb < 2; ++sb) {
            if (sb <= tb) {
                f32x16 S;
#pragma unroll
                for (int i = 0; i < 16; ++i) S[i] = 0.f;
#pragma unroll
                for (int st = 0; st < 4; ++st) { const bf16x8 kf = *(const LAS bf16x8*)(Ks + (32 * sb + r) * 144 + (16 * st + 8 * h2) * 2); S = MFMA32(kf, qf[st], S); }
#pragma unroll
                for (int i = 0; i < 16; ++i) { const int s = 32 * sb + (i & 3) + 8 * (i >> 2) + 4 * h2; const float wgt = (s <= t) ? __expf(va[s] - Mt) : 0.f; S[i] = wgt * S[i]; dsum += S[i]; }
#pragma unroll
                for (int sp = 0; sp < 2; ++sp) {
                    u32x4 wv; wv.x = pk2(S[8 * sp + 0], S[8 * sp + 1]); wv.y = pk2(S[8 * sp + 2], S[8 * sp + 3]); wv.z = pk2(S[8 * sp + 4], S[8 * sp + 5]); wv.w = pk2(S[8 * sp + 6], S[8 * sp + 7]);
                    const bf16x8 pfr = __builtin_bit_cast(bf16x8, wv);
                    const s16x4 lo = *(const LAS s16x4*)(vT + (32 * dvb + r) * 144 + (32 * sb + 16 * sp + 4 * h2) * 2);
                    const s16x4 hi = *(const LAS s16x4*)(vT + (32 * dvb + r) * 144 + (32 * sb + 16 * sp + 8 + 4 * h2) * 2);
                    const bf16x8 af = __builtin_shufflevector(lo, hi, 0, 1, 2, 3, 4, 5, 6, 7);
                    acc1 = MFMA32(af, pfr, acc1);
                }
            }
        }
        dsum += __shfl_xor(dsum, 32);
        const bf16* crow_p = Cst + ((size_t)item * 128 + 32 * dvb + r) * 64 + 8 * h2;
#pragma unroll
        for (int st = 0; st < 4; ++st) { const bf16x8 cf = *(const bf16x8*)(crow_p + 16 * st); acc2 = MFMA32(cf, qf[st], acc2); }
        const float winter = __expf(mc - Mt);
        const float den = dsum + winter * qn;
        const float dnm = fmaxf(fabsf(den), __expf(-(bt + Mt)));
        const float idn = 1.0f / dnm;
        float hsq = 0.f;
#pragma unroll
        for (int i = 0; i < 16; ++i) { acc1[i] = (acc1[i] + winter * acc2[i]) * idn; hsq += acc1[i] * acc1[i]; }
        hsq += __shfl_xor(hsq, 32);
        if (h2 == 0) part[dvb * 64 + t] = hsq;
        __syncthreads();
        const float tot = (part[t] + part[64 + t]) + (part[128 + t] + part[192 + t]);
        const float rsn = 1.0f / sqrtf(tot * (1.0f / 128.0f) + RMS_EPS);
        const size_t orow = (t0 + t) * 1024 + h * 128 + 32 * dvb + 4 * h2;
#pragma unroll
        for (int gq = 0; gq < 4; ++gq) {
            const u32x2 op = *(const u32x2*)(OP + orow + 8 * gq);
            const f32x4 gn = *(const f32x4*)(hgain + h * 128 + 32 * dvb + 4 * h2 + 8 * gq);
            const float y0 = acc1[4 * gq + 0] * rsn * gn[0] * sigmoid_f(bf_lo(op.x)), y1 = acc1[4 * gq + 1] * rsn * gn[1] * sigmoid_f(bf_hi(op.x));
            const float y2 = acc1[4 * gq + 2] * rsn * gn[2] * sigmoid_f(bf_lo(op.y)), y3 = acc1[4 * gq + 3] * rsn * gn[3] * sigmoid_f(bf_hi(op.y));
            u32x2 wv; wv.x = pk2(y0, y1); wv.y = pk2(y2, y3); *(u32x2*)(MX + orow + 8 * gq) = wv;
        }
        __syncthreads();
    }
}
__device__ __forceinline__ void final_phase(float* __restrict__ out, const float* __restrict__ ss, const float* __restrict__ gain, int G, int bid) {
    const int gt = bid * 512 + threadIdx.x, NGT = G * 512;
    for (int i = gt; i < T_TOK * 256; i += NGT) { const int t = i >> 8, c4 = i & 255; const float rs = rs_from_ss(ss[t]);
        f32x4 v = *(f32x4*)(out + (size_t)t * 1024 + 4 * c4); const f32x4 gn = *(const f32x4*)(gain + 4 * c4); v = v * rs * gn; *(f32x4*)(out + (size_t)t * 1024 + 4 * c4) = v; }
}

__global__ void __launch_bounds__(NWAVES * 64, 2) mega_fwd(Args A) {
    extern __shared__ __attribute__((aligned(16))) unsigned char lds_raw[];
    LAS unsigned char* lds = (LAS unsigned char*)lds_raw;
    cg::grid_group grid = cg::this_grid();
    const int G = gridDim.x, bid = blockIdx.x;
    unsigned char* ws = A.ws;
    float* ss = (float*)(ws + WS_SS);
    bf16* hb = (bf16*)(ws + WS_HB); bf16* MX = (bf16*)(ws + WS_MX);
    bf16* QKVh = (bf16*)(ws + WS_BIG); float* H = (float*)(ws + WS_H); bf16* ACT = (bf16*)(ws + WS_ACT); bf16* P2 = (bf16*)(ws + WS_ACT);
    bf16* Oh = (bf16*)A.out; bf16* Cst = (bf16*)A.out; bf16* OP = (bf16*)A.out + (size_t)32 * 1024 * 1024;
    float* lse = (float*)(ws + WS_LSE); float* gates = (float*)(ws + WS_GATES); float* rope = (float*)(ws + WS_ROPE);
    float* mst = (float*)(ws + WS_MST); float* nst = (float*)(ws + WS_NST);
    const int lo = A.ph_lo, hi = A.ph_hi;
#define IN(k) (lo <= (k) && (k) < hi)
#define SYNC(k) do { if (IN(k) && IN((k) + 1)) { __threadfence(); grid.sync(); __threadfence(); } } while (0)
    if (IN(0)) p0_prologue(A, lds, G, bid);
    SYNC(0);
    if (IN(1)) { pg8::Gemm g{hb, (const bf16*)(ws + WS_WQKV), THALF, 9216, 1024}; pg8::StaticOrder S; S.init(THALF, 9216, G, bid);
        pg8::EpiQKV E{QKVh, ss, rope}; pg8::gemm_phase<pg8::EpiQKV, pg8::StaticOrder, true, true>(lds, g, S, E); }
    SYNC(1);
    if (IN(2)) attn_phase(lds, QKVh, Oh, lse, 0, G, bid);
    SYNC(2);
    if (IN(3)) { merge_phase(Oh, lse, MX, 0, G, bid);
        pg8::Gemm g{hb + (size_t)THALF * 1024, (const bf16*)(ws + WS_WQKV), THALF, 9216, 1024}; pg8::StaticOrder S; S.init(THALF, 9216, G, bid);
        pg8::EpiQKV E{QKVh, ss + THALF, rope + (size_t)THALF * 32}; pg8::gemm_phase<pg8::EpiQKV, pg8::StaticOrder, true, true>(lds, g, S, E); }
    SYNC(3);
    if (IN(4)) attn_phase(lds, QKVh, Oh, lse, 1, G, bid);
    SYNC(4);
    if (IN(5)) merge_phase(Oh, lse, MX, 1, G, bid);
    SYNC(5);
    if (IN(6)) { pg8::Gemm g{MX, (const bf16*)(ws + WS_WAO), T_TOK, 1024, 1024}; pg8::StaticOrder S; S.init(T_TOK, 1024, G, bid);
        pg8::EpiResid E{A.x, H, hb, ss + T_TOK}; pg8::gemm_phase<pg8::EpiResid, pg8::StaticOrder, true, true>(lds, g, S, E); }
    SYNC(6);
    if (IN(7)) { pg8::Gemm g{hb, (const bf16*)(ws + WS_WFFIN), T_TOK, 5632, 1024}; pg8::StaticOrder S; S.init(T_TOK, 5632, G, bid);
        pg8::EpiSwiGLU E{ACT, ss + T_TOK}; pg8::gemm_phase<pg8::EpiSwiGLU, pg8::StaticOrder, true, true>(lds, g, S, E); }
    SYNC(7);
    if (IN(8)) { pg8::Gemm g{ACT, (const bf16*)(ws + WS_WFFOUT), T_TOK, 1024, DFF}; pg8::StaticOrder S; S.init(T_TOK, 1024, G, bid);
        pg8::EpiResid E{H, H, hb, ss + 2 * T_TOK}; pg8::gemm_phase<pg8::EpiResid, pg8::StaticOrder, true, true>(lds, g, S, E); }
    SYNC(8);
    if (IN(9)) { pg8::Gemm g{hb, (const bf16*)(ws + WS_WMIN), T_TOK, 3328, 1024}; pg8::StaticOrder S; S.init(T_TOK, 3328, G, bid);
        pg8::EpiMlstmIn E{P2, OP, gates, ss + 2 * T_TOK}; pg8::gemm_phase<pg8::EpiMlstmIn, pg8::StaticOrder, true, true>(lds, g, S, E); }
    SYNC(9);
    if (IN(10)) mlstm_scan_phase(lds, P2, gates, A.conv_w, A.conv_b, A.ig_bias, A.fg_bias, Cst, nst, mst, G, bid);
    SYNC(10);
    if (IN(11)) mlstm_out_phase(lds, P2, OP, gates, A.conv_w, A.conv_b, A.ig_bias, A.fg_bias, A.head_gain, Cst, nst, mst, MX, G, bid);
    SYNC(11);
    if (IN(12)) { pg8::Gemm g{MX, (const bf16*)(ws + WS_WMOUT), T_TOK, 1024, 1024}; pg8::StaticOrder S; S.init(T_TOK, 1024, G, bid);
        pg8::EpiResid E{H, H, hb, ss + 3 * T_TOK}; pg8::gemm_phase<pg8::EpiResid, pg8::StaticOrder, true, true>(lds, g, S, E); }
    SYNC(12);
    if (IN(13)) { pg8::Gemm g{hb, (const bf16*)(ws + WS_WFFIN) + (size_t)5632 * 1024, T_TOK, 5632, 1024}; pg8::StaticOrder S; S.init(T_TOK, 5632, G, bid);
        pg8::EpiSwiGLU E{ACT, ss + 3 * T_TOK}; pg8::gemm_phase<pg8::EpiSwiGLU, pg8::StaticOrder, true, true>(lds, g, S, E); }
    SYNC(13);
    if (IN(14)) { pg8::Gemm g{ACT, (const bf16*)(ws + WS_WFFOUT) + (size_t)1024 * DFF, T_TOK, 1024, DFF}; pg8::StaticOrder S; S.init(T_TOK, 1024, G, bid);
        pg8::EpiResid E{H, A.out, nullptr, ss + 4 * T_TOK}; pg8::gemm_phase<pg8::EpiResid, pg8::StaticOrder, true, true>(lds, g, S, E); }
    SYNC(14);
    if (IN(15)) final_phase(A.out, ss + 4 * T_TOK, A.final_norm, G, bid);
#undef IN
#undef SYNC
}

extern "C" void kernel_launch(void* const* d_in, const int* in_sizes, int n_in, void* d_out, int out_size, void* d_ws, size_t ws_size, hipStream_t stream) {
    static int grid = 0;
    if (grid == 0) {
        if (n_in != 17 || in_sizes[0] != T_TOK * DM || out_size != T_TOK * DM || ws_size < WS_END) { fprintf(stderr, "kernel_launch: unexpected shapes (n_in %d, in0 %d, out %d, ws %zu); nothing launched\n", n_in, n_in > 0 ? in_sizes[0] : -1, out_size, ws_size); grid = -1; return; }
        int dev = 0, cus = 0, per_cu = 0;
        if (hipGetDevice(&dev) != hipSuccess || hipDeviceGetAttribute(&cus, hipDeviceAttributeMultiprocessorCount, dev) != hipSuccess) { grid = -1; return; }
        if (hipFuncSetAttribute((const void*)mega_fwd, hipFuncAttributeMaxDynamicSharedMemorySize, LDS_BYTES) != hipSuccess) { fprintf(stderr, "kernel_launch: hipFuncSetAttribute failed\n"); grid = -1; return; }
        if (hipOccupancyMaxActiveBlocksPerMultiprocessor(&per_cu, (const void*)mega_fwd, NWAVES * 64, LDS_BYTES) != hipSuccess || per_cu < 1) { fprintf(stderr, "kernel_launch: occupancy query says %d\n", per_cu); per_cu = 1; }
        (void)hipGetLastError();
        grid = cus;
    }
    if (grid < 0) return;
    Args a{};
    a.x = (const float*)d_in[0]; a.pos = (const int*)d_in[1]; a.attn_norm = (const float*)d_in[2]; a.attn_w_in = (const float*)d_in[3]; a.attn_w_out = (const float*)d_in[4];
    a.mlstm_norm = (const float*)d_in[5]; a.mlstm_w_in = (const float*)d_in[6]; a.conv_w = (const float*)d_in[7]; a.conv_b = (const float*)d_in[8]; a.ig_bias = (const float*)d_in[9];
    a.fg_bias = (const float*)d_in[10]; a.head_gain = (const float*)d_in[11]; a.mlstm_w_out = (const float*)d_in[12]; a.ffn_norm = (const float*)d_in[13]; a.ffn_w_in = (const float*)d_in[14];
    a.ffn_w_out = (const float*)d_in[15]; a.final_norm = (const float*)d_in[16];
    a.out = (float*)d_out; a.ws = (unsigned char*)d_ws; a.ph_lo = 0; a.ph_hi = 16;
    void* args[] = {&a};
    const hipError_t e = hipLaunchCooperativeKernel((const void*)mega_fwd, dim3(grid), dim3(NWAVES * 64), args, LDS_BYTES, stream);
    if (e != hipSuccess) fprintf(stderr, "kernel_launch: cooperative launch failed: %s (grid %d)\n", hipGetErrorString(e), grid);
}
```

```cpp
#include <hip/hip_runtime.h>
#include <hip/hip_cooperative_groups.h>
#include <cstdio>
#include <cstdint>
namespace cg = cooperative_groups;

constexpr float RMS_EPS = 1e-6f;
__device__ __forceinline__ float rs_from_ss(float ss) { return 1.0f / sqrtf(ss * (1.0f / 1024.0f) + RMS_EPS); }
__device__ __forceinline__ float silu_f(float x) { return x / (1.0f + __expf(-x)); }
__device__ __forceinline__ float sigmoid_f(float x) { return 1.0f / (1.0f + __expf(-x)); }

namespace pg8 {
#define PG8_LAS __attribute__((address_space(3)))
typedef unsigned short bf16_t;
typedef short bf16x8 __attribute__((ext_vector_type(8)));
typedef float f32x4 __attribute__((ext_vector_type(4)));
typedef unsigned u32x4 __attribute__((ext_vector_type(4)));
constexpr int BM = 256, BK = 64, HALF = 128, HTB = HALF * BK * 2  , STAGE_BYTES = 8 * HTB, NXCD = 8, WGM = 8;

__host__ __device__ __forceinline__ int lds_byte(int r, int c) { const int st = (r >> 4) * 2 + (c >> 5), rr = r & 15, cc = c & 31, ob = rr * 64 + cc * 2; return st * 1024 + (ob ^ (((ob >> 9) & 1) << 5)); }
__host__ __device__ __forceinline__ void stage_rc(int b, int& R, int& C) { const int st = b / 1024, sb = b % 1024, swz = sb ^ (((sb >> 9) & 1) << 5); R = (st >> 1) * 16 + swz / 64; C = (st & 1) * 32 + (swz % 64) / 2; }
__host__ __device__ __forceinline__ int perm32(int rho) { const int n = rho >> 4, i = rho & 15; return 8 * (i >> 2) + 4 * n + (i & 3); }

struct Unit { int pm, pn; };
struct Gemm { const bf16_t* A; const bf16_t* Bt; int M, N, K; };

struct StaticOrder {
    int nM, nN, nwg, G, c;
    __host__ __device__ void init(int M, int N, int G_, int c_) { nM = M / BM; nN = N / BM; nwg = nM * nN; G = G_; c = c_; }
    __host__ __device__ bool next(int i, Unit& u) const {
        const long L = (long)i * G + c; if (L >= nwg) return false;
        int wgid = (int)L; { const int q = nwg / NXCD, r = nwg % NXCD, xcd = wgid % NXCD, off = wgid / NXCD; wgid = (xcd < r ? xcd * (q + 1) : r * (q + 1) + (xcd - r) * q) + off; }
        const int nig = WGM * nN, gid = wgid / nig, fm = gid * WGM, gsz = (nM - fm) < WGM ? (nM - fm) : WGM;
        u.pm = fm + ((wgid % nig) % gsz); u.pn = (wgid % nig) / gsz; return true;
    }
    __device__ __forceinline__ void a_ready(const Unit&) const {}
    __device__ __forceinline__ void done(const Unit&) const {}
};
__device__ __forceinline__ unsigned cvt_pk_bf16(float lo, float hi) { unsigned r; asm volatile("v_cvt_pk_bf16_f32 %0, %1, %2" : "=v"(r) : "v"(lo), "v"(hi)); return r; }

struct EpiQKV {
    static constexpr bool PERM = true, AFTER_DRAIN = false;
    bf16_t* O; const float* ss; const float* cs;
    __device__ __forceinline__ void operator()(const f32x4 (&acc)[2][2][4][2], const Unit& u, int wr, int wc, int fr, int fq) const {
        const int row0 = u.pm * BM + wr * 64 + fr; const int colt = u.pn * BM;
        const int tsel = (colt % 3072) / 1024;
        const bool rope = (tsel < 2) && (wc == 0);
        const int gsel = colt / 3072, lg = 2 * gsel, dil = 1 << lg;
        const int hb0 = (gsel * 3 + tsel) * 8 + (colt % 1024) / 128;
        const float sgn = (fq < 2) ? -1.f : 1.f;
#pragma unroll
        for (int ai = 0; ai < 2; ++ai)
#pragma unroll
            for (int m = 0; m < 4; ++m) {
                const int row = row0 + ai * HALF + m * 16;
                const float rs = rs_from_ss(ss[row]);
                f32x4 c0 = {0.f, 0.f, 0.f, 0.f}, c1 = c0, s0 = c0, s1 = c0;
                if (rope) { const float* p = cs + (size_t)row * 32 + 8 * (fq & 1); c0 = *(const f32x4*)p; c1 = *(const f32x4*)(p + 4); s0 = *(const f32x4*)(p + 16); s1 = *(const f32x4*)(p + 20); }
                const int sq = row & 2047, perm = ((sq & (dil - 1)) << (11 - lg)) + (sq >> lg);
                bf16_t* rowp = O + ((size_t)hb0 * 17408 + (row >> 11) * 2176 + perm) * 128 + wc * 32 + 8 * fq;
#pragma unroll
                for (int bj = 0; bj < 2; ++bj) {
                    f32x4 v0 = acc[ai][bj][m][0], v1 = acc[ai][bj][m][1];
                    if (rope) {
                        f32x4 o0, o1;
#pragma unroll
                        for (int e = 0; e < 4; ++e) { o0[e] = __shfl_xor(v0[e], 32); o1[e] = __shfl_xor(v1[e], 32); }
                        v0 = v0 * c0 + (o0 * s0) * sgn; v1 = v1 * c1 + (o1 * s1) * sgn;
                    }
                    v0 = v0 * rs; v1 = v1 * rs;
                    u32x4 wv; wv.x = cvt_pk_bf16(v0[0], v0[1]); wv.y = cvt_pk_bf16(v0[2], v0[3]); wv.z = cvt_pk_bf16(v1[0], v1[1]); wv.w = cvt_pk_bf16(v1[2], v1[3]);
                    *(u32x4*)(rowp + (size_t)bj * 17408 * 128) = wv;
                }
            }
    }
};
struct EpiResid {
    static constexpr bool PERM = true, AFTER_DRAIN = false;
    const float* base; float* out; bf16_t* outb; float* ssn;
    __device__ __forceinline__ void operator()(const f32x4 (&acc)[2][2][4][2], const Unit& u, int wr, int wc, int fr, int fq) const {
        const int row0 = u.pm * BM + wr * 64 + fr; const int col0 = u.pn * BM + wc * 32 + 8 * fq;
#pragma unroll
        for (int ai = 0; ai < 2; ++ai)
#pragma unroll
            for (int m = 0; m < 4; ++m) {
                const int row = row0 + ai * HALF + m * 16; float sq = 0.f;
#pragma unroll
                for (int bj = 0; bj < 2; ++bj) {
                    const size_t off = (size_t)row * 1024 + col0 + bj * HALF;
                    const f32x4 r0 = *(const f32x4*)(base + off), r1 = *(const f32x4*)(base + off + 4);
                    const f32x4 v0 = acc[ai][bj][m][0] + r0, v1 = acc[ai][bj][m][1] + r1;
                    *(f32x4*)(out + off) = v0; *(f32x4*)(out + off + 4) = v1;
                    if (outb) { u32x4 wv; wv.x = cvt_pk_bf16(v0[0], v0[1]); wv.y = cvt_pk_bf16(v0[2], v0[3]); wv.z = cvt_pk_bf16(v1[0], v1[1]); wv.w = cvt_pk_bf16(v1[2], v1[3]); *(u32x4*)(outb + off) = wv; }
                    sq += (v0[0] * v0[0] + v0[1] * v0[1]) + (v0[2] * v0[2] + v0[3] * v0[3]) + (v1[0] * v1[0] + v1[1] * v1[1]) + (v1[2] * v1[2] + v1[3] * v1[3]);
                }
                sq += __shfl_xor(sq, 16); sq += __shfl_xor(sq, 32);
                if (fq == 0) atomicAdd(ssn + row, sq);
            }
    }
};
struct EpiSwiGLU {
    static constexpr bool PERM = true, AFTER_DRAIN = false;
    bf16_t* O; const float* ss;
    __device__ __forceinline__ void operator()(const f32x4 (&acc)[2][2][4][2], const Unit& u, int wr, int wc, int fr, int fq) const {
        const int row0 = u.pm * BM + wr * 64 + fr; const int col0 = u.pn * HALF + wc * 32 + 8 * fq;
#pragma unroll
        for (int ai = 0; ai < 2; ++ai)
#pragma unroll
            for (int m = 0; m < 4; ++m) {
                const int row = row0 + ai * HALF + m * 16;
                const float rs = rs_from_ss(ss[row]);
                float o[8];
#pragma unroll
                for (int n = 0; n < 2; ++n)
#pragma unroll
                    for (int e = 0; e < 4; ++e) { const float g = acc[ai][0][m][n][e] * rs, uu = acc[ai][1][m][n][e] * rs; o[4 * n + e] = silu_f(g) * uu; }
                u32x4 wv; wv.x = cvt_pk_bf16(o[0], o[1]); wv.y = cvt_pk_bf16(o[2], o[3]); wv.z = cvt_pk_bf16(o[4], o[5]); wv.w = cvt_pk_bf16(o[6], o[7]);
                *(u32x4*)(O + (size_t)row * 2816 + col0) = wv;
            }
    }
};
struct EpiMlstmIn {
    static constexpr bool PERM = true, AFTER_DRAIN = false;
    bf16_t* P2; bf16_t* OP; float* gates; const float* ss;
    __device__ __forceinline__ void operator()(const f32x4 (&acc)[2][2][4][2], const Unit& u, int wr, int wc, int fr, int fq) const {
        const int row0 = u.pm * BM + wr * 64 + fr;
#pragma unroll
        for (int ai = 0; ai < 2; ++ai)
#pragma unroll
            for (int m = 0; m < 4; ++m) {
                const int row = row0 + ai * HALF + m * 16;
                const float rs = rs_from_ss(ss[row]);
#pragma unroll
                for (int bj = 0; bj < 2; ++bj) {
                    const int cb = u.pn * BM + bj * HALF;
                    const f32x4 v0 = acc[ai][bj][m][0] * rs, v1 = acc[ai][bj][m][1] * rs;
                    const int cc = wc * 32 + 8 * fq;
                    if (cb < 3072) {
                        u32x4 wv; wv.x = cvt_pk_bf16(v0[0], v0[1]); wv.y = cvt_pk_bf16(v0[2], v0[3]); wv.z = cvt_pk_bf16(v1[0], v1[1]); wv.w = cvt_pk_bf16(v1[2], v1[3]);
                        bf16_t* dst = (cb < 2048) ? (P2 + (size_t)row * 2048 + cb + cc) : (OP + (size_t)row * 1024 + (cb - 2048) + cc);
                        *(u32x4*)dst = wv;
                    } else if (cb == 3072 && cc < 16) {
                        float* dst = gates + (size_t)row * 16 + cc;
                        *(f32x4*)dst = v0; *(f32x4*)(dst + 4) = v1;
                    }
                }
            }
    }
};

template <class Epi, class Sched, bool ALIGN_EPI = false, bool SP2 = false>
__device__ __forceinline__ void gemm_phase(PG8_LAS unsigned char* lds, const Gemm g, const Sched& S, const Epi& E) {
    const int tid = threadIdx.x, wid = __builtin_amdgcn_readfirstlane(tid >> 6), lane = tid & 63, wr = wid >> 2, wc = wid & 3, fr = lane & 15, fq = lane >> 4;
    const int K = g.K, nt = K / BK;
    unsigned voffA[2], voffB[2];
#pragma unroll
    for (int i = 0; i < 2; ++i) { int R, C; stage_rc(tid * 16 + i * 8192, R, C); const int Rb = Epi::PERM ? ((R & ~31) + perm32(R & 31)) : R;
        voffA[i] = (unsigned)(R * K + C) * 2u; voffB[i] = (unsigned)(Rb * K + C) * 2u; }
    const size_t kstep = (size_t)(BK * 2);
    const size_t hstep = (size_t)HALF * K * 2;
    const size_t tstep = 2 * hstep;
    const unsigned ldsw = (unsigned)wid * 1024u;
    const int aoff = lds_byte(wr * 64 + fr, fq * 8), boff = lds_byte(wc * 32 + fr, fq * 8);
#define PG8_SA(b, h) (((b) * 2 + (h)) * HTB)
#define PG8_SB(b, h) ((4 + (b) * 2 + (h)) * HTB)
#define PG8_STAGE(bufoff, gbase, voff) do { _Pragma("unroll") for (int _i = 0; _i < 2; ++_i) \
        __builtin_amdgcn_global_load_lds((const unsigned*)((const char*)(gbase) + (voff)[_i]), (PG8_LAS unsigned*)(lds + (bufoff) + ldsw + _i * 8192), 16, 0, 0); } while (0)
#define PG8_LDA(dst, b, h) do { _Pragma("unroll") for (int m = 0; m < 4; ++m) _Pragma("unroll") for (int k = 0; k < 2; ++k) dst[m][k] = *(const PG8_LAS bf16x8*)(lds + PG8_SA(b, h) + aoff + m * 2048 + k * 1024); } while (0)
#define PG8_LDB(dst, b, h) do { _Pragma("unroll") for (int n = 0; n < 2; ++n) _Pragma("unroll") for (int k = 0; k < 2; ++k) dst[n][k] = *(const PG8_LAS bf16x8*)(lds + PG8_SB(b, h) + boff + n * 2048 + k * 1024); } while (0)
#define PG8_MMA(ai, bj, At, Bt) do { __builtin_amdgcn_s_setprio(1); _Pragma("unroll") for (int m = 0; m < 4; ++m) _Pragma("unroll") for (int n = 0; n < 2; ++n) _Pragma("unroll") for (int k = 0; k < 2; ++k) \
        acc[ai][bj][m][n] = __builtin_amdgcn_mfma_f32_16x16x32_bf16(Bt[n][k], At[m][k], acc[ai][bj][m][n], 0, 0, 0); __builtin_amdgcn_s_setprio(0); } while (0)
#define PG8_WAIT_V(n) asm volatile("s_waitcnt vmcnt(" #n ")" ::: "memory")
#define PG8_WAIT_L(n) asm volatile("s_waitcnt lgkmcnt(" #n ")" ::: "memory")
#define PG8_BAR __builtin_amdgcn_s_barrier()
#define PG8_SCHED __builtin_amdgcn_sched_barrier(0)
    Unit cur, nxt; int ui = 0;
    if (!S.next(0, cur)) return;
    f32x4 acc[2][2][4][2];
#pragma unroll
    for (int a = 0; a < 2; ++a)
#pragma unroll
        for (int b = 0; b < 2; ++b)
#pragma unroll
            for (int m = 0; m < 4; ++m)
#pragma unroll
                for (int n = 0; n < 2; ++n) acc[a][b][m][n] = (f32x4){0.f, 0.f, 0.f, 0.f};
    bf16x8 At[4][2], B0[2][2], B1[2][2];
    const char* cA = (const char*)g.A + (size_t)cur.pm * tstep; const char* cB = (const char*)g.Bt + (size_t)cur.pn * tstep;
    S.a_ready(cur);
    if constexpr (SP2) {
        PG8_STAGE(PG8_SB(0, 0), cB, voffB); PG8_STAGE(PG8_SB(0, 1), cB + hstep, voffB); PG8_STAGE(PG8_SA(0, 0), cA, voffA); PG8_STAGE(PG8_SA(0, 1), cA + hstep, voffA);
        if (wr == 1) PG8_BAR;
        PG8_WAIT_V(2); PG8_BAR;
        PG8_STAGE(PG8_SB(1, 0), cB + kstep, voffB); PG8_STAGE(PG8_SA(1, 0), cA + kstep, voffA); PG8_STAGE(PG8_SB(1, 1), cB + hstep + kstep, voffB);
        PG8_WAIT_V(6); PG8_BAR;
    } else {
        PG8_STAGE(PG8_SB(0, 0), cB, voffB); PG8_STAGE(PG8_SA(0, 0), cA, voffA); PG8_STAGE(PG8_SB(0, 1), cB + hstep, voffB); PG8_STAGE(PG8_SA(0, 1), cA + hstep, voffA);
        if (wr == 1) PG8_BAR;
        PG8_WAIT_V(4); PG8_BAR;
        PG8_STAGE(PG8_SB(1, 0), cB + kstep, voffB); PG8_STAGE(PG8_SA(1, 0), cA + kstep, voffA); PG8_STAGE(PG8_SB(1, 1), cB + hstep + kstep, voffB);
        PG8_WAIT_V(6); PG8_BAR;
    }
    for (;;) {
        const bool has_next = S.next(ui + 1, nxt);
        const char* nA = has_next ? (const char*)g.A + (size_t)nxt.pm * tstep : cA; const char* nB = has_next ? (const char*)g.Bt + (size_t)nxt.pn * tstep : cB;
        for (int t = 0; t < nt; t += 2) {
            const bool last = (t == nt - 2);
            const char* a1 = cA + (size_t)(t + 1) * kstep;
            const char* a2 = last ? nA : cA + (size_t)(t + 2) * kstep; const char* b2 = last ? nB : cB + (size_t)(t + 2) * kstep;
            const char* a3 = a2 + kstep; const char* b3 = b2 + kstep;
            if (last && has_next) S.a_ready(nxt);
            if constexpr (SP2) {
            PG8_LDB(B0, 0, 0); PG8_LDB(B1, 0, 1); PG8_SCHED; PG8_LDA(At, 0, 0); PG8_STAGE(PG8_SA(1, 1), a1 + hstep, voffA);
            PG8_WAIT_V(8); PG8_WAIT_L(0); PG8_BAR; PG8_MMA(0, 0, At, B0); PG8_MMA(0, 1, At, B1); PG8_BAR; PG8_SCHED;
            PG8_LDA(At, 0, 1); PG8_STAGE(PG8_SB(0, 0), b2, voffB); PG8_STAGE(PG8_SB(0, 1), b2 + hstep, voffB); PG8_STAGE(PG8_SA(0, 0), a2, voffA);
            PG8_WAIT_V(8); PG8_WAIT_L(0); PG8_BAR; PG8_MMA(1, 0, At, B0); PG8_MMA(1, 1, At, B1); PG8_BAR; PG8_SCHED;
            PG8_LDB(B0, 1, 0); PG8_LDB(B1, 1, 1); PG8_SCHED; PG8_LDA(At, 1, 0); PG8_STAGE(PG8_SA(0, 1), a2 + hstep, voffA);
            PG8_WAIT_V(8); PG8_WAIT_L(0); PG8_BAR; PG8_MMA(0, 0, At, B0); PG8_MMA(0, 1, At, B1); PG8_BAR; PG8_SCHED;
            PG8_LDA(At, 1, 1); PG8_STAGE(PG8_SB(1, 0), b3, voffB); PG8_STAGE(PG8_SB(1, 1), b3 + hstep, voffB); PG8_STAGE(PG8_SA(1, 0), a3, voffA);
            PG8_WAIT_V(8); PG8_WAIT_L(0); PG8_BAR; PG8_MMA(1, 0, At, B0); PG8_MMA(1, 1, At, B1); PG8_BAR; PG8_SCHED;
            } else {
            PG8_LDB(B0, 0, 0); PG8_SCHED; PG8_LDA(At, 0, 0); PG8_STAGE(PG8_SA(1, 1), a1 + hstep, voffA);
            PG8_WAIT_L(8); PG8_BAR; PG8_WAIT_L(0); PG8_MMA(0, 0, At, B0); PG8_BAR; PG8_SCHED;
            PG8_LDB(B1, 0, 1); PG8_STAGE(PG8_SB(0, 0), b2, voffB);
            PG8_BAR; PG8_WAIT_L(0); PG8_MMA(0, 1, At, B1); PG8_BAR;
            PG8_LDA(At, 0, 1); PG8_STAGE(PG8_SA(0, 0), a2, voffA);
            PG8_BAR; PG8_WAIT_L(0); PG8_MMA(1, 0, At, B0); PG8_BAR; PG8_SCHED;
            PG8_STAGE(PG8_SB(0, 1), b2 + hstep, voffB);
            PG8_WAIT_V(6); PG8_BAR; PG8_MMA(1, 1, At, B1); PG8_BAR;
            PG8_LDB(B0, 1, 0); PG8_SCHED; PG8_LDA(At, 1, 0); PG8_STAGE(PG8_SA(0, 1), a2 + hstep, voffA);
            PG8_WAIT_L(8); PG8_BAR; PG8_WAIT_L(0); PG8_MMA(0, 0, At, B0); PG8_BAR; PG8_SCHED;
            PG8_LDB(B1, 1, 1); PG8_STAGE(PG8_SB(1, 0), b3, voffB);
            PG8_BAR; PG8_WAIT_L(0); PG8_MMA(0, 1, At, B1); PG8_BAR;
            PG8_LDA(At, 1, 1); PG8_STAGE(PG8_SA(1, 0), a3, voffA);
            PG8_BAR; PG8_WAIT_L(0); PG8_MMA(1, 0, At, B0); PG8_BAR; PG8_SCHED;
            PG8_STAGE(PG8_SB(1, 1), b3 + hstep, voffB);
            PG8_WAIT_V(6); PG8_BAR; PG8_MMA(1, 1, At, B1); PG8_BAR;
            }
        }
        if constexpr (ALIGN_EPI) { if (wr == 0) PG8_BAR; }
        if constexpr (!Epi::AFTER_DRAIN) { E(acc, cur, wr, wc, fr, fq); S.done(cur); }
        if (!has_next) break;
#pragma unroll
        for (int a = 0; a < 2; ++a)
#pragma unroll
            for (int b = 0; b < 2; ++b)
#pragma unroll
                for (int m = 0; m < 4; ++m)
#pragma unroll
                    for (int n = 0; n < 2; ++n) acc[a][b][m][n] = (f32x4){0.f, 0.f, 0.f, 0.f};
        cur = nxt; cA = nA; cB = nB; ++ui;
        if constexpr (ALIGN_EPI) { if (wr == 1) PG8_BAR; }
    }
    PG8_WAIT_V(0);
    if constexpr (!ALIGN_EPI) { if (wr == 0) PG8_BAR; }
    PG8_BAR;
    if constexpr (Epi::AFTER_DRAIN) { E.fused(acc, cur, wr, wc, fr, fq, lds, wid, lane); S.done(cur); }
#undef PG8_SA
#undef PG8_SB
#undef PG8_STAGE
#undef PG8_LDA
#undef PG8_LDB
#undef PG8_MMA
#undef PG8_WAIT_V
#undef PG8_WAIT_L
#undef PG8_BAR
#undef PG8_SCHED
}
}

constexpr int T_TOK = 32768, DM = 1024, SEQ = 2048, NB = 16, DFF = 2816, THALF = 16384;
constexpr int NWAVES = 8;
constexpr int RB = 2176, HBR = 8 * RB;
constexpr int LDS_BYTES = 147456;
constexpr size_t MiB = 1u << 20;
constexpr size_t WS_SS = 0;
constexpr size_t WS_MST = 1 * MiB;
constexpr size_t WS_NST = 1 * MiB + 65536;
constexpr size_t WS_BAR = 3 * MiB;
constexpr size_t WS_WQKV = 4 * MiB;
constexpr size_t WS_WAO = 22 * MiB;
constexpr size_t WS_WFFIN = 24 * MiB;
constexpr size_t WS_WFFOUT = 46 * MiB;
constexpr size_t WS_WMIN = 57 * MiB;
constexpr size_t WS_WMOUT = 64 * MiB;
constexpr size_t WS_ROPE = 66 * MiB;
constexpr size_t WS_LSE = 70 * MiB;
constexpr size_t WS_GATES = 73 * MiB;
constexpr size_t WS_HB = 76 * MiB;
constexpr size_t WS_MX = 140 * MiB;
constexpr size_t WS_BIG = 204 * MiB;
constexpr size_t WS_H = WS_BIG;
constexpr size_t WS_ACT = WS_BIG + 128 * MiB;
constexpr size_t WS_END = 512 * MiB;
static_assert(WS_ACT + (size_t)T_TOK * DFF * 2 <= WS_END && WS_BIG + (size_t)72 * 8 * 2176 * 256 <= WS_END, "d_ws map");

#define LAS __attribute__((address_space(3)))
typedef unsigned short bf16;
typedef unsigned u32x4 __attribute__((ext_vector_type(4)));
typedef unsigned u32x2 __attribute__((ext_vector_type(2)));
typedef float f32x4 __attribute__((ext_vector_type(4)));
typedef float f32x16 __attribute__((ext_vector_type(16)));
typedef short bf16x8 __attribute__((ext_vector_type(8)));
typedef short s16x4 __attribute__((ext_vector_type(4)));
typedef float f32x2_t __attribute__((ext_vector_type(2)));
typedef __bf16 bf16x2_t __attribute__((ext_vector_type(2)));
__device__ __forceinline__ unsigned pk2(float lo, float hi) { f32x2_t v = {lo, hi}; bf16x2_t b = __builtin_convertvector(v, bf16x2_t); return __builtin_bit_cast(unsigned, b); }
__device__ __forceinline__ float bf_lo(unsigned w) { return __uint_as_float(w << 16); }
__device__ __forceinline__ float bf_hi(unsigned w) { return __uint_as_float(w & 0xffff0000u); }
__device__ __forceinline__ float wave_sum(float v) {
#pragma unroll
    for (int o = 1; o < 64; o <<= 1) v += __shfl_xor(v, o);
    return v;
}
__device__ __forceinline__ float wave_max(float v) {
#pragma unroll
    for (int o = 1; o < 64; o <<= 1) v = fmaxf(v, __shfl_xor(v, o));
    return v;
}
#define MFMA16(a, b, c) __builtin_amdgcn_mfma_f32_16x16x32_bf16((a), (b), (c), 0, 0, 0)
#define MFMA32(a, b, c) __builtin_amdgcn_mfma_f32_32x32x16_bf16((a), (b), (c), 0, 0, 0)

#define XB_TMO      128
#define XB_XCNT(j)  (256  + 64 * (j))
#define XB_XSUB(j)  (1280 + 64 * (j))
#define XB_XGEN(j)  (2304 + 64 * (j))
#define XB_TOP      3328
#define XB_TOPGEN   3392
#define XCD_BAR_WORDS 3456
#define XB_SPIN_CAP (1u << 18)

__device__ __forceinline__ unsigned xb_ld(unsigned* p)              { return __hip_atomic_load(p, __ATOMIC_RELAXED, __HIP_MEMORY_SCOPE_AGENT); }
__device__ __forceinline__ unsigned xb_add(unsigned* p, unsigned v) { return __hip_atomic_fetch_add(p, v, __ATOMIC_RELAXED, __HIP_MEMORY_SCOPE_AGENT); }
__device__ __forceinline__ unsigned xb_xcc_id() { return (unsigned)__builtin_amdgcn_s_getreg((3 << 11) | 20) & 0xFu; }
#define XB_SPIN(cond, bar) do { unsigned _sp = 0; while (cond) { __builtin_amdgcn_s_sleep(1); \
    if ((++_sp & 255u) == 0u) { if (xb_ld(&(bar)[XB_TMO])) break; if (_sp > XB_SPIN_CAP) { atomicAdd(&(bar)[XB_TMO], 1u); break; } } } } while (0)

struct XcdBarrier {
    unsigned* bar; unsigned x;
    volatile LAS unsigned* st;
};

__device__ __forceinline__ XcdBarrier xcd_barrier_post(unsigned* bar, volatile LAS unsigned* st) {
    XcdBarrier b; b.bar = bar; b.x = xb_xcc_id(); b.st = st;
    if (threadIdx.x == 0) (void)xb_add(&bar[XB_XCNT(b.x)], 1u);
    return b;
}
__device__ __forceinline__ void xcd_barrier_complete(unsigned* bar, unsigned x, unsigned& nloc, unsigned& nx) {
    const unsigned G = gridDim.x * gridDim.y * gridDim.z;
    unsigned sum, cnt, mine, sp = 0u;
    for (;;) {
        sum = 0u; cnt = 0u; mine = 0u;
#pragma unroll
        for (unsigned j = 0; j < 16; ++j) { const unsigned c = xb_ld(&bar[XB_XCNT(j)]); sum += c; cnt += (c > 0u) ? 1u : 0u; mine = (j == x) ? c : mine; }
        if (sum == G) break;
        __builtin_amdgcn_s_sleep(1);
        if ((++sp & 255u) == 0u) { if (xb_ld(&bar[XB_TMO])) break; if (sp > XB_SPIN_CAP) { atomicAdd(&bar[XB_TMO], 1u); break; } }
    }
    nloc = mine > 0u ? mine : 1u; nx = cnt > 0u ? cnt : 1u;
}

__device__ __forceinline__ void xcd_barrier(const XcdBarrier& b) {
    asm volatile("s_waitcnt vmcnt(0)" ::: "memory");
    __syncthreads();
    if (threadIdx.x == 0) {
        unsigned* bar = b.bar;
        __builtin_amdgcn_s_waitcnt(0);
        unsigned nloc = b.st[0], nx = b.st[1];
        if (nloc == 0u) { xcd_barrier_complete(bar, b.x, nloc, nx); b.st[0] = nloc; b.st[1] = nx; }
        const unsigned old = xb_add(&bar[XB_XSUB(b.x)], 1u);
        const unsigned gen = old / nloc;
        if (old + 1u == (gen + 1u) * nloc) {
            __builtin_amdgcn_fence(__ATOMIC_RELEASE, "agent");
            asm volatile("s_waitcnt vmcnt(0)" ::: "memory");
            const unsigned og = xb_add(&bar[XB_TOP], 1u);
            const unsigned tg = og / nx;
            if (og + 1u == (tg + 1u) * nx) xb_add(&bar[XB_TOPGEN], 1u);
            else XB_SPIN(xb_ld(&bar[XB_TOPGEN]) == tg, bar);
            __builtin_amdgcn_fence(__ATOMIC_ACQUIRE, "agent");
            xb_add(&bar[XB_XGEN(b.x)], 1u);
            asm volatile("s_waitcnt vmcnt(0)" ::: "memory");
        } else {
            XB_SPIN(xb_ld(&bar[XB_XGEN(b.x)]) == gen, bar);
            __builtin_amdgcn_fence(__ATOMIC_ACQUIRE, "agent");
            asm volatile("s_waitcnt vmcnt(0)" ::: "memory");
        }
    }
    __syncthreads();
}


struct Args {
    const float* x; const int* pos; const float* attn_norm; const float* attn_w_in; const float* attn_w_out; const float* mlstm_norm; const float* mlstm_w_in;
    const float* conv_w; const float* conv_b; const float* ig_bias; const float* fg_bias; const float* head_gain; const float* mlstm_w_out;
    const float* ffn_norm; const float* ffn_w_in; const float* ffn_w_out; const float* final_norm;
    float* out; unsigned char* ws; int ph_lo, ph_hi;
};

__device__ __forceinline__ void tr_item(const float* __restrict__ W, int K, int Nsrc, bf16* WT, int n0_dst, int n0_src, int k0, const float* __restrict__ gain, float scale, LAS float* scr, int lane) {
    const int n4 = lane & 15, kq = lane >> 4; const int col = n0_src + 4 * n4; const bool ok = col < Nsrc;
    f32x4 v[16];
#pragma unroll
    for (int i = 0; i < 16; ++i) { v[i] = (f32x4){0.f, 0.f, 0.f, 0.f}; if (ok) v[i] = *(const f32x4*)(W + (size_t)(k0 + 4 * i + kq) * Nsrc + col); }
#pragma unroll
    for (int i = 0; i < 16; ++i) { const int kk = 4 * i + kq; const float g = gain ? gain[k0 + kk] * scale : scale; LAS float* d = scr + kk * 65 + 4 * n4;
        d[0] = v[i][0] * g; d[1] = v[i][1] * g; d[2] = v[i][2] * g; d[3] = v[i][3] * g; }
    asm volatile("s_waitcnt lgkmcnt(0)" ::: "memory");
    const int c = lane & 7;
#pragma unroll
    for (int j = 0; j < 8; ++j) { const int n = (lane >> 3) + 8 * j; const LAS float* sp = scr + (8 * c) * 65 + n;
        u32x4 o; o.x = pk2(sp[0 * 65], sp[1 * 65]); o.y = pk2(sp[2 * 65], sp[3 * 65]); o.z = pk2(sp[4 * 65], sp[5 * 65]); o.w = pk2(sp[6 * 65], sp[7 * 65]);
        *(u32x4*)(WT + (size_t)(n0_dst + n) * K + k0 + 8 * c) = o; }
    asm volatile("s_waitcnt lgkmcnt(0)" ::: "memory");
}
__device__ __forceinline__ void p0_prologue(const Args& A, LAS unsigned char* lds, int G, int bid) {
    const int tid = threadIdx.x, lane = tid & 63, wave = tid >> 6;
    LAS float* scr = (LAS float*)(lds + wave * 16640);
    const int gw = bid * NWAVES + wave, NGW = G * NWAVES;
    unsigned char* ws = A.ws;
    constexpr int I_QKV = 16 * 144, I_AO = 16 * 16, I_FFIN = 16 * 88, I_FFOUT = 44 * 16, I_MIN = 16 * 52, I_MOUT = 16 * 16;
    constexpr int NITEMS = I_QKV + I_AO + 2 * I_FFIN + 2 * I_FFOUT + I_MIN + I_MOUT;
    constexpr float QSCALE = 0.08838834764831845f * 1.4426950408889634f;
    for (int it = gw; it < NITEMS; it += NGW) {
        int r = it;
        if (r < I_QKV) { const int kb = r / 144, nb = r % 144, n0 = 64 * nb; const int tsel = (n0 % 3072) / 1024;
            tr_item(A.attn_w_in, 1024, 9216, (bf16*)(ws + WS_WQKV), n0, n0, 64 * kb, A.attn_norm, tsel == 0 ? QSCALE : 1.f, scr, lane); continue; } r -= I_QKV;
        if (r < I_AO) { const int kb = r / 16, nb = r % 16; tr_item(A.attn_w_out, 1024, 1024, (bf16*)(ws + WS_WAO), 64 * nb, 64 * nb, 64 * kb, nullptr, 1.f, scr, lane); continue; } r -= I_AO;
        if (r < 2 * I_FFIN) { const int l = r / I_FFIN; r -= l * I_FFIN; const int kb = r / 88, nb = r % 88, n0 = 64 * nb;
            const int pn = n0 >> 8, bj = (n0 >> 7) & 1, jj = n0 & 127; const int nsrc = (bj ? DFF : 0) + 128 * pn + jj;
            tr_item(A.ffn_w_in + (size_t)l * 1024 * 5632, 1024, 5632, (bf16*)(ws + WS_WFFIN) + (size_t)l * 5632 * 1024, n0, nsrc, 64 * kb, A.ffn_norm + l * 1024, 1.f, scr, lane); continue; } r -= 2 * I_FFIN;
        if (r < 2 * I_FFOUT) { const int l = r / I_FFOUT; r -= l * I_FFOUT; const int kb = r / 16, nb = r % 16;
            tr_item(A.ffn_w_out + (size_t)l * DFF * 1024, DFF, 1024, (bf16*)(ws + WS_WFFOUT) + (size_t)l * 1024 * DFF, 64 * nb, 64 * nb, 64 * kb, nullptr, 1.f, scr, lane); continue; } r -= 2 * I_FFOUT;
        if (r < I_MIN) { const int kb = r / 52, nb = r % 52; tr_item(A.mlstm_w_in, 1024, 3088, (bf16*)(ws + WS_WMIN), 64 * nb, 64 * nb, 64 * kb, A.mlstm_norm, 1.f, scr, lane); continue; } r -= I_MIN;
        { const int kb = r / 16, nb = r % 16; tr_item(A.mlstm_w_out, 1024, 1024, (bf16*)(ws + WS_WMOUT), 64 * nb, 64 * nb, 64 * kb, nullptr, 1.f, scr, lane); }
    }
    float* ss = (float*)(ws + WS_SS); bf16* hb = (bf16*)(ws + WS_HB);
    for (int m4 = gw; m4 < T_TOK / 4; m4 += NGW) {
        f32x4 v[4][4];
#pragma unroll
        for (int q = 0; q < 4; ++q) { const f32x4* xr = (const f32x4*)(A.x + (size_t)(4 * m4 + q) * DM) + lane;
#pragma unroll
            for (int j = 0; j < 4; ++j) v[q][j] = xr[64 * j]; }
#pragma unroll
        for (int q = 0; q < 4; ++q) { const int m = 4 * m4 + q; float sq = 0.f;
#pragma unroll
            for (int j = 0; j < 4; ++j) sq += (v[q][j].x * v[q][j].x + v[q][j].y * v[q][j].y) + (v[q][j].z * v[q][j].z + v[q][j].w * v[q][j].w);
            sq = wave_sum(sq);
            u32x2* o8 = (u32x2*)(hb + (size_t)m * DM) + lane;
#pragma unroll
            for (int j = 0; j < 4; ++j) { u32x2 o; o.x = pk2(v[q][j].x, v[q][j].y); o.y = pk2(v[q][j].z, v[q][j].w); o8[64 * j] = o; }
            if (lane == 0) ss[m] = sq; }
    }
    const int gt = bid * 512 + tid, NGT = G * 512;
    for (int i = gt; i < 4 * T_TOK; i += NGT) ss[T_TOK + i] = 0.f;
    float* rope = (float*)(ws + WS_ROPE);
    for (int i = gt; i < T_TOK * 16; i += NGT) {
        const int t = i >> 4, f = i & 15;
        const float invf = (float)exp2(-(double)f * (18.931568569324174 / 16.0));
        const float ang = (float)A.pos[t] * invf;
        const double rev = (double)ang * 0.15915494309189535; const float fr = (float)(rev - rint(rev));
        rope[(size_t)t * 32 + f] = __builtin_amdgcn_cosf(fr); rope[(size_t)t * 32 + 16 + f] = __builtin_amdgcn_sinf(fr);
    }
}

struct AStep { const bf16* base; size_t rowstride; int blk, g, h, dil, rr, b; bool valid, compute; };
__device__ __forceinline__ AStep attn_step(int u, int s, const bf16* QKVh) {
    AStep t; t.valid = true; t.compute = true;
    if (s < 5) { t.g = 0; t.dil = 1; t.rr = 0; const int qt = u & 3; t.h = (u >> 2) & 7; t.b = u >> 5; t.blk = 4 * qt + s - 1; if (s == 0) { t.compute = false; t.valid = qt > 0; if (!t.valid) t.blk = 0; } }
    else if (s < 9) { t.g = 1; t.dil = 4; t.h = u & 7; t.rr = (u >> 3) & 3; t.b = u >> 5; t.blk = s - 5; }
    else { t.g = 2; t.dil = 16; const int v = 4 * u + (s - 9); t.h = v & 7; t.rr = (v >> 3) & 15; t.b = v >> 7; t.blk = 0; }
    t.rowstride = 128;
    t.base = QKVh + ((size_t)(t.g * 24 + t.h) * HBR + t.b * RB + t.rr * (SEQ / t.dil)) * 128;
    return t;
}
typedef short v4i16_t __attribute__((ext_vector_type(4)));
__device__ __forceinline__ s16x4 tr_read(const LAS unsigned char* p) { return __builtin_bit_cast(s16x4, __builtin_amdgcn_ds_read_tr16_b64_v4i16((LAS v4i16_t*)p)); }
__device__ __forceinline__ void attn_phase(LAS unsigned char* lds, const bf16* __restrict__ QKVh, bf16* __restrict__ Oh, float* __restrict__ lse, int half, int G, int bid) {
    const int tid = threadIdx.x, lane = tid & 63, w = __builtin_amdgcn_readfirstlane(tid >> 6), r = lane & 15, q4 = lane >> 4;
    constexpr int SLOT = 34816;
#define ATT_LOAD(st) do { \
        _Pragma("unroll") for (int i = 0; i < 4; ++i) { const int chunk = tid + 512 * i, c = chunk >> 4, ch = chunk & 15; const bf16* gp = (st).base + (size_t)(128 * (st).blk + c) * (st).rowstride + 8 * ch; \
            kr[i] = *(const u32x4*)(gp + (size_t)8 * HBR * 128); vr[i] = *(const u32x4*)(gp + (size_t)16 * HBR * 128); } \
        { const bf16* qrow = (st).base + (size_t)(128 * (st).blk + 16 * w + r) * (st).rowstride; \
            _Pragma("unroll") for (int q = 0; q < 4; ++q) qn[q] = *(const bf16x8*)(qrow + 32 * q + 8 * q4); } } while (0)
    for (int u = bid; u < 256; u += G) {
        AStep nx = attn_step(u, 0, QKVh);
        u32x4 kr[4], vr[4]; bf16x8 qn[4];
#pragma unroll
        for (int i = 0; i < 4; ++i) { kr[i] = (u32x4){0u, 0u, 0u, 0u}; vr[i] = kr[i]; qn[i] = (bf16x8){0, 0, 0, 0, 0, 0, 0, 0}; }
        ATT_LOAD(nx);
        for (int s = 0; s < 13; ++s) {
            const AStep cu = nx; const int cs = s & 1;
            LAS unsigned char* Kc = lds + cs * SLOT; LAS unsigned char* Vc = lds + 2 * SLOT + cs * SLOT;
#pragma unroll
            for (int i = 0; i < 4; ++i) { const int chunk = tid + 512 * i, c = chunk >> 4, ch = chunk & 15; *(LAS u32x4*)(Kc + c * 272 + ch * 16) = kr[i]; *(LAS u32x4*)(Vc + c * 272 + ch * 16) = vr[i]; }
            bf16x8 qf[4];
#pragma unroll
            for (int q = 0; q < 4; ++q) qf[q] = qn[q];
            __syncthreads();
            { nx = attn_step(u, (s + 1 < 13) ? s + 1 : 12, QKVh); ATT_LOAD(nx); }
            if (cu.compute) {
                const bool first = (cu.blk == 0);
                const LAS unsigned char* Kp = first ? Kc : lds + (cs ^ 1) * SLOT; const LAS unsigned char* Vp = first ? Vc : lds + 2 * SLOT + (cs ^ 1) * SLOT;
                const int a = 16 * w + r;
                const int jlo = first ? 8 : 0;
                f32x4 S[9]; float mx = -INFINITY;
#pragma unroll
                for (int jj = 0; jj < 9; ++jj) { const int j = w + jj; S[jj] = (f32x4){0.f, 0.f, 0.f, 0.f};
                    if (j >= jlo) { const LAS unsigned char* kp = (j >= 8 ? Kc : Kp) + ((j & 7) * 16 + r) * 272 + 16 * q4;
#pragma unroll
                        for (int st = 0; st < 4; ++st) { const bf16x8 kf = *(const LAS bf16x8*)(kp + 64 * st); S[jj] = MFMA16(kf, qf[st], S[jj]); } }
#pragma unroll
                    for (int i = 0; i < 4; ++i) { const int c = 16 * j + 4 * q4 + i; const bool valid = (c >= a) && (c <= a + 128) && (c >= 128 || !first);
                        S[jj][i] = valid ? S[jj][i] : -INFINITY; mx = fmaxf(mx, S[jj][i]); } }
                mx = fmaxf(mx, __shfl_xor(mx, 16)); mx = fmaxf(mx, __shfl_xor(mx, 32));
                float den = 0.f;
#pragma unroll
                for (int jj = 0; jj < 9; ++jj)
#pragma unroll
                    for (int i = 0; i < 4; ++i) { const float pe = __builtin_amdgcn_exp2f(S[jj][i] - mx); S[jj][i] = pe; den += pe; }
                den += __shfl_xor(den, 16); den += __shfl_xor(den, 32);
                bf16x8 pf[5];
#pragma unroll
                for (int p = 0; p < 5; ++p) { u32x4 wv; wv.x = pk2(S[2 * p][0], S[2 * p][1]); wv.y = pk2(S[2 * p][2], S[2 * p][3]);
                    if (2 * p + 1 < 9) { wv.z = pk2(S[(2 * p + 1) % 9][0], S[(2 * p + 1) % 9][1]); wv.w = pk2(S[(2 * p + 1) % 9][2], S[(2 * p + 1) % 9][3]); } else { wv.z = 0u; wv.w = 0u; }
                    pf[p] = __builtin_bit_cast(bf16x8, wv); }
                f32x4 o[8];
#pragma unroll
                for (int db = 0; db < 8; ++db) o[db] = (f32x4){0.f, 0.f, 0.f, 0.f};
#pragma unroll
                for (int p = 0; p < 5; ++p) { const int j0 = w + 2 * p, j1 = (j0 + 1 > 15) ? 15 : j0 + 1;
                    if (j0 + 1 >= jlo) {
                        const LAS unsigned char* v0p = (j0 >= 8 ? Vc : Vp) + ((j0 & 7) * 16 + 4 * q4 + (r >> 2)) * 272 + 8 * (r & 3);
                        const LAS unsigned char* v1p = (j1 >= 8 ? Vc : Vp) + ((j1 & 7) * 16 + 4 * q4 + (r >> 2)) * 272 + 8 * (r & 3);
#pragma unroll
                        for (int db = 0; db < 8; ++db) {
                            const s16x4 lo = tr_read(v0p + 32 * db), hi = tr_read(v1p + 32 * db);
                            const bf16x8 af = __builtin_shufflevector(lo, hi, 0, 1, 2, 3, 4, 5, 6, 7);
                            o[db] = MFMA16(af, pf[p], o[db]); } } }
                const float inv = 1.0f / den;
                const int tl = cu.b * SEQ + (128 * cu.blk + a) * cu.dil + cu.rr;
                bf16* orow = Oh + ((size_t)(cu.g * 8 + cu.h) * HBR + cu.b * RB + cu.rr * (SEQ / cu.dil) + 128 * cu.blk + a) * 128 + 4 * q4;
#pragma unroll
                for (int db = 0; db < 8; ++db) { u32x2 wv; wv.x = pk2(o[db][0] * inv, o[db][1] * inv); wv.y = pk2(o[db][2] * inv, o[db][3] * inv); *(u32x2*)(orow + 16 * db) = wv; }
                if (q4 == 0) lse[((size_t)cu.g * T_TOK + (size_t)half * THALF + tl) * 8 + cu.h] = mx * 0.6931471805599453f + __logf(den);
            }
            __syncthreads();
        }
    }
#undef ATT_LOAD
}
__device__ __forceinline__ void merge_phase(const bf16* __restrict__ Oh, const float* __restrict__ lse, bf16* __restrict__ MX, int half, int G, int bid) {
    const int gt = bid * 512 + threadIdx.x, NGT = G * 512;
    for (int i = gt; i < THALF * 128; i += NGT) {
        const int tl = i >> 7, ch = i & 127, h = ch >> 4; const size_t tg = (size_t)half * THALF + tl;
        const float l0 = lse[((size_t)0 * T_TOK + tg) * 8 + h], l1 = lse[((size_t)1 * T_TOK + tg) * 8 + h], l2 = lse[((size_t)2 * T_TOK + tg) * 8 + h];
        const float mxl = fmaxf(l0, fmaxf(l1, l2)); float w0 = __expf(l0 - mxl), w1 = __expf(l1 - mxl), w2 = __expf(l2 - mxl); const float inv = 1.0f / (w0 + w1 + w2); w0 *= inv; w1 *= inv; w2 *= inv;
        const int sq = tl & 2047, bb = (tl >> 11) * RB, dch = ch & 15;
        const int p1 = ((sq & 3) << 9) + (sq >> 2), p2 = ((sq & 15) << 7) + (sq >> 4);
        const u32x4 a = *(const u32x4*)(Oh + ((size_t)(0 + h) * HBR + bb + sq) * 128 + 8 * dch), b = *(const u32x4*)(Oh + ((size_t)(8 + h) * HBR + bb + p1) * 128 + 8 * dch), c = *(const u32x4*)(Oh + ((size_t)(16 + h) * HBR + bb + p2) * 128 + 8 * dch);
        u32x4 o;
#pragma unroll
        for (int e = 0; e < 4; ++e) o[e] = pk2(w0 * bf_lo(a[e]) + w1 * bf_lo(b[e]) + w2 * bf_lo(c[e]), w0 * bf_hi(a[e]) + w1 * bf_hi(b[e]) + w2 * bf_hi(c[e]));
        *(u32x4*)(MX + tg * 1024 + 8 * ch) = o;
    }
}
__device__ __forceinline__ float logsigmoid_f(float x) { return fminf(x, 0.f) - __logf(1.0f + __expf(-fabsf(x))); }
__device__ __forceinline__ void mlstm_pre_phase(const bf16* __restrict__ P2, const float* __restrict__ gates, const float* __restrict__ convw, const float* __restrict__ convb, const float* __restrict__ igb, const float* __restrict__ fgb,
                                                bf16* __restrict__ QKc, float* __restrict__ GA, float* __restrict__ GB, float* __restrict__ GP, float* __restrict__ CH, int G, int bid) {
    const int tid = threadIdx.x, lane = tid & 63, wave = tid >> 6;
    const int gt = bid * 512 + tid, NGT = G * 512;
    for (int it = gt; it < (T_TOK / 8) * 128; it += NGT) {
        const int ch = it & 127, tg = it >> 7; const int t0 = 8 * tg, sq0 = t0 & 2047; const int col = 8 * ch;
        float cw[4][8], cb[8];
#pragma unroll
        for (int q = 0; q < 2; ++q) { const f32x4 b4 = *(const f32x4*)(convb + col + 4 * q);
#pragma unroll
            for (int e = 0; e < 4; ++e) cb[4 * q + e] = b4[e];
#pragma unroll
            for (int j = 0; j < 4; ++j) { const f32x4 w4 = *(const f32x4*)(convw + j * 1024 + col + 4 * q);
#pragma unroll
                for (int e = 0; e < 4; ++e) cw[j][4 * q + e] = w4[e]; } }
        u32x4 rw[11];
#pragma unroll
        for (int i = 0; i < 11; ++i) { rw[i] = (u32x4){0u, 0u, 0u, 0u}; if (sq0 + i - 3 >= 0) rw[i] = *(const u32x4*)(P2 + (size_t)(t0 + i - 3) * 2048 + col); }
        const float ksc = (ch >= 64) ? 0.125f : 1.0f;
#pragma unroll
        for (int i = 0; i < 8; ++i) { u32x4 o;
#pragma unroll
            for (int e = 0; e < 4; ++e) { float x0 = cb[2 * e], x1 = cb[2 * e + 1];
#pragma unroll
                for (int j = 0; j < 4; ++j) { x0 += cw[j][2 * e] * bf_lo(rw[i + j][e]); x1 += cw[j][2 * e + 1] * bf_hi(rw[i + j][e]); }
                o[e] = pk2(silu_f(x0) * ksc, silu_f(x1) * ksc); }
            *(u32x4*)(QKc + (size_t)(t0 + i) * 1024 + col) = o; }
    }
    const int gw = bid * NWAVES + wave, NGW = G * NWAVES;
    for (int it = gw; it < NB * 32; it += NGW) {
        const int c = it & 31, b = it >> 5; const size_t t = (size_t)b * SEQ + 64 * c + lane;
        f32x4 g4[4];
#pragma unroll
        for (int q = 0; q < 4; ++q) g4[q] = *(const f32x4*)(gates + t * 16 + 4 * q);
        float bs[8], av[8], pm[8];
#pragma unroll
        for (int h = 0; h < 8; ++h) bs[h] = logsigmoid_f(g4[2 + (h >> 2)][h & 3] + fgb[h]);
#pragma unroll
        for (int o = 1; o < 64; o <<= 1) {
#pragma unroll
            for (int h = 0; h < 8; ++h) { const float v = __shfl_up(bs[h], o); if (lane >= o) bs[h] += v; } }
#pragma unroll
        for (int h = 0; h < 8; ++h) { av[h] = g4[h >> 2][h & 3] + igb[h] - bs[h]; pm[h] = av[h]; }
#pragma unroll
        for (int o = 1; o < 64; o <<= 1) {
#pragma unroll
            for (int h = 0; h < 8; ++h) { const float v = __shfl_up(pm[h], o); if (lane >= o) pm[h] = fmaxf(pm[h], v); } }
#pragma unroll
        for (int h = 0; h < 8; ++h) { const size_t o = (size_t)(b * 8 + h) * SEQ + 64 * c + lane; GA[o] = av[h]; GB[o] = bs[h]; GP[o] = pm[h];
            if (lane == 63) { const size_t cid = (size_t)(b * 8 + h) * 32 + c; CH[2 * cid] = bs[h]; CH[2 * cid + 1] = bs[h] + pm[h]; } }
    }
}
__device__ __forceinline__ void mlstm_scan_phase(LAS unsigned char* lds, const bf16* __restrict__ P2, const bf16* __restrict__ QKc, const float* __restrict__ GA, const float* __restrict__ CH,
                                                 bf16* __restrict__ Cst, float* __restrict__ nst, float* __restrict__ mst, int G, int bid) {
    const int tid = threadIdx.x, lane = tid & 63, w = __builtin_amdgcn_readfirstlane(tid >> 6), r = lane & 15, q4 = lane >> 4;
    const int dvb = w & 3, dkh = w >> 2;
    const bf16x8 ones = {0x3F80, 0x3F80, 0x3F80, 0x3F80, 0x3F80, 0x3F80, 0x3F80, 0x3F80};
    for (int item = bid; item < 256; item += G) {
        const int dvh = item & 1, h = (item >> 1) & 7, b = item >> 4;
        const size_t cid0 = (size_t)(b * 8 + h) * 32;
        f32x4 acc[2], accn[2]; acc[0] = (f32x4){0.f, 0.f, 0.f, 0.f}; acc[1] = acc[0]; accn[0] = acc[0]; accn[1] = acc[0];
        float mcar = 0.f;
        u32x4 nk, nv; float na, nbl, nml;
#define MSCAN_LOAD(c) do { const size_t t_ = (size_t)b * SEQ + 64 * (c) + lane; nk = *(const u32x4*)(QKc + t_ * 1024 + 512 + h * 64 + 8 * w); nv = *(const u32x4*)(P2 + t_ * 2048 + 1024 + h * 128 + 64 * dvh + 8 * w); \
            na = GA[(size_t)(b * 8 + h) * SEQ + 64 * (c) + lane]; nbl = CH[2 * (cid0 + (c))]; nml = CH[2 * (cid0 + (c)) + 1]; } while (0)
        MSCAN_LOAD(0);
        for (int c = 0; c < 32; ++c) {
            const u32x4 ck = nk, cv = nv; const float as = na, blast = nbl, mloc = nml;
            if (c + 1 < 32) MSCAN_LOAD(c + 1);
            const float mnew = fmaxf(blast + mcar, mloc);
            const float wsv = __expf(blast + as - mnew), carry = __expf(blast + mcar - mnew);
            const size_t cid = cid0 + c;
#pragma unroll
            for (int nb = 0; nb < 2; ++nb)
#pragma unroll
                for (int i = 0; i < 4; ++i) { const int dv = 64 * dvh + 16 * dvb + 4 * q4 + i, dk = 32 * dkh + 16 * nb + r;
                    Cst[(cid * 128 + dv) * 64 + dk] = (bf16)(pk2(acc[nb][i], 0.f) & 0xffffu); }
            if (dvh == 0 && dvb == 0 && q4 == 0) { nst[cid * 64 + 32 * dkh + r] = accn[0][0]; nst[cid * 64 + 32 * dkh + 16 + r] = accn[1][0]; }
            if (dvh == 0 && tid == 0) mst[cid] = mcar;
            LAS unsigned char* Kw = lds + (c & 1) * 18432; LAS unsigned char* Vs = Kw + 9216;
            u32x4 kw;
#pragma unroll
            for (int e = 0; e < 4; ++e) kw[e] = pk2(bf_lo(ck[e]) * wsv, bf_hi(ck[e]) * wsv);
            *(LAS u32x4*)(Kw + lane * 144 + 16 * w) = kw; *(LAS u32x4*)(Vs + lane * 144 + 16 * w) = cv;
            __syncthreads();
            acc[0] = acc[0] * carry; acc[1] = acc[1] * carry; accn[0] = accn[0] * carry; accn[1] = accn[1] * carry;
#pragma unroll
            for (int st = 0; st < 2; ++st) {
                const int rowb = (32 * st + 8 * q4 + (r >> 2)) * 144 + 8 * (r & 3);
                const s16x4 alo = tr_read(Vs + rowb + 32 * dvb), ahi = tr_read(Vs + rowb + 4 * 144 + 32 * dvb);
                const bf16x8 af = __builtin_shufflevector(alo, ahi, 0, 1, 2, 3, 4, 5, 6, 7);
#pragma unroll
                for (int nb = 0; nb < 2; ++nb) {
                    const s16x4 blo = tr_read(Kw + rowb + 64 * dkh + 32 * nb), bhi = tr_read(Kw + rowb + 4 * 144 + 64 * dkh + 32 * nb);
                    const bf16x8 bfr = __builtin_shufflevector(blo, bhi, 0, 1, 2, 3, 4, 5, 6, 7);
                    acc[nb] = MFMA16(af, bfr, acc[nb]);
                    if (dvb == 0) accn[nb] = MFMA16(ones, bfr, accn[nb]); }
            }
            mcar = mnew;
        }
        __syncthreads();
#undef MSCAN_LOAD
    }
}
__device__ __forceinline__ void mlstm_out_phase(LAS unsigned char* lds, const bf16* __restrict__ P2, const bf16* __restrict__ QKc, const bf16* __restrict__ OP, const float* __restrict__ GA, const float* __restrict__ GB, const float* __restrict__ GP,
                                                const float* __restrict__ hgain, const bf16* __restrict__ Cst, const float* __restrict__ nst, const float* __restrict__ mst, bf16* __restrict__ MX, int G, int bid) {
    const int tid = threadIdx.x, lane = tid & 63, w = __builtin_amdgcn_readfirstlane(tid >> 6), r = lane & 31, h2 = lane >> 5;
    const int dvb = w & 3, tb = w >> 2;
    constexpr int O_Q = 0, O_K = 9216, O_V = 18432, O_C = 35840, O_VEC = 54272, O_GN = 55296, O_PART = 55808, SETB = 56832;
    u32x4 pq, pk, pv0, pv1, pc0, pc1; float pvec = 0.f, pgn = 0.f, pmc = 0.f; u32x2 popv[4];
    pq = (u32x4){0u, 0u, 0u, 0u}; pk = pq; pv0 = pq; pv1 = pq; pc0 = pq; pc1 = pq;
#pragma unroll
    for (int gq = 0; gq < 4; ++gq) popv[gq] = (u32x2){0u, 0u};
#define OUT_LOAD(it) do { const int c_ = (it) & 31, h_ = ((it) >> 5) & 7, b_ = (it) >> 8; const size_t t0_ = (size_t)b_ * SEQ + 64 * c_; const size_t gb_ = (size_t)(b_ * 8 + h_) * SEQ + 64 * c_; \
        { const bf16* p_ = QKc + (t0_ + (tid >> 3)) * 1024 + h_ * 64 + 8 * (tid & 7); pq = *(const u32x4*)p_; pk = *(const u32x4*)(p_ + 512); } \
        { const bf16* p_ = P2 + (t0_ + (tid >> 4)) * 2048 + 1024 + h_ * 128 + 8 * (tid & 15); pv0 = *(const u32x4*)p_; pv1 = *(const u32x4*)(p_ + (size_t)32 * 2048); } \
        { const bf16* p_ = Cst + ((size_t)(it) * 128 + (tid >> 3)) * 64 + 8 * (tid & 7); pc0 = *(const u32x4*)p_; pc1 = *(const u32x4*)(p_ + 64 * 64); } \
        { const int wh_ = tid >> 6, ix_ = tid & 63; const float* src_ = (wh_ == 0) ? (GA + gb_) : (wh_ == 1) ? (GB + gb_) : (wh_ == 2) ? (GP + gb_) : (wh_ == 3) ? (nst + (size_t)(it) * 64) : (hgain + h_ * 128 + ((wh_ & 1) << 6)); pvec = src_[ix_]; } \
        pmc = mst[(it)]; \
        { const size_t orow_ = (t0_ + 32 * tb + r) * 1024 + h_ * 128 + 32 * dvb + 4 * h2; _Pragma("unroll") for (int gq = 0; gq < 4; ++gq) popv[gq] = *(const u32x2*)(OP + orow_ + 8 * gq); } } while (0)
    { const int fit = (bid < 4096) ? bid : 0; OUT_LOAD(fit); }
    int par = 0;
    for (int item = bid; item < 4096; item += G, par ^= 1) {
        const int c = item & 31, h = (item >> 5) & 7, b = item >> 8;
        const size_t t0 = (size_t)b * SEQ + 64 * c;
        LAS unsigned char* L = lds + par * SETB;
        LAS float* vec = (LAS float*)(L + O_VEC); LAS float* gnl = (LAS float*)(L + O_GN); LAS float* part = (LAS float*)(L + O_PART);
        *(LAS u32x4*)(L + O_Q + (tid >> 3) * 144 + (tid & 7) * 16) = pq; *(LAS u32x4*)(L + O_K + (tid >> 3) * 144 + (tid & 7) * 16) = pk;
        *(LAS u32x4*)(L + O_V + (tid >> 4) * 272 + (tid & 15) * 16) = pv0; *(LAS u32x4*)(L + O_V + (32 + (tid >> 4)) * 272 + (tid & 15) * 16) = pv1;
        *(LAS u32x4*)(L + O_C + (tid >> 3) * 144 + (tid & 7) * 16) = pc0; *(LAS u32x4*)(L + O_C + (64 + (tid >> 3)) * 144 + (tid & 7) * 16) = pc1;
        if (tid < 384) vec[tid] = pvec;
        const float mc = pmc; u32x2 opv[4];
#pragma unroll
        for (int gq = 0; gq < 4; ++gq) opv[gq] = popv[gq];
        __syncthreads();
        { const int nit = (item + G < 4096) ? item + G : item; OUT_LOAD(nit); }
        const int t = 32 * tb + r;
        const float Mt = fmaxf(mc, vec[128 + t]), bt = vec[64 + t];
        bf16x8 qf[4];
#pragma unroll
        for (int st = 0; st < 4; ++st) qf[st] = *(const LAS bf16x8*)(L + O_Q + t * 144 + (16 * st + 8 * h2) * 2);
        float qn = 0.f;
#pragma unroll
        for (int st = 0; st < 4; ++st) { const u32x4 qq = __builtin_bit_cast(u32x4, qf[st]); const f32x4 n0 = *(const LAS f32x4*)(vec + 192 + 16 * st + 8 * h2), n1 = *(const LAS f32x4*)(vec + 192 + 16 * st + 8 * h2 + 4);
#pragma unroll
            for (int e = 0; e < 2; ++e) { qn += bf_lo(qq[e]) * n0[2 * e] + bf_hi(qq[e]) * n0[2 * e + 1]; qn += bf_lo(qq[2 + e]) * n1[2 * e] + bf_hi(qq[2 + e]) * n1[2 * e + 1]; } }
        qn += __shfl_xor(qn, 32);
        f32x16 acc1, acc2;
#pragma unroll
        for (int i = 0; i < 16; ++i) { acc1[i] = 0.f; acc2[i] = 0.f; }
        float dsum = 0.f;
#pragma unroll
        for (int sb = 0; sb < 2; ++sb) {
            if (sb <= tb) {
                f32x16 S;
#pragma unroll
                for (int i = 0; i < 16; ++i) S[i] = 0.f;
#pragma unroll
                for (int st = 0; st < 4; ++st) { const bf16x8 kf = *(const LAS bf16x8*)(L + O_K + (32 * sb + r) * 144 + (16 * st + 8 * h2) * 2); S = MFMA32(kf, qf[st], S); }
#pragma unroll
                for (int gq = 0; gq < 4; ++gq) { const f32x4 a4 = *(const LAS f32x4*)(vec + 32 * sb + 8 * gq + 4 * h2);
#pragma unroll
                    for (int k = 0; k < 4; ++k) { const int i = 4 * gq + k, s = 32 * sb + 8 * gq + 4 * h2 + k; const float ev = __builtin_amdgcn_exp2f(fminf(a4[k] - Mt, 0.f) * 1.4426950408889634f);
                        const float wgt = (s <= t) ? ev : 0.f; S[i] = wgt * S[i]; dsum += S[i]; } }
#pragma unroll
                for (int sp = 0; sp < 2; ++sp) {
                    u32x4 wv; wv.x = pk2(S[8 * sp + 0], S[8 * sp + 1]); wv.y = pk2(S[8 * sp + 2], S[8 * sp + 3]); wv.z = pk2(S[8 * sp + 4], S[8 * sp + 5]); wv.w = pk2(S[8 * sp + 6], S[8 * sp + 7]);
                    const bf16x8 pfr = __builtin_bit_cast(bf16x8, wv);
                    const LAS unsigned char* vp = L + O_V + (32 * sb + 16 * sp + 4 * h2 + ((lane & 15) >> 2)) * 272 + (32 * dvb + 16 * ((lane >> 4) & 1) + 4 * (lane & 3)) * 2;
                    const s16x4 lo = tr_read(vp), hi = tr_read(vp + 8 * 272);
                    const bf16x8 af = __builtin_shufflevector(lo, hi, 0, 1, 2, 3, 4, 5, 6, 7);
                    acc1 = MFMA32(af, pfr, acc1);
                }
            }
        }
        dsum += __shfl_xor(dsum, 32);
#pragma unroll
        for (int st = 0; st < 4; ++st) { const bf16x8 cf = *(const LAS bf16x8*)(L + O_C + (32 * dvb + r) * 144 + (16 * st + 8 * h2) * 2); acc2 = MFMA32(cf, qf[st], acc2); }
        const float winter = __expf(mc - Mt);
        const float den = dsum + winter * qn;
        const float dnm = fmaxf(fabsf(den), __expf(-(bt + Mt)));
        const float idn = 1.0f / dnm;
        float hsq = 0.f;
#pragma unroll
        for (int i = 0; i < 16; ++i) { acc1[i] = (acc1[i] + winter * acc2[i]) * idn; hsq += acc1[i] * acc1[i]; }
        hsq += __shfl_xor(hsq, 32);
        if (h2 == 0) part[dvb * 64 + t] = hsq;
        __syncthreads();
        const float tot = (part[t] + part[64 + t]) + (part[128 + t] + part[192 + t]);
        const float rsn = 1.0f / sqrtf(tot * (1.0f / 128.0f) + RMS_EPS);
        const size_t orow = (t0 + t) * 1024 + h * 128 + 32 * dvb + 4 * h2;
#pragma unroll
        for (int gq = 0; gq < 4; ++gq) {
            const u32x2 op = opv[gq]; const f32x4 gn = *(const LAS f32x4*)(gnl + 32 * dvb + 4 * h2 + 8 * gq);
            const float y0 = acc1[4 * gq + 0] * rsn * gn[0] * sigmoid_f(bf_lo(op.x)), y1 = acc1[4 * gq + 1] * rsn * gn[1] * sigmoid_f(bf_hi(op.x));
            const float y2 = acc1[4 * gq + 2] * rsn * gn[2] * sigmoid_f(bf_lo(op.y)), y3 = acc1[4 * gq + 3] * rsn * gn[3] * sigmoid_f(bf_hi(op.y));
            u32x2 wv; wv.x = pk2(y0, y1); wv.y = pk2(y2, y3); *(u32x2*)(MX + orow + 8 * gq) = wv;
        }
    }
    __syncthreads();
#undef OUT_LOAD
}
__device__ __forceinline__ void final_phase(float* __restrict__ out, const float* __restrict__ ss, const float* __restrict__ gain, int G, int bid) {
    const int gt = bid * 512 + threadIdx.x, NGT = G * 512;
    for (int i = gt; i < T_TOK * 256; i += NGT) { const int t = i >> 8, c4 = i & 255; const float rs = rs_from_ss(ss[t]);
        f32x4 v = *(f32x4*)(out + (size_t)t * 1024 + 4 * c4); const f32x4 gn = *(const f32x4*)(gain + 4 * c4); v = v * rs * gn; *(f32x4*)(out + (size_t)t * 1024 + 4 * c4) = v; }
}

__global__ void __launch_bounds__(NWAVES * 64, 2) mega_fwd(Args A) {
    extern __shared__ __attribute__((aligned(16))) unsigned char lds_raw[];
    LAS unsigned char* lds = (LAS unsigned char*)lds_raw;
    cg::grid_group grid = cg::this_grid();
    const int G = gridDim.x, bid = blockIdx.x;
    unsigned char* ws = A.ws;
    float* ss = (float*)(ws + WS_SS);
    bf16* hb = (bf16*)(ws + WS_HB); bf16* MX = (bf16*)(ws + WS_MX);
    bf16* QKVh = (bf16*)(ws + WS_BIG); float* H = (float*)(ws + WS_H); bf16* ACT = (bf16*)(ws + WS_ACT); bf16* P2 = (bf16*)(ws + WS_ACT);
    bf16* Oh = (bf16*)A.out; bf16* Cst = (bf16*)A.out; bf16* OP = (bf16*)A.out + (size_t)32 * 1024 * 1024;
    float* lse = (float*)(ws + WS_LSE); float* gates = (float*)(ws + WS_GATES); float* rope = (float*)(ws + WS_ROPE);
    float* mst = (float*)(ws + WS_MST); float* nst = (float*)(ws + WS_NST);
    bf16* QKc = hb;
    float* GA = (float*)(ws + 460 * MiB); float* GB = GA + (size_t)T_TOK * 8; float* GP = GB + (size_t)T_TOK * 8; float* CH = GP + (size_t)T_TOK * 8;
    const int lo = A.ph_lo, hi = A.ph_hi;
    volatile LAS unsigned* MISC = (volatile LAS unsigned*)(lds + LDS_BYTES - 256);
    if (threadIdx.x < 16) MISC[threadIdx.x] = 0u;
    __syncthreads();
    const XcdBarrier bar = xcd_barrier_post((unsigned*)(ws + WS_BAR), MISC + 8);
#ifndef PROBE_MASK
#define PROBE_MASK 0u
#endif
#define PROBE_K 4ull
    unsigned long long pr_sum = 0ull, pr_t0 = 0ull, pr_s0 = 0ull;
#define PB(k) do { if (PROBE_MASK & (1u << (k))) pr_t0 = __builtin_amdgcn_s_memrealtime(); } while (0)
#define PE(k) do { if (PROBE_MASK & (1u << (k))) pr_sum += __builtin_amdgcn_s_memrealtime() - pr_t0; } while (0)
#define IN(k) (lo <= (k) && (k) < hi)
#define SYNC(k) do { if (IN(k) && IN((k) + 1)) { if (PROBE_MASK & (1u << 30)) pr_s0 = __builtin_amdgcn_s_memrealtime(); if (hi < 0) { __threadfence(); grid.sync(); __threadfence(); } else xcd_barrier(bar); if (PROBE_MASK & (1u << 30)) pr_sum += __builtin_amdgcn_s_memrealtime() - pr_s0; if (PROBE_MASK & (1u << 29)) { pr_s0 = __builtin_amdgcn_s_memrealtime(); xcd_barrier(bar); pr_sum += __builtin_amdgcn_s_memrealtime() - pr_s0; } } PE(k); } while (0)
    PB(0); if (IN(0)) p0_prologue(A, lds, G, bid);
    SYNC(0);
    PB(1); if (IN(1)) { pg8::Gemm g{hb, (const bf16*)(ws + WS_WQKV), THALF, 9216, 1024}; pg8::StaticOrder S; S.init(THALF, 9216, G, bid);
        pg8::EpiQKV E{QKVh, ss, rope}; pg8::gemm_phase<pg8::EpiQKV, pg8::StaticOrder, true, true>(lds, g, S, E); }
    SYNC(1);
    PB(2); if (IN(2)) attn_phase(lds, QKVh, Oh, lse, 0, G, bid);
    SYNC(2);
    PB(3); if (IN(3)) { merge_phase(Oh, lse, MX, 0, G, bid);
        pg8::Gemm g{hb + (size_t)THALF * 1024, (const bf16*)(ws + WS_WQKV), THALF, 9216, 1024}; pg8::StaticOrder S; S.init(THALF, 9216, G, bid);
        pg8::EpiQKV E{QKVh, ss + THALF, rope + (size_t)THALF * 32}; pg8::gemm_phase<pg8::EpiQKV, pg8::StaticOrder, true, true>(lds, g, S, E); }
    SYNC(3);
    PB(4); if (IN(4)) attn_phase(lds, QKVh, Oh, lse, 1, G, bid);
    SYNC(4);
    PB(5); if (IN(5)) merge_phase(Oh, lse, MX, 1, G, bid);
    SYNC(5);
    PB(6); if (IN(6)) { pg8::Gemm g{MX, (const bf16*)(ws + WS_WAO), T_TOK, 1024, 1024}; pg8::StaticOrder S; S.init(T_TOK, 1024, G, bid);
        pg8::EpiResid E{A.x, H, hb, ss + T_TOK}; pg8::gemm_phase<pg8::EpiResid, pg8::StaticOrder, true, true>(lds, g, S, E); }
    SYNC(6);
    PB(7); if (IN(7)) { pg8::Gemm g{hb, (const bf16*)(ws + WS_WFFIN), T_TOK, 5632, 1024}; pg8::StaticOrder S; S.init(T_TOK, 5632, G, bid);
        pg8::EpiSwiGLU E{ACT, ss + T_TOK}; pg8::gemm_phase<pg8::EpiSwiGLU, pg8::StaticOrder, true, true>(lds, g, S, E); }
    SYNC(7);
    PB(8); if (IN(8)) { pg8::Gemm g{ACT, (const bf16*)(ws + WS_WFFOUT), T_TOK, 1024, DFF}; pg8::StaticOrder S; S.init(T_TOK, 1024, G, bid);
        pg8::EpiResid E{H, H, hb, ss + 2 * T_TOK}; pg8::gemm_phase<pg8::EpiResid, pg8::StaticOrder, true, true>(lds, g, S, E); }
    SYNC(8);
    PB(9); if (IN(9)) { pg8::Gemm g{hb, (const bf16*)(ws + WS_WMIN), T_TOK, 3328, 1024}; pg8::StaticOrder S; S.init(T_TOK, 3328, G, bid);
        pg8::EpiMlstmIn E{P2, OP, gates, ss + 2 * T_TOK}; pg8::gemm_phase<pg8::EpiMlstmIn, pg8::StaticOrder, true, true>(lds, g, S, E); }
    SYNC(9);
    PB(10); if (IN(10)) { mlstm_pre_phase(P2, gates, A.conv_w, A.conv_b, A.ig_bias, A.fg_bias, QKc, GA, GB, GP, CH, G, bid); xcd_barrier(bar);
        mlstm_scan_phase(lds, P2, QKc, GA, CH, Cst, nst, mst, G, bid); }
    SYNC(10);
    PB(11); if (IN(11)) mlstm_out_phase(lds, P2, QKc, OP, GA, GB, GP, A.head_gain, Cst, nst, mst, MX, G, bid);
    SYNC(11);
    PB(12); if (IN(12)) { pg8::Gemm g{MX, (const bf16*)(ws + WS_WMOUT), T_TOK, 1024, 1024}; pg8::StaticOrder S; S.init(T_TOK, 1024, G, bid);
        pg8::EpiResid E{H, H, hb, ss + 3 * T_TOK}; pg8::gemm_phase<pg8::EpiResid, pg8::StaticOrder, true, true>(lds, g, S, E); }
    SYNC(12);
    PB(13); if (IN(13)) { pg8::Gemm g{hb, (const bf16*)(ws + WS_WFFIN) + (size_t)5632 * 1024, T_TOK, 5632, 1024}; pg8::StaticOrder S; S.init(T_TOK, 5632, G, bid);
        pg8::EpiSwiGLU E{ACT, ss + 3 * T_TOK}; pg8::gemm_phase<pg8::EpiSwiGLU, pg8::StaticOrder, true, true>(lds, g, S, E); }
    SYNC(13);
    PB(14); if (IN(14)) { pg8::Gemm g{ACT, (const bf16*)(ws + WS_WFFOUT) + (size_t)1024 * DFF, T_TOK, 1024, DFF}; pg8::StaticOrder S; S.init(T_TOK, 1024, G, bid);
        pg8::EpiResid E{H, A.out, nullptr, ss + 4 * T_TOK}; pg8::gemm_phase<pg8::EpiResid, pg8::StaticOrder, true, true>(lds, g, S, E); }
    SYNC(14);
    PB(15); if (IN(15)) final_phase(A.out, ss + 4 * T_TOK, A.final_norm, G, bid);
    PE(15);
    if (PROBE_MASK != 0u && bid == 0 && threadIdx.x == 0) { const unsigned long long te = __builtin_amdgcn_s_memrealtime(); while (__builtin_amdgcn_s_memrealtime() - te < PROBE_K * pr_sum) __builtin_amdgcn_s_sleep(8); }
#undef IN
#undef SYNC
}

extern "C" void kernel_launch(void* const* d_in, const int* in_sizes, int n_in, void* d_out, int out_size, void* d_ws, size_t ws_size, hipStream_t stream) {
    static int grid = 0;
    if (grid == 0) {
        if (n_in != 17 || in_sizes[0] != T_TOK * DM || out_size != T_TOK * DM || ws_size < WS_END) { fprintf(stderr, "kernel_launch: unexpected shapes (n_in %d, in0 %d, out %d, ws %zu); nothing launched\n", n_in, n_in > 0 ? in_sizes[0] : -1, out_size, ws_size); grid = -1; return; }
        int dev = 0, cus = 0, per_cu = 0;
        if (hipGetDevice(&dev) != hipSuccess || hipDeviceGetAttribute(&cus, hipDeviceAttributeMultiprocessorCount, dev) != hipSuccess) { grid = -1; return; }
        if (hipFuncSetAttribute((const void*)mega_fwd, hipFuncAttributeMaxDynamicSharedMemorySize, LDS_BYTES) != hipSuccess) { fprintf(stderr, "kernel_launch: hipFuncSetAttribute failed\n"); grid = -1; return; }
        if (hipOccupancyMaxActiveBlocksPerMultiprocessor(&per_cu, (const void*)mega_fwd, NWAVES * 64, LDS_BYTES) != hipSuccess || per_cu < 1) { fprintf(stderr, "kernel_launch: occupancy query says %d\n", per_cu); per_cu = 1; }
        (void)hipGetLastError();
        grid = cus;
    }
    if (grid < 0) return;
    Args a{};
    a.x = (const float*)d_in[0]; a.pos = (const int*)d_in[1]; a.attn_norm = (const float*)d_in[2]; a.attn_w_in = (const float*)d_in[3]; a.attn_w_out = (const float*)d_in[4];
    a.mlstm_norm = (const float*)d_in[5]; a.mlstm_w_in = (const float*)d_in[6]; a.conv_w = (const float*)d_in[7]; a.conv_b = (const float*)d_in[8]; a.ig_bias = (const float*)d_in[9];
    a.fg_bias = (const float*)d_in[10]; a.head_gain = (const float*)d_in[11]; a.mlstm_w_out = (const float*)d_in[12]; a.ffn_norm = (const float*)d_in[13]; a.ffn_w_in = (const float*)d_in[14];
    a.ffn_w_out = (const float*)d_in[15]; a.final_norm = (const float*)d_in[16];
    a.out = (float*)d_out; a.ws = (unsigned char*)d_ws; a.ph_lo = 0; a.ph_hi = 16;
    if (hipMemsetAsync((char*)d_ws + WS_BAR, 0, 16384, stream) != hipSuccess) { fprintf(stderr, "kernel_launch: hipMemsetAsync failed\n"); return; }
    void* args[] = {&a};
    const hipError_t e = hipLaunchCooperativeKernel((const void*)mega_fwd, dim3(grid), dim3(NWAVES * 64), args, LDS_BYTES, stream);
    if (e != hipSuccess) fprintf(stderr, "kernel_launch: cooperative launch failed: %s (grid %d)\n", hipGetErrorString(e), grid);
}
```

```cpp
#include <hip/hip_runtime.h>
#include <hip/hip_cooperative_groups.h>
#include <cstdio>
#include <cstdint>
namespace cg = cooperative_groups;

constexpr float RMS_EPS = 1e-6f;
__device__ __forceinline__ float rs_from_ss(float ss) { return 1.0f / sqrtf(ss * (1.0f / 1024.0f) + RMS_EPS); }
__device__ __forceinline__ float silu_f(float x) { return x / (1.0f + __expf(-x)); }
__device__ __forceinline__ float sigmoid_f(float x) { return 1.0f / (1.0f + __expf(-x)); }

namespace pg8 {
#define PG8_LAS __attribute__((address_space(3)))
typedef unsigned short bf16_t;
typedef short bf16x8 __attribute__((ext_vector_type(8)));
typedef float f32x4 __attribute__((ext_vector_type(4)));
typedef unsigned u32x4 __attribute__((ext_vector_type(4)));
constexpr int BM = 256, BK = 64, HALF = 128, HTB = HALF * BK * 2  , STAGE_BYTES = 8 * HTB, NXCD = 8, WGM = 8;

__host__ __device__ __forceinline__ int lds_byte(int r, int c) { const int st = (r >> 4) * 2 + (c >> 5), rr = r & 15, cc = c & 31, ob = rr * 64 + cc * 2; return st * 1024 + (ob ^ (((ob >> 9) & 1) << 5)); }
__host__ __device__ __forceinline__ void stage_rc(int b, int& R, int& C) { const int st = b / 1024, sb = b % 1024, swz = sb ^ (((sb >> 9) & 1) << 5); R = (st >> 1) * 16 + swz / 64; C = (st & 1) * 32 + (swz % 64) / 2; }
__host__ __device__ __forceinline__ int perm32(int rho) { const int n = rho >> 4, i = rho & 15; return 8 * (i >> 2) + 4 * n + (i & 3); }

struct Unit { int pm, pn; };
struct Gemm { const bf16_t* A; const bf16_t* Bt; int M, N, K; };

struct StaticOrder {
    int nM, nN, nwg, G, c;
    __host__ __device__ void init(int M, int N, int G_, int c_) { nM = M / BM; nN = N / BM; nwg = nM * nN; G = G_; c = c_; }
    __host__ __device__ bool next(int i, Unit& u) const {
        const long L = (long)i * G + c; if (L >= nwg) return false;
        int wgid = (int)L; { const int q = nwg / NXCD, r = nwg % NXCD, xcd = wgid % NXCD, off = wgid / NXCD; wgid = (xcd < r ? xcd * (q + 1) : r * (q + 1) + (xcd - r) * q) + off; }
        const int nig = WGM * nN, gid = wgid / nig, fm = gid * WGM, gsz = (nM - fm) < WGM ? (nM - fm) : WGM;
        u.pm = fm + ((wgid % nig) % gsz); u.pn = (wgid % nig) / gsz; return true;
    }
    __device__ __forceinline__ void a_ready(const Unit&) const {}
    __device__ __forceinline__ void done(const Unit&) const {}
};
__device__ __forceinline__ unsigned cvt_pk_bf16(float lo, float hi) { unsigned r; asm volatile("v_cvt_pk_bf16_f32 %0, %1, %2" : "=v"(r) : "v"(lo), "v"(hi)); return r; }

struct EpiQKV {
    static constexpr bool PERM = true, AFTER_DRAIN = false;
    bf16_t* O; const float* ss; const float* cs;
    __device__ __forceinline__ void operator()(const f32x4 (&acc)[2][2][4][2], const Unit& u, int wr, int wc, int fr, int fq) const {
        const int row0 = u.pm * BM + wr * 64 + fr; const int colt = u.pn * BM;
        const int tsel = (colt % 3072) / 1024;
        const bool rope = (tsel < 2) && (wc == 0);
        const int gsel = colt / 3072, lg = 2 * gsel, dil = 1 << lg;
        const int hb0 = (gsel * 3 + tsel) * 8 + (colt % 1024) / 128;
        const float sgn = (fq < 2) ? -1.f : 1.f;
#pragma unroll
        for (int ai = 0; ai < 2; ++ai)
#pragma unroll
            for (int m = 0; m < 4; ++m) {
                const int row = row0 + ai * HALF + m * 16;
                const float rs = rs_from_ss(ss[row]);
                f32x4 c0 = {0.f, 0.f, 0.f, 0.f}, c1 = c0, s0 = c0, s1 = c0;
                if (rope) { const float* p = cs + (size_t)row * 32 + 8 * (fq & 1); c0 = *(const f32x4*)p; c1 = *(const f32x4*)(p + 4); s0 = *(const f32x4*)(p + 16); s1 = *(const f32x4*)(p + 20); }
                const int sq = row & 2047, perm = ((sq & (dil - 1)) << (11 - lg)) + (sq >> lg);
                bf16_t* rowp = O + ((size_t)hb0 * 17408 + (row >> 11) * 2176 + perm) * 128 + wc * 32 + 8 * fq;
#pragma unroll
                for (int bj = 0; bj < 2; ++bj) {
                    f32x4 v0 = acc[ai][bj][m][0], v1 = acc[ai][bj][m][1];
                    if (rope) {
                        f32x4 o0, o1;
#pragma unroll
                        for (int e = 0; e < 4; ++e) { o0[e] = __shfl_xor(v0[e], 32); o1[e] = __shfl_xor(v1[e], 32); }
                        v0 = v0 * c0 + (o0 * s0) * sgn; v1 = v1 * c1 + (o1 * s1) * sgn;
                    }
                    v0 = v0 * rs; v1 = v1 * rs;
                    u32x4 wv; wv.x = cvt_pk_bf16(v0[0], v0[1]); wv.y = cvt_pk_bf16(v0[2], v0[3]); wv.z = cvt_pk_bf16(v1[0], v1[1]); wv.w = cvt_pk_bf16(v1[2], v1[3]);
                    *(u32x4*)(rowp + (size_t)bj * 17408 * 128) = wv;
                }
            }
    }
};
struct EpiResid {
    static constexpr bool PERM = true, AFTER_DRAIN = false;
    const float* base; float* out; bf16_t* outb; float* ssn;
    __device__ __forceinline__ void operator()(const f32x4 (&acc)[2][2][4][2], const Unit& u, int wr, int wc, int fr, int fq) const {
        const int row0 = u.pm * BM + wr * 64 + fr; const int col0 = u.pn * BM + wc * 32 + 8 * fq;
#pragma unroll
        for (int ai = 0; ai < 2; ++ai)
#pragma unroll
            for (int m = 0; m < 4; ++m) {
                const int row = row0 + ai * HALF + m * 16; float sq = 0.f;
#pragma unroll
                for (int bj = 0; bj < 2; ++bj) {
                    const size_t off = (size_t)row * 1024 + col0 + bj * HALF;
                    const f32x4 r0 = *(const f32x4*)(base + off), r1 = *(const f32x4*)(base + off + 4);
                    const f32x4 v0 = acc[ai][bj][m][0] + r0, v1 = acc[ai][bj][m][1] + r1;
                    *(f32x4*)(out + off) = v0; *(f32x4*)(out + off + 4) = v1;
                    if (outb) { u32x4 wv; wv.x = cvt_pk_bf16(v0[0], v0[1]); wv.y = cvt_pk_bf16(v0[2], v0[3]); wv.z = cvt_pk_bf16(v1[0], v1[1]); wv.w = cvt_pk_bf16(v1[2], v1[3]); *(u32x4*)(outb + off) = wv; }
                    sq += (v0[0] * v0[0] + v0[1] * v0[1]) + (v0[2] * v0[2] + v0[3] * v0[3]) + (v1[0] * v1[0] + v1[1] * v1[1]) + (v1[2] * v1[2] + v1[3] * v1[3]);
                }
                sq += __shfl_xor(sq, 16); sq += __shfl_xor(sq, 32);
                if (fq == 0) atomicAdd(ssn + row, sq);
            }
    }
};
struct EpiSwiGLU {
    static constexpr bool PERM = true, AFTER_DRAIN = false;
    bf16_t* O; const float* ss;
    __device__ __forceinline__ void operator()(const f32x4 (&acc)[2][2][4][2], const Unit& u, int wr, int wc, int fr, int fq) const {
        const int row0 = u.pm * BM + wr * 64 + fr; const int col0 = u.pn * HALF + wc * 32 + 8 * fq;
#pragma unroll
        for (int ai = 0; ai < 2; ++ai)
#pragma unroll
            for (int m = 0; m < 4; ++m) {
                const int row = row0 + ai * HALF + m * 16;
                const float rs = rs_from_ss(ss[row]);
                float o[8];
#pragma unroll
                for (int n = 0; n < 2; ++n)
#pragma unroll
                    for (int e = 0; e < 4; ++e) { const float g = acc[ai][0][m][n][e] * rs, uu = acc[ai][1][m][n][e] * rs; o[4 * n + e] = silu_f(g) * uu; }
                u32x4 wv; wv.x = cvt_pk_bf16(o[0], o[1]); wv.y = cvt_pk_bf16(o[2], o[3]); wv.z = cvt_pk_bf16(o[4], o[5]); wv.w = cvt_pk_bf16(o[6], o[7]);
                *(u32x4*)(O + (size_t)row * 2816 + col0) = wv;
            }
    }
};
struct EpiMlstmIn {
    static constexpr bool PERM = true, AFTER_DRAIN = false;
    bf16_t* P2; bf16_t* OP; float* gates; const float* ss;
    __device__ __forceinline__ void operator()(const f32x4 (&acc)[2][2][4][2], const Unit& u, int wr, int wc, int fr, int fq) const {
        const int row0 = u.pm * BM + wr * 64 + fr;
#pragma unroll
        for (int ai = 0; ai < 2; ++ai)
#pragma unroll
            for (int m = 0; m < 4; ++m) {
                const int row = row0 + ai * HALF + m * 16;
                const float rs = rs_from_ss(ss[row]);
#pragma unroll
                for (int bj = 0; bj < 2; ++bj) {
                    const int cb = u.pn * BM + bj * HALF;
                    const f32x4 v0 = acc[ai][bj][m][0] * rs, v1 = acc[ai][bj][m][1] * rs;
                    const int cc = wc * 32 + 8 * fq;
                    if (cb < 3072) {
                        u32x4 wv; wv.x = cvt_pk_bf16(v0[0], v0[1]); wv.y = cvt_pk_bf16(v0[2], v0[3]); wv.z = cvt_pk_bf16(v1[0], v1[1]); wv.w = cvt_pk_bf16(v1[2], v1[3]);
                        bf16_t* dst = (cb < 2048) ? (P2 + (size_t)row * 2048 + cb + cc) : (OP + (size_t)row * 1024 + (cb - 2048) + cc);
                        *(u32x4*)dst = wv;
                    } else if (cb == 3072 && cc < 16) {
                        float* dst = gates + (size_t)row * 16 + cc;
                        *(f32x4*)dst = v0; *(f32x4*)(dst + 4) = v1;
                    }
                }
            }
    }
};

template <class Epi, class Sched, bool ALIGN_EPI = false, bool SP2 = false>
__device__ __forceinline__ void gemm_phase(PG8_LAS unsigned char* lds, const Gemm g, const Sched& S, const Epi& E) {
    const int tid = threadIdx.x, wid = __builtin_amdgcn_readfirstlane(tid >> 6), lane = tid & 63, wr = wid >> 2, wc = wid & 3, fr = lane & 15, fq = lane >> 4;
    const int K = g.K, nt = K / BK;
    unsigned voffA[2], voffB[2];
#pragma unroll
    for (int i = 0; i < 2; ++i) { int R, C; stage_rc(tid * 16 + i * 8192, R, C); const int Rb = Epi::PERM ? ((R & ~31) + perm32(R & 31)) : R;
        voffA[i] = (unsigned)(R * K + C) * 2u; voffB[i] = (unsigned)(Rb * K + C) * 2u; }
    const size_t kstep = (size_t)(BK * 2);
    const size_t hstep = (size_t)HALF * K * 2;
    const size_t tstep = 2 * hstep;
    const unsigned ldsw = (unsigned)wid * 1024u;
    const int aoff = lds_byte(wr * 64 + fr, fq * 8), boff = lds_byte(wc * 32 + fr, fq * 8);
#define PG8_SA(b, h) (((b) * 2 + (h)) * HTB)
#define PG8_SB(b, h) ((4 + (b) * 2 + (h)) * HTB)
#define PG8_STAGE(bufoff, gbase, voff) do { _Pragma("unroll") for (int _i = 0; _i < 2; ++_i) \
        __builtin_amdgcn_global_load_lds((const unsigned*)((const char*)(gbase) + (voff)[_i]), (PG8_LAS unsigned*)(lds + (bufoff) + ldsw + _i * 8192), 16, 0, 0); } while (0)
#define PG8_LDA(dst, b, h) do { _Pragma("unroll") for (int m = 0; m < 4; ++m) _Pragma("unroll") for (int k = 0; k < 2; ++k) dst[m][k] = *(const PG8_LAS bf16x8*)(lds + PG8_SA(b, h) + aoff + m * 2048 + k * 1024); } while (0)
#define PG8_LDB(dst, b, h) do { _Pragma("unroll") for (int n = 0; n < 2; ++n) _Pragma("unroll") for (int k = 0; k < 2; ++k) dst[n][k] = *(const PG8_LAS bf16x8*)(lds + PG8_SB(b, h) + boff + n * 2048 + k * 1024); } while (0)
#define PG8_MMA(ai, bj, At, Bt) do { __builtin_amdgcn_s_setprio(1); _Pragma("unroll") for (int m = 0; m < 4; ++m) _Pragma("unroll") for (int n = 0; n < 2; ++n) _Pragma("unroll") for (int k = 0; k < 2; ++k) \
        acc[ai][bj][m][n] = __builtin_amdgcn_mfma_f32_16x16x32_bf16(Bt[n][k], At[m][k], acc[ai][bj][m][n], 0, 0, 0); __builtin_amdgcn_s_setprio(0); } while (0)
#define PG8_WAIT_V(n) asm volatile("s_waitcnt vmcnt(" #n ")" ::: "memory")
#define PG8_WAIT_L(n) asm volatile("s_waitcnt lgkmcnt(" #n ")" ::: "memory")
#define PG8_BAR __builtin_amdgcn_s_barrier()
#define PG8_SCHED __builtin_amdgcn_sched_barrier(0)
    Unit cur, nxt; int ui = 0;
    if (!S.next(0, cur)) return;
    f32x4 acc[2][2][4][2];
#pragma unroll
    for (int a = 0; a < 2; ++a)
#pragma unroll
        for (int b = 0; b < 2; ++b)
#pragma unroll
            for (int m = 0; m < 4; ++m)
#pragma unroll
                for (int n = 0; n < 2; ++n) acc[a][b][m][n] = (f32x4){0.f, 0.f, 0.f, 0.f};
    bf16x8 At[4][2], B0[2][2], B1[2][2];
    const char* cA = (const char*)g.A + (size_t)cur.pm * tstep; const char* cB = (const char*)g.Bt + (size_t)cur.pn * tstep;
    S.a_ready(cur);
    if constexpr (SP2) {
        PG8_STAGE(PG8_SB(0, 0), cB, voffB); PG8_STAGE(PG8_SB(0, 1), cB + hstep, voffB); PG8_STAGE(PG8_SA(0, 0), cA, voffA); PG8_STAGE(PG8_SA(0, 1), cA + hstep, voffA);
        if (wr == 1) PG8_BAR;
        PG8_WAIT_V(2); PG8_BAR;
        PG8_STAGE(PG8_SB(1, 0), cB + kstep, voffB); PG8_STAGE(PG8_SA(1, 0), cA + kstep, voffA); PG8_STAGE(PG8_SB(1, 1), cB + hstep + kstep, voffB);
        PG8_WAIT_V(6); PG8_BAR;
    } else {
        PG8_STAGE(PG8_SB(0, 0), cB, voffB); PG8_STAGE(PG8_SA(0, 0), cA, voffA); PG8_STAGE(PG8_SB(0, 1), cB + hstep, voffB); PG8_STAGE(PG8_SA(0, 1), cA + hstep, voffA);
        if (wr == 1) PG8_BAR;
        PG8_WAIT_V(4); PG8_BAR;
        PG8_STAGE(PG8_SB(1, 0), cB + kstep, voffB); PG8_STAGE(PG8_SA(1, 0), cA + kstep, voffA); PG8_STAGE(PG8_SB(1, 1), cB + hstep + kstep, voffB);
        PG8_WAIT_V(6); PG8_BAR;
    }
    for (;;) {
        const bool has_next = S.next(ui + 1, nxt);
        const char* nA = has_next ? (const char*)g.A + (size_t)nxt.pm * tstep : cA; const char* nB = has_next ? (const char*)g.Bt + (size_t)nxt.pn * tstep : cB;
        for (int t = 0; t < nt; t += 2) {
            const bool last = (t == nt - 2);
            const char* a1 = cA + (size_t)(t + 1) * kstep;
            const char* a2 = last ? nA : cA + (size_t)(t + 2) * kstep; const char* b2 = last ? nB : cB + (size_t)(t + 2) * kstep;
            const char* a3 = a2 + kstep; const char* b3 = b2 + kstep;
            if (last && has_next) S.a_ready(nxt);
            if constexpr (SP2) {
            PG8_LDB(B0, 0, 0); PG8_LDB(B1, 0, 1); PG8_SCHED; PG8_LDA(At, 0, 0); PG8_STAGE(PG8_SA(1, 1), a1 + hstep, voffA);
            PG8_WAIT_V(8); PG8_WAIT_L(0); PG8_BAR; PG8_MMA(0, 0, At, B0); PG8_MMA(0, 1, At, B1); PG8_BAR; PG8_SCHED;
            PG8_LDA(At, 0, 1); PG8_STAGE(PG8_SB(0, 0), b2, voffB); PG8_STAGE(PG8_SB(0, 1), b2 + hstep, voffB); PG8_STAGE(PG8_SA(0, 0), a2, voffA);
            PG8_WAIT_V(8); PG8_WAIT_L(0); PG8_BAR; PG8_MMA(1, 0, At, B0); PG8_MMA(1, 1, At, B1); PG8_BAR; PG8_SCHED;
            PG8_LDB(B0, 1, 0); PG8_LDB(B1, 1, 1); PG8_SCHED; PG8_LDA(At, 1, 0); PG8_STAGE(PG8_SA(0, 1), a2 + hstep, voffA);
            PG8_WAIT_V(8); PG8_WAIT_L(0); PG8_BAR; PG8_MMA(0, 0, At, B0); PG8_MMA(0, 1, At, B1); PG8_BAR; PG8_SCHED;
            PG8_LDA(At, 1, 1); PG8_STAGE(PG8_SB(1, 0), b3, voffB); PG8_STAGE(PG8_SB(1, 1), b3 + hstep, voffB); PG8_STAGE(PG8_SA(1, 0), a3, voffA);
            PG8_WAIT_V(8); PG8_WAIT_L(0); PG8_BAR; PG8_MMA(1, 0, At, B0); PG8_MMA(1, 1, At, B1); PG8_BAR; PG8_SCHED;
            } else {
            PG8_LDB(B0, 0, 0); PG8_SCHED; PG8_LDA(At, 0, 0); PG8_STAGE(PG8_SA(1, 1), a1 + hstep, voffA);
            PG8_WAIT_L(8); PG8_BAR; PG8_WAIT_L(0); PG8_MMA(0, 0, At, B0); PG8_BAR; PG8_SCHED;
            PG8_LDB(B1, 0, 1); PG8_STAGE(PG8_SB(0, 0), b2, voffB);
            PG8_BAR; PG8_WAIT_L(0); PG8_MMA(0, 1, At, B1); PG8_BAR;
            PG8_LDA(At, 0, 1); PG8_STAGE(PG8_SA(0, 0), a2, voffA);
            PG8_BAR; PG8_WAIT_L(0); PG8_MMA(1, 0, At, B0); PG8_BAR; PG8_SCHED;
            PG8_STAGE(PG8_SB(0, 1), b2 + hstep, voffB);
            PG8_WAIT_V(6); PG8_BAR; PG8_MMA(1, 1, At, B1); PG8_BAR;
            PG8_LDB(B0, 1, 0); PG8_SCHED; PG8_LDA(At, 1, 0); PG8_STAGE(PG8_SA(0, 1), a2 + hstep, voffA);
            PG8_WAIT_L(8); PG8_BAR; PG8_WAIT_L(0); PG8_MMA(0, 0, At, B0); PG8_BAR; PG8_SCHED;
            PG8_LDB(B1, 1, 1); PG8_STAGE(PG8_SB(1, 0), b3, voffB);
            PG8_BAR; PG8_WAIT_L(0); PG8_MMA(0, 1, At, B1); PG8_BAR;
            PG8_LDA(At, 1, 1); PG8_STAGE(PG8_SA(1, 0), a3, voffA);
            PG8_BAR; PG8_WAIT_L(0); PG8_MMA(1, 0, At, B0); PG8_BAR; PG8_SCHED;
            PG8_STAGE(PG8_SB(1, 1), b3 + hstep, voffB);
            PG8_WAIT_V(6); PG8_BAR; PG8_MMA(1, 1, At, B1); PG8_BAR;
            }
        }
        if constexpr (ALIGN_EPI) { if (wr == 0) PG8_BAR; }
        if constexpr (!Epi::AFTER_DRAIN) { E(acc, cur, wr, wc, fr, fq); S.done(cur); }
        if (!has_next) break;
#pragma unroll
        for (int a = 0; a < 2; ++a)
#pragma unroll
            for (int b = 0; b < 2; ++b)
#pragma unroll
                for (int m = 0; m < 4; ++m)
#pragma unroll
                    for (int n = 0; n < 2; ++n) acc[a][b][m][n] = (f32x4){0.f, 0.f, 0.f, 0.f};
        cur = nxt; cA = nA; cB = nB; ++ui;
        if constexpr (ALIGN_EPI) { if (wr == 1) PG8_BAR; }
    }
    PG8_WAIT_V(0);
    if constexpr (!ALIGN_EPI) { if (wr == 0) PG8_BAR; }
    PG8_BAR;
    if constexpr (Epi::AFTER_DRAIN) { E.fused(acc, cur, wr, wc, fr, fq, lds, wid, lane); S.done(cur); }
#undef PG8_SA
#undef PG8_SB
#undef PG8_STAGE
#undef PG8_LDA
#undef PG8_LDB
#undef PG8_MMA
#undef PG8_WAIT_V
#undef PG8_WAIT_L
#undef PG8_BAR
#undef PG8_SCHED
}
}

constexpr int T_TOK = 32768, DM = 1024, SEQ = 2048, NB = 16, DFF = 2816, THALF = 16384;
constexpr int NWAVES = 8;
constexpr int RB = 2176, HBR = 8 * RB;
constexpr int LDS_BYTES = 147456;
constexpr size_t MiB = 1u << 20;
constexpr size_t WS_SS = 0;
constexpr size_t WS_MST = 1 * MiB;
constexpr size_t WS_NST = 1 * MiB + 65536;
constexpr size_t WS_BAR = 3 * MiB;
constexpr size_t WS_WQKV = 4 * MiB;
constexpr size_t WS_WAO = 22 * MiB;
constexpr size_t WS_WFFIN = 24 * MiB;
constexpr size_t WS_WFFOUT = 46 * MiB;
constexpr size_t WS_WMIN = 57 * MiB;
constexpr size_t WS_WMOUT = 64 * MiB;
constexpr size_t WS_ROPE = 66 * MiB;
constexpr size_t WS_LSE = 70 * MiB;
constexpr size_t WS_GATES = 73 * MiB;
constexpr size_t WS_HB = 76 * MiB;
constexpr size_t WS_MX = 140 * MiB;
constexpr size_t WS_BIG = 204 * MiB;
constexpr size_t WS_H = WS_BIG;
constexpr size_t WS_ACT = WS_BIG + 128 * MiB;
constexpr size_t WS_END = 512 * MiB;
static_assert(WS_ACT + (size_t)T_TOK * DFF * 2 <= WS_END && WS_BIG + (size_t)72 * 8 * 2176 * 256 <= WS_END, "d_ws map");

#define LAS __attribute__((address_space(3)))
typedef unsigned short bf16;
typedef unsigned u32x4 __attribute__((ext_vector_type(4)));
typedef unsigned u32x2 __attribute__((ext_vector_type(2)));
typedef float f32x4 __attribute__((ext_vector_type(4)));
typedef float f32x16 __attribute__((ext_vector_type(16)));
typedef short bf16x8 __attribute__((ext_vector_type(8)));
typedef short s16x4 __attribute__((ext_vector_type(4)));
typedef float f32x2_t __attribute__((ext_vector_type(2)));
typedef __bf16 bf16x2_t __attribute__((ext_vector_type(2)));
__device__ __forceinline__ unsigned pk2(float lo, float hi) { f32x2_t v = {lo, hi}; bf16x2_t b = __builtin_convertvector(v, bf16x2_t); return __builtin_bit_cast(unsigned, b); }
__device__ __forceinline__ float bf_lo(unsigned w) { return __uint_as_float(w << 16); }
__device__ __forceinline__ float bf_hi(unsigned w) { return __uint_as_float(w & 0xffff0000u); }
__device__ __forceinline__ float wave_sum(float v) {
#pragma unroll
    for (int o = 1; o < 64; o <<= 1) v += __shfl_xor(v, o);
    return v;
}
__device__ __forceinline__ float wave_max(float v) {
#pragma unroll
    for (int o = 1; o < 64; o <<= 1) v = fmaxf(v, __shfl_xor(v, o));
    return v;
}
#define MFMA16(a, b, c) __builtin_amdgcn_mfma_f32_16x16x32_bf16((a), (b), (c), 0, 0, 0)
#define MFMA32(a, b, c) __builtin_amdgcn_mfma_f32_32x32x16_bf16((a), (b), (c), 0, 0, 0)

#define XB_TMO      128
#define XB_XCNT(j)  (256  + 64 * (j))
#define XB_XSUB(j)  (1280 + 64 * (j))
#define XB_XGEN(j)  (2304 + 64 * (j))
#define XB_TOP      3328
#define XB_TOPGEN   3392
#define XCD_BAR_WORDS 3456
#define XB_SPIN_CAP (1u << 18)

__device__ __forceinline__ unsigned xb_ld(unsigned* p)              { return __hip_atomic_load(p, __ATOMIC_RELAXED, __HIP_MEMORY_SCOPE_AGENT); }
__device__ __forceinline__ unsigned xb_add(unsigned* p, unsigned v) { return __hip_atomic_fetch_add(p, v, __ATOMIC_RELAXED, __HIP_MEMORY_SCOPE_AGENT); }
__device__ __forceinline__ unsigned xb_xcc_id() { return (unsigned)__builtin_amdgcn_s_getreg((3 << 11) | 20) & 0xFu; }
#define XB_SPIN(cond, bar) do { unsigned _sp = 0; while (cond) { __builtin_amdgcn_s_sleep(1); \
    if ((++_sp & 255u) == 0u) { if (xb_ld(&(bar)[XB_TMO])) break; if (_sp > XB_SPIN_CAP) { atomicAdd(&(bar)[XB_TMO], 1u); break; } } } } while (0)

struct XcdBarrier {
    unsigned* bar; unsigned x;
    volatile LAS unsigned* st;
};

__device__ __forceinline__ XcdBarrier xcd_barrier_post(unsigned* bar, volatile LAS unsigned* st) {
    XcdBarrier b; b.bar = bar; b.x = xb_xcc_id(); b.st = st;
    if (threadIdx.x == 0) (void)xb_add(&bar[XB_XCNT(b.x)], 1u);
    return b;
}
__device__ __forceinline__ void xcd_barrier_complete(unsigned* bar, unsigned x, unsigned& nloc, unsigned& nx) {
    const unsigned G = gridDim.x * gridDim.y * gridDim.z;
    unsigned sum, cnt, mine, sp = 0u;
    for (;;) {
        sum = 0u; cnt = 0u; mine = 0u;
#pragma unroll
        for (unsigned j = 0; j < 16; ++j) { const unsigned c = xb_ld(&bar[XB_XCNT(j)]); sum += c; cnt += (c > 0u) ? 1u : 0u; mine = (j == x) ? c : mine; }
        if (sum == G) break;
        __builtin_amdgcn_s_sleep(1);
        if ((++sp & 255u) == 0u) { if (xb_ld(&bar[XB_TMO])) break; if (sp > XB_SPIN_CAP) { atomicAdd(&bar[XB_TMO], 1u); break; } }
    }
    nloc = mine > 0u ? mine : 1u; nx = cnt > 0u ? cnt : 1u;
}

__device__ __forceinline__ void xcd_barrier(const XcdBarrier& b) {
    asm volatile("s_waitcnt vmcnt(0)" ::: "memory");
    __syncthreads();
    if (threadIdx.x == 0) {
        unsigned* bar = b.bar;
        __builtin_amdgcn_s_waitcnt(0);
        unsigned nloc = b.st[0], nx = b.st[1];
        if (nloc == 0u) { xcd_barrier_complete(bar, b.x, nloc, nx); b.st[0] = nloc; b.st[1] = nx; }
        const unsigned old = xb_add(&bar[XB_XSUB(b.x)], 1u);
        const unsigned gen = old / nloc;
        if (old + 1u == (gen + 1u) * nloc) {
            __builtin_amdgcn_fence(__ATOMIC_RELEASE, "agent");
            asm volatile("s_waitcnt vmcnt(0)" ::: "memory");
            const unsigned og = xb_add(&bar[XB_TOP], 1u);
            const unsigned tg = og / nx;
            if (og + 1u == (tg + 1u) * nx) xb_add(&bar[XB_TOPGEN], 1u);
            else XB_SPIN(xb_ld(&bar[XB_TOPGEN]) == tg, bar);
            __builtin_amdgcn_fence(__ATOMIC_ACQUIRE, "agent");
            xb_add(&bar[XB_XGEN(b.x)], 1u);
            asm volatile("s_waitcnt vmcnt(0)" ::: "memory");
        } else {
            XB_SPIN(xb_ld(&bar[XB_XGEN(b.x)]) == gen, bar);
            __builtin_amdgcn_fence(__ATOMIC_ACQUIRE, "agent");
            asm volatile("s_waitcnt vmcnt(0)" ::: "memory");
        }
    }
    __syncthreads();
}


struct Args {
    const float* x; const int* pos; const float* attn_norm; const float* attn_w_in; const float* attn_w_out; const float* mlstm_norm; const float* mlstm_w_in;
    const float* conv_w; const float* conv_b; const float* ig_bias; const float* fg_bias; const float* head_gain; const float* mlstm_w_out;
    const float* ffn_norm; const float* ffn_w_in; const float* ffn_w_out; const float* final_norm;
    float* out; unsigned char* ws; int ph_lo, ph_hi;
};

__device__ __forceinline__ void tr_item(const float* __restrict__ W, int K, int Nsrc, bf16* WT, int n0_dst, int n0_src, int k0, const float* __restrict__ gain, float scale, LAS float* scr, int lane) {
    const int n4 = lane & 15, kq = lane >> 4; const int col = n0_src + 4 * n4; const bool ok = col < Nsrc;
    f32x4 v[16];
#pragma unroll
    for (int i = 0; i < 16; ++i) { v[i] = (f32x4){0.f, 0.f, 0.f, 0.f}; if (ok) v[i] = *(const f32x4*)(W + (size_t)(k0 + 4 * i + kq) * Nsrc + col); }
#pragma unroll
    for (int i = 0; i < 16; ++i) { const int kk = 4 * i + kq; const float g = gain ? gain[k0 + kk] * scale : scale; LAS float* d = scr + kk * 65 + 4 * n4;
        d[0] = v[i][0] * g; d[1] = v[i][1] * g; d[2] = v[i][2] * g; d[3] = v[i][3] * g; }
    asm volatile("s_waitcnt lgkmcnt(0)" ::: "memory");
    const int c = lane & 7;
#pragma unroll
    for (int j = 0; j < 8; ++j) { const int n = (lane >> 3) + 8 * j; const LAS float* sp = scr + (8 * c) * 65 + n;
        u32x4 o; o.x = pk2(sp[0 * 65], sp[1 * 65]); o.y = pk2(sp[2 * 65], sp[3 * 65]); o.z = pk2(sp[4 * 65], sp[5 * 65]); o.w = pk2(sp[6 * 65], sp[7 * 65]);
        *(u32x4*)(WT + (size_t)(n0_dst + n) * K + k0 + 8 * c) = o; }
    asm volatile("s_waitcnt lgkmcnt(0)" ::: "memory");
}
__device__ __forceinline__ void p0_prologue(const Args& A, LAS unsigned char* lds, int G, int bid) {
    const int tid = threadIdx.x, lane = tid & 63, wave = tid >> 6;
    LAS float* scr = (LAS float*)(lds + wave * 16640);
    const int gw = bid * NWAVES + wave, NGW = G * NWAVES;
    unsigned char* ws = A.ws;
    constexpr int I_QKV = 16 * 144, I_AO = 16 * 16, I_FFIN = 16 * 88, I_FFOUT = 44 * 16, I_MIN = 16 * 52, I_MOUT = 16 * 16;
    constexpr int NITEMS = I_QKV + I_AO + 2 * I_FFIN + 2 * I_FFOUT + I_MIN + I_MOUT;
    constexpr float QSCALE = 0.08838834764831845f * 1.4426950408889634f;
    for (int it = gw; it < NITEMS; it += NGW) {
        int r = it;
        if (r < I_QKV) { const int kb = r / 144, nb = r % 144, n0 = 64 * nb; const int tsel = (n0 % 3072) / 1024;
            tr_item(A.attn_w_in, 1024, 9216, (bf16*)(ws + WS_WQKV), n0, n0, 64 * kb, A.attn_norm, tsel == 0 ? QSCALE : 1.f, scr, lane); continue; } r -= I_QKV;
        if (r < I_AO) { const int kb = r / 16, nb = r % 16; tr_item(A.attn_w_out, 1024, 1024, (bf16*)(ws + WS_WAO), 64 * nb, 64 * nb, 64 * kb, nullptr, 1.f, scr, lane); continue; } r -= I_AO;
        if (r < 2 * I_FFIN) { const int l = r / I_FFIN; r -= l * I_FFIN; const int kb = r / 88, nb = r % 88, n0 = 64 * nb;
            const int pn = n0 >> 8, bj = (n0 >> 7) & 1, jj = n0 & 127; const int nsrc = (bj ? DFF : 0) + 128 * pn + jj;
            tr_item(A.ffn_w_in + (size_t)l * 1024 * 5632, 1024, 5632, (bf16*)(ws + WS_WFFIN) + (size_t)l * 5632 * 1024, n0, nsrc, 64 * kb, A.ffn_norm + l * 1024, 1.f, scr, lane); continue; } r -= 2 * I_FFIN;
        if (r < 2 * I_FFOUT) { const int l = r / I_FFOUT; r -= l * I_FFOUT; const int kb = r / 16, nb = r % 16;
            tr_item(A.ffn_w_out + (size_t)l * DFF * 1024, DFF, 1024, (bf16*)(ws + WS_WFFOUT) + (size_t)l * 1024 * DFF, 64 * nb, 64 * nb, 64 * kb, nullptr, 1.f, scr, lane); continue; } r -= 2 * I_FFOUT;
        if (r < I_MIN) { const int kb = r / 52, nb = r % 52; tr_item(A.mlstm_w_in, 1024, 3088, (bf16*)(ws + WS_WMIN), 64 * nb, 64 * nb, 64 * kb, A.mlstm_norm, 1.f, scr, lane); continue; } r -= I_MIN;
        { const int kb = r / 16, nb = r % 16; tr_item(A.mlstm_w_out, 1024, 1024, (bf16*)(ws + WS_WMOUT), 64 * nb, 64 * nb, 64 * kb, nullptr, 1.f, scr, lane); }
    }
    float* ss = (float*)(ws + WS_SS); bf16* hb = (bf16*)(ws + WS_HB);
    for (int m4 = gw; m4 < T_TOK / 4; m4 += NGW) {
        f32x4 v[4][4];
#pragma unroll
        for (int q = 0; q < 4; ++q) { const f32x4* xr = (const f32x4*)(A.x + (size_t)(4 * m4 + q) * DM) + lane;
#pragma unroll
            for (int j = 0; j < 4; ++j) v[q][j] = xr[64 * j]; }
#pragma unroll
        for (int q = 0; q < 4; ++q) { const int m = 4 * m4 + q; float sq = 0.f;
#pragma unroll
            for (int j = 0; j < 4; ++j) sq += (v[q][j].x * v[q][j].x + v[q][j].y * v[q][j].y) + (v[q][j].z * v[q][j].z + v[q][j].w * v[q][j].w);
            sq = wave_sum(sq);
            u32x2* o8 = (u32x2*)(hb + (size_t)m * DM) + lane;
#pragma unroll
            for (int j = 0; j < 4; ++j) { u32x2 o; o.x = pk2(v[q][j].x, v[q][j].y); o.y = pk2(v[q][j].z, v[q][j].w); o8[64 * j] = o; }
            if (lane == 0) ss[m] = sq; }
    }
    const int gt = bid * 512 + tid, NGT = G * 512;
    for (int i = gt; i < 4 * T_TOK; i += NGT) ss[T_TOK + i] = 0.f;
    float* rope = (float*)(ws + WS_ROPE);
    for (int i = gt; i < T_TOK * 16; i += NGT) {
        const int t = i >> 4, f = i & 15;
        const float invf = (float)exp2(-(double)f * (18.931568569324174 / 16.0));
        const float ang = (float)A.pos[t] * invf;
        const double rev = (double)ang * 0.15915494309189535; const float fr = (float)(rev - rint(rev));
        rope[(size_t)t * 32 + f] = __builtin_amdgcn_cosf(fr); rope[(size_t)t * 32 + 16 + f] = __builtin_amdgcn_sinf(fr);
    }
}

struct AStep { const bf16* base; size_t rowstride; int blk, g, h, dil, rr, b; bool valid, compute; };
__device__ __forceinline__ AStep attn_step(int u, int s, const bf16* QKVh) {
    AStep t; t.valid = true; t.compute = true;
    if (s < 5) { t.g = 0; t.dil = 1; t.rr = 0; const int qt = u & 3; t.h = (u >> 2) & 7; t.b = u >> 5; t.blk = 4 * qt + s - 1; if (s == 0) { t.compute = false; t.valid = qt > 0; if (!t.valid) t.blk = 0; } }
    else if (s < 9) { t.g = 1; t.dil = 4; t.h = u & 7; t.rr = (u >> 3) & 3; t.b = u >> 5; t.blk = s - 5; }
    else { t.g = 2; t.dil = 16; const int v = 4 * u + (s - 9); t.h = v & 7; t.rr = (v >> 3) & 15; t.b = v >> 7; t.blk = 0; }
    t.rowstride = 128;
    t.base = QKVh + ((size_t)(t.g * 24 + t.h) * HBR + t.b * RB + t.rr * (SEQ / t.dil)) * 128;
    return t;
}
typedef short v4i16_t __attribute__((ext_vector_type(4)));
__device__ __forceinline__ s16x4 tr_read(const LAS unsigned char* p) { return __builtin_bit_cast(s16x4, __builtin_amdgcn_ds_read_tr16_b64_v4i16((LAS v4i16_t*)p)); }
__device__ __forceinline__ void attn_phase(LAS unsigned char* lds, const bf16* __restrict__ QKVh, bf16* __restrict__ Oh, float* __restrict__ lse, int half, int G, int bid) {
    const int tid = threadIdx.x, lane = tid & 63, w = __builtin_amdgcn_readfirstlane(tid >> 6), r = lane & 15, q4 = lane >> 4;
    constexpr int SLOT = 34816;
#define ATT_LOAD(st) do { \
        _Pragma("unroll") for (int i = 0; i < 4; ++i) { const int chunk = tid + 512 * i, c = chunk >> 4, ch = chunk & 15; const bf16* gp = (st).base + (size_t)(128 * (st).blk + c) * (st).rowstride + 8 * ch; \
            kr[i] = *(const u32x4*)(gp + (size_t)8 * HBR * 128); vr[i] = *(const u32x4*)(gp + (size_t)16 * HBR * 128); } \
        { const bf16* qrow = (st).base + (size_t)(128 * (st).blk + 16 * w + r) * (st).rowstride; \
            _Pragma("unroll") for (int q = 0; q < 4; ++q) qn[q] = *(const bf16x8*)(qrow + 32 * q + 8 * q4); } } while (0)
    for (int u = bid; u < 256; u += G) {
        AStep nx = attn_step(u, 0, QKVh);
        u32x4 kr[4], vr[4]; bf16x8 qn[4];
#pragma unroll
        for (int i = 0; i < 4; ++i) { kr[i] = (u32x4){0u, 0u, 0u, 0u}; vr[i] = kr[i]; qn[i] = (bf16x8){0, 0, 0, 0, 0, 0, 0, 0}; }
        ATT_LOAD(nx);
        for (int s = 0; s < 13; ++s) {
            const AStep cu = nx; const int cs = s & 1;
            LAS unsigned char* Kc = lds + cs * SLOT; LAS unsigned char* Vc = lds + 2 * SLOT + cs * SLOT;
#pragma unroll
            for (int i = 0; i < 4; ++i) { const int chunk = tid + 512 * i, c = chunk >> 4, ch = chunk & 15; *(LAS u32x4*)(Kc + c * 272 + ch * 16) = kr[i]; *(LAS u32x4*)(Vc + c * 272 + ch * 16) = vr[i]; }
            bf16x8 qf[4];
#pragma unroll
            for (int q = 0; q < 4; ++q) qf[q] = qn[q];
            __syncthreads();
            { nx = attn_step(u, (s + 1 < 13) ? s + 1 : 12, QKVh); ATT_LOAD(nx); }
            if (cu.compute) {
                const bool first = (cu.blk == 0);
                const LAS unsigned char* Kp = first ? Kc : lds + (cs ^ 1) * SLOT; const LAS unsigned char* Vp = first ? Vc : lds + 2 * SLOT + (cs ^ 1) * SLOT;
                const int a = 16 * w + r;
                const int jlo = first ? 8 : 0;
                f32x4 S[9]; float mx = -INFINITY;
#pragma unroll
                for (int jj = 0; jj < 9; ++jj) { const int j = w + jj; S[jj] = (f32x4){0.f, 0.f, 0.f, 0.f};
                    if (j >= jlo) { const LAS unsigned char* kp = (j >= 8 ? Kc : Kp) + ((j & 7) * 16 + r) * 272 + 16 * q4;
#pragma unroll
                        for (int st = 0; st < 4; ++st) { const bf16x8 kf = *(const LAS bf16x8*)(kp + 64 * st); S[jj] = MFMA16(kf, qf[st], S[jj]); } }
#pragma unroll
                    for (int i = 0; i < 4; ++i) { bool valid = (j >= jlo);
                        if (jj == 0) valid = valid && (4 * q4 + i >= r);
                        if (jj == 8) valid = valid && (4 * q4 + i <= r);
                        S[jj][i] = valid ? S[jj][i] : -INFINITY; mx = fmaxf(mx, S[jj][i]); } }
                mx = fmaxf(mx, __shfl_xor(mx, 16)); mx = fmaxf(mx, __shfl_xor(mx, 32));
                float den = 0.f;
#pragma unroll
                for (int jj = 0; jj < 9; ++jj)
#pragma unroll
                    for (int i = 0; i < 4; ++i) { const float pe = __builtin_amdgcn_exp2f(S[jj][i] - mx); S[jj][i] = pe; den += pe; }
                den += __shfl_xor(den, 16); den += __shfl_xor(den, 32);
                bf16x8 pf[5];
#pragma unroll
                for (int p = 0; p < 5; ++p) { u32x4 wv; wv.x = pk2(S[2 * p][0], S[2 * p][1]); wv.y = pk2(S[2 * p][2], S[2 * p][3]);
                    if (2 * p + 1 < 9) { wv.z = pk2(S[(2 * p + 1) % 9][0], S[(2 * p + 1) % 9][1]); wv.w = pk2(S[(2 * p + 1) % 9][2], S[(2 * p + 1) % 9][3]); } else { wv.z = 0u; wv.w = 0u; }
                    pf[p] = __builtin_bit_cast(bf16x8, wv); }
                f32x4 o[8];
#pragma unroll
                for (int db = 0; db < 8; ++db) o[db] = (f32x4){0.f, 0.f, 0.f, 0.f};
#pragma unroll
                for (int p = 0; p < 5; ++p) { const int j0 = w + 2 * p, j1 = (j0 + 1 > 15) ? 15 : j0 + 1;
                    if (j0 + 1 >= jlo) {
                        const LAS unsigned char* v0p = (j0 >= 8 ? Vc : Vp) + ((j0 & 7) * 16 + 4 * q4 + (r >> 2)) * 272 + 8 * (r & 3);
                        const LAS unsigned char* v1p = (j1 >= 8 ? Vc : Vp) + ((j1 & 7) * 16 + 4 * q4 + (r >> 2)) * 272 + 8 * (r & 3);
#pragma unroll
                        for (int db = 0; db < 8; ++db) {
                            const s16x4 lo = tr_read(v0p + 32 * db), hi = tr_read(v1p + 32 * db);
                            const bf16x8 af = __builtin_shufflevector(lo, hi, 0, 1, 2, 3, 4, 5, 6, 7);
                            o[db] = MFMA16(af, pf[p], o[db]); } } }
                const float inv = 1.0f / den;
                const int tl = cu.b * SEQ + (128 * cu.blk + a) * cu.dil + cu.rr;
                bf16* orow = Oh + ((size_t)(cu.g * 8 + cu.h) * HBR + cu.b * RB + cu.rr * (SEQ / cu.dil) + 128 * cu.blk + a) * 128 + 4 * q4;
#pragma unroll
                for (int db = 0; db < 8; ++db) { u32x2 wv; wv.x = pk2(o[db][0] * inv, o[db][1] * inv); wv.y = pk2(o[db][2] * inv, o[db][3] * inv); *(u32x2*)(orow + 16 * db) = wv; }
                if (q4 == 0) lse[((size_t)cu.g * T_TOK + (size_t)half * THALF + tl) * 8 + cu.h] = mx * 0.6931471805599453f + __logf(den);
            }
            __syncthreads();
        }
    }
#undef ATT_LOAD
}
__device__ __forceinline__ void merge_phase(const bf16* __restrict__ Oh, const float* __restrict__ lse, bf16* __restrict__ MX, int half, int G, int bid) {
    const int gt = bid * 512 + threadIdx.x, NGT = G * 512;
    for (int i = gt; i < THALF * 128; i += NGT) {
        const int tl = i >> 7, ch = i & 127, h = ch >> 4; const size_t tg = (size_t)half * THALF + tl;
        const float l0 = lse[((size_t)0 * T_TOK + tg) * 8 + h], l1 = lse[((size_t)1 * T_TOK + tg) * 8 + h], l2 = lse[((size_t)2 * T_TOK + tg) * 8 + h];
        const float mxl = fmaxf(l0, fmaxf(l1, l2)); float w0 = __expf(l0 - mxl), w1 = __expf(l1 - mxl), w2 = __expf(l2 - mxl); const float inv = 1.0f / (w0 + w1 + w2); w0 *= inv; w1 *= inv; w2 *= inv;
        const int sq = tl & 2047, bb = (tl >> 11) * RB, dch = ch & 15;
        const int p1 = ((sq & 3) << 9) + (sq >> 2), p2 = ((sq & 15) << 7) + (sq >> 4);
        const u32x4 a = *(const u32x4*)(Oh + ((size_t)(0 + h) * HBR + bb + sq) * 128 + 8 * dch), b = *(const u32x4*)(Oh + ((size_t)(8 + h) * HBR + bb + p1) * 128 + 8 * dch), c = *(const u32x4*)(Oh + ((size_t)(16 + h) * HBR + bb + p2) * 128 + 8 * dch);
        u32x4 o;
#pragma unroll
        for (int e = 0; e < 4; ++e) o[e] = pk2(w0 * bf_lo(a[e]) + w1 * bf_lo(b[e]) + w2 * bf_lo(c[e]), w0 * bf_hi(a[e]) + w1 * bf_hi(b[e]) + w2 * bf_hi(c[e]));
        *(u32x4*)(MX + tg * 1024 + 8 * ch) = o;
    }
}
__device__ __forceinline__ float logsigmoid_f(float x) { return fminf(x, 0.f) - __logf(1.0f + __expf(-fabsf(x))); }
__device__ __forceinline__ void mlstm_pre_phase(const bf16* __restrict__ P2, const float* __restrict__ gates, const float* __restrict__ convw, const float* __restrict__ convb, const float* __restrict__ igb, const float* __restrict__ fgb,
                                                bf16* __restrict__ QKc, float* __restrict__ GA, float* __restrict__ GB, float* __restrict__ GP, float* __restrict__ CH, int G, int bid) {
    const int tid = threadIdx.x, lane = tid & 63, wave = tid >> 6;
    const int gt = bid * 512 + tid, NGT = G * 512;
    for (int it = gt; it < (T_TOK / 8) * 128; it += NGT) {
        const int ch = it & 127, tg = it >> 7; const int t0 = 8 * tg, sq0 = t0 & 2047; const int col = 8 * ch;
        float cw[4][8], cb[8];
#pragma unroll
        for (int q = 0; q < 2; ++q) { const f32x4 b4 = *(const f32x4*)(convb + col + 4 * q);
#pragma unroll
            for (int e = 0; e < 4; ++e) cb[4 * q + e] = b4[e];
#pragma unroll
            for (int j = 0; j < 4; ++j) { const f32x4 w4 = *(const f32x4*)(convw + j * 1024 + col + 4 * q);
#pragma unroll
                for (int e = 0; e < 4; ++e) cw[j][4 * q + e] = w4[e]; } }
        u32x4 rw[11];
#pragma unroll
        for (int i = 0; i < 11; ++i) { rw[i] = (u32x4){0u, 0u, 0u, 0u}; if (sq0 + i - 3 >= 0) rw[i] = *(const u32x4*)(P2 + (size_t)(t0 + i - 3) * 2048 + col); }
        const float ksc = (ch >= 64) ? 0.125f : 1.0f;
#pragma unroll
        for (int i = 0; i < 8; ++i) { u32x4 o;
#pragma unroll
            for (int e = 0; e < 4; ++e) { float x0 = cb[2 * e], x1 = cb[2 * e + 1];
#pragma unroll
                for (int j = 0; j < 4; ++j) { x0 += cw[j][2 * e] * bf_lo(rw[i + j][e]); x1 += cw[j][2 * e + 1] * bf_hi(rw[i + j][e]); }
                o[e] = pk2(silu_f(x0) * ksc, silu_f(x1) * ksc); }
            *(u32x4*)(QKc + (size_t)(t0 + i) * 1024 + col) = o; }
    }
    const int gw = bid * NWAVES + wave, NGW = G * NWAVES;
    for (int it = gw; it < NB * 32; it += NGW) {
        const int c = it & 31, b = it >> 5; const size_t t = (size_t)b * SEQ + 64 * c + lane;
        f32x4 g4[4];
#pragma unroll
        for (int q = 0; q < 4; ++q) g4[q] = *(const f32x4*)(gates + t * 16 + 4 * q);
        float bs[8], av[8], pm[8];
#pragma unroll
        for (int h = 0; h < 8; ++h) bs[h] = logsigmoid_f(g4[2 + (h >> 2)][h & 3] + fgb[h]);
#pragma unroll
        for (int o = 1; o < 64; o <<= 1) {
#pragma unroll
            for (int h = 0; h < 8; ++h) { const float v = __shfl_up(bs[h], o); if (lane >= o) bs[h] += v; } }
#pragma unroll
        for (int h = 0; h < 8; ++h) { av[h] = g4[h >> 2][h & 3] + igb[h] - bs[h]; pm[h] = av[h]; }
#pragma unroll
        for (int o = 1; o < 64; o <<= 1) {
#pragma unroll
            for (int h = 0; h < 8; ++h) { const float v = __shfl_up(pm[h], o); if (lane >= o) pm[h] = fmaxf(pm[h], v); } }
#pragma unroll
        for (int h = 0; h < 8; ++h) { const size_t o = (size_t)(b * 8 + h) * SEQ + 64 * c + lane; GA[o] = av[h]; GB[o] = bs[h]; GP[o] = pm[h];
            if (lane == 63) { const size_t cid = (size_t)(b * 8 + h) * 32 + c; CH[2 * cid] = bs[h]; CH[2 * cid + 1] = bs[h] + pm[h]; } }
    }
}
__device__ __forceinline__ void mlstm_scan_phase(LAS unsigned char* lds, const bf16* __restrict__ P2, const bf16* __restrict__ QKc, const float* __restrict__ GA, const float* __restrict__ CH,
                                                 bf16* __restrict__ Cst, float* __restrict__ nst, float* __restrict__ mst, int G, int bid) {
    const int tid = threadIdx.x, lane = tid & 63, w = __builtin_amdgcn_readfirstlane(tid >> 6), r = lane & 15, q4 = lane >> 4;
    const int dvb = w & 3, dkh = w >> 2;
    const bf16x8 ones = {0x3F80, 0x3F80, 0x3F80, 0x3F80, 0x3F80, 0x3F80, 0x3F80, 0x3F80};
    for (int item = bid; item < 256; item += G) {
        const int dvh = item & 1, h = (item >> 1) & 7, b = item >> 4;
        const size_t cid0 = (size_t)(b * 8 + h) * 32;
        f32x4 acc[2], accn[2]; acc[0] = (f32x4){0.f, 0.f, 0.f, 0.f}; acc[1] = acc[0]; accn[0] = acc[0]; accn[1] = acc[0];
        float mcar = 0.f;
        u32x4 nk, nv; float na, nbl, nml;
#define MSCAN_LOAD(c) do { const size_t t_ = (size_t)b * SEQ + 64 * (c) + lane; nk = *(const u32x4*)(QKc + t_ * 1024 + 512 + h * 64 + 8 * w); nv = *(const u32x4*)(P2 + t_ * 2048 + 1024 + h * 128 + 64 * dvh + 8 * w); \
            na = GA[(size_t)(b * 8 + h) * SEQ + 64 * (c) + lane]; nbl = CH[2 * (cid0 + (c))]; nml = CH[2 * (cid0 + (c)) + 1]; } while (0)
        MSCAN_LOAD(0);
        for (int c = 0; c < 32; ++c) {
            const u32x4 ck = nk, cv = nv; const float as = na, blast = nbl, mloc = nml;
            if (c + 1 < 32) MSCAN_LOAD(c + 1);
            const float mnew = fmaxf(blast + mcar, mloc);
            const float wsv = __expf(blast + as - mnew), carry = __expf(blast + mcar - mnew);
            const size_t cid = cid0 + c;
#pragma unroll
            for (int nb = 0; nb < 2; ++nb)
#pragma unroll
                for (int i = 0; i < 4; ++i) { const int dv = 64 * dvh + 16 * dvb + 4 * q4 + i, dk = 32 * dkh + 16 * nb + r;
                    Cst[(cid * 128 + dv) * 64 + dk] = (bf16)(pk2(acc[nb][i], 0.f) & 0xffffu); }
            if (dvh == 0 && dvb == 0 && q4 == 0) { nst[cid * 64 + 32 * dkh + r] = accn[0][0]; nst[cid * 64 + 32 * dkh + 16 + r] = accn[1][0]; }
            if (dvh == 0 && tid == 0) mst[cid] = mcar;
            LAS unsigned char* Kw = lds + (c & 1) * 18432; LAS unsigned char* Vs = Kw + 9216;
            u32x4 kw;
#pragma unroll
            for (int e = 0; e < 4; ++e) kw[e] = pk2(bf_lo(ck[e]) * wsv, bf_hi(ck[e]) * wsv);
            *(LAS u32x4*)(Kw + lane * 144 + 16 * w) = kw; *(LAS u32x4*)(Vs + lane * 144 + 16 * w) = cv;
            __syncthreads();
            acc[0] = acc[0] * carry; acc[1] = acc[1] * carry; accn[0] = accn[0] * carry; accn[1] = accn[1] * carry;
#pragma unroll
            for (int st = 0; st < 2; ++st) {
                const int rowb = (32 * st + 8 * q4 + (r >> 2)) * 144 + 8 * (r & 3);
                const s16x4 alo = tr_read(Vs + rowb + 32 * dvb), ahi = tr_read(Vs + rowb + 4 * 144 + 32 * dvb);
                const bf16x8 af = __builtin_shufflevector(alo, ahi, 0, 1, 2, 3, 4, 5, 6, 7);
#pragma unroll
                for (int nb = 0; nb < 2; ++nb) {
                    const s16x4 blo = tr_read(Kw + rowb + 64 * dkh + 32 * nb), bhi = tr_read(Kw + rowb + 4 * 144 + 64 * dkh + 32 * nb);
                    const bf16x8 bfr = __builtin_shufflevector(blo, bhi, 0, 1, 2, 3, 4, 5, 6, 7);
                    acc[nb] = MFMA16(af, bfr, acc[nb]);
                    if (dvb == 0) accn[nb] = MFMA16(ones, bfr, accn[nb]); }
            }
            mcar = mnew;
        }
        __syncthreads();
#undef MSCAN_LOAD
    }
}
__device__ __forceinline__ void mlstm_out_phase(LAS unsigned char* lds, const bf16* __restrict__ P2, const bf16* __restrict__ QKc, const bf16* __restrict__ OP, const float* __restrict__ GA, const float* __restrict__ GB, const float* __restrict__ GP,
                                                const float* __restrict__ hgain, const bf16* __restrict__ Cst, const float* __restrict__ nst, const float* __restrict__ mst, bf16* __restrict__ MX, int G, int bid) {
    const int tid = threadIdx.x, lane = tid & 63, w = __builtin_amdgcn_readfirstlane(tid >> 6), r = lane & 31, h2 = lane >> 5;
    const int dvb = w & 3, tb = w >> 2;
    constexpr int O_Q = 0, O_K = 9216, O_V = 18432, O_C = 35840, O_VEC = 54272, O_GN = 55296, O_PART = 55808, SETB = 56832;
    u32x4 pq, pk, pv0, pv1, pc0, pc1; float pvec = 0.f, pgn = 0.f, pmc = 0.f; u32x2 popv[4];
    pq = (u32x4){0u, 0u, 0u, 0u}; pk = pq; pv0 = pq; pv1 = pq; pc0 = pq; pc1 = pq;
#pragma unroll
    for (int gq = 0; gq < 4; ++gq) popv[gq] = (u32x2){0u, 0u};
#define OUT_LOAD(it) do { const int c_ = (it) & 31, h_ = ((it) >> 5) & 7, b_ = (it) >> 8; const size_t t0_ = (size_t)b_ * SEQ + 64 * c_; const size_t gb_ = (size_t)(b_ * 8 + h_) * SEQ + 64 * c_; \
        { const bf16* p_ = QKc + (t0_ + (tid >> 3)) * 1024 + h_ * 64 + 8 * (tid & 7); pq = *(const u32x4*)p_; pk = *(const u32x4*)(p_ + 512); } \
        { const bf16* p_ = P2 + (t0_ + (tid >> 4)) * 2048 + 1024 + h_ * 128 + 8 * (tid & 15); pv0 = *(const u32x4*)p_; pv1 = *(const u32x4*)(p_ + (size_t)32 * 2048); } \
        { const bf16* p_ = Cst + ((size_t)(it) * 128 + (tid >> 3)) * 64 + 8 * (tid & 7); pc0 = *(const u32x4*)p_; pc1 = *(const u32x4*)(p_ + 64 * 64); } \
        { const int wh_ = tid >> 6, ix_ = tid & 63; const float* src_ = (wh_ == 0) ? (GA + gb_) : (wh_ == 1) ? (GB + gb_) : (wh_ == 2) ? (GP + gb_) : (wh_ == 3) ? (nst + (size_t)(it) * 64) : (hgain + h_ * 128 + ((wh_ & 1) << 6)); pvec = src_[ix_]; } \
        pmc = mst[(it)]; \
        { const size_t orow_ = (t0_ + 32 * tb + r) * 1024 + h_ * 128 + 32 * dvb + 4 * h2; _Pragma("unroll") for (int gq = 0; gq < 4; ++gq) popv[gq] = *(const u32x2*)(OP + orow_ + 8 * gq); } } while (0)
    { const int fit = (bid < 4096) ? bid : 0; OUT_LOAD(fit); }
    int par = 0;
    for (int item = bid; item < 4096; item += G, par ^= 1) {
        const int c = item & 31, h = (item >> 5) & 7, b = item >> 8;
        const size_t t0 = (size_t)b * SEQ + 64 * c;
        LAS unsigned char* L = lds + par * SETB;
        LAS float* vec = (LAS float*)(L + O_VEC); LAS float* gnl = (LAS float*)(L + O_GN); LAS float* part = (LAS float*)(L + O_PART);
        *(LAS u32x4*)(L + O_Q + (tid >> 3) * 144 + (tid & 7) * 16) = pq; *(LAS u32x4*)(L + O_K + (tid >> 3) * 144 + (tid & 7) * 16) = pk;
        *(LAS u32x4*)(L + O_V + (tid >> 4) * 272 + (tid & 15) * 16) = pv0; *(LAS u32x4*)(L + O_V + (32 + (tid >> 4)) * 272 + (tid & 15) * 16) = pv1;
        *(LAS u32x4*)(L + O_C + (tid >> 3) * 144 + (tid & 7) * 16) = pc0; *(LAS u32x4*)(L + O_C + (64 + (tid >> 3)) * 144 + (tid & 7) * 16) = pc1;
        if (tid < 384) vec[tid] = pvec;
        const float mc = pmc; u32x2 opv[4];
#pragma unroll
        for (int gq = 0; gq < 4; ++gq) opv[gq] = popv[gq];
        __syncthreads();
        { const int nit = (item + G < 4096) ? item + G : item; OUT_LOAD(nit); }
        const int t = 32 * tb + r;
        const float Mt = fmaxf(mc, vec[128 + t]), bt = vec[64 + t];
        bf16x8 qf[4];
#pragma unroll
        for (int st = 0; st < 4; ++st) qf[st] = *(const LAS bf16x8*)(L + O_Q + t * 144 + (16 * st + 8 * h2) * 2);
        float qn = 0.f;
#pragma unroll
        for (int st = 0; st < 4; ++st) { const u32x4 qq = __builtin_bit_cast(u32x4, qf[st]); const f32x4 n0 = *(const LAS f32x4*)(vec + 192 + 16 * st + 8 * h2), n1 = *(const LAS f32x4*)(vec + 192 + 16 * st + 8 * h2 + 4);
#pragma unroll
            for (int e = 0; e < 2; ++e) { qn += bf_lo(qq[e]) * n0[2 * e] + bf_hi(qq[e]) * n0[2 * e + 1]; qn += bf_lo(qq[2 + e]) * n1[2 * e] + bf_hi(qq[2 + e]) * n1[2 * e + 1]; } }
        qn += __shfl_xor(qn, 32);
        f32x16 acc1, acc2;
#pragma unroll
        for (int i = 0; i < 16; ++i) { acc1[i] = 0.f; acc2[i] = 0.f; }
        float dsum = 0.f;
#pragma unroll
        for (int sb = 0; sb < 2; ++sb) {
            if (sb <= tb) {
                f32x16 S;
#pragma unroll
                for (int i = 0; i < 16; ++i) S[i] = 0.f;
#pragma unroll
                for (int st = 0; st < 4; ++st) { const bf16x8 kf = *(const LAS bf16x8*)(L + O_K + (32 * sb + r) * 144 + (16 * st + 8 * h2) * 2); S = MFMA32(kf, qf[st], S); }
#pragma unroll
                for (int gq = 0; gq < 4; ++gq) { const f32x4 a4 = *(const LAS f32x4*)(vec + 32 * sb + 8 * gq + 4 * h2);
#pragma unroll
                    for (int k = 0; k < 4; ++k) { const int i = 4 * gq + k, s = 32 * sb + 8 * gq + 4 * h2 + k; const float ev = __builtin_amdgcn_exp2f(fminf(a4[k] - Mt, 0.f) * 1.4426950408889634f);
                        const float wgt = (s <= t) ? ev : 0.f; S[i] = wgt * S[i]; dsum += S[i]; } }
#pragma unroll
                for (int sp = 0; sp < 2; ++sp) {
                    u32x4 wv; wv.x = pk2(S[8 * sp + 0], S[8 * sp + 1]); wv.y = pk2(S[8 * sp + 2], S[8 * sp + 3]); wv.z = pk2(S[8 * sp + 4], S[8 * sp + 5]); wv.w = pk2(S[8 * sp + 6], S[8 * sp + 7]);
                    const bf16x8 pfr = __builtin_bit_cast(bf16x8, wv);
                    const LAS unsigned char* vp = L + O_V + (32 * sb + 16 * sp + 4 * h2 + ((lane & 15) >> 2)) * 272 + (32 * dvb + 16 * ((lane >> 4) & 1) + 4 * (lane & 3)) * 2;
                    const s16x4 lo = tr_read(vp), hi = tr_read(vp + 8 * 272);
                    const bf16x8 af = __builtin_shufflevector(lo, hi, 0, 1, 2, 3, 4, 5, 6, 7);
                    acc1 = MFMA32(af, pfr, acc1);
                }
            }
        }
        dsum += __shfl_xor(dsum, 32);
#pragma unroll
        for (int st = 0; st < 4; ++st) { const bf16x8 cf = *(const LAS bf16x8*)(L + O_C + (32 * dvb + r) * 144 + (16 * st + 8 * h2) * 2); acc2 = MFMA32(cf, qf[st], acc2); }
        const float winter = __expf(mc - Mt);
        const float den = dsum + winter * qn;
        const float dnm = fmaxf(fabsf(den), __expf(-(bt + Mt)));
        const float idn = 1.0f / dnm;
        float hsq = 0.f;
#pragma unroll
        for (int i = 0; i < 16; ++i) { acc1[i] = (acc1[i] + winter * acc2[i]) * idn; hsq += acc1[i] * acc1[i]; }
        hsq += __shfl_xor(hsq, 32);
        if (h2 == 0) part[dvb * 64 + t] = hsq;
        __syncthreads();
        const float tot = (part[t] + part[64 + t]) + (part[128 + t] + part[192 + t]);
        const float rsn = 1.0f / sqrtf(tot * (1.0f / 128.0f) + RMS_EPS);
        const size_t orow = (t0 + t) * 1024 + h * 128 + 32 * dvb + 4 * h2;
#pragma unroll
        for (int gq = 0; gq < 4; ++gq) {
            const u32x2 op = opv[gq]; const f32x4 gn = *(const LAS f32x4*)(gnl + 32 * dvb + 4 * h2 + 8 * gq);
            const float y0 = acc1[4 * gq + 0] * rsn * gn[0] * sigmoid_f(bf_lo(op.x)), y1 = acc1[4 * gq + 1] * rsn * gn[1] * sigmoid_f(bf_hi(op.x));
            const float y2 = acc1[4 * gq + 2] * rsn * gn[2] * sigmoid_f(bf_lo(op.y)), y3 = acc1[4 * gq + 3] * rsn * gn[3] * sigmoid_f(bf_hi(op.y));
            u32x2 wv; wv.x = pk2(y0, y1); wv.y = pk2(y2, y3); *(u32x2*)(MX + orow + 8 * gq) = wv;
        }
    }
    __syncthreads();
#undef OUT_LOAD
}
__device__ __forceinline__ void final_phase(float* __restrict__ out, const float* __restrict__ ss, const float* __restrict__ gain, int G, int bid) {
    const int gt = bid * 512 + threadIdx.x, NGT = G * 512;
    for (int i = gt; i < T_TOK * 256; i += NGT) { const int t = i >> 8, c4 = i & 255; const float rs = rs_from_ss(ss[t]);
        f32x4 v = *(f32x4*)(out + (size_t)t * 1024 + 4 * c4); const f32x4 gn = *(const f32x4*)(gain + 4 * c4); v = v * rs * gn; *(f32x4*)(out + (size_t)t * 1024 + 4 * c4) = v; }
}

__global__ void __launch_bounds__(NWAVES * 64, 2) mega_fwd(Args A) {
    extern __shared__ __attribute__((aligned(16))) unsigned char lds_raw[];
    LAS unsigned char* lds = (LAS unsigned char*)lds_raw;
    cg::grid_group grid = cg::this_grid();
    const int G = gridDim.x, bid = blockIdx.x;
    unsigned char* ws = A.ws;
    float* ss = (float*)(ws + WS_SS);
    bf16* hb = (bf16*)(ws + WS_HB); bf16* MX = (bf16*)(ws + WS_MX);
    bf16* QKVh = (bf16*)(ws + WS_BIG); float* H = (float*)(ws + WS_H); bf16* ACT = (bf16*)(ws + WS_ACT); bf16* P2 = (bf16*)(ws + WS_ACT);
    bf16* Oh = (bf16*)A.out; bf16* Cst = (bf16*)A.out; bf16* OP = (bf16*)A.out + (size_t)32 * 1024 * 1024;
    float* lse = (float*)(ws + WS_LSE); float* gates = (float*)(ws + WS_GATES); float* rope = (float*)(ws + WS_ROPE);
    float* mst = (float*)(ws + WS_MST); float* nst = (float*)(ws + WS_NST);
    bf16* QKc = hb;
    float* GA = (float*)(ws + 460 * MiB); float* GB = GA + (size_t)T_TOK * 8; float* GP = GB + (size_t)T_TOK * 8; float* CH = GP + (size_t)T_TOK * 8;
    const int lo = A.ph_lo, hi = A.ph_hi;
    volatile LAS unsigned* MISC = (volatile LAS unsigned*)(lds + LDS_BYTES - 256);
    if (threadIdx.x < 16) MISC[threadIdx.x] = 0u;
    __syncthreads();
    const XcdBarrier bar = xcd_barrier_post((unsigned*)(ws + WS_BAR), MISC + 8);
#ifndef PROBE_MASK
#define PROBE_MASK 0u
#endif
#define PROBE_K 4ull
    unsigned long long pr_sum = 0ull, pr_t0 = 0ull, pr_s0 = 0ull;
#define PB(k) do { if (PROBE_MASK & (1u << (k))) pr_t0 = __builtin_amdgcn_s_memrealtime(); } while (0)
#define PE(k) do { if (PROBE_MASK & (1u << (k))) pr_sum += __builtin_amdgcn_s_memrealtime() - pr_t0; } while (0)
#define IN(k) (lo <= (k) && (k) < hi)
#define SYNC(k) do { if (IN(k) && IN((k) + 1)) { if (PROBE_MASK & (1u << 30)) pr_s0 = __builtin_amdgcn_s_memrealtime(); if (hi < 0) { __threadfence(); grid.sync(); __threadfence(); } else xcd_barrier(bar); if (PROBE_MASK & (1u << 30)) pr_sum += __builtin_amdgcn_s_memrealtime() - pr_s0; if (PROBE_MASK & (1u << 29)) { pr_s0 = __builtin_amdgcn_s_memrealtime(); xcd_barrier(bar); pr_sum += __builtin_amdgcn_s_memrealtime() - pr_s0; } } PE(k); } while (0)
    PB(0); if (IN(0)) p0_prologue(A, lds, G, bid);
    SYNC(0);
    PB(1); if (IN(1)) { pg8::Gemm g{hb, (const bf16*)(ws + WS_WQKV), THALF, 9216, 1024}; pg8::StaticOrder S; S.init(THALF, 9216, G, bid);
        pg8::EpiQKV E{QKVh, ss, rope}; pg8::gemm_phase<pg8::EpiQKV, pg8::StaticOrder, true, true>(lds, g, S, E); }
    SYNC(1);
    PB(2); if (IN(2)) attn_phase(lds, QKVh, Oh, lse, 0, G, bid);
    SYNC(2);
    PB(3); if (IN(3)) { merge_phase(Oh, lse, MX, 0, G, bid);
        pg8::Gemm g{hb + (size_t)THALF * 1024, (const bf16*)(ws + WS_WQKV), THALF, 9216, 1024}; pg8::StaticOrder S; S.init(THALF, 9216, G, bid);
        pg8::EpiQKV E{QKVh, ss + THALF, rope + (size_t)THALF * 32}; pg8::gemm_phase<pg8::EpiQKV, pg8::StaticOrder, true, true>(lds, g, S, E); }
    SYNC(3);
    PB(4); if (IN(4)) attn_phase(lds, QKVh, Oh, lse, 1, G, bid);
    SYNC(4);
    PB(5); if (IN(5)) merge_phase(Oh, lse, MX, 1, G, bid);
    SYNC(5);
    PB(6); if (IN(6)) { pg8::Gemm g{MX, (const bf16*)(ws + WS_WAO), T_TOK, 1024, 1024}; pg8::StaticOrder S; S.init(T_TOK, 1024, G, bid);
        pg8::EpiResid E{A.x, H, hb, ss + T_TOK}; pg8::gemm_phase<pg8::EpiResid, pg8::StaticOrder, true, true>(lds, g, S, E); }
    SYNC(6);
    PB(7); if (IN(7)) { pg8::Gemm g{hb, (const bf16*)(ws + WS_WFFIN), T_TOK, 5632, 1024}; pg8::StaticOrder S; S.init(T_TOK, 5632, G, bid);
        pg8::EpiSwiGLU E{ACT, ss + T_TOK}; pg8::gemm_phase<pg8::EpiSwiGLU, pg8::StaticOrder, true, true>(lds, g, S, E); }
    SYNC(7);
    PB(8); if (IN(8)) { pg8::Gemm g{ACT, (const bf16*)(ws + WS_WFFOUT), T_TOK, 1024, DFF}; pg8::StaticOrder S; S.init(T_TOK, 1024, G, bid);
        pg8::EpiResid E{H, H, hb, ss + 2 * T_TOK}; pg8::gemm_phase<pg8::EpiResid, pg8::StaticOrder, true, true>(lds, g, S, E); }
    SYNC(8);
    PB(9); if (IN(9)) { pg8::Gemm g{hb, (const bf16*)(ws + WS_WMIN), T_TOK, 3328, 1024}; pg8::StaticOrder S; S.init(T_TOK, 3328, G, bid);
        pg8::EpiMlstmIn E{P2, OP, gates, ss + 2 * T_TOK}; pg8::gemm_phase<pg8::EpiMlstmIn, pg8::StaticOrder, true, true>(lds, g, S, E); }
    SYNC(9);
    PB(10); if (IN(10)) { mlstm_pre_phase(P2, gates, A.conv_w, A.conv_b, A.ig_bias, A.fg_bias, QKc, GA, GB, GP, CH, G, bid); xcd_barrier(bar);
        mlstm_scan_phase(lds, P2, QKc, GA, CH, Cst, nst, mst, G, bid); }
    SYNC(10);
    PB(11); if (IN(11)) mlstm_out_phase(lds, P2, QKc, OP, GA, GB, GP, A.head_gain, Cst, nst, mst, MX, G, bid);
    SYNC(11);
    PB(12); if (IN(12)) { pg8::Gemm g{MX, (const bf16*)(ws + WS_WMOUT), T_TOK, 1024, 1024}; pg8::StaticOrder S; S.init(T_TOK, 1024, G, bid);
        pg8::EpiResid E{H, H, hb, ss + 3 * T_TOK}; pg8::gemm_phase<pg8::EpiResid, pg8::StaticOrder, true, true>(lds, g, S, E); }
    SYNC(12);
    PB(13); if (IN(13)) { pg8::Gemm g{hb, (const bf16*)(ws + WS_WFFIN) + (size_t)5632 * 1024, T_TOK, 5632, 1024}; pg8::StaticOrder S; S.init(T_TOK, 5632, G, bid);
        pg8::EpiSwiGLU E{ACT, ss + 3 * T_TOK}; pg8::gemm_phase<pg8::EpiSwiGLU, pg8::StaticOrder, true, true>(lds, g, S, E); }
    SYNC(13);
    PB(14); if (IN(14)) { pg8::Gemm g{ACT, (const bf16*)(ws + WS_WFFOUT) + (size_t)1024 * DFF, T_TOK, 1024, DFF}; pg8::StaticOrder S; S.init(T_TOK, 1024, G, bid);
        pg8::EpiResid E{H, A.out, nullptr, ss + 4 * T_TOK}; pg8::gemm_phase<pg8::EpiResid, pg8::StaticOrder, true, true>(lds, g, S, E); }
    SYNC(14);
    PB(15); if (IN(15)) final_phase(A.out, ss + 4 * T_TOK, A.final_norm, G, bid);
    PE(15);
    if (PROBE_MASK != 0u && bid == 0 && threadIdx.x == 0) { const unsigned long long te = __builtin_amdgcn_s_memrealtime(); while (__builtin_amdgcn_s_memrealtime() - te < PROBE_K * pr_sum) __builtin_amdgcn_s_sleep(8); }
#undef IN
#undef SYNC
}

extern "C" void kernel_launch(void* const* d_in, const int* in_sizes, int n_in, void* d_out, int out_size, void* d_ws, size_t ws_size, hipStream_t stream) {
    static int grid = 0;
    if (grid == 0) {
        if (n_in != 17 || in_sizes[0] != T_TOK * DM || out_size != T_TOK * DM || ws_size < WS_END) { fprintf(stderr, "kernel_launch: unexpected shapes (n_in %d, in0 %d, out %d, ws %zu); nothing launched\n", n_in, n_in > 0 ? in_sizes[0] : -1, out_size, ws_size); grid = -1; return; }
        int dev = 0, cus = 0, per_cu = 0;
        if (hipGetDevice(&dev) != hipSuccess || hipDeviceGetAttribute(&cus, hipDeviceAttributeMultiprocessorCount, dev) != hipSuccess) { grid = -1; return; }
        if (hipFuncSetAttribute((const void*)mega_fwd, hipFuncAttributeMaxDynamicSharedMemorySize, LDS_BYTES) != hipSuccess) { fprintf(stderr, "kernel_launch: hipFuncSetAttribute failed\n"); grid = -1; return; }
        if (hipOccupancyMaxActiveBlocksPerMultiprocessor(&per_cu, (const void*)mega_fwd, NWAVES * 64, LDS_BYTES) != hipSuccess || per_cu < 1) { fprintf(stderr, "kernel_launch: occupancy query says %d\n", per_cu); per_cu = 1; }
        (void)hipGetLastError();
        grid = cus;
    }
    if (grid < 0) return;
    Args a{};
    a.x = (const float*)d_in[0]; a.pos = (const int*)d_in[1]; a.attn_norm = (const float*)d_in[2]; a.attn_w_in = (const float*)d_in[3]; a.attn_w_out = (const float*)d_in[4];
    a.mlstm_norm = (const float*)d_in[5]; a.mlstm_w_in = (const float*)d_in[6]; a.conv_w = (const float*)d_in[7]; a.conv_b = (const float*)d_in[8]; a.ig_bias = (const float*)d_in[9];
    a.fg_bias = (const float*)d_in[10]; a.head_gain = (const float*)d_in[11]; a.mlstm_w_out = (const float*)d_in[12]; a.ffn_norm = (const float*)d_in[13]; a.ffn_w_in = (const float*)d_in[14];
    a.ffn_w_out = (const float*)d_in[15]; a.final_norm = (const float*)d_in[16];
    a.out = (float*)d_out; a.ws = (unsigned char*)d_ws; a.ph_lo = 0; a.ph_hi = 16;
    if (hipMemsetAsync((char*)d_ws + WS_BAR, 0, 16384, stream) != hipSuccess) { fprintf(stderr, "kernel_launch: hipMemsetAsync failed\n"); return; }
    void* args[] = {&a};
    const hipError_t e = hipLaunchCooperativeKernel((const void*)mega_fwd, dim3(grid), dim3(NWAVES * 64), args, LDS_BYTES, stream);
    if (e != hipSuccess) fprintf(stderr, "kernel_launch: cooperative launch failed: %s (grid %d)\n", hipGetErrorString(e), grid);
}
```

```cpp
#include <hip/hip_runtime.h>
#include <hip/hip_cooperative_groups.h>
#include <cstdio>
#include <cstdint>
namespace cg = cooperative_groups;

constexpr float RMS_EPS = 1e-6f;
__device__ __forceinline__ float rs_from_ss(float ss) { return __builtin_amdgcn_rsqf(ss * (1.0f / 1024.0f) + RMS_EPS); }
__device__ __forceinline__ float silu_f(float x) { return x * __builtin_amdgcn_rcpf(1.0f + __builtin_amdgcn_exp2f(x * -1.4426950408889634f)); }
__device__ __forceinline__ float sigmoid_f(float x) { return __builtin_amdgcn_rcpf(1.0f + __builtin_amdgcn_exp2f(x * -1.4426950408889634f)); }

namespace pg8 {
#define PG8_LAS __attribute__((address_space(3)))
typedef unsigned short bf16_t;
typedef short bf16x8 __attribute__((ext_vector_type(8)));
typedef float f32x4 __attribute__((ext_vector_type(4)));
typedef unsigned u32x4 __attribute__((ext_vector_type(4)));
constexpr int BM = 256, BK = 64, HALF = 128, HTB = HALF * BK * 2  , STAGE_BYTES = 8 * HTB, NXCD = 8, WGM = 8;

__host__ __device__ __forceinline__ int lds_byte(int r, int c) { const int st = (r >> 4) * 2 + (c >> 5), rr = r & 15, cc = c & 31, ob = rr * 64 + cc * 2; return st * 1024 + (ob ^ (((ob >> 9) & 1) << 5)); }
__host__ __device__ __forceinline__ void stage_rc(int b, int& R, int& C) { const int st = b / 1024, sb = b % 1024, swz = sb ^ (((sb >> 9) & 1) << 5); R = (st >> 1) * 16 + swz / 64; C = (st & 1) * 32 + (swz % 64) / 2; }
__host__ __device__ __forceinline__ int perm32(int rho) { const int n = rho >> 4, i = rho & 15; return 8 * (i >> 2) + 4 * n + (i & 3); }

struct Unit { int pm, pn; };
struct Gemm { const bf16_t* A; const bf16_t* Bt; int M, N, K; };

struct StaticOrder {
    int nM, nN, nwg, G, c;
    __host__ __device__ void init(int M, int N, int G_, int c_) { nM = M / BM; nN = N / BM; nwg = nM * nN; G = G_; c = c_; }
    __host__ __device__ bool next(int i, Unit& u) const {
        const long L = (long)i * G + c; if (L >= nwg) return false;
        int wgid = (int)L; { const int q = nwg / NXCD, r = nwg % NXCD, xcd = wgid % NXCD, off = wgid / NXCD; wgid = (xcd < r ? xcd * (q + 1) : r * (q + 1) + (xcd - r) * q) + off; }
        const int nig = WGM * nN, gid = wgid / nig, fm = gid * WGM, gsz = (nM - fm) < WGM ? (nM - fm) : WGM;
        u.pm = fm + ((wgid % nig) % gsz); u.pn = (wgid % nig) / gsz; return true;
    }
    __device__ __forceinline__ void a_ready(const Unit&) const {}
    __device__ __forceinline__ void done(const Unit&) const {}
};
__device__ __forceinline__ unsigned cvt_pk_bf16(float lo, float hi) { unsigned r; asm volatile("v_cvt_pk_bf16_f32 %0, %1, %2" : "=v"(r) : "v"(lo), "v"(hi)); return r; }

#define EPI_FENCE() asm volatile("" ::: "memory")
struct EpiQKV {
    static constexpr bool PERM = true, AFTER_DRAIN = false;
    bf16_t* O; const float* ss; const float* cs;
    __device__ __forceinline__ void operator()(const f32x4 (&acc)[2][2][4][2], const Unit& u, int wr, int wc, int fr, int fq) const {
        const int row0 = u.pm * BM + wr * 64 + fr; const int colt = u.pn * BM;
        const int tsel = (colt % 3072) / 1024;
        const bool rope = (tsel < 2) && (wc == 0);
        const int gsel = colt / 3072, lg = 2 * gsel, dil = 1 << lg;
        const int hb0 = (gsel * 3 + tsel) * 8 + (colt % 1024) / 128;
        const float sgn = (fq < 2) ? -1.f : 1.f;
        float rsv[8];
#pragma unroll
        for (int k = 0; k < 8; ++k) rsv[k] = ss[row0 + (k >> 2) * HALF + (k & 3) * 16];
        f32x4 cA[4];
#pragma unroll
        for (int q = 0; q < 4; ++q) cA[q] = (f32x4){0.f, 0.f, 0.f, 0.f};
        if (rope) { const float* p = cs + (size_t)row0 * 32 + 8 * (fq & 1); cA[0] = *(const f32x4*)p; cA[1] = *(const f32x4*)(p + 4); cA[2] = *(const f32x4*)(p + 16); cA[3] = *(const f32x4*)(p + 20); }
#pragma unroll
        for (int k = 0; k < 8; ++k) {
            const int ai = k >> 2, m = k & 3;
            const int row = row0 + ai * HALF + m * 16;
            f32x4 cN[4];
#pragma unroll
            for (int q = 0; q < 4; ++q) cN[q] = cA[q];
            if (rope && k + 1 < 8) { const int rown = row0 + ((k + 1) >> 2) * HALF + ((k + 1) & 3) * 16; const float* p = cs + (size_t)rown * 32 + 8 * (fq & 1);
                cN[0] = *(const f32x4*)p; cN[1] = *(const f32x4*)(p + 4); cN[2] = *(const f32x4*)(p + 16); cN[3] = *(const f32x4*)(p + 20); }
            EPI_FENCE();
            const float rs = rs_from_ss(rsv[k]);
            const int sq = row & 2047, perm = ((sq & (dil - 1)) << (11 - lg)) + (sq >> lg);
            bf16_t* rowp = O + ((size_t)hb0 * 17408 + (row >> 11) * 2176 + perm) * 128 + wc * 32 + 8 * fq;
#pragma unroll
            for (int bj = 0; bj < 2; ++bj) {
                f32x4 v0 = acc[ai][bj][m][0], v1 = acc[ai][bj][m][1];
                if (rope) {
                    f32x4 o0, o1;
#pragma unroll
                    for (int e = 0; e < 4; ++e) { o0[e] = __shfl_xor(v0[e], 32); o1[e] = __shfl_xor(v1[e], 32); }
                    v0 = v0 * cA[0] + (o0 * cA[2]) * sgn; v1 = v1 * cA[1] + (o1 * cA[3]) * sgn;
                }
                v0 = v0 * rs; v1 = v1 * rs;
                u32x4 wv; wv.x = cvt_pk_bf16(v0[0], v0[1]); wv.y = cvt_pk_bf16(v0[2], v0[3]); wv.z = cvt_pk_bf16(v1[0], v1[1]); wv.w = cvt_pk_bf16(v1[2], v1[3]);
                *(u32x4*)(rowp + (size_t)bj * 17408 * 128) = wv;
            }
#pragma unroll
            for (int q = 0; q < 4; ++q) cA[q] = cN[q];
        }
    }
};
struct EpiResid {
    static constexpr bool PERM = true, AFTER_DRAIN = false;
    const float* base; float* out; bf16_t* outb; float* ssn;
    __device__ __forceinline__ void operator()(const f32x4 (&acc)[2][2][4][2], const Unit& u, int wr, int wc, int fr, int fq) const {
        const int row0 = u.pm * BM + wr * 64 + fr; const int col0 = u.pn * BM + wc * 32 + 8 * fq;
        f32x4 bA[4];
        { const float* p = base + (size_t)row0 * 1024 + col0; bA[0] = *(const f32x4*)p; bA[1] = *(const f32x4*)(p + 4); bA[2] = *(const f32x4*)(p + HALF); bA[3] = *(const f32x4*)(p + HALF + 4); }
#pragma unroll
        for (int k = 0; k < 8; ++k) {
            const int ai = k >> 2, m = k & 3;
            const int row = row0 + ai * HALF + m * 16;
            f32x4 bN[4];
#pragma unroll
            for (int q = 0; q < 4; ++q) bN[q] = bA[q];
            if (k + 1 < 8) { const int rown = row0 + ((k + 1) >> 2) * HALF + ((k + 1) & 3) * 16; const float* p = base + (size_t)rown * 1024 + col0;
                bN[0] = *(const f32x4*)p; bN[1] = *(const f32x4*)(p + 4); bN[2] = *(const f32x4*)(p + HALF); bN[3] = *(const f32x4*)(p + HALF + 4); }
            EPI_FENCE();
            float sq = 0.f;
#pragma unroll
            for (int bj = 0; bj < 2; ++bj) {
                const size_t off = (size_t)row * 1024 + col0 + bj * HALF;
                const f32x4 v0 = acc[ai][bj][m][0] + bA[2 * bj], v1 = acc[ai][bj][m][1] + bA[2 * bj + 1];
                *(f32x4*)(out + off) = v0; *(f32x4*)(out + off + 4) = v1;
                if (outb) { u32x4 wv; wv.x = cvt_pk_bf16(v0[0], v0[1]); wv.y = cvt_pk_bf16(v0[2], v0[3]); wv.z = cvt_pk_bf16(v1[0], v1[1]); wv.w = cvt_pk_bf16(v1[2], v1[3]); *(u32x4*)(outb + off) = wv; }
                sq += (v0[0] * v0[0] + v0[1] * v0[1]) + (v0[2] * v0[2] + v0[3] * v0[3]) + (v1[0] * v1[0] + v1[1] * v1[1]) + (v1[2] * v1[2] + v1[3] * v1[3]);
            }
            sq += __shfl_xor(sq, 16); sq += __shfl_xor(sq, 32);
            if (fq == 0) atomicAdd(ssn + row, sq);
#pragma unroll
            for (int q = 0; q < 4; ++q) bA[q] = bN[q];
        }
    }
};
struct EpiSwiGLU {
    static constexpr bool PERM = true, AFTER_DRAIN = false;
    bf16_t* O; const float* ss;
    __device__ __forceinline__ void operator()(const f32x4 (&acc)[2][2][4][2], const Unit& u, int wr, int wc, int fr, int fq) const {
        const int row0 = u.pm * BM + wr * 64 + fr; const int col0 = u.pn * HALF + wc * 32 + 8 * fq;
        float rsv[8];
#pragma unroll
        for (int k = 0; k < 8; ++k) rsv[k] = ss[row0 + (k >> 2) * HALF + (k & 3) * 16];
        EPI_FENCE();
#pragma unroll
        for (int ai = 0; ai < 2; ++ai)
#pragma unroll
            for (int m = 0; m < 4; ++m) {
                const int row = row0 + ai * HALF + m * 16;
                const float rs = rs_from_ss(rsv[ai * 4 + m]); const float rs2 = rs * rs, nrs = rs * -1.4426950408889634f;
                float o[8];
#pragma unroll
                for (int n = 0; n < 2; ++n)
#pragma unroll
                    for (int e = 0; e < 4; ++e) { const float g = acc[ai][0][m][n][e], uu = acc[ai][1][m][n][e] * rs2;
                        o[4 * n + e] = (g * uu) * __builtin_amdgcn_rcpf(1.0f + __builtin_amdgcn_exp2f(g * nrs)); }
                u32x4 wv; wv.x = cvt_pk_bf16(o[0], o[1]); wv.y = cvt_pk_bf16(o[2], o[3]); wv.z = cvt_pk_bf16(o[4], o[5]); wv.w = cvt_pk_bf16(o[6], o[7]);
                *(u32x4*)(O + (size_t)row * 2816 + col0) = wv;
            }
    }
};
struct EpiMlstmIn {
    static constexpr bool PERM = true, AFTER_DRAIN = false;
    bf16_t* P2; bf16_t* OP; float* gates; const float* ss;
    __device__ __forceinline__ void operator()(const f32x4 (&acc)[2][2][4][2], const Unit& u, int wr, int wc, int fr, int fq) const {
        const int row0 = u.pm * BM + wr * 64 + fr;
        float rsv[8];
#pragma unroll
        for (int k = 0; k < 8; ++k) rsv[k] = ss[row0 + (k >> 2) * HALF + (k & 3) * 16];
        EPI_FENCE();
#pragma unroll
        for (int ai = 0; ai < 2; ++ai)
#pragma unroll
            for (int m = 0; m < 4; ++m) {
                const int row = row0 + ai * HALF + m * 16;
                const float rs = rs_from_ss(rsv[ai * 4 + m]);
#pragma unroll
                for (int bj = 0; bj < 2; ++bj) {
                    const int cb = u.pn * BM + bj * HALF;
                    const f32x4 v0 = acc[ai][bj][m][0] * rs, v1 = acc[ai][bj][m][1] * rs;
                    const int cc = wc * 32 + 8 * fq;
                    if (cb < 3072) {
                        u32x4 wv; wv.x = cvt_pk_bf16(v0[0], v0[1]); wv.y = cvt_pk_bf16(v0[2], v0[3]); wv.z = cvt_pk_bf16(v1[0], v1[1]); wv.w = cvt_pk_bf16(v1[2], v1[3]);
                        bf16_t* dst = (cb < 2048) ? (P2 + (size_t)row * 2048 + cb + cc) : (OP + (size_t)row * 1024 + (cb - 2048) + cc);
                        *(u32x4*)dst = wv;
                    } else if (cb == 3072 && cc < 16) {
                        float* dst = gates + (size_t)row * 16 + cc;
                        *(f32x4*)dst = v0; *(f32x4*)(dst + 4) = v1;
                    }
                }
            }
    }
};

template <class Epi, class Sched, bool ALIGN_EPI = false, bool SP2 = false>
__device__ __forceinline__ void gemm_phase(PG8_LAS unsigned char* lds, const Gemm g, const Sched& S, const Epi& E) {
    const int tid = threadIdx.x, wid = __builtin_amdgcn_readfirstlane(tid >> 6), lane = tid & 63, wr = wid >> 2, wc = wid & 3, fr = lane & 15, fq = lane >> 4;
    const int K = g.K, nt = K / BK;
    unsigned voffA[2], voffB[2];
#pragma unroll
    for (int i = 0; i < 2; ++i) { int R, C; stage_rc(tid * 16 + i * 8192, R, C); const int Rb = Epi::PERM ? ((R & ~31) + perm32(R & 31)) : R;
        voffA[i] = (unsigned)(R * K + C) * 2u; voffB[i] = (unsigned)(Rb * K + C) * 2u; }
    const size_t kstep = (size_t)(BK * 2);
    const size_t hstep = (size_t)HALF * K * 2;
    const size_t tstep = 2 * hstep;
    const unsigned ldsw = (unsigned)wid * 1024u;
    const int aoff = lds_byte(wr * 64 + fr, fq * 8), boff = lds_byte(wc * 32 + fr, fq * 8);
#define PG8_SA(b, h) (((b) * 2 + (h)) * HTB)
#define PG8_SB(b, h) ((4 + (b) * 2 + (h)) * HTB)
#define PG8_STAGE(bufoff, gbase, voff) do { _Pragma("unroll") for (int _i = 0; _i < 2; ++_i) \
        __builtin_amdgcn_global_load_lds((const unsigned*)((const char*)(gbase) + (voff)[_i]), (PG8_LAS unsigned*)(lds + (bufoff) + ldsw + _i * 8192), 16, 0, 0); } while (0)
#define PG8_LDA(dst, b, h) do { _Pragma("unroll") for (int m = 0; m < 4; ++m) _Pragma("unroll") for (int k = 0; k < 2; ++k) dst[m][k] = *(const PG8_LAS bf16x8*)(lds + PG8_SA(b, h) + aoff + m * 2048 + k * 1024); } while (0)
#define PG8_LDB(dst, b, h) do { _Pragma("unroll") for (int n = 0; n < 2; ++n) _Pragma("unroll") for (int k = 0; k < 2; ++k) dst[n][k] = *(const PG8_LAS bf16x8*)(lds + PG8_SB(b, h) + boff + n * 2048 + k * 1024); } while (0)
#define PG8_MMA(ai, bj, At, Bt) do { __builtin_amdgcn_s_setprio(1); _Pragma("unroll") for (int m = 0; m < 4; ++m) _Pragma("unroll") for (int n = 0; n < 2; ++n) _Pragma("unroll") for (int k = 0; k < 2; ++k) \
        acc[ai][bj][m][n] = __builtin_amdgcn_mfma_f32_16x16x32_bf16(Bt[n][k], At[m][k], acc[ai][bj][m][n], 0, 0, 0); __builtin_amdgcn_s_setprio(0); } while (0)
#define PG8_WAIT_V(n) asm volatile("s_waitcnt vmcnt(" #n ")" ::: "memory")
#define PG8_WAIT_L(n) asm volatile("s_waitcnt lgkmcnt(" #n ")" ::: "memory")
#define PG8_BAR __builtin_amdgcn_s_barrier()
#define PG8_SCHED __builtin_amdgcn_sched_barrier(0)
    Unit cur, nxt; int ui = 0;
    if (!S.next(0, cur)) return;
    f32x4 acc[2][2][4][2];
#pragma unroll
    for (int a = 0; a < 2; ++a)
#pragma unroll
        for (int b = 0; b < 2; ++b)
#pragma unroll
            for (int m = 0; m < 4; ++m)
#pragma unroll
                for (int n = 0; n < 2; ++n) acc[a][b][m][n] = (f32x4){0.f, 0.f, 0.f, 0.f};
    bf16x8 At[4][2], B0[2][2], B1[2][2];
    const char* cA = (const char*)g.A + (size_t)cur.pm * tstep; const char* cB = (const char*)g.Bt + (size_t)cur.pn * tstep;
    S.a_ready(cur);
    if constexpr (SP2) {
        PG8_STAGE(PG8_SB(0, 0), cB, voffB); PG8_STAGE(PG8_SB(0, 1), cB + hstep, voffB); PG8_STAGE(PG8_SA(0, 0), cA, voffA); PG8_STAGE(PG8_SA(0, 1), cA + hstep, voffA);
        if (wr == 1) PG8_BAR;
        PG8_WAIT_V(2); PG8_BAR;
        PG8_STAGE(PG8_SB(1, 0), cB + kstep, voffB); PG8_STAGE(PG8_SA(1, 0), cA + kstep, voffA); PG8_STAGE(PG8_SB(1, 1), cB + hstep + kstep, voffB);
        PG8_WAIT_V(6); PG8_BAR;
    } else {
        PG8_STAGE(PG8_SB(0, 0), cB, voffB); PG8_STAGE(PG8_SA(0, 0), cA, voffA); PG8_STAGE(PG8_SB(0, 1), cB + hstep, voffB); PG8_STAGE(PG8_SA(0, 1), cA + hstep, voffA);
        if (wr == 1) PG8_BAR;
        PG8_WAIT_V(4); PG8_BAR;
        PG8_STAGE(PG8_SB(1, 0), cB + kstep, voffB); PG8_STAGE(PG8_SA(1, 0), cA + kstep, voffA); PG8_STAGE(PG8_SB(1, 1), cB + hstep + kstep, voffB);
        PG8_WAIT_V(6); PG8_BAR;
    }
    for (;;) {
        const bool has_next = S.next(ui + 1, nxt);
        const char* nA = has_next ? (const char*)g.A + (size_t)nxt.pm * tstep : cA; const char* nB = has_next ? (const char*)g.Bt + (size_t)nxt.pn * tstep : cB;
        for (int t = 0; t < nt; t += 2) {
            const bool last = (t == nt - 2);
            const char* a1 = cA + (size_t)(t + 1) * kstep;
            const char* a2 = last ? nA : cA + (size_t)(t + 2) * kstep; const char* b2 = last ? nB : cB + (size_t)(t + 2) * kstep;
            const char* a3 = a2 + kstep; const char* b3 = b2 + kstep;
            if (last && has_next) S.a_ready(nxt);
            if constexpr (SP2) {
            PG8_LDB(B0, 0, 0); PG8_LDB(B1, 0, 1); PG8_SCHED; PG8_LDA(At, 0, 0); PG8_STAGE(PG8_SA(1, 1), a1 + hstep, voffA);
            PG8_WAIT_V(8); PG8_WAIT_L(0); PG8_BAR; PG8_MMA(0, 0, At, B0); PG8_MMA(0, 1, At, B1); PG8_BAR; PG8_SCHED;
            PG8_LDA(At, 0, 1); PG8_STAGE(PG8_SB(0, 0), b2, voffB); PG8_STAGE(PG8_SB(0, 1), b2 + hstep, voffB); PG8_STAGE(PG8_SA(0, 0), a2, voffA);
            PG8_WAIT_V(8); PG8_WAIT_L(0); PG8_BAR; PG8_MMA(1, 0, At, B0); PG8_MMA(1, 1, At, B1); PG8_BAR; PG8_SCHED;
            PG8_LDB(B0, 1, 0); PG8_LDB(B1, 1, 1); PG8_SCHED; PG8_LDA(At, 1, 0); PG8_STAGE(PG8_SA(0, 1), a2 + hstep, voffA);
            PG8_WAIT_V(8); PG8_WAIT_L(0); PG8_BAR; PG8_MMA(0, 0, At, B0); PG8_MMA(0, 1, At, B1); PG8_BAR; PG8_SCHED;
            PG8_LDA(At, 1, 1); PG8_STAGE(PG8_SB(1, 0), b3, voffB); PG8_STAGE(PG8_SB(1, 1), b3 + hstep, voffB); PG8_STAGE(PG8_SA(1, 0), a3, voffA);
            PG8_WAIT_V(8); PG8_WAIT_L(0); PG8_BAR; PG8_MMA(1, 0, At, B0); PG8_MMA(1, 1, At, B1); PG8_BAR; PG8_SCHED;
            } else {
            PG8_LDB(B0, 0, 0); PG8_SCHED; PG8_LDA(At, 0, 0); PG8_STAGE(PG8_SA(1, 1), a1 + hstep, voffA);
            PG8_WAIT_L(8); PG8_BAR; PG8_WAIT_L(0); PG8_MMA(0, 0, At, B0); PG8_BAR; PG8_SCHED;
            PG8_LDB(B1, 0, 1); PG8_STAGE(PG8_SB(0, 0), b2, voffB);
            PG8_BAR; PG8_WAIT_L(0); PG8_MMA(0, 1, At, B1); PG8_BAR;
            PG8_LDA(At, 0, 1); PG8_STAGE(PG8_SA(0, 0), a2, voffA);
            PG8_BAR; PG8_WAIT_L(0); PG8_MMA(1, 0, At, B0); PG8_BAR; PG8_SCHED;
            PG8_STAGE(PG8_SB(0, 1), b2 + hstep, voffB);
            PG8_WAIT_V(6); PG8_BAR; PG8_MMA(1, 1, At, B1); PG8_BAR;
            PG8_LDB(B0, 1, 0); PG8_SCHED; PG8_LDA(At, 1, 0); PG8_STAGE(PG8_SA(0, 1), a2 + hstep, voffA);
            PG8_WAIT_L(8); PG8_BAR; PG8_WAIT_L(0); PG8_MMA(0, 0, At, B0); PG8_BAR; PG8_SCHED;
            PG8_LDB(B1, 1, 1); PG8_STAGE(PG8_SB(1, 0), b3, voffB);
            PG8_BAR; PG8_WAIT_L(0); PG8_MMA(0, 1, At, B1); PG8_BAR;
            PG8_LDA(At, 1, 1); PG8_STAGE(PG8_SA(1, 0), a3, voffA);
            PG8_BAR; PG8_WAIT_L(0); PG8_MMA(1, 0, At, B0); PG8_BAR; PG8_SCHED;
            PG8_STAGE(PG8_SB(1, 1), b3 + hstep, voffB);
            PG8_WAIT_V(6); PG8_BAR; PG8_MMA(1, 1, At, B1); PG8_BAR;
            }
        }
        if constexpr (ALIGN_EPI) { if (wr == 0) PG8_BAR; }
        if constexpr (!Epi::AFTER_DRAIN) { E(acc, cur, wr, wc, fr, fq); S.done(cur); }
        if (!has_next) break;
#pragma unroll
        for (int a = 0; a < 2; ++a)
#pragma unroll
            for (int b = 0; b < 2; ++b)
#pragma unroll
                for (int m = 0; m < 4; ++m)
#pragma unroll
                    for (int n = 0; n < 2; ++n) acc[a][b][m][n] = (f32x4){0.f, 0.f, 0.f, 0.f};
        cur = nxt; cA = nA; cB = nB; ++ui;
        if constexpr (ALIGN_EPI) { if (wr == 1) PG8_BAR; }
    }
    PG8_WAIT_V(0);
    if constexpr (!ALIGN_EPI) { if (wr == 0) PG8_BAR; }
    PG8_BAR;
    if constexpr (Epi::AFTER_DRAIN) { E.fused(acc, cur, wr, wc, fr, fq, lds, wid, lane); S.done(cur); }
#undef PG8_SA
#undef PG8_SB
#undef PG8_STAGE
#undef PG8_LDA
#undef PG8_LDB
#undef PG8_MMA
#undef PG8_WAIT_V
#undef PG8_WAIT_L
#undef PG8_BAR
#undef PG8_SCHED
}
}

constexpr int T_TOK = 32768, DM = 1024, SEQ = 2048, NB = 16, DFF = 2816, THALF = 16384;
constexpr int NWAVES = 8;
constexpr int RB = 2176, HBR = 8 * RB;
constexpr int LDS_BYTES = 147456;
constexpr size_t MiB = 1u << 20;
constexpr size_t WS_SS = 0;
constexpr size_t WS_MST = 1 * MiB;
constexpr size_t WS_NST = 1 * MiB + 65536;
constexpr size_t WS_BAR = 3 * MiB;
constexpr size_t WS_WQKV = 4 * MiB;
constexpr size_t WS_WAO = 22 * MiB;
constexpr size_t WS_WFFIN = 24 * MiB;
constexpr size_t WS_WFFOUT = 46 * MiB;
constexpr size_t WS_WMIN = 57 * MiB;
constexpr size_t WS_WMOUT = 64 * MiB;
constexpr size_t WS_ROPE = 66 * MiB;
constexpr size_t WS_LSE = 70 * MiB;
constexpr size_t WS_GATES = 73 * MiB;
constexpr size_t WS_HB = 76 * MiB;
constexpr size_t WS_MX = 140 * MiB;
constexpr size_t WS_BIG = 204 * MiB;
constexpr size_t WS_H = WS_BIG;
constexpr size_t WS_ACT = WS_BIG + 128 * MiB;
constexpr size_t WS_END = 512 * MiB;
static_assert(WS_ACT + (size_t)T_TOK * DFF * 2 <= WS_END && WS_BIG + (size_t)72 * 8 * 2176 * 256 <= WS_END, "d_ws map");

#define LAS __attribute__((address_space(3)))
typedef unsigned short bf16;
typedef unsigned u32x4 __attribute__((ext_vector_type(4)));
typedef unsigned u32x2 __attribute__((ext_vector_type(2)));
typedef float f32x4 __attribute__((ext_vector_type(4)));
typedef float f32x16 __attribute__((ext_vector_type(16)));
typedef short bf16x8 __attribute__((ext_vector_type(8)));
typedef short s16x4 __attribute__((ext_vector_type(4)));
typedef float f32x2_t __attribute__((ext_vector_type(2)));
typedef __bf16 bf16x2_t __attribute__((ext_vector_type(2)));
__device__ __forceinline__ unsigned pk2(float lo, float hi) { f32x2_t v = {lo, hi}; bf16x2_t b = __builtin_convertvector(v, bf16x2_t); return __builtin_bit_cast(unsigned, b); }
__device__ __forceinline__ float bf_lo(unsigned w) { return __uint_as_float(w << 16); }
__device__ __forceinline__ float bf_hi(unsigned w) { return __uint_as_float(w & 0xffff0000u); }
__device__ __forceinline__ float wave_sum(float v) {
#pragma unroll
    for (int o = 1; o < 64; o <<= 1) v += __shfl_xor(v, o);
    return v;
}
__device__ __forceinline__ float wave_max(float v) {
#pragma unroll
    for (int o = 1; o < 64; o <<= 1) v = fmaxf(v, __shfl_xor(v, o));
    return v;
}
#define MFMA16(a, b, c) __builtin_amdgcn_mfma_f32_16x16x32_bf16((a), (b), (c), 0, 0, 0)
#define MFMA32(a, b, c) __builtin_amdgcn_mfma_f32_32x32x16_bf16((a), (b), (c), 0, 0, 0)

#define XB_TMO      128
#define XB_XCNT(j)  (256  + 64 * (j))
#define XB_XSUB(j)  (1280 + 64 * (j))
#define XB_XGEN(j)  (2304 + 64 * (j))
#define XB_TOP      3328
#define XB_TOPGEN   3392
#define XCD_BAR_WORDS 3456
#define XB_SPIN_CAP (1u << 18)

__device__ __forceinline__ unsigned xb_ld(unsigned* p)              { return __hip_atomic_load(p, __ATOMIC_RELAXED, __HIP_MEMORY_SCOPE_AGENT); }
__device__ __forceinline__ unsigned xb_add(unsigned* p, unsigned v) { return __hip_atomic_fetch_add(p, v, __ATOMIC_RELAXED, __HIP_MEMORY_SCOPE_AGENT); }
__device__ __forceinline__ unsigned xb_xcc_id() { return (unsigned)__builtin_amdgcn_s_getreg((3 << 11) | 20) & 0xFu; }
#define XB_SPIN(cond, bar) do { unsigned _sp = 0; while (cond) { __builtin_amdgcn_s_sleep(1); \
    if ((++_sp & 255u) == 0u) { if (xb_ld(&(bar)[XB_TMO])) break; if (_sp > XB_SPIN_CAP) { atomicAdd(&(bar)[XB_TMO], 1u); break; } } } } while (0)

struct XcdBarrier {
    unsigned* bar; unsigned x;
    volatile LAS unsigned* st;
};

__device__ __forceinline__ XcdBarrier xcd_barrier_post(unsigned* bar, volatile LAS unsigned* st) {
    XcdBarrier b; b.bar = bar; b.x = xb_xcc_id(); b.st = st;
    if (threadIdx.x == 0) (void)xb_add(&bar[XB_XCNT(b.x)], 1u);
    return b;
}
__device__ __forceinline__ void xcd_barrier_complete(unsigned* bar, unsigned x, unsigned& nloc, unsigned& nx) {
    const unsigned G = gridDim.x * gridDim.y * gridDim.z;
    unsigned sum, cnt, mine, sp = 0u;
    for (;;) {
        sum = 0u; cnt = 0u; mine = 0u;
#pragma unroll
        for (unsigned j = 0; j < 16; ++j) { const unsigned c = xb_ld(&bar[XB_XCNT(j)]); sum += c; cnt += (c > 0u) ? 1u : 0u; mine = (j == x) ? c : mine; }
        if (sum == G) break;
        __builtin_amdgcn_s_sleep(1);
        if ((++sp & 255u) == 0u) { if (xb_ld(&bar[XB_TMO])) break; if (sp > XB_SPIN_CAP) { atomicAdd(&bar[XB_TMO], 1u); break; } }
    }
    nloc = mine > 0u ? mine : 1u; nx = cnt > 0u ? cnt : 1u;
}

__device__ __forceinline__ void xcd_barrier(const XcdBarrier& b) {
    asm volatile("s_waitcnt vmcnt(0)" ::: "memory");
    __syncthreads();
    if (threadIdx.x == 0) {
        unsigned* bar = b.bar;
        __builtin_amdgcn_s_waitcnt(0);
        unsigned nloc = b.st[0], nx = b.st[1];
        if (nloc == 0u) { xcd_barrier_complete(bar, b.x, nloc, nx); b.st[0] = nloc; b.st[1] = nx; }
        const unsigned old = xb_add(&bar[XB_XSUB(b.x)], 1u);
        const unsigned gen = old / nloc;
        if (old + 1u == (gen + 1u) * nloc) {
            __builtin_amdgcn_fence(__ATOMIC_RELEASE, "agent");
            asm volatile("s_waitcnt vmcnt(0)" ::: "memory");
            const unsigned og = xb_add(&bar[XB_TOP], 1u);
            const unsigned tg = og / nx;
            if (og + 1u == (tg + 1u) * nx) xb_add(&bar[XB_TOPGEN], 1u);
            else XB_SPIN(xb_ld(&bar[XB_TOPGEN]) == tg, bar);
            __builtin_amdgcn_fence(__ATOMIC_ACQUIRE, "agent");
            xb_add(&bar[XB_XGEN(b.x)], 1u);
            asm volatile("s_waitcnt vmcnt(0)" ::: "memory");
        } else {
            XB_SPIN(xb_ld(&bar[XB_XGEN(b.x)]) == gen, bar);
            __builtin_amdgcn_fence(__ATOMIC_ACQUIRE, "agent");
            asm volatile("s_waitcnt vmcnt(0)" ::: "memory");
        }
    }
    __syncthreads();
}


struct Args {
    const float* x; const int* pos; const float* attn_norm; const float* attn_w_in; const float* attn_w_out; const float* mlstm_norm; const float* mlstm_w_in;
    const float* conv_w; const float* conv_b; const float* ig_bias; const float* fg_bias; const float* head_gain; const float* mlstm_w_out;
    const float* ffn_norm; const float* ffn_w_in; const float* ffn_w_out; const float* final_norm;
    float* out; unsigned char* ws; int ph_lo, ph_hi;
};

__device__ __forceinline__ void tr_item(const float* __restrict__ W, int K, int Nsrc, bf16* WT, int n0_dst, int n0_src, int k0, const float* __restrict__ gain, float scale, LAS float* scr, int lane) {
    const int n4 = lane & 15, kq = lane >> 4; const int col = n0_src + 4 * n4; const bool ok = col < Nsrc;
    f32x4 v[16];
#pragma unroll
    for (int i = 0; i < 16; ++i) { v[i] = (f32x4){0.f, 0.f, 0.f, 0.f}; if (ok) v[i] = *(const f32x4*)(W + (size_t)(k0 + 4 * i + kq) * Nsrc + col); }
#pragma unroll
    for (int i = 0; i < 16; ++i) { const int kk = 4 * i + kq; const float g = gain ? gain[k0 + kk] * scale : scale; LAS float* d = scr + kk * 65 + 4 * n4;
        d[0] = v[i][0] * g; d[1] = v[i][1] * g; d[2] = v[i][2] * g; d[3] = v[i][3] * g; }
    asm volatile("s_waitcnt lgkmcnt(0)" ::: "memory");
    const int c = lane & 7;
#pragma unroll
    for (int j = 0; j < 8; ++j) { const int n = (lane >> 3) + 8 * j; const LAS float* sp = scr + (8 * c) * 65 + n;
        u32x4 o; o.x = pk2(sp[0 * 65], sp[1 * 65]); o.y = pk2(sp[2 * 65], sp[3 * 65]); o.z = pk2(sp[4 * 65], sp[5 * 65]); o.w = pk2(sp[6 * 65], sp[7 * 65]);
        *(u32x4*)(WT + (size_t)(n0_dst + n) * K + k0 + 8 * c) = o; }
    asm volatile("s_waitcnt lgkmcnt(0)" ::: "memory");
}
__device__ __forceinline__ void p0_prologue(const Args& A, LAS unsigned char* lds, int G, int bid) {
    const int tid = threadIdx.x, lane = tid & 63, wave = tid >> 6;
    LAS float* scr = (LAS float*)(lds + wave * 16640);
    const int gw = bid * NWAVES + wave, NGW = G * NWAVES;
    unsigned char* ws = A.ws;
    constexpr int I_QKV = 16 * 144, I_AO = 16 * 16, I_FFIN = 16 * 88, I_FFOUT = 44 * 16, I_MIN = 16 * 52, I_MOUT = 16 * 16;
    constexpr int NITEMS = I_QKV + I_AO + 2 * I_FFIN + 2 * I_FFOUT + I_MIN + I_MOUT;
    constexpr float QSCALE = 0.08838834764831845f * 1.4426950408889634f;
    for (int it = gw; it < NITEMS; it += NGW) {
        int r = it;
        if (r < I_QKV) { const int kb = r / 144, nb = r % 144, n0 = 64 * nb; const int tsel = (n0 % 3072) / 1024;
            tr_item(A.attn_w_in, 1024, 9216, (bf16*)(ws + WS_WQKV), n0, n0, 64 * kb, A.attn_norm, tsel == 0 ? QSCALE : 1.f, scr, lane); continue; } r -= I_QKV;
        if (r < I_AO) { const int kb = r / 16, nb = r % 16; tr_item(A.attn_w_out, 1024, 1024, (bf16*)(ws + WS_WAO), 64 * nb, 64 * nb, 64 * kb, nullptr, 1.f, scr, lane); continue; } r -= I_AO;
        if (r < 2 * I_FFIN) { const int l = r / I_FFIN; r -= l * I_FFIN; const int kb = r / 88, nb = r % 88, n0 = 64 * nb;
            const int pn = n0 >> 8, bj = (n0 >> 7) & 1, jj = n0 & 127; const int nsrc = (bj ? DFF : 0) + 128 * pn + jj;
            tr_item(A.ffn_w_in + (size_t)l * 1024 * 5632, 1024, 5632, (bf16*)(ws + WS_WFFIN) + (size_t)l * 5632 * 1024, n0, nsrc, 64 * kb, A.ffn_norm + l * 1024, 1.f, scr, lane); continue; } r -= 2 * I_FFIN;
        if (r < 2 * I_FFOUT) { const int l = r / I_FFOUT; r -= l * I_FFOUT; const int kb = r / 16, nb = r % 16;
            tr_item(A.ffn_w_out + (size_t)l * DFF * 1024, DFF, 1024, (bf16*)(ws + WS_WFFOUT) + (size_t)l * 1024 * DFF, 64 * nb, 64 * nb, 64 * kb, nullptr, 1.f, scr, lane); continue; } r -= 2 * I_FFOUT;
        if (r < I_MIN) { const int kb = r / 52, nb = r % 52; tr_item(A.mlstm_w_in, 1024, 3088, (bf16*)(ws + WS_WMIN), 64 * nb, 64 * nb, 64 * kb, A.mlstm_norm, 1.f, scr, lane); continue; } r -= I_MIN;
        { const int kb = r / 16, nb = r % 16; tr_item(A.mlstm_w_out, 1024, 1024, (bf16*)(ws + WS_WMOUT), 64 * nb, 64 * nb, 64 * kb, nullptr, 1.f, scr, lane); }
    }
    float* ss = (float*)(ws + WS_SS); bf16* hb = (bf16*)(ws + WS_HB);
    for (int m4 = gw; m4 < T_TOK / 4; m4 += NGW) {
        f32x4 v[4][4];
#pragma unroll
        for (int q = 0; q < 4; ++q) { const f32x4* xr = (const f32x4*)(A.x + (size_t)(4 * m4 + q) * DM) + lane;
#pragma unroll
            for (int j = 0; j < 4; ++j) v[q][j] = xr[64 * j]; }
#pragma unroll
        for (int q = 0; q < 4; ++q) { const int m = 4 * m4 + q; float sq = 0.f;
#pragma unroll
            for (int j = 0; j < 4; ++j) sq += (v[q][j].x * v[q][j].x + v[q][j].y * v[q][j].y) + (v[q][j].z * v[q][j].z + v[q][j].w * v[q][j].w);
            sq = wave_sum(sq);
            u32x2* o8 = (u32x2*)(hb + (size_t)m * DM) + lane;
#pragma unroll
            for (int j = 0; j < 4; ++j) { u32x2 o; o.x = pk2(v[q][j].x, v[q][j].y); o.y = pk2(v[q][j].z, v[q][j].w); o8[64 * j] = o; }
            if (lane == 0) ss[m] = sq; }
    }
    const int gt = bid * 512 + tid, NGT = G * 512;
    for (int i = gt; i < 4 * T_TOK; i += NGT) ss[T_TOK + i] = 0.f;
    float* rope = (float*)(ws + WS_ROPE);
    for (int i = gt; i < T_TOK * 16; i += NGT) {
        const int t = i >> 4, f = i & 15;
        const float invf = (float)exp2(-(double)f * (18.931568569324174 / 16.0));
        const float ang = (float)A.pos[t] * invf;
        const double rev = (double)ang * 0.15915494309189535; const float fr = (float)(rev - rint(rev));
        rope[(size_t)t * 32 + f] = __builtin_amdgcn_cosf(fr); rope[(size_t)t * 32 + 16 + f] = __builtin_amdgcn_sinf(fr);
    }
}

struct AStep { const bf16* base; size_t rowstride; int blk, g, h, dil, rr, b; bool valid, compute; };
__device__ __forceinline__ AStep attn_step(int u, int s, const bf16* QKVh) {
    AStep t; t.valid = true; t.compute = true;
    if (s < 5) { t.g = 0; t.dil = 1; t.rr = 0; const int qt = u & 3; t.h = (u >> 2) & 7; t.b = u >> 5; t.blk = 4 * qt + s - 1; if (s == 0) { t.compute = false; t.valid = qt > 0; if (!t.valid) t.blk = 0; } }
    else if (s < 9) { t.g = 1; t.dil = 4; t.h = u & 7; t.rr = (u >> 3) & 3; t.b = u >> 5; t.blk = s - 5; }
    else { t.g = 2; t.dil = 16; const int v = 4 * u + (s - 9); t.h = v & 7; t.rr = (v >> 3) & 15; t.b = v >> 7; t.blk = 0; }
    t.rowstride = 128;
    t.base = QKVh + ((size_t)(t.g * 24 + t.h) * HBR + t.b * RB + t.rr * (SEQ / t.dil)) * 128;
    return t;
}
typedef short v4i16_t __attribute__((ext_vector_type(4)));
__device__ __forceinline__ s16x4 tr_read(const LAS unsigned char* p) { return __builtin_bit_cast(s16x4, __builtin_amdgcn_ds_read_tr16_b64_v4i16((LAS v4i16_t*)p)); }
__device__ __forceinline__ void attn_phase(LAS unsigned char* lds, const bf16* __restrict__ QKVh, bf16* __restrict__ Oh, float* __restrict__ lse, int half, int G, int bid) {
    const int tid = threadIdx.x, lane = tid & 63, w = __builtin_amdgcn_readfirstlane(tid >> 6), r = lane & 15, q4 = lane >> 4;
    constexpr int SLOT = 34816;
#define ATT_LOAD(st) do { \
        _Pragma("unroll") for (int i = 0; i < 4; ++i) { const int chunk = tid + 512 * i, c = chunk >> 4, ch = chunk & 15; const bf16* gp = (st).base + (size_t)(128 * (st).blk + c) * (st).rowstride + 8 * ch; \
            kr[i] = *(const u32x4*)(gp + (size_t)8 * HBR * 128); vr[i] = *(const u32x4*)(gp + (size_t)16 * HBR * 128); } \
        { const bf16* qrow = (st).base + (size_t)(128 * (st).blk + 16 * w + r) * (st).rowstride; \
            _Pragma("unroll") for (int q = 0; q < 4; ++q) qn[q] = *(const bf16x8*)(qrow + 32 * q + 8 * q4); } } while (0)
    for (int u = bid; u < 256; u += G) {
        AStep nx = attn_step(u, 0, QKVh);
        u32x4 kr[4], vr[4]; bf16x8 qn[4];
#pragma unroll
        for (int i = 0; i < 4; ++i) { kr[i] = (u32x4){0u, 0u, 0u, 0u}; vr[i] = kr[i]; qn[i] = (bf16x8){0, 0, 0, 0, 0, 0, 0, 0}; }
        ATT_LOAD(nx);
        for (int s = 0; s < 13; ++s) {
            const AStep cu = nx; const int cs = s & 1;
            LAS unsigned char* Kc = lds + cs * SLOT; LAS unsigned char* Vc = lds + 2 * SLOT + cs * SLOT;
#pragma unroll
            for (int i = 0; i < 4; ++i) { const int chunk = tid + 512 * i, c = chunk >> 4, ch = chunk & 15; *(LAS u32x4*)(Kc + c * 272 + ch * 16) = kr[i]; *(LAS u32x4*)(Vc + c * 272 + ch * 16) = vr[i]; }
            bf16x8 qf[4];
#pragma unroll
            for (int q = 0; q < 4; ++q) qf[q] = qn[q];
            __syncthreads();
            { nx = attn_step(u, (s + 1 < 13) ? s + 1 : 12, QKVh); ATT_LOAD(nx); }
            if (cu.compute) {
                const bool first = (cu.blk == 0);
                const LAS unsigned char* Kp = first ? Kc : lds + (cs ^ 1) * SLOT; const LAS unsigned char* Vp = first ? Vc : lds + 2 * SLOT + (cs ^ 1) * SLOT;
                const int a = 16 * w + r;
                const int jlo = first ? 8 : 0;
                f32x4 S[9]; float mx = -INFINITY;
#pragma unroll
                for (int jj = 0; jj < 9; ++jj) { const int j = w + jj; S[jj] = (f32x4){0.f, 0.f, 0.f, 0.f};
                    if (j >= jlo) { const LAS unsigned char* kp = (j >= 8 ? Kc : Kp) + ((j & 7) * 16 + r) * 272 + 16 * q4;
#pragma unroll
                        for (int st = 0; st < 4; ++st) { const bf16x8 kf = *(const LAS bf16x8*)(kp + 64 * st); S[jj] = MFMA16(kf, qf[st], S[jj]); } }
#pragma unroll
                    for (int i = 0; i < 4; ++i) { bool valid = (j >= jlo);
                        if (jj == 0) valid = valid && (4 * q4 + i >= r);
                        if (jj == 8) valid = valid && (4 * q4 + i <= r);
                        S[jj][i] = valid ? S[jj][i] : -INFINITY; mx = fmaxf(mx, S[jj][i]); } }
                mx = fmaxf(mx, __shfl_xor(mx, 16)); mx = fmaxf(mx, __shfl_xor(mx, 32));
                float den = 0.f;
#pragma unroll
                for (int jj = 0; jj < 9; ++jj)
#pragma unroll
                    for (int i = 0; i < 4; ++i) { const float pe = __builtin_amdgcn_exp2f(S[jj][i] - mx); S[jj][i] = pe; den += pe; }
                den += __shfl_xor(den, 16); den += __shfl_xor(den, 32);
                bf16x8 pf[5];
#pragma unroll
                for (int p = 0; p < 5; ++p) { u32x4 wv; wv.x = pk2(S[2 * p][0], S[2 * p][1]); wv.y = pk2(S[2 * p][2], S[2 * p][3]);
                    if (2 * p + 1 < 9) { wv.z = pk2(S[(2 * p + 1) % 9][0], S[(2 * p + 1) % 9][1]); wv.w = pk2(S[(2 * p + 1) % 9][2], S[(2 * p + 1) % 9][3]); } else { wv.z = 0u; wv.w = 0u; }
                    pf[p] = __builtin_bit_cast(bf16x8, wv); }
                f32x4 o[8];
#pragma unroll
                for (int db = 0; db < 8; ++db) o[db] = (f32x4){0.f, 0.f, 0.f, 0.f};
#pragma unroll
                for (int p = 0; p < 5; ++p) { const int j0 = w + 2 * p, j1 = (j0 + 1 > 15) ? 15 : j0 + 1;
                    if (j0 + 1 >= jlo) {
                        const LAS unsigned char* v0p = (j0 >= 8 ? Vc : Vp) + ((j0 & 7) * 16 + 4 * q4 + (r >> 2)) * 272 + 8 * (r & 3);
                        const LAS unsigned char* v1p = (j1 >= 8 ? Vc : Vp) + ((j1 & 7) * 16 + 4 * q4 + (r >> 2)) * 272 + 8 * (r & 3);
#pragma unroll
                        for (int db = 0; db < 8; ++db) {
                            const s16x4 lo = tr_read(v0p + 32 * db), hi = tr_read(v1p + 32 * db);
                            const bf16x8 af = __builtin_shufflevector(lo, hi, 0, 1, 2, 3, 4, 5, 6, 7);
                            o[db] = MFMA16(af, pf[p], o[db]); } } }
                const float inv = __builtin_amdgcn_rcpf(den);
                const int tl = cu.b * SEQ + (128 * cu.blk + a) * cu.dil + cu.rr;
                bf16* orow = Oh + ((size_t)(cu.g * 8 + cu.h) * HBR + cu.b * RB + cu.rr * (SEQ / cu.dil) + 128 * cu.blk + a) * 128 + 4 * q4;
#pragma unroll
                for (int db = 0; db < 8; ++db) { u32x2 wv; wv.x = pk2(o[db][0] * inv, o[db][1] * inv); wv.y = pk2(o[db][2] * inv, o[db][3] * inv); *(u32x2*)(orow + 16 * db) = wv; }
                if (q4 == 0) lse[((size_t)cu.g * T_TOK + (size_t)half * THALF + tl) * 8 + cu.h] = mx * 0.6931471805599453f + __logf(den);
            }
            __syncthreads();
        }
    }
#undef ATT_LOAD
}
__device__ __forceinline__ void merge_phase(const bf16* __restrict__ Oh, const float* __restrict__ lse, bf16* __restrict__ MX, int half, int G, int bid) {
    const int gt = bid * 512 + threadIdx.x, NGT = G * 512;
    for (int i = gt; i < THALF * 128; i += NGT) {
        const int tl = i >> 7, ch = i & 127, h = ch >> 4; const size_t tg = (size_t)half * THALF + tl;
        const float l0 = lse[((size_t)0 * T_TOK + tg) * 8 + h], l1 = lse[((size_t)1 * T_TOK + tg) * 8 + h], l2 = lse[((size_t)2 * T_TOK + tg) * 8 + h];
        const float mxl = fmaxf(l0, fmaxf(l1, l2)); float w0 = __expf(l0 - mxl), w1 = __expf(l1 - mxl), w2 = __expf(l2 - mxl); const float inv = 1.0f / (w0 + w1 + w2); w0 *= inv; w1 *= inv; w2 *= inv;
        const int sq = tl & 2047, bb = (tl >> 11) * RB, dch = ch & 15;
        const int p1 = ((sq & 3) << 9) + (sq >> 2), p2 = ((sq & 15) << 7) + (sq >> 4);
        const u32x4 a = *(const u32x4*)(Oh + ((size_t)(0 + h) * HBR + bb + sq) * 128 + 8 * dch), b = *(const u32x4*)(Oh + ((size_t)(8 + h) * HBR + bb + p1) * 128 + 8 * dch), c = *(const u32x4*)(Oh + ((size_t)(16 + h) * HBR + bb + p2) * 128 + 8 * dch);
        u32x4 o;
#pragma unroll
        for (int e = 0; e < 4; ++e) o[e] = pk2(w0 * bf_lo(a[e]) + w1 * bf_lo(b[e]) + w2 * bf_lo(c[e]), w0 * bf_hi(a[e]) + w1 * bf_hi(b[e]) + w2 * bf_hi(c[e]));
        *(u32x4*)(MX + tg * 1024 + 8 * ch) = o;
    }
}
__device__ __forceinline__ float logsigmoid_f(float x) { return fminf(x, 0.f) - __logf(1.0f + __expf(-fabsf(x))); }
__device__ __forceinline__ void mlstm_pre_phase(const bf16* __restrict__ P2, const float* __restrict__ gates, const float* __restrict__ convw, const float* __restrict__ convb, const float* __restrict__ igb, const float* __restrict__ fgb,
                                                bf16* __restrict__ QKc, float* __restrict__ GA, float* __restrict__ GB, float* __restrict__ GP, float* __restrict__ CH, int G, int bid) {
    const int tid = threadIdx.x, lane = tid & 63, wave = tid >> 6;
    const int gt = bid * 512 + tid, NGT = G * 512;
    for (int it = gt; it < (T_TOK / 8) * 128; it += NGT) {
        const int ch = it & 127, tg = it >> 7; const int t0 = 8 * tg, sq0 = t0 & 2047; const int col = 8 * ch;
        float cw[4][8], cb[8];
#pragma unroll
        for (int q = 0; q < 2; ++q) { const f32x4 b4 = *(const f32x4*)(convb + col + 4 * q);
#pragma unroll
            for (int e = 0; e < 4; ++e) cb[4 * q + e] = b4[e];
#pragma unroll
            for (int j = 0; j < 4; ++j) { const f32x4 w4 = *(const f32x4*)(convw + j * 1024 + col + 4 * q);
#pragma unroll
                for (int e = 0; e < 4; ++e) cw[j][4 * q + e] = w4[e]; } }
        u32x4 rw[11];
#pragma unroll
        for (int i = 0; i < 11; ++i) { rw[i] = (u32x4){0u, 0u, 0u, 0u}; if (sq0 + i - 3 >= 0) rw[i] = *(const u32x4*)(P2 + (size_t)(t0 + i - 3) * 2048 + col); }
        const float ksc = (ch >= 64) ? 0.125f : 1.0f;
#pragma unroll
        for (int i = 0; i < 8; ++i) { u32x4 o;
#pragma unroll
            for (int e = 0; e < 4; ++e) { float x0 = cb[2 * e], x1 = cb[2 * e + 1];
#pragma unroll
                for (int j = 0; j < 4; ++j) { x0 += cw[j][2 * e] * bf_lo(rw[i + j][e]); x1 += cw[j][2 * e + 1] * bf_hi(rw[i + j][e]); }
                o[e] = pk2(silu_f(x0) * ksc, silu_f(x1) * ksc); }
            *(u32x4*)(QKc + (size_t)(t0 + i) * 1024 + col) = o; }
    }
    const int gw = bid * NWAVES + wave, NGW = G * NWAVES;
    for (int it = gw; it < NB * 32; it += NGW) {
        const int c = it & 31, b = it >> 5; const size_t t = (size_t)b * SEQ + 64 * c + lane;
        f32x4 g4[4];
#pragma unroll
        for (int q = 0; q < 4; ++q) g4[q] = *(const f32x4*)(gates + t * 16 + 4 * q);
        float bs[8], av[8], pm[8];
#pragma unroll
        for (int h = 0; h < 8; ++h) bs[h] = logsigmoid_f(g4[2 + (h >> 2)][h & 3] + fgb[h]);
#pragma unroll
        for (int o = 1; o < 64; o <<= 1) {
#pragma unroll
            for (int h = 0; h < 8; ++h) { const float v = __shfl_up(bs[h], o); if (lane >= o) bs[h] += v; } }
#pragma unroll
        for (int h = 0; h < 8; ++h) { av[h] = g4[h >> 2][h & 3] + igb[h] - bs[h]; pm[h] = av[h]; }
#pragma unroll
        for (int o = 1; o < 64; o <<= 1) {
#pragma unroll
            for (int h = 0; h < 8; ++h) { const float v = __shfl_up(pm[h], o); if (lane >= o) pm[h] = fmaxf(pm[h], v); } }
#pragma unroll
        for (int h = 0; h < 8; ++h) { const size_t o = (size_t)(b * 8 + h) * SEQ + 64 * c + lane; GA[o] = av[h]; GB[o] = bs[h]; GP[o] = pm[h];
            if (lane == 63) { const size_t cid = (size_t)(b * 8 + h) * 32 + c; CH[2 * cid] = bs[h]; CH[2 * cid + 1] = bs[h] + pm[h]; } }
    }
}
__device__ __forceinline__ void mlstm_scan_phase(LAS unsigned char* lds, const bf16* __restrict__ P2, const bf16* __restrict__ QKc, const float* __restrict__ GA, const float* __restrict__ CH,
                                                 bf16* __restrict__ Cst, float* __restrict__ nst, float* __restrict__ mst, int G, int bid) {
    const int tid = threadIdx.x, lane = tid & 63, w = __builtin_amdgcn_readfirstlane(tid >> 6), r = lane & 15, q4 = lane >> 4;
    const int dvb = w & 3, dkh = w >> 2;
    const bf16x8 ones = {0x3F80, 0x3F80, 0x3F80, 0x3F80, 0x3F80, 0x3F80, 0x3F80, 0x3F80};
    for (int item = bid; item < 256; item += G) {
        const int dvh = item & 1, h = (item >> 1) & 7, b = item >> 4;
        const size_t cid0 = (size_t)(b * 8 + h) * 32;
        f32x4 acc[2], accn[2]; acc[0] = (f32x4){0.f, 0.f, 0.f, 0.f}; acc[1] = acc[0]; accn[0] = acc[0]; accn[1] = acc[0];
        float mcar = 0.f;
        u32x4 nk, nv; float na, nbl, nml;
#define MSCAN_LOAD(c) do { const size_t t_ = (size_t)b * SEQ + 64 * (c) + lane; nk = *(const u32x4*)(QKc + t_ * 1024 + 512 + h * 64 + 8 * w); nv = *(const u32x4*)(P2 + t_ * 2048 + 1024 + h * 128 + 64 * dvh + 8 * w); \
            na = GA[(size_t)(b * 8 + h) * SEQ + 64 * (c) + lane]; nbl = CH[2 * (cid0 + (c))]; nml = CH[2 * (cid0 + (c)) + 1]; } while (0)
        MSCAN_LOAD(0);
        for (int c = 0; c < 32; ++c) {
            const u32x4 ck = nk, cv = nv; const float as = na, blast = nbl, mloc = nml;
            if (c + 1 < 32) MSCAN_LOAD(c + 1);
            const float mnew = fmaxf(blast + mcar, mloc);
            const float wsv = __expf(blast + as - mnew), carry = __expf(blast + mcar - mnew);
            const size_t cid = cid0 + c;
#pragma unroll
            for (int nb = 0; nb < 2; ++nb)
#pragma unroll
                for (int i = 0; i < 4; ++i) { const int dv = 64 * dvh + 16 * dvb + 4 * q4 + i, dk = 32 * dkh + 16 * nb + r;
                    Cst[(cid * 128 + dv) * 64 + dk] = (bf16)(pk2(acc[nb][i], 0.f) & 0xffffu); }
            if (dvh == 0 && dvb == 0 && q4 == 0) { nst[cid * 64 + 32 * dkh + r] = accn[0][0]; nst[cid * 64 + 32 * dkh + 16 + r] = accn[1][0]; }
            if (dvh == 0 && tid == 0) mst[cid] = mcar;
            LAS unsigned char* Kw = lds + (c & 1) * 18432; LAS unsigned char* Vs = Kw + 9216;
            u32x4 kw;
#pragma unroll
            for (int e = 0; e < 4; ++e) kw[e] = pk2(bf_lo(ck[e]) * wsv, bf_hi(ck[e]) * wsv);
            *(LAS u32x4*)(Kw + lane * 144 + 16 * w) = kw; *(LAS u32x4*)(Vs + lane * 144 + 16 * w) = cv;
            __syncthreads();
            acc[0] = acc[0] * carry; acc[1] = acc[1] * carry; accn[0] = accn[0] * carry; accn[1] = accn[1] * carry;
#pragma unroll
            for (int st = 0; st < 2; ++st) {
                const int rowb = (32 * st + 8 * q4 + (r >> 2)) * 144 + 8 * (r & 3);
                const s16x4 alo = tr_read(Vs + rowb + 32 * dvb), ahi = tr_read(Vs + rowb + 4 * 144 + 32 * dvb);
                const bf16x8 af = __builtin_shufflevector(alo, ahi, 0, 1, 2, 3, 4, 5, 6, 7);
#pragma unroll
                for (int nb = 0; nb < 2; ++nb) {
                    const s16x4 blo = tr_read(Kw + rowb + 64 * dkh + 32 * nb), bhi = tr_read(Kw + rowb + 4 * 144 + 64 * dkh + 32 * nb);
                    const bf16x8 bfr = __builtin_shufflevector(blo, bhi, 0, 1, 2, 3, 4, 5, 6, 7);
                    acc[nb] = MFMA16(af, bfr, acc[nb]);
                    if (dvb == 0) accn[nb] = MFMA16(ones, bfr, accn[nb]); }
            }
            mcar = mnew;
        }
        __syncthreads();
#undef MSCAN_LOAD
    }
}
__device__ __forceinline__ void mlstm_out_phase(LAS unsigned char* lds, const bf16* __restrict__ P2, const bf16* __restrict__ QKc, const bf16* __restrict__ OP, const float* __restrict__ GA, const float* __restrict__ GB, const float* __restrict__ GP,
                                                const float* __restrict__ hgain, const bf16* __restrict__ Cst, const float* __restrict__ nst, const float* __restrict__ mst, bf16* __restrict__ MX, int G, int bid) {
    const int tid = threadIdx.x, lane = tid & 63, w = __builtin_amdgcn_readfirstlane(tid >> 6), r = lane & 31, h2 = lane >> 5;
    const int dvb = w & 3, tb = w >> 2;
    constexpr int O_Q = 0, O_K = 9216, O_V = 18432, O_C = 35840, O_VEC = 54272, O_GN = 55296, O_PART = 55808, SETB = 56832;
    u32x4 pq, pk, pv0, pv1, pc0, pc1; float pvec = 0.f, pgn = 0.f, pmc = 0.f; u32x2 popv[4];
    pq = (u32x4){0u, 0u, 0u, 0u}; pk = pq; pv0 = pq; pv1 = pq; pc0 = pq; pc1 = pq;
#pragma unroll
    for (int gq = 0; gq < 4; ++gq) popv[gq] = (u32x2){0u, 0u};
#define OUT_LOAD(it) do { const int c_ = (it) & 31, h_ = ((it) >> 5) & 7, b_ = (it) >> 8; const size_t t0_ = (size_t)b_ * SEQ + 64 * c_; const size_t gb_ = (size_t)(b_ * 8 + h_) * SEQ + 64 * c_; \
        { const bf16* p_ = QKc + (t0_ + (tid >> 3)) * 1024 + h_ * 64 + 8 * (tid & 7); pq = *(const u32x4*)p_; pk = *(const u32x4*)(p_ + 512); } \
        { const bf16* p_ = P2 + (t0_ + (tid >> 4)) * 2048 + 1024 + h_ * 128 + 8 * (tid & 15); pv0 = *(const u32x4*)p_; pv1 = *(const u32x4*)(p_ + (size_t)32 * 2048); } \
        { const bf16* p_ = Cst + ((size_t)(it) * 128 + (tid >> 3)) * 64 + 8 * (tid & 7); pc0 = *(const u32x4*)p_; pc1 = *(const u32x4*)(p_ + 64 * 64); } \
        { const int wh_ = tid >> 6, ix_ = tid & 63; const float* src_ = (wh_ == 0) ? (GA + gb_) : (wh_ == 1) ? (GB + gb_) : (wh_ == 2) ? (GP + gb_) : (wh_ == 3) ? (nst + (size_t)(it) * 64) : (hgain + h_ * 128 + ((wh_ & 1) << 6)); pvec = src_[ix_]; } \
        pmc = mst[(it)]; \
        { const size_t orow_ = (t0_ + 32 * tb + r) * 1024 + h_ * 128 + 32 * dvb + 4 * h2; _Pragma("unroll") for (int gq = 0; gq < 4; ++gq) popv[gq] = *(const u32x2*)(OP + orow_ + 8 * gq); } } while (0)
    { const int fit = (bid < 4096) ? bid : 0; OUT_LOAD(fit); }
    int par = 0;
    for (int item = bid; item < 4096; item += G, par ^= 1) {
        const int c = item & 31, h = (item >> 5) & 7, b = item >> 8;
        const size_t t0 = (size_t)b * SEQ + 64 * c;
        LAS unsigned char* L = lds + par * SETB;
        LAS float* vec = (LAS float*)(L + O_VEC); LAS float* gnl = (LAS float*)(L + O_GN); LAS float* part = (LAS float*)(L + O_PART);
        *(LAS u32x4*)(L + O_Q + (tid >> 3) * 144 + (tid & 7) * 16) = pq; *(LAS u32x4*)(L + O_K + (tid >> 3) * 144 + (tid & 7) * 16) = pk;
        *(LAS u32x4*)(L + O_V + (tid >> 4) * 272 + (tid & 15) * 16) = pv0; *(LAS u32x4*)(L + O_V + (32 + (tid >> 4)) * 272 + (tid & 15) * 16) = pv1;
        *(LAS u32x4*)(L + O_C + (tid >> 3) * 144 + (tid & 7) * 16) = pc0; *(LAS u32x4*)(L + O_C + (64 + (tid >> 3)) * 144 + (tid & 7) * 16) = pc1;
        if (tid < 384) vec[tid] = pvec;
        const float mc = pmc; u32x2 opv[4];
#pragma unroll
        for (int gq = 0; gq < 4; ++gq) opv[gq] = popv[gq];
        __syncthreads();
        { const int nit = (item + G < 4096) ? item + G : item; OUT_LOAD(nit); }
        const int t = 32 * tb + r;
        const float Mt = fmaxf(mc, vec[128 + t]), bt = vec[64 + t];
        bf16x8 qf[4];
#pragma unroll
        for (int st = 0; st < 4; ++st) qf[st] = *(const LAS bf16x8*)(L + O_Q + t * 144 + (16 * st + 8 * h2) * 2);
        float qn = 0.f;
#pragma unroll
        for (int st = 0; st < 4; ++st) { const u32x4 qq = __builtin_bit_cast(u32x4, qf[st]); const f32x4 n0 = *(const LAS f32x4*)(vec + 192 + 16 * st + 8 * h2), n1 = *(const LAS f32x4*)(vec + 192 + 16 * st + 8 * h2 + 4);
#pragma unroll
            for (int e = 0; e < 2; ++e) { qn += bf_lo(qq[e]) * n0[2 * e] + bf_hi(qq[e]) * n0[2 * e + 1]; qn += bf_lo(qq[2 + e]) * n1[2 * e] + bf_hi(qq[2 + e]) * n1[2 * e + 1]; } }
        qn += __shfl_xor(qn, 32);
        f32x16 acc1, acc2;
#pragma unroll
        for (int i = 0; i < 16; ++i) { acc1[i] = 0.f; acc2[i] = 0.f; }
        float dsum = 0.f;
#pragma unroll
        for (int sb = 0; sb < 2; ++sb) {
            if (sb <= tb) {
                f32x16 S;
#pragma unroll
                for (int i = 0; i < 16; ++i) S[i] = 0.f;
#pragma unroll
                for (int st = 0; st < 4; ++st) { const bf16x8 kf = *(const LAS bf16x8*)(L + O_K + (32 * sb + r) * 144 + (16 * st + 8 * h2) * 2); S = MFMA32(kf, qf[st], S); }
#pragma unroll
                for (int gq = 0; gq < 4; ++gq) { const f32x4 a4 = *(const LAS f32x4*)(vec + 32 * sb + 8 * gq + 4 * h2);
#pragma unroll
                    for (int k = 0; k < 4; ++k) { const int i = 4 * gq + k, s = 32 * sb + 8 * gq + 4 * h2 + k; const float ev = __builtin_amdgcn_exp2f(fminf(a4[k] - Mt, 0.f) * 1.4426950408889634f);
                        const float wgt = (s <= t) ? ev : 0.f; S[i] = wgt * S[i]; dsum += S[i]; } }
#pragma unroll
                for (int sp = 0; sp < 2; ++sp) {
                    u32x4 wv; wv.x = pk2(S[8 * sp + 0], S[8 * sp + 1]); wv.y = pk2(S[8 * sp + 2], S[8 * sp + 3]); wv.z = pk2(S[8 * sp + 4], S[8 * sp + 5]); wv.w = pk2(S[8 * sp + 6], S[8 * sp + 7]);
                    const bf16x8 pfr = __builtin_bit_cast(bf16x8, wv);
                    const LAS unsigned char* vp = L + O_V + (32 * sb + 16 * sp + 4 * h2 + ((lane & 15) >> 2)) * 272 + (32 * dvb + 16 * ((lane >> 4) & 1) + 4 * (lane & 3)) * 2;
                    const s16x4 lo = tr_read(vp), hi = tr_read(vp + 8 * 272);
                    const bf16x8 af = __builtin_shufflevector(lo, hi, 0, 1, 2, 3, 4, 5, 6, 7);
                    acc1 = MFMA32(af, pfr, acc1);
                }
            }
        }
        dsum += __shfl_xor(dsum, 32);
#pragma unroll
        for (int st = 0; st < 4; ++st) { const bf16x8 cf = *(const LAS bf16x8*)(L + O_C + (32 * dvb + r) * 144 + (16 * st + 8 * h2) * 2); acc2 = MFMA32(cf, qf[st], acc2); }
        const float winter = __expf(mc - Mt);
        const float den = dsum + winter * qn;
        const float dnm = fmaxf(fabsf(den), __expf(-(bt + Mt)));
        const float idn = __builtin_amdgcn_rcpf(dnm);
        float hsq = 0.f;
#pragma unroll
        for (int i = 0; i < 16; ++i) { acc1[i] = (acc1[i] + winter * acc2[i]) * idn; hsq += acc1[i] * acc1[i]; }
        hsq += __shfl_xor(hsq, 32);
        if (h2 == 0) part[dvb * 64 + t] = hsq;
        __syncthreads();
        const float tot = (part[t] + part[64 + t]) + (part[128 + t] + part[192 + t]);
        const float rsn = __builtin_amdgcn_rsqf(tot * (1.0f / 128.0f) + RMS_EPS);
        const size_t orow = (t0 + t) * 1024 + h * 128 + 32 * dvb + 4 * h2;
#pragma unroll
        for (int gq = 0; gq < 4; ++gq) {
            const u32x2 op = opv[gq]; const f32x4 gn = *(const LAS f32x4*)(gnl + 32 * dvb + 4 * h2 + 8 * gq);
            const float y0 = acc1[4 * gq + 0] * rsn * gn[0] * sigmoid_f(bf_lo(op.x)), y1 = acc1[4 * gq + 1] * rsn * gn[1] * sigmoid_f(bf_hi(op.x));
            const float y2 = acc1[4 * gq + 2] * rsn * gn[2] * sigmoid_f(bf_lo(op.y)), y3 = acc1[4 * gq + 3] * rsn * gn[3] * sigmoid_f(bf_hi(op.y));
            u32x2 wv; wv.x = pk2(y0, y1); wv.y = pk2(y2, y3); *(u32x2*)(MX + orow + 8 * gq) = wv;
        }
    }
    __syncthreads();
#undef OUT_LOAD
}
__device__ __forceinline__ void final_phase(float* __restrict__ out, const float* __restrict__ ss, const float* __restrict__ gain, int G, int bid) {
    const int gt = bid * 512 + threadIdx.x, NGT = G * 512;
    for (int i = gt; i < T_TOK * 256; i += NGT) { const int t = i >> 8, c4 = i & 255; const float rs = rs_from_ss(ss[t]);
        f32x4 v = *(f32x4*)(out + (size_t)t * 1024 + 4 * c4); const f32x4 gn = *(const f32x4*)(gain + 4 * c4); v = v * rs * gn; *(f32x4*)(out + (size_t)t * 1024 + 4 * c4) = v; }
}

__global__ void __launch_bounds__(NWAVES * 64, 2) mega_fwd(Args A) {
    extern __shared__ __attribute__((aligned(16))) unsigned char lds_raw[];
    LAS unsigned char* lds = (LAS unsigned char*)lds_raw;
    cg::grid_group grid = cg::this_grid();
    const int G = gridDim.x, bid = blockIdx.x;
    unsigned char* ws = A.ws;
    float* ss = (float*)(ws + WS_SS);
    bf16* hb = (bf16*)(ws + WS_HB); bf16* MX = (bf16*)(ws + WS_MX);
    bf16* QKVh = (bf16*)(ws + WS_BIG); float* H = (float*)(ws + WS_H); bf16* ACT = (bf16*)(ws + WS_ACT); bf16* P2 = (bf16*)(ws + WS_ACT);
    bf16* Oh = (bf16*)A.out; bf16* Cst = (bf16*)A.out; bf16* OP = (bf16*)A.out + (size_t)32 * 1024 * 1024;
    float* lse = (float*)(ws + WS_LSE); float* gates = (float*)(ws + WS_GATES); float* rope = (float*)(ws + WS_ROPE);
    float* mst = (float*)(ws + WS_MST); float* nst = (float*)(ws + WS_NST);
    bf16* QKc = hb;
    float* GA = (float*)(ws + 460 * MiB); float* GB = GA + (size_t)T_TOK * 8; float* GP = GB + (size_t)T_TOK * 8; float* CH = GP + (size_t)T_TOK * 8;
    const int lo = A.ph_lo, hi = A.ph_hi;
    volatile LAS unsigned* MISC = (volatile LAS unsigned*)(lds + LDS_BYTES - 256);
    if (threadIdx.x < 16) MISC[threadIdx.x] = 0u;
    __syncthreads();
    const XcdBarrier bar = xcd_barrier_post((unsigned*)(ws + WS_BAR), MISC + 8);
#ifndef PROBE_MASK
#define PROBE_MASK 0u
#endif
#define PROBE_K 4ull
    unsigned long long pr_sum = 0ull, pr_t0 = 0ull, pr_s0 = 0ull;
#define PB(k) do { if (PROBE_MASK & (1u << (k))) pr_t0 = __builtin_amdgcn_s_memrealtime(); } while (0)
#define PE(k) do { if (PROBE_MASK & (1u << (k))) pr_sum += __builtin_amdgcn_s_memrealtime() - pr_t0; } while (0)
#define IN(k) (lo <= (k) && (k) < hi)
#define SYNC(k) do { if (IN(k) && IN((k) + 1)) { if (PROBE_MASK & (1u << 30)) pr_s0 = __builtin_amdgcn_s_memrealtime(); if (hi < 0) { __threadfence(); grid.sync(); __threadfence(); } else xcd_barrier(bar); if (PROBE_MASK & (1u << 30)) pr_sum += __builtin_amdgcn_s_memrealtime() - pr_s0; if (PROBE_MASK & (1u << 29)) { pr_s0 = __builtin_amdgcn_s_memrealtime(); xcd_barrier(bar); pr_sum += __builtin_amdgcn_s_memrealtime() - pr_s0; } } PE(k); } while (0)
    PB(0); if (IN(0)) p0_prologue(A, lds, G, bid);
    SYNC(0);
    PB(1); if (IN(1)) { pg8::Gemm g{hb, (const bf16*)(ws + WS_WQKV), THALF, 9216, 1024}; pg8::StaticOrder S; S.init(THALF, 9216, G, bid);
        pg8::EpiQKV E{QKVh, ss, rope}; pg8::gemm_phase<pg8::EpiQKV, pg8::StaticOrder, true, true>(lds, g, S, E); }
    SYNC(1);
    PB(2); if (IN(2)) attn_phase(lds, QKVh, Oh, lse, 0, G, bid);
    SYNC(2);
    PB(3); if (IN(3)) { merge_phase(Oh, lse, MX, 0, G, bid);
        pg8::Gemm g{hb + (size_t)THALF * 1024, (const bf16*)(ws + WS_WQKV), THALF, 9216, 1024}; pg8::StaticOrder S; S.init(THALF, 9216, G, bid);
        pg8::EpiQKV E{QKVh, ss + THALF, rope + (size_t)THALF * 32}; pg8::gemm_phase<pg8::EpiQKV, pg8::StaticOrder, true, true>(lds, g, S, E); }
    SYNC(3);
    PB(4); if (IN(4)) attn_phase(lds, QKVh, Oh, lse, 1, G, bid);
    SYNC(4);
    PB(5); if (IN(5)) merge_phase(Oh, lse, MX, 1, G, bid);
    SYNC(5);
    PB(6); if (IN(6)) { pg8::Gemm g{MX, (const bf16*)(ws + WS_WAO), T_TOK, 1024, 1024}; pg8::StaticOrder S; S.init(T_TOK, 1024, G, bid);
        pg8::EpiResid E{A.x, H, hb, ss + T_TOK}; pg8::gemm_phase<pg8::EpiResid, pg8::StaticOrder, true, true>(lds, g, S, E); }
    SYNC(6);
    PB(7); if (IN(7)) { pg8::Gemm g{hb, (const bf16*)(ws + WS_WFFIN), T_TOK, 5632, 1024}; pg8::StaticOrder S; S.init(T_TOK, 5632, G, bid);
        pg8::EpiSwiGLU E{ACT, ss + T_TOK}; pg8::gemm_phase<pg8::EpiSwiGLU, pg8::StaticOrder, true, true>(lds, g, S, E); }
    SYNC(7);
    PB(8); if (IN(8)) { pg8::Gemm g{ACT, (const bf16*)(ws + WS_WFFOUT), T_TOK, 1024, DFF}; pg8::StaticOrder S; S.init(T_TOK, 1024, G, bid);
        pg8::EpiResid E{H, H, hb, ss + 2 * T_TOK}; pg8::gemm_phase<pg8::EpiResid, pg8::StaticOrder, true, true>(lds, g, S, E); }
    SYNC(8);
    PB(9); if (IN(9)) { pg8::Gemm g{hb, (const bf16*)(ws + WS_WMIN), T_TOK, 3328, 1024}; pg8::StaticOrder S; S.init(T_TOK, 3328, G, bid);
        pg8::EpiMlstmIn E{P2, OP, gates, ss + 2 * T_TOK}; pg8::gemm_phase<pg8::EpiMlstmIn, pg8::StaticOrder, true, true>(lds, g, S, E); }
    SYNC(9);
    PB(10); if (IN(10)) { mlstm_pre_phase(P2, gates, A.conv_w, A.conv_b, A.ig_bias, A.fg_bias, QKc, GA, GB, GP, CH, G, bid); xcd_barrier(bar);
        mlstm_scan_phase(lds, P2, QKc, GA, CH, Cst, nst, mst, G, bid); }
    SYNC(10);
    PB(11); if (IN(11)) mlstm_out_phase(lds, P2, QKc, OP, GA, GB, GP, A.head_gain, Cst, nst, mst, MX, G, bid);
    SYNC(11);
    PB(12); if (IN(12)) { pg8::Gemm g{MX, (const bf16*)(ws + WS_WMOUT), T_TOK, 1024, 1024}; pg8::StaticOrder S; S.init(T_TOK, 1024, G, bid);
        pg8::EpiResid E{H, H, hb, ss + 3 * T_TOK}; pg8::gemm_phase<pg8::EpiResid, pg8::StaticOrder, true, true>(lds, g, S, E); }
    SYNC(12);
    PB(13); if (IN(13)) { pg8::Gemm g{hb, (const bf16*)(ws + WS_WFFIN) + (size_t)5632 * 1024, T_TOK, 5632, 1024}; pg8::StaticOrder S; S.init(T_TOK, 5632, G, bid);
        pg8::EpiSwiGLU E{ACT, ss + 3 * T_TOK}; pg8::gemm_phase<pg8::EpiSwiGLU, pg8::StaticOrder, true, true>(lds, g, S, E); }
    SYNC(13);
    PB(14); if (IN(14)) { pg8::Gemm g{ACT, (const bf16*)(ws + WS_WFFOUT) + (size_t)1024 * DFF, T_TOK, 1024, DFF}; pg8::StaticOrder S; S.init(T_TOK, 1024, G, bid);
        pg8::EpiResid E{H, A.out, nullptr, ss + 4 * T_TOK}; pg8::gemm_phase<pg8::EpiResid, pg8::StaticOrder, true, true>(lds, g, S, E); }
    SYNC(14);
    PB(15); if (IN(15)) final_phase(A.out, ss + 4 * T_TOK, A.final_norm, G, bid);
    PE(15);
    if (PROBE_MASK != 0u && bid == 0 && threadIdx.x == 0) { const unsigned long long te = __builtin_amdgcn_s_memrealtime(); while (__builtin_amdgcn_s_memrealtime() - te < PROBE_K * pr_sum) __builtin_amdgcn_s_sleep(8); }
#undef IN
#undef SYNC
}

extern "C" void kernel_launch(void* const* d_in, const int* in_sizes, int n_in, void* d_out, int out_size, void* d_ws, size_t ws_size, hipStream_t stream) {
    static int grid = 0;
    if (grid == 0) {
        if (n_in != 17 || in_sizes[0] != T_TOK * DM || out_size != T_TOK * DM || ws_size < WS_END) { fprintf(stderr, "kernel_launch: unexpected shapes (n_in %d, in0 %d, out %d, ws %zu); nothing launched\n", n_in, n_in > 0 ? in_sizes[0] : -1, out_size, ws_size); grid = -1; return; }
        int dev = 0, cus = 0, per_cu = 0;
        if (hipGetDevice(&dev) != hipSuccess || hipDeviceGetAttribute(&cus, hipDeviceAttributeMultiprocessorCount, dev) != hipSuccess) { grid = -1; return; }
        if (hipFuncSetAttribute((const void*)mega_fwd, hipFuncAttributeMaxDynamicSharedMemorySize, LDS_BYTES) != hipSuccess) { fprintf(stderr, "kernel_launch: hipFuncSetAttribute failed\n"); grid = -1; return; }
        if (hipOccupancyMaxActiveBlocksPerMultiprocessor(&per_cu, (const void*)mega_fwd, NWAVES * 64, LDS_BYTES) != hipSuccess || per_cu < 1) { fprintf(stderr, "kernel_launch: occupancy query says %d\n", per_cu); per_cu = 1; }
        (void)hipGetLastError();
        grid = cus;
    }
    if (grid < 0) return;
    Args a{};
    a.x = (const float*)d_in[0]; a.pos = (const int*)d_in[1]; a.attn_norm = (const float*)d_in[2]; a.attn_w_in = (const float*)d_in[3]; a.attn_w_out = (const float*)d_in[4];
    a.mlstm_norm = (const float*)d_in[5]; a.mlstm_w_in = (const float*)d_in[6]; a.conv_w = (const float*)d_in[7]; a.conv_b = (const float*)d_in[8]; a.ig_bias = (const float*)d_in[9];
    a.fg_bias = (const float*)d_in[10]; a.head_gain = (const float*)d_in[11]; a.mlstm_w_out = (const float*)d_in[12]; a.ffn_norm = (const float*)d_in[13]; a.ffn_w_in = (const float*)d_in[14];
    a.ffn_w_out = (const float*)d_in[15]; a.final_norm = (const float*)d_in[16];
    a.out = (float*)d_out; a.ws = (unsigned char*)d_ws; a.ph_lo = 0; a.ph_hi = 16;
    if (hipMemsetAsync((char*)d_ws + WS_BAR, 0, 16384, stream) != hipSuccess) { fprintf(stderr, "kernel_launch: hipMemsetAsync failed\n"); return; }
    void* args[] = {&a};
    const hipError_t e = hipLaunchCooperativeKernel((const void*)mega_fwd, dim3(grid), dim3(NWAVES * 64), args, LDS_BYTES, stream);
    if (e != hipSuccess) fprintf(stderr, "kernel_launch: cooperative launch failed: %s (grid %d)\n", hipGetErrorString(e), grid);
}
```

```cpp
#include <hip/hip_runtime.h>
#include <hip/hip_cooperative_groups.h>
#include <cstdio>
#include <cstdint>
namespace cg = cooperative_groups;

constexpr float RMS_EPS = 1e-6f;
__device__ __forceinline__ float rs_from_ss(float ss) { return __builtin_amdgcn_rsqf(ss * (1.0f / 1024.0f) + RMS_EPS); }
__device__ __forceinline__ float silu_f(float x) { return x * __builtin_amdgcn_rcpf(1.0f + __builtin_amdgcn_exp2f(x * -1.4426950408889634f)); }
__device__ __forceinline__ float sigmoid_f(float x) { return __builtin_amdgcn_rcpf(1.0f + __builtin_amdgcn_exp2f(x * -1.4426950408889634f)); }

namespace pg8 {
#define PG8_LAS __attribute__((address_space(3)))
typedef unsigned short bf16_t;
typedef short bf16x8 __attribute__((ext_vector_type(8)));
typedef float f32x4 __attribute__((ext_vector_type(4)));
typedef unsigned u32x4 __attribute__((ext_vector_type(4)));
constexpr int BM = 256, BK = 64, HALF = 128, HTB = HALF * BK * 2  , STAGE_BYTES = 8 * HTB, NXCD = 8, WGM = 8;

__host__ __device__ __forceinline__ int lds_byte(int r, int c) { const int st = (r >> 4) * 2 + (c >> 5), rr = r & 15, cc = c & 31, ob = rr * 64 + cc * 2; return st * 1024 + (ob ^ (((ob >> 9) & 1) << 5)); }
__host__ __device__ __forceinline__ void stage_rc(int b, int& R, int& C) { const int st = b / 1024, sb = b % 1024, swz = sb ^ (((sb >> 9) & 1) << 5); R = (st >> 1) * 16 + swz / 64; C = (st & 1) * 32 + (swz % 64) / 2; }
__host__ __device__ __forceinline__ int perm32(int rho) { const int n = rho >> 4, i = rho & 15; return 8 * (i >> 2) + 4 * n + (i & 3); }

typedef unsigned u32x2 __attribute__((ext_vector_type(2)));
struct Unit { int pm, pn; };
struct Gemm { const bf16_t* A; const bf16_t* Bt; int M, N, K; };

struct StaticOrder {
    int nM, nN, nwg, G, c;
    __host__ __device__ void init(int M, int N, int G_, int c_) { nM = M / BM; nN = N / BM; nwg = nM * nN; G = G_; c = c_; }
    __host__ __device__ bool next(int i, Unit& u) const {
        const long L = (long)i * G + c; if (L >= nwg) return false;
        int wgid = (int)L; { const int q = nwg / NXCD, r = nwg % NXCD, xcd = wgid % NXCD, off = wgid / NXCD; wgid = (xcd < r ? xcd * (q + 1) : r * (q + 1) + (xcd - r) * q) + off; }
        const int nig = WGM * nN, gid = wgid / nig, fm = gid * WGM, gsz = (nM - fm) < WGM ? (nM - fm) : WGM;
        u.pm = fm + ((wgid % nig) % gsz); u.pn = (wgid % nig) / gsz; return true;
    }
    __device__ __forceinline__ void a_ready(const Unit&) const {}
    __device__ __forceinline__ void done(const Unit&) const {}
};
__device__ __forceinline__ unsigned cvt_pk_bf16(float lo, float hi) { unsigned r; asm volatile("v_cvt_pk_bf16_f32 %0, %1, %2" : "=v"(r) : "v"(lo), "v"(hi)); return r; }

#define EPI_FENCE() asm volatile("" ::: "memory")
struct EpiQKV {
    static constexpr bool PERM = true, AFTER_DRAIN = false;
    bf16_t* O; const float* ss; const float* cs;
    __device__ __forceinline__ void operator()(const f32x4 (&acc)[2][2][4][2], const Unit& u, int wr, int wc, int fr, int fq) const {
        const int row0 = u.pm * BM + wr * 64 + fr; const int colt = u.pn * BM;
        const int tsel = (colt % 3072) / 1024;
        const bool rope = (tsel < 2) && (wc == 0);
        const int gsel = colt / 3072, lg = 2 * gsel, dil = 1 << lg;
        const int hb0 = (gsel * 3 + tsel) * 8 + (colt % 1024) / 128;
        float rsv[8];
#pragma unroll
        for (int k = 0; k < 8; ++k) rsv[k] = ss[row0 + (k >> 2) * HALF + (k & 3) * 16];
        f32x4 cA = {0.f, 0.f, 0.f, 0.f}, sA = cA;
        if (rope) { const float* p = cs + (size_t)row0 * 32 + 4 * fq; cA = *(const f32x4*)p; sA = *(const f32x4*)(p + 16); }
#pragma unroll
        for (int k = 0; k < 8; ++k) {
            const int ai = k >> 2, m = k & 3;
            const int row = row0 + ai * HALF + m * 16;
            f32x4 cN = cA, sN = sA;
            if (rope && k + 1 < 8) { const int rown = row0 + ((k + 1) >> 2) * HALF + ((k + 1) & 3) * 16; const float* p = cs + (size_t)rown * 32 + 4 * fq; cN = *(const f32x4*)p; sN = *(const f32x4*)(p + 16); }
            EPI_FENCE();
            const float rs = rs_from_ss(rsv[k]);
            const int sq = row & 2047, perm = ((sq & (dil - 1)) << (11 - lg)) + (sq >> lg);
            bf16_t* rowp = O + ((size_t)hb0 * 17408 + (row >> 11) * 2176 + perm) * 128;
            if (rope) {
                const f32x4 cr = cA * rs, sr = sA * rs;
#pragma unroll
                for (int bj = 0; bj < 2; ++bj) {
                    const f32x4 v0 = acc[ai][bj][m][0], v1 = acc[ai][bj][m][1];
                    const f32x4 o0 = v0 * cr - v1 * sr, o1 = v1 * cr + v0 * sr;
                    u32x2 w0, w1; w0.x = cvt_pk_bf16(o0[0], o0[1]); w0.y = cvt_pk_bf16(o0[2], o0[3]); w1.x = cvt_pk_bf16(o1[0], o1[1]); w1.y = cvt_pk_bf16(o1[2], o1[3]);
                    bf16_t* hp = rowp + (size_t)bj * 17408 * 128 + 4 * fq;
                    *(u32x2*)hp = w0; *(u32x2*)(hp + 16) = w1;
                }
            } else {
#pragma unroll
                for (int bj = 0; bj < 2; ++bj) {
                    const f32x4 v0 = acc[ai][bj][m][0] * rs, v1 = acc[ai][bj][m][1] * rs;
                    u32x4 wv; wv.x = cvt_pk_bf16(v0[0], v0[1]); wv.y = cvt_pk_bf16(v0[2], v0[3]); wv.z = cvt_pk_bf16(v1[0], v1[1]); wv.w = cvt_pk_bf16(v1[2], v1[3]);
                    *(u32x4*)(rowp + (size_t)bj * 17408 * 128 + wc * 32 + 8 * fq) = wv;
                }
            }
            cA = cN; sA = sN;
        }
    }
};
struct EpiResid {
    static constexpr bool PERM = true, AFTER_DRAIN = false;
    const float* base; float* out; bf16_t* outb; float* ssn;
    __device__ __forceinline__ void operator()(const f32x4 (&acc)[2][2][4][2], const Unit& u, int wr, int wc, int fr, int fq) const {
        const int row0 = u.pm * BM + wr * 64 + fr; const int col0 = u.pn * BM + wc * 32 + 8 * fq;
        f32x4 bA[4];
        { const float* p = base + (size_t)row0 * 1024 + col0; bA[0] = *(const f32x4*)p; bA[1] = *(const f32x4*)(p + 4); bA[2] = *(const f32x4*)(p + HALF); bA[3] = *(const f32x4*)(p + HALF + 4); }
#pragma unroll
        for (int k = 0; k < 8; ++k) {
            const int ai = k >> 2, m = k & 3;
            const int row = row0 + ai * HALF + m * 16;
            f32x4 bN[4];
#pragma unroll
            for (int q = 0; q < 4; ++q) bN[q] = bA[q];
            if (k + 1 < 8) { const int rown = row0 + ((k + 1) >> 2) * HALF + ((k + 1) & 3) * 16; const float* p = base + (size_t)rown * 1024 + col0;
                bN[0] = *(const f32x4*)p; bN[1] = *(const f32x4*)(p + 4); bN[2] = *(const f32x4*)(p + HALF); bN[3] = *(const f32x4*)(p + HALF + 4); }
            EPI_FENCE();
            float sq = 0.f;
#pragma unroll
            for (int bj = 0; bj < 2; ++bj) {
                const size_t off = (size_t)row * 1024 + col0 + bj * HALF;
                const f32x4 v0 = acc[ai][bj][m][0] + bA[2 * bj], v1 = acc[ai][bj][m][1] + bA[2 * bj + 1];
                *(f32x4*)(out + off) = v0; *(f32x4*)(out + off + 4) = v1;
                if (outb) { u32x4 wv; wv.x = cvt_pk_bf16(v0[0], v0[1]); wv.y = cvt_pk_bf16(v0[2], v0[3]); wv.z = cvt_pk_bf16(v1[0], v1[1]); wv.w = cvt_pk_bf16(v1[2], v1[3]); *(u32x4*)(outb + off) = wv; }
                sq += (v0[0] * v0[0] + v0[1] * v0[1]) + (v0[2] * v0[2] + v0[3] * v0[3]) + (v1[0] * v1[0] + v1[1] * v1[1]) + (v1[2] * v1[2] + v1[3] * v1[3]);
            }
            sq += __shfl_xor(sq, 16); sq += __shfl_xor(sq, 32);
            if (fq == 0) atomicAdd(ssn + row, sq);
#pragma unroll
            for (int q = 0; q < 4; ++q) bA[q] = bN[q];
        }
    }
};
struct EpiSwiGLU {
    static constexpr bool PERM = true, AFTER_DRAIN = false;
    bf16_t* O; const float* ss;
    __device__ __forceinline__ void operator()(const f32x4 (&acc)[2][2][4][2], const Unit& u, int wr, int wc, int fr, int fq) const {
        const int row0 = u.pm * BM + wr * 64 + fr; const int col0 = u.pn * HALF + wc * 32 + 8 * fq;
        float rsv[8];
#pragma unroll
        for (int k = 0; k < 8; ++k) rsv[k] = ss[row0 + (k >> 2) * HALF + (k & 3) * 16];
        EPI_FENCE();
#pragma unroll
        for (int ai = 0; ai < 2; ++ai)
#pragma unroll
            for (int m = 0; m < 4; ++m) {
                const int row = row0 + ai * HALF + m * 16;
                const float rs = rs_from_ss(rsv[ai * 4 + m]); const float rs2 = rs * rs, nrs = rs * -1.4426950408889634f;
                float o[8];
#pragma unroll
                for (int n = 0; n < 2; ++n)
#pragma unroll
                    for (int e = 0; e < 4; ++e) { const float g = acc[ai][0][m][n][e], uu = acc[ai][1][m][n][e] * rs2;
                        o[4 * n + e] = (g * uu) * __builtin_amdgcn_rcpf(1.0f + __builtin_amdgcn_exp2f(g * nrs)); }
                u32x4 wv; wv.x = cvt_pk_bf16(o[0], o[1]); wv.y = cvt_pk_bf16(o[2], o[3]); wv.z = cvt_pk_bf16(o[4], o[5]); wv.w = cvt_pk_bf16(o[6], o[7]);
                *(u32x4*)(O + (size_t)row * 2816 + col0) = wv;
            }
    }
};
struct EpiMlstmIn {
    static constexpr bool PERM = true, AFTER_DRAIN = false;
    bf16_t* P2; bf16_t* OP; float* gates; const float* ss;
    __device__ __forceinline__ void operator()(const f32x4 (&acc)[2][2][4][2], const Unit& u, int wr, int wc, int fr, int fq) const {
        const int row0 = u.pm * BM + wr * 64 + fr;
        float rsv[8];
#pragma unroll
        for (int k = 0; k < 8; ++k) rsv[k] = ss[row0 + (k >> 2) * HALF + (k & 3) * 16];
        EPI_FENCE();
#pragma unroll
        for (int ai = 0; ai < 2; ++ai)
#pragma unroll
            for (int m = 0; m < 4; ++m) {
                const int row = row0 + ai * HALF + m * 16;
                const float rs = rs_from_ss(rsv[ai * 4 + m]);
#pragma unroll
                for (int bj = 0; bj < 2; ++bj) {
                    const int cb = u.pn * BM + bj * HALF;
                    const f32x4 v0 = acc[ai][bj][m][0] * rs, v1 = acc[ai][bj][m][1] * rs;
                    const int cc = wc * 32 + 8 * fq;
                    if (cb < 3072) {
                        u32x4 wv; wv.x = cvt_pk_bf16(v0[0], v0[1]); wv.y = cvt_pk_bf16(v0[2], v0[3]); wv.z = cvt_pk_bf16(v1[0], v1[1]); wv.w = cvt_pk_bf16(v1[2], v1[3]);
                        bf16_t* dst = (cb < 2048) ? (P2 + (size_t)row * 2048 + cb + cc) : (OP + (size_t)row * 1024 + (cb - 2048) + cc);
                        *(u32x4*)dst = wv;
                    } else if (cb == 3072 && cc < 16) {
                        float* dst = gates + (size_t)row * 16 + cc;
                        *(f32x4*)dst = v0; *(f32x4*)(dst + 4) = v1;
                    }
                }
            }
    }
};

template <class Epi, class Sched, bool ALIGN_EPI = false, bool SP2 = false>
__device__ __forceinline__ void gemm_phase(PG8_LAS unsigned char* lds, const Gemm g, const Sched& S, const Epi& E) {
    const int tid = threadIdx.x, wid = __builtin_amdgcn_readfirstlane(tid >> 6), lane = tid & 63, wr = wid >> 2, wc = wid & 3, fr = lane & 15, fq = lane >> 4;
    const int K = g.K, nt = K / BK;
    unsigned voffA[2], voffB[2];
#pragma unroll
    for (int i = 0; i < 2; ++i) { int R, C; stage_rc(tid * 16 + i * 8192, R, C); const int Rb = Epi::PERM ? ((R & ~31) + perm32(R & 31)) : R;
        voffA[i] = (unsigned)(R * K + C) * 2u; voffB[i] = (unsigned)(Rb * K + C) * 2u; }
    const size_t kstep = (size_t)(BK * 2);
    const size_t hstep = (size_t)HALF * K * 2;
    const size_t tstep = 2 * hstep;
    const unsigned ldsw = (unsigned)wid * 1024u;
    const int aoff = lds_byte(wr * 64 + fr, fq * 8), boff = lds_byte(wc * 32 + fr, fq * 8);
#define PG8_SA(b, h) (((b) * 2 + (h)) * HTB)
#define PG8_SB(b, h) ((4 + (b) * 2 + (h)) * HTB)
#define PG8_STAGE(bufoff, gbase, voff) do { _Pragma("unroll") for (int _i = 0; _i < 2; ++_i) \
        __builtin_amdgcn_global_load_lds((const unsigned*)((const char*)(gbase) + (voff)[_i]), (PG8_LAS unsigned*)(lds + (bufoff) + ldsw + _i * 8192), 16, 0, 0); } while (0)
#define PG8_LDA(dst, b, h) do { _Pragma("unroll") for (int m = 0; m < 4; ++m) _Pragma("unroll") for (int k = 0; k < 2; ++k) dst[m][k] = *(const PG8_LAS bf16x8*)(lds + PG8_SA(b, h) + aoff + m * 2048 + k * 1024); } while (0)
#define PG8_LDB(dst, b, h) do { _Pragma("unroll") for (int n = 0; n < 2; ++n) _Pragma("unroll") for (int k = 0; k < 2; ++k) dst[n][k] = *(const PG8_LAS bf16x8*)(lds + PG8_SB(b, h) + boff + n * 2048 + k * 1024); } while (0)
#define PG8_MMA(ai, bj, At, Bt) do { __builtin_amdgcn_s_setprio(1); _Pragma("unroll") for (int m = 0; m < 4; ++m) _Pragma("unroll") for (int n = 0; n < 2; ++n) _Pragma("unroll") for (int k = 0; k < 2; ++k) \
        acc[ai][bj][m][n] = __builtin_amdgcn_mfma_f32_16x16x32_bf16(Bt[n][k], At[m][k], acc[ai][bj][m][n], 0, 0, 0); __builtin_amdgcn_s_setprio(0); } while (0)
#define PG8_WAIT_V(n) asm volatile("s_waitcnt vmcnt(" #n ")" ::: "memory")
#define PG8_WAIT_L(n) asm volatile("s_waitcnt lgkmcnt(" #n ")" ::: "memory")
#define PG8_BAR __builtin_amdgcn_s_barrier()
#define PG8_SCHED __builtin_amdgcn_sched_barrier(0)
    Unit cur, nxt; int ui = 0;
    if (!S.next(0, cur)) return;
    f32x4 acc[2][2][4][2];
#pragma unroll
    for (int a = 0; a < 2; ++a)
#pragma unroll
        for (int b = 0; b < 2; ++b)
#pragma unroll
            for (int m = 0; m < 4; ++m)
#pragma unroll
                for (int n = 0; n < 2; ++n) acc[a][b][m][n] = (f32x4){0.f, 0.f, 0.f, 0.f};
    bf16x8 At[4][2], B0[2][2], B1[2][2];
    const char* cA = (const char*)g.A + (size_t)cur.pm * tstep; const char* cB = (const char*)g.Bt + (size_t)cur.pn * tstep;
    S.a_ready(cur);
    if constexpr (SP2) {
        PG8_STAGE(PG8_SB(0, 0), cB, voffB); PG8_STAGE(PG8_SB(0, 1), cB + hstep, voffB); PG8_STAGE(PG8_SA(0, 0), cA, voffA); PG8_STAGE(PG8_SA(0, 1), cA + hstep, voffA);
        if (wr == 1) PG8_BAR;
        PG8_WAIT_V(2); PG8_BAR;
        PG8_STAGE(PG8_SB(1, 0), cB + kstep, voffB); PG8_STAGE(PG8_SA(1, 0), cA + kstep, voffA); PG8_STAGE(PG8_SB(1, 1), cB + hstep + kstep, voffB);
        PG8_WAIT_V(6); PG8_BAR;
    } else {
        PG8_STAGE(PG8_SB(0, 0), cB, voffB); PG8_STAGE(PG8_SA(0, 0), cA, voffA); PG8_STAGE(PG8_SB(0, 1), cB + hstep, voffB); PG8_STAGE(PG8_SA(0, 1), cA + hstep, voffA);
        if (wr == 1) PG8_BAR;
        PG8_WAIT_V(4); PG8_BAR;
        PG8_STAGE(PG8_SB(1, 0), cB + kstep, voffB); PG8_STAGE(PG8_SA(1, 0), cA + kstep, voffA); PG8_STAGE(PG8_SB(1, 1), cB + hstep + kstep, voffB);
        PG8_WAIT_V(6); PG8_BAR;
    }
    for (;;) {
        const bool has_next = S.next(ui + 1, nxt);
        const char* nA = has_next ? (const char*)g.A + (size_t)nxt.pm * tstep : cA; const char* nB = has_next ? (const char*)g.Bt + (size_t)nxt.pn * tstep : cB;
        for (int t = 0; t < nt; t += 2) {
            const bool last = (t == nt - 2);
            const char* a1 = cA + (size_t)(t + 1) * kstep;
            const char* a2 = last ? nA : cA + (size_t)(t + 2) * kstep; const char* b2 = last ? nB : cB + (size_t)(t + 2) * kstep;
            const char* a3 = a2 + kstep; const char* b3 = b2 + kstep;
            if (last && has_next) S.a_ready(nxt);
            if constexpr (SP2) {
            PG8_LDB(B0, 0, 0); PG8_LDB(B1, 0, 1); PG8_SCHED; PG8_LDA(At, 0, 0); PG8_STAGE(PG8_SA(1, 1), a1 + hstep, voffA);
            PG8_WAIT_V(8); PG8_WAIT_L(0); PG8_BAR; PG8_MMA(0, 0, At, B0); PG8_MMA(0, 1, At, B1); PG8_BAR; PG8_SCHED;
            PG8_LDA(At, 0, 1); PG8_STAGE(PG8_SB(0, 0), b2, voffB); PG8_STAGE(PG8_SB(0, 1), b2 + hstep, voffB); PG8_STAGE(PG8_SA(0, 0), a2, voffA);
            PG8_WAIT_V(8); PG8_WAIT_L(0); PG8_BAR; PG8_MMA(1, 0, At, B0); PG8_MMA(1, 1, At, B1); PG8_BAR; PG8_SCHED;
            PG8_LDB(B0, 1, 0); PG8_LDB(B1, 1, 1); PG8_SCHED; PG8_LDA(At, 1, 0); PG8_STAGE(PG8_SA(0, 1), a2 + hstep, voffA);
            PG8_WAIT_V(8); PG8_WAIT_L(0); PG8_BAR; PG8_MMA(0, 0, At, B0); PG8_MMA(0, 1, At, B1); PG8_BAR; PG8_SCHED;
            PG8_LDA(At, 1, 1); PG8_STAGE(PG8_SB(1, 0), b3, voffB); PG8_STAGE(PG8_SB(1, 1), b3 + hstep, voffB); PG8_STAGE(PG8_SA(1, 0), a3, voffA);
            PG8_WAIT_V(8); PG8_WAIT_L(0); PG8_BAR; PG8_MMA(1, 0, At, B0); PG8_MMA(1, 1, At, B1); PG8_BAR; PG8_SCHED;
            } else {
            PG8_LDB(B0, 0, 0); PG8_SCHED; PG8_LDA(At, 0, 0); PG8_STAGE(PG8_SA(1, 1), a1 + hstep, voffA);
            PG8_WAIT_L(8); PG8_BAR; PG8_WAIT_L(0); PG8_MMA(0, 0, At, B0); PG8_BAR; PG8_SCHED;
            PG8_LDB(B1, 0, 1); PG8_STAGE(PG8_SB(0, 0), b2, voffB);
            PG8_BAR; PG8_WAIT_L(0); PG8_MMA(0, 1, At, B1); PG8_BAR;
            PG8_LDA(At, 0, 1); PG8_STAGE(PG8_SA(0, 0), a2, voffA);
            PG8_BAR; PG8_WAIT_L(0); PG8_MMA(1, 0, At, B0); PG8_BAR; PG8_SCHED;
            PG8_STAGE(PG8_SB(0, 1), b2 + hstep, voffB);
            PG8_WAIT_V(6); PG8_BAR; PG8_MMA(1, 1, At, B1); PG8_BAR;
            PG8_LDB(B0, 1, 0); PG8_SCHED; PG8_LDA(At, 1, 0); PG8_STAGE(PG8_SA(0, 1), a2 + hstep, voffA);
            PG8_WAIT_L(8); PG8_BAR; PG8_WAIT_L(0); PG8_MMA(0, 0, At, B0); PG8_BAR; PG8_SCHED;
            PG8_LDB(B1, 1, 1); PG8_STAGE(PG8_SB(1, 0), b3, voffB);
            PG8_BAR; PG8_WAIT_L(0); PG8_MMA(0, 1, At, B1); PG8_BAR;
            PG8_LDA(At, 1, 1); PG8_STAGE(PG8_SA(1, 0), a3, voffA);
            PG8_BAR; PG8_WAIT_L(0); PG8_MMA(1, 0, At, B0); PG8_BAR; PG8_SCHED;
            PG8_STAGE(PG8_SB(1, 1), b3 + hstep, voffB);
            PG8_WAIT_V(6); PG8_BAR; PG8_MMA(1, 1, At, B1); PG8_BAR;
            }
        }
        if constexpr (ALIGN_EPI) { if (wr == 0) PG8_BAR; }
        if constexpr (!Epi::AFTER_DRAIN) { E(acc, cur, wr, wc, fr, fq); S.done(cur); }
        if (!has_next) break;
#pragma unroll
        for (int a = 0; a < 2; ++a)
#pragma unroll
            for (int b = 0; b < 2; ++b)
#pragma unroll
                for (int m = 0; m < 4; ++m)
#pragma unroll
                    for (int n = 0; n < 2; ++n) acc[a][b][m][n] = (f32x4){0.f, 0.f, 0.f, 0.f};
        cur = nxt; cA = nA; cB = nB; ++ui;
        if constexpr (ALIGN_EPI) { if (wr == 1) PG8_BAR; }
    }
    PG8_WAIT_V(0);
    if constexpr (!ALIGN_EPI) { if (wr == 0) PG8_BAR; }
    PG8_BAR;
    if constexpr (Epi::AFTER_DRAIN) { E.fused(acc, cur, wr, wc, fr, fq, lds, wid, lane); S.done(cur); }
#undef PG8_SA
#undef PG8_SB
#undef PG8_STAGE
#undef PG8_LDA
#undef PG8_LDB
#undef PG8_MMA
#undef PG8_WAIT_V
#undef PG8_WAIT_L
#undef PG8_BAR
#undef PG8_SCHED
}
}

constexpr int T_TOK = 32768, DM = 1024, SEQ = 2048, NB = 16, DFF = 2816, THALF = 16384;
constexpr int NWAVES = 8;
constexpr int RB = 2176, HBR = 8 * RB;
constexpr int LDS_BYTES = 147456;
constexpr size_t MiB = 1u << 20;
constexpr size_t WS_SS = 0;
constexpr size_t WS_MST = 1 * MiB;
constexpr size_t WS_NST = 1 * MiB + 65536;
constexpr size_t WS_BAR = 3 * MiB;
constexpr size_t WS_WQKV = 4 * MiB;
constexpr size_t WS_WAO = 22 * MiB;
constexpr size_t WS_WFFIN = 24 * MiB;
constexpr size_t WS_WFFOUT = 46 * MiB;
constexpr size_t WS_WMIN = 57 * MiB;
constexpr size_t WS_WMOUT = 64 * MiB;
constexpr size_t WS_ROPE = 66 * MiB;
constexpr size_t WS_LSE = 70 * MiB;
constexpr size_t WS_GATES = 73 * MiB;
constexpr size_t WS_HB = 76 * MiB;
constexpr size_t WS_MX = 140 * MiB;
constexpr size_t WS_BIG = 204 * MiB;
constexpr size_t WS_H = WS_BIG;
constexpr size_t WS_ACT = WS_BIG + 128 * MiB;
constexpr size_t WS_END = 512 * MiB;
static_assert(WS_ACT + (size_t)T_TOK * DFF * 2 <= WS_END && WS_BIG + (size_t)72 * 8 * 2176 * 256 <= WS_END, "d_ws map");

#define LAS __attribute__((address_space(3)))
typedef unsigned short bf16;
typedef unsigned u32x4 __attribute__((ext_vector_type(4)));
typedef unsigned u32x2 __attribute__((ext_vector_type(2)));
typedef float f32x4 __attribute__((ext_vector_type(4)));
typedef float f32x16 __attribute__((ext_vector_type(16)));
typedef short bf16x8 __attribute__((ext_vector_type(8)));
typedef short s16x4 __attribute__((ext_vector_type(4)));
typedef float f32x2_t __attribute__((ext_vector_type(2)));
typedef __bf16 bf16x2_t __attribute__((ext_vector_type(2)));
__device__ __forceinline__ unsigned pk2(float lo, float hi) { f32x2_t v = {lo, hi}; bf16x2_t b = __builtin_convertvector(v, bf16x2_t); return __builtin_bit_cast(unsigned, b); }
__device__ __forceinline__ float bf_lo(unsigned w) { return __uint_as_float(w << 16); }
__device__ __forceinline__ float bf_hi(unsigned w) { return __uint_as_float(w & 0xffff0000u); }
__device__ __forceinline__ float wave_sum(float v) {
#pragma unroll
    for (int o = 1; o < 64; o <<= 1) v += __shfl_xor(v, o);
    return v;
}
__device__ __forceinline__ float wave_max(float v) {
#pragma unroll
    for (int o = 1; o < 64; o <<= 1) v = fmaxf(v, __shfl_xor(v, o));
    return v;
}
#define MFMA16(a, b, c) __builtin_amdgcn_mfma_f32_16x16x32_bf16((a), (b), (c), 0, 0, 0)
#define MFMA32(a, b, c) __builtin_amdgcn_mfma_f32_32x32x16_bf16((a), (b), (c), 0, 0, 0)

#define XB_TMO      128
#define XB_XCNT(j)  (256  + 64 * (j))
#define XB_XSUB(j)  (1280 + 64 * (j))
#define XB_XGEN(j)  (2304 + 64 * (j))
#define XB_TOP      3328
#define XB_TOPGEN   3392
#define XCD_BAR_WORDS 3456
#define XB_SPIN_CAP (1u << 18)

__device__ __forceinline__ unsigned xb_ld(unsigned* p)              { return __hip_atomic_load(p, __ATOMIC_RELAXED, __HIP_MEMORY_SCOPE_AGENT); }
__device__ __forceinline__ unsigned xb_add(unsigned* p, unsigned v) { return __hip_atomic_fetch_add(p, v, __ATOMIC_RELAXED, __HIP_MEMORY_SCOPE_AGENT); }
__device__ __forceinline__ unsigned xb_xcc_id() { return (unsigned)__builtin_amdgcn_s_getreg((3 << 11) | 20) & 0xFu; }
#define XB_SPIN(cond, bar) do { unsigned _sp = 0; while (cond) { __builtin_amdgcn_s_sleep(1); \
    if ((++_sp & 255u) == 0u) { if (xb_ld(&(bar)[XB_TMO])) break; if (_sp > XB_SPIN_CAP) { atomicAdd(&(bar)[XB_TMO], 1u); break; } } } } while (0)

struct XcdBarrier {
    unsigned* bar; unsigned x;
    volatile LAS unsigned* st;
};

__device__ __forceinline__ XcdBarrier xcd_barrier_post(unsigned* bar, volatile LAS unsigned* st) {
    XcdBarrier b; b.bar = bar; b.x = xb_xcc_id(); b.st = st;
    if (threadIdx.x == 0) (void)xb_add(&bar[XB_XCNT(b.x)], 1u);
    return b;
}
__device__ __forceinline__ void xcd_barrier_complete(unsigned* bar, unsigned x, unsigned& nloc, unsigned& nx) {
    const unsigned G = gridDim.x * gridDim.y * gridDim.z;
    unsigned sum, cnt, mine, sp = 0u;
    for (;;) {
        sum = 0u; cnt = 0u; mine = 0u;
#pragma unroll
        for (unsigned j = 0; j < 16; ++j) { const unsigned c = xb_ld(&bar[XB_XCNT(j)]); sum += c; cnt += (c > 0u) ? 1u : 0u; mine = (j == x) ? c : mine; }
        if (sum == G) break;
        __builtin_amdgcn_s_sleep(1);
        if ((++sp & 255u) == 0u) { if (xb_ld(&bar[XB_TMO])) break; if (sp > XB_SPIN_CAP) { atomicAdd(&bar[XB_TMO], 1u); break; } }
    }
    nloc = mine > 0u ? mine : 1u; nx = cnt > 0u ? cnt : 1u;
}

__device__ __forceinline__ void xcd_barrier(const XcdBarrier& b) {
    asm volatile("s_waitcnt vmcnt(0)" ::: "memory");
    __syncthreads();
    if (threadIdx.x == 0) {
        unsigned* bar = b.bar;
        __builtin_amdgcn_s_waitcnt(0);
        unsigned nloc = b.st[0], nx = b.st[1];
        if (nloc == 0u) { xcd_barrier_complete(bar, b.x, nloc, nx); b.st[0] = nloc; b.st[1] = nx; }
        const unsigned old = xb_add(&bar[XB_XSUB(b.x)], 1u);
        const unsigned gen = old / nloc;
        if (old + 1u == (gen + 1u) * nloc) {
            __builtin_amdgcn_fence(__ATOMIC_RELEASE, "agent");
            asm volatile("s_waitcnt vmcnt(0)" ::: "memory");
            const unsigned og = xb_add(&bar[XB_TOP], 1u);
            const unsigned tg = og / nx;
            if (og + 1u == (tg + 1u) * nx) xb_add(&bar[XB_TOPGEN], 1u);
            else XB_SPIN(xb_ld(&bar[XB_TOPGEN]) == tg, bar);
            __builtin_amdgcn_fence(__ATOMIC_ACQUIRE, "agent");
            xb_add(&bar[XB_XGEN(b.x)], 1u);
            asm volatile("s_waitcnt vmcnt(0)" ::: "memory");
        } else {
            XB_SPIN(xb_ld(&bar[XB_XGEN(b.x)]) == gen, bar);
            __builtin_amdgcn_fence(__ATOMIC_ACQUIRE, "agent");
            asm volatile("s_waitcnt vmcnt(0)" ::: "memory");
        }
    }
    __syncthreads();
}


struct Args {
    const float* x; const int* pos; const float* attn_norm; const float* attn_w_in; const float* attn_w_out; const float* mlstm_norm; const float* mlstm_w_in;
    const float* conv_w; const float* conv_b; const float* ig_bias; const float* fg_bias; const float* head_gain; const float* mlstm_w_out;
    const float* ffn_norm; const float* ffn_w_in; const float* ffn_w_out; const float* final_norm;
    float* out; unsigned char* ws; int ph_lo, ph_hi;
};

__device__ __forceinline__ void tr_item(const float* __restrict__ W, int K, int Nsrc, bf16* WT, int n0_dst, int n0_src, int k0, const float* __restrict__ gain, float scale, LAS float* scr, int lane, bool ropeperm = false) {
    const int n4 = lane & 15, kq = lane >> 4; const int s4 = (ropeperm && n4 < 8) ? (((n4 & 1) << 2) + (n4 >> 1)) : n4; const int col = n0_src + 4 * s4; const bool ok = col < Nsrc;
    f32x4 v[16];
#pragma unroll
    for (int i = 0; i < 16; ++i) { v[i] = (f32x4){0.f, 0.f, 0.f, 0.f}; if (ok) v[i] = *(const f32x4*)(W + (size_t)(k0 + 4 * i + kq) * Nsrc + col); }
#pragma unroll
    for (int i = 0; i < 16; ++i) { const int kk = 4 * i + kq; const float g = gain ? gain[k0 + kk] * scale : scale; LAS float* d = scr + kk * 65 + 4 * n4;
        d[0] = v[i][0] * g; d[1] = v[i][1] * g; d[2] = v[i][2] * g; d[3] = v[i][3] * g; }
    asm volatile("s_waitcnt lgkmcnt(0)" ::: "memory");
    const int c = lane & 7;
#pragma unroll
    for (int j = 0; j < 8; ++j) { const int n = (lane >> 3) + 8 * j; const LAS float* sp = scr + (8 * c) * 65 + n;
        u32x4 o; o.x = pk2(sp[0 * 65], sp[1 * 65]); o.y = pk2(sp[2 * 65], sp[3 * 65]); o.z = pk2(sp[4 * 65], sp[5 * 65]); o.w = pk2(sp[6 * 65], sp[7 * 65]);
        *(u32x4*)(WT + (size_t)(n0_dst + n) * K + k0 + 8 * c) = o; }
    asm volatile("s_waitcnt lgkmcnt(0)" ::: "memory");
}
__device__ __forceinline__ void p0_prologue(const Args& A, LAS unsigned char* lds, int G, int bid) {
    const int tid = threadIdx.x, lane = tid & 63, wave = tid >> 6;
    LAS float* scr = (LAS float*)(lds + wave * 16640);
    const int gw = bid * NWAVES + wave, NGW = G * NWAVES;
    unsigned char* ws = A.ws;
    constexpr int I_QKV = 16 * 144, I_AO = 16 * 16, I_FFIN = 16 * 88, I_FFOUT = 44 * 16, I_MIN = 16 * 52, I_MOUT = 16 * 16;
    constexpr int NITEMS = I_QKV + I_AO + 2 * I_FFIN + 2 * I_FFOUT + I_MIN + I_MOUT;
    constexpr float QSCALE = 0.08838834764831845f * 1.4426950408889634f;
    for (int it = gw; it < NITEMS; it += NGW) {
        int r = it;
        if (r < I_QKV) { const int kb = r / 144, nb = r % 144, n0 = 64 * nb; const int tsel = (n0 % 3072) / 1024;
            tr_item(A.attn_w_in, 1024, 9216, (bf16*)(ws + WS_WQKV), n0, n0, 64 * kb, A.attn_norm, tsel == 0 ? QSCALE : 1.f, scr, lane, tsel < 2 && (n0 & 127) == 0); continue; } r -= I_QKV;
        if (r < I_AO) { const int kb = r / 16, nb = r % 16; tr_item(A.attn_w_out, 1024, 1024, (bf16*)(ws + WS_WAO), 64 * nb, 64 * nb, 64 * kb, nullptr, 1.f, scr, lane); continue; } r -= I_AO;
        if (r < 2 * I_FFIN) { const int l = r / I_FFIN; r -= l * I_FFIN; const int kb = r / 88, nb = r % 88, n0 = 64 * nb;
            const int pn = n0 >> 8, bj = (n0 >> 7) & 1, jj = n0 & 127; const int nsrc = (bj ? DFF : 0) + 128 * pn + jj;
            tr_item(A.ffn_w_in + (size_t)l * 1024 * 5632, 1024, 5632, (bf16*)(ws + WS_WFFIN) + (size_t)l * 5632 * 1024, n0, nsrc, 64 * kb, A.ffn_norm + l * 1024, 1.f, scr, lane); continue; } r -= 2 * I_FFIN;
        if (r < 2 * I_FFOUT) { const int l = r / I_FFOUT; r -= l * I_FFOUT; const int kb = r / 16, nb = r % 16;
            tr_item(A.ffn_w_out + (size_t)l * DFF * 1024, DFF, 1024, (bf16*)(ws + WS_WFFOUT) + (size_t)l * 1024 * DFF, 64 * nb, 64 * nb, 64 * kb, nullptr, 1.f, scr, lane); continue; } r -= 2 * I_FFOUT;
        if (r < I_MIN) { const int kb = r / 52, nb = r % 52; tr_item(A.mlstm_w_in, 1024, 3088, (bf16*)(ws + WS_WMIN), 64 * nb, 64 * nb, 64 * kb, A.mlstm_norm, 1.f, scr, lane); continue; } r -= I_MIN;
        { const int kb = r / 16, nb = r % 16; tr_item(A.mlstm_w_out, 1024, 1024, (bf16*)(ws + WS_WMOUT), 64 * nb, 64 * nb, 64 * kb, nullptr, 1.f, scr, lane); }
    }
    float* ss = (float*)(ws + WS_SS); bf16* hb = (bf16*)(ws + WS_HB);
    for (int m4 = gw; m4 < T_TOK / 4; m4 += NGW) {
        f32x4 v[4][4];
#pragma unroll
        for (int q = 0; q < 4; ++q) { const f32x4* xr = (const f32x4*)(A.x + (size_t)(4 * m4 + q) * DM) + lane;
#pragma unroll
            for (int j = 0; j < 4; ++j) v[q][j] = xr[64 * j]; }
#pragma unroll
        for (int q = 0; q < 4; ++q) { const int m = 4 * m4 + q; float sq = 0.f;
#pragma unroll
            for (int j = 0; j < 4; ++j) sq += (v[q][j].x * v[q][j].x + v[q][j].y * v[q][j].y) + (v[q][j].z * v[q][j].z + v[q][j].w * v[q][j].w);
            sq = wave_sum(sq);
            u32x2* o8 = (u32x2*)(hb + (size_t)m * DM) + lane;
#pragma unroll
            for (int j = 0; j < 4; ++j) { u32x2 o; o.x = pk2(v[q][j].x, v[q][j].y); o.y = pk2(v[q][j].z, v[q][j].w); o8[64 * j] = o; }
            if (lane == 0) ss[m] = sq; }
    }
    const int gt = bid * 512 + tid, NGT = G * 512;
    for (int i = gt; i < 4 * T_TOK; i += NGT) ss[T_TOK + i] = 0.f;
    float* rope = (float*)(ws + WS_ROPE);
    for (int i = gt; i < T_TOK * 16; i += NGT) {
        const int t = i >> 4, f = i & 15;
        const float invf = __builtin_amdgcn_exp2f((float)f * -1.1832230355827609f);
        const float ang = (float)A.pos[t] * invf;
        const double rev = (double)ang * 0.15915494309189535; const float fr = (float)(rev - rint(rev));
        rope[(size_t)t * 32 + f] = __builtin_amdgcn_cosf(fr); rope[(size_t)t * 32 + 16 + f] = __builtin_amdgcn_sinf(fr);
    }
}

struct AStep { const bf16* base; size_t rowstride; int blk, g, h, dil, rr, b; bool valid, compute; };
__device__ __forceinline__ AStep attn_step(int u, int s, const bf16* QKVh) {
    AStep t; t.valid = true; t.compute = true;
    if (s < 5) { t.g = 0; t.dil = 1; t.rr = 0; const int qt = u & 3; t.h = (u >> 2) & 7; t.b = u >> 5; t.blk = 4 * qt + s - 1; if (s == 0) { t.compute = false; t.valid = qt > 0; if (!t.valid) t.blk = 0; } }
    else if (s < 9) { t.g = 1; t.dil = 4; t.h = u & 7; t.rr = (u >> 3) & 3; t.b = u >> 5; t.blk = s - 5; }
    else { t.g = 2; t.dil = 16; const int v = 4 * u + (s - 9); t.h = v & 7; t.rr = (v >> 3) & 15; t.b = v >> 7; t.blk = 0; }
    t.rowstride = 128;
    t.base = QKVh + ((size_t)(t.g * 24 + t.h) * HBR + t.b * RB + t.rr * (SEQ / t.dil)) * 128;
    return t;
}
typedef short v4i16_t __attribute__((ext_vector_type(4)));
__device__ __forceinline__ s16x4 tr_read(const LAS unsigned char* p) { return __builtin_bit_cast(s16x4, __builtin_amdgcn_ds_read_tr16_b64_v4i16((LAS v4i16_t*)p)); }
__device__ __forceinline__ void attn_phase(LAS unsigned char* lds, const bf16* __restrict__ QKVh, bf16* __restrict__ Oh, float* __restrict__ lse, int half, int G, int bid) {
    const int tid = threadIdx.x, lane = tid & 63, w = __builtin_amdgcn_readfirstlane(tid >> 6), r = lane & 15, q4 = lane >> 4;
    constexpr int SLOT = 34816, VSLOT = 36864;
#define ATT_LOAD(st) do { \
        _Pragma("unroll") for (int i = 0; i < 4; ++i) { const int chunk = tid + 512 * i, c = chunk >> 4, ch = chunk & 15; const bf16* gp = (st).base + (size_t)(128 * (st).blk + c) * (st).rowstride + 8 * ch; \
            kr[i] = *(const u32x4*)(gp + (size_t)8 * HBR * 128); vr[i] = *(const u32x4*)(gp + (size_t)16 * HBR * 128); } \
        { const bf16* qrow = (st).base + (size_t)(128 * (st).blk + 16 * w + r) * (st).rowstride; \
            _Pragma("unroll") for (int q = 0; q < 4; ++q) qn[q] = *(const bf16x8*)(qrow + 32 * q + 8 * q4); } } while (0)
    for (int u = bid; u < 256; u += G) {
        AStep nx = attn_step(u, 0, QKVh);
        u32x4 kr[4], vr[4]; bf16x8 qn[4];
#pragma unroll
        for (int i = 0; i < 4; ++i) { kr[i] = (u32x4){0u, 0u, 0u, 0u}; vr[i] = kr[i]; qn[i] = (bf16x8){0, 0, 0, 0, 0, 0, 0, 0}; }
        ATT_LOAD(nx);
        for (int s = 0; s < 13; ++s) {
            const AStep cu = nx; const int cs = s & 1;
            LAS unsigned char* Kc = lds + cs * SLOT; LAS unsigned char* Vc = lds + 2 * SLOT + cs * VSLOT;
#pragma unroll
            for (int i = 0; i < 4; ++i) { const int chunk = tid + 512 * i, c = chunk >> 4, ch = chunk & 15; *(LAS u32x4*)(Kc + c * 272 + ch * 16) = kr[i]; *(LAS u32x4*)(Vc + c * 288 + ch * 16) = vr[i]; }
            bf16x8 qf[4];
#pragma unroll
            for (int q = 0; q < 4; ++q) qf[q] = qn[q];
            __syncthreads();
            { nx = attn_step(u, (s + 1 < 13) ? s + 1 : 12, QKVh); ATT_LOAD(nx); }
            if (cu.compute) {
                const bool first = (cu.blk == 0);
                const LAS unsigned char* Kp = first ? Kc : lds + (cs ^ 1) * SLOT; const LAS unsigned char* Vp = first ? Vc : lds + 2 * SLOT + (cs ^ 1) * VSLOT;
                const int a = 16 * w + r;
                const int jlo = first ? 8 : 0;
                f32x4 S[9]; float mx = -INFINITY;
#pragma unroll
                for (int jj = 0; jj < 9; ++jj) { const int j = w + jj; S[jj] = (f32x4){0.f, 0.f, 0.f, 0.f};
                    if (j >= jlo) { const LAS unsigned char* kp = (j >= 8 ? Kc : Kp) + ((j & 7) * 16 + r) * 272 + 16 * q4;
#pragma unroll
                        for (int st = 0; st < 4; ++st) { const bf16x8 kf = *(const LAS bf16x8*)(kp + 64 * st); S[jj] = MFMA16(kf, qf[st], S[jj]); } }
#pragma unroll
                    for (int i = 0; i < 4; ++i) { bool valid = (j >= jlo);
                        if (jj == 0) valid = valid && (4 * q4 + i >= r);
                        if (jj == 8) valid = valid && (4 * q4 + i <= r);
                        S[jj][i] = valid ? S[jj][i] : -INFINITY; mx = fmaxf(mx, S[jj][i]); } }
                mx = fmaxf(mx, __shfl_xor(mx, 16)); mx = fmaxf(mx, __shfl_xor(mx, 32));
                float den = 0.f;
#pragma unroll
                for (int jj = 0; jj < 9; ++jj)
#pragma unroll
                    for (int i = 0; i < 4; ++i) { const float pe = __builtin_amdgcn_exp2f(S[jj][i] - mx); S[jj][i] = pe; den += pe; }
                den += __shfl_xor(den, 16); den += __shfl_xor(den, 32);
                bf16x8 pf[5];
#pragma unroll
                for (int p = 0; p < 5; ++p) { u32x4 wv; wv.x = pk2(S[2 * p][0], S[2 * p][1]); wv.y = pk2(S[2 * p][2], S[2 * p][3]);
                    if (2 * p + 1 < 9) { wv.z = pk2(S[(2 * p + 1) % 9][0], S[(2 * p + 1) % 9][1]); wv.w = pk2(S[(2 * p + 1) % 9][2], S[(2 * p + 1) % 9][3]); } else { wv.z = 0u; wv.w = 0u; }
                    pf[p] = __builtin_bit_cast(bf16x8, wv); }
                f32x4 o[8];
#pragma unroll
                for (int db = 0; db < 8; ++db) o[db] = (f32x4){0.f, 0.f, 0.f, 0.f};
#pragma unroll
                for (int p = 0; p < 5; ++p) { const int j0 = w + 2 * p, j1 = (j0 + 1 > 15) ? 15 : j0 + 1;
                    if (j0 + 1 >= jlo) {
                        const LAS unsigned char* v0p = (j0 >= 8 ? Vc : Vp) + ((j0 & 7) * 16 + 4 * q4 + (r >> 2)) * 288 + 8 * (r & 3);
                        const LAS unsigned char* v1p = (j1 >= 8 ? Vc : Vp) + ((j1 & 7) * 16 + 4 * q4 + (r >> 2)) * 288 + 8 * (r & 3);
#pragma unroll
                        for (int db = 0; db < 8; ++db) {
                            const s16x4 lo = tr_read(v0p + 32 * db), hi = tr_read(v1p + 32 * db);
                            const bf16x8 af = __builtin_shufflevector(lo, hi, 0, 1, 2, 3, 4, 5, 6, 7);
                            o[db] = MFMA16(af, pf[p], o[db]); } } }
                const float inv = __builtin_amdgcn_rcpf(den);
                const int tl = cu.b * SEQ + (128 * cu.blk + a) * cu.dil + cu.rr;
                bf16* orow = Oh + ((size_t)(cu.g * 8 + cu.h) * HBR + cu.b * RB + cu.rr * (SEQ / cu.dil) + 128 * cu.blk + a) * 128 + 4 * q4;
#pragma unroll
                for (int db = 0; db < 8; ++db) { u32x2 wv; wv.x = pk2(o[db][0] * inv, o[db][1] * inv); wv.y = pk2(o[db][2] * inv, o[db][3] * inv); *(u32x2*)(orow + 16 * db) = wv; }
                if (q4 == 0) lse[((size_t)cu.g * T_TOK + (size_t)half * THALF + tl) * 8 + cu.h] = mx * 0.6931471805599453f + __logf(den);
            }
            __syncthreads();
        }
    }
#undef ATT_LOAD
}
__device__ __forceinline__ void merge_phase(const bf16* __restrict__ Oh, const float* __restrict__ lse, bf16* __restrict__ MX, int half, int G, int bid) {
    const int gt = bid * 512 + threadIdx.x, NGT = G * 512;
    for (int i = gt; i < THALF * 128; i += NGT) {
        const int tl = i >> 7, ch = i & 127, h = ch >> 4; const size_t tg = (size_t)half * THALF + tl;
        const float l0 = lse[((size_t)0 * T_TOK + tg) * 8 + h], l1 = lse[((size_t)1 * T_TOK + tg) * 8 + h], l2 = lse[((size_t)2 * T_TOK + tg) * 8 + h];
        const float mxl = fmaxf(l0, fmaxf(l1, l2)); float w0 = __expf(l0 - mxl), w1 = __expf(l1 - mxl), w2 = __expf(l2 - mxl); const float inv = 1.0f / (w0 + w1 + w2); w0 *= inv; w1 *= inv; w2 *= inv;
        const int sq = tl & 2047, bb = (tl >> 11) * RB, dch = ch & 15;
        const int p1 = ((sq & 3) << 9) + (sq >> 2), p2 = ((sq & 15) << 7) + (sq >> 4);
        const u32x4 a = *(const u32x4*)(Oh + ((size_t)(0 + h) * HBR + bb + sq) * 128 + 8 * dch), b = *(const u32x4*)(Oh + ((size_t)(8 + h) * HBR + bb + p1) * 128 + 8 * dch), c = *(const u32x4*)(Oh + ((size_t)(16 + h) * HBR + bb + p2) * 128 + 8 * dch);
        u32x4 o;
#pragma unroll
        for (int e = 0; e < 4; ++e) o[e] = pk2(w0 * bf_lo(a[e]) + w1 * bf_lo(b[e]) + w2 * bf_lo(c[e]), w0 * bf_hi(a[e]) + w1 * bf_hi(b[e]) + w2 * bf_hi(c[e]));
        *(u32x4*)(MX + tg * 1024 + 8 * ch) = o;
    }
}
__device__ __forceinline__ float logsigmoid_f(float x) { return fminf(x, 0.f) - __logf(1.0f + __expf(-fabsf(x))); }
__device__ __forceinline__ void mlstm_pre_phase(const bf16* __restrict__ P2, const float* __restrict__ gates, const float* __restrict__ convw, const float* __restrict__ convb, const float* __restrict__ igb, const float* __restrict__ fgb,
                                                bf16* __restrict__ QKc, float* __restrict__ GA, float* __restrict__ GB, float* __restrict__ GP, float* __restrict__ CH, int G, int bid) {
    const int tid = threadIdx.x, lane = tid & 63, wave = tid >> 6;
    const int gt = bid * 512 + tid, NGT = G * 512;
    for (int it = gt; it < (T_TOK / 8) * 128; it += NGT) {
        const int ch = it & 127, tg = it >> 7; const int t0 = 8 * tg, sq0 = t0 & 2047; const int col = 8 * ch;
        float cw[4][8], cb[8];
#pragma unroll
        for (int q = 0; q < 2; ++q) { const f32x4 b4 = *(const f32x4*)(convb + col + 4 * q);
#pragma unroll
            for (int e = 0; e < 4; ++e) cb[4 * q + e] = b4[e];
#pragma unroll
            for (int j = 0; j < 4; ++j) { const f32x4 w4 = *(const f32x4*)(convw + j * 1024 + col + 4 * q);
#pragma unroll
                for (int e = 0; e < 4; ++e) cw[j][4 * q + e] = w4[e]; } }
        u32x4 rw[11];
#pragma unroll
        for (int i = 0; i < 11; ++i) { rw[i] = (u32x4){0u, 0u, 0u, 0u}; if (sq0 + i - 3 >= 0) rw[i] = *(const u32x4*)(P2 + (size_t)(t0 + i - 3) * 2048 + col); }
        const float ksc = (ch >= 64) ? 0.125f : 1.0f;
#pragma unroll
        for (int i = 0; i < 8; ++i) { u32x4 o;
#pragma unroll
            for (int e = 0; e < 4; ++e) { float x0 = cb[2 * e], x1 = cb[2 * e + 1];
#pragma unroll
                for (int j = 0; j < 4; ++j) { x0 += cw[j][2 * e] * bf_lo(rw[i + j][e]); x1 += cw[j][2 * e + 1] * bf_hi(rw[i + j][e]); }
                o[e] = pk2(silu_f(x0) * ksc, silu_f(x1) * ksc); }
            *(u32x4*)(QKc + (size_t)(t0 + i) * 1024 + col) = o; }
    }
    const int gw = bid * NWAVES + wave, NGW = G * NWAVES;
    for (int it = gw; it < NB * 32; it += NGW) {
        const int c = it & 31, b = it >> 5; const size_t t = (size_t)b * SEQ + 64 * c + lane;
        f32x4 g4[4];
#pragma unroll
        for (int q = 0; q < 4; ++q) g4[q] = *(const f32x4*)(gates + t * 16 + 4 * q);
        float bs[8], av[8], pm[8];
#pragma unroll
        for (int h = 0; h < 8; ++h) bs[h] = logsigmoid_f(g4[2 + (h >> 2)][h & 3] + fgb[h]);
#pragma unroll
        for (int o = 1; o < 64; o <<= 1) {
#pragma unroll
            for (int h = 0; h < 8; ++h) { const float v = __shfl_up(bs[h], o); if (lane >= o) bs[h] += v; } }
#pragma unroll
        for (int h = 0; h < 8; ++h) { av[h] = g4[h >> 2][h & 3] + igb[h] - bs[h]; pm[h] = av[h]; }
#pragma unroll
        for (int o = 1; o < 64; o <<= 1) {
#pragma unroll
            for (int h = 0; h < 8; ++h) { const float v = __shfl_up(pm[h], o); if (lane >= o) pm[h] = fmaxf(pm[h], v); } }
#pragma unroll
        for (int h = 0; h < 8; ++h) { const size_t o = (size_t)(b * 8 + h) * SEQ + 64 * c + lane; GA[o] = av[h]; GB[o] = bs[h]; GP[o] = pm[h];
            if (lane == 63) { const size_t cid = (size_t)(b * 8 + h) * 32 + c; CH[2 * cid] = bs[h]; CH[2 * cid + 1] = bs[h] + pm[h]; } }
    }
}
__device__ __forceinline__ void mlstm_scan_phase(LAS unsigned char* lds, const bf16* __restrict__ P2, const bf16* __restrict__ QKc, const float* __restrict__ GA, const float* __restrict__ CH,
                                                 bf16* __restrict__ Cst, float* __restrict__ nst, float* __restrict__ mst, int G, int bid) {
    const int tid = threadIdx.x, lane = tid & 63, w = __builtin_amdgcn_readfirstlane(tid >> 6), r = lane & 15, q4 = lane >> 4;
    const int dvb = w & 3, dkh = w >> 2;
    const bf16x8 ones = {0x3F80, 0x3F80, 0x3F80, 0x3F80, 0x3F80, 0x3F80, 0x3F80, 0x3F80};
    for (int item = bid; item < 256; item += G) {
        const int dvh = item & 1, h = (item >> 1) & 7, b = item >> 4;
        const size_t cid0 = (size_t)(b * 8 + h) * 32;
        f32x4 acc[2], accn[2]; acc[0] = (f32x4){0.f, 0.f, 0.f, 0.f}; acc[1] = acc[0]; accn[0] = acc[0]; accn[1] = acc[0];
        float mcar = 0.f;
        u32x4 nk, nv; float na, nbl, nml;
#define MSCAN_LOAD(c) do { const size_t t_ = (size_t)b * SEQ + 64 * (c) + lane; nk = *(const u32x4*)(QKc + t_ * 1024 + 512 + h * 64 + 8 * w); nv = *(const u32x4*)(P2 + t_ * 2048 + 1024 + h * 128 + 64 * dvh + 8 * w); \
            na = GA[(size_t)(b * 8 + h) * SEQ + 64 * (c) + lane]; nbl = CH[2 * (cid0 + (c))]; nml = CH[2 * (cid0 + (c)) + 1]; } while (0)
        MSCAN_LOAD(0);
        for (int c = 0; c < 32; ++c) {
            const u32x4 ck = nk, cv = nv; const float as = na, blast = nbl, mloc = nml;
            if (c + 1 < 32) MSCAN_LOAD(c + 1);
            const float mnew = fmaxf(blast + mcar, mloc);
            const float wsv = __expf(blast + as - mnew), carry = __expf(blast + mcar - mnew);
            const size_t cid = cid0 + c;
#pragma unroll
            for (int nb = 0; nb < 2; ++nb)
#pragma unroll
                for (int i = 0; i < 4; ++i) { const int dv = 64 * dvh + 16 * dvb + 4 * q4 + i, dk = 32 * dkh + 16 * nb + r;
                    Cst[(cid * 128 + dv) * 64 + dk] = (bf16)(pk2(acc[nb][i], 0.f) & 0xffffu); }
            if (dvh == 0 && dvb == 0 && q4 == 0) { nst[cid * 64 + 32 * dkh + r] = accn[0][0]; nst[cid * 64 + 32 * dkh + 16 + r] = accn[1][0]; }
            if (dvh == 0 && tid == 0) mst[cid] = mcar;
            LAS unsigned char* Kw = lds + (c & 1) * 18432; LAS unsigned char* Vs = Kw + 9216;
            u32x4 kw;
#pragma unroll
            for (int e = 0; e < 4; ++e) kw[e] = pk2(bf_lo(ck[e]) * wsv, bf_hi(ck[e]) * wsv);
            *(LAS u32x4*)(Kw + lane * 144 + 16 * w) = kw; *(LAS u32x4*)(Vs + lane * 144 + 16 * w) = cv;
            __syncthreads();
            acc[0] = acc[0] * carry; acc[1] = acc[1] * carry; accn[0] = accn[0] * carry; accn[1] = accn[1] * carry;
#pragma unroll
            for (int st = 0; st < 2; ++st) {
                const int rowb = (32 * st + 8 * q4 + (r >> 2)) * 144 + 8 * (r & 3);
                const s16x4 alo = tr_read(Vs + rowb + 32 * dvb), ahi = tr_read(Vs + rowb + 4 * 144 + 32 * dvb);
                const bf16x8 af = __builtin_shufflevector(alo, ahi, 0, 1, 2, 3, 4, 5, 6, 7);
#pragma unroll
                for (int nb = 0; nb < 2; ++nb) {
                    const s16x4 blo = tr_read(Kw + rowb + 64 * dkh + 32 * nb), bhi = tr_read(Kw + rowb + 4 * 144 + 64 * dkh + 32 * nb);
                    const bf16x8 bfr = __builtin_shufflevector(blo, bhi, 0, 1, 2, 3, 4, 5, 6, 7);
                    acc[nb] = MFMA16(af, bfr, acc[nb]);
                    if (dvb == 0) accn[nb] = MFMA16(ones, bfr, accn[nb]); }
            }
            mcar = mnew;
        }
        __syncthreads();
#undef MSCAN_LOAD
    }
}
__device__ __forceinline__ void mlstm_out_phase(LAS unsigned char* lds, const bf16* __restrict__ P2, const bf16* __restrict__ QKc, const bf16* __restrict__ OP, const float* __restrict__ GA, const float* __restrict__ GB, const float* __restrict__ GP,
                                                const float* __restrict__ hgain, const bf16* __restrict__ Cst, const float* __restrict__ nst, const float* __restrict__ mst, bf16* __restrict__ MX, int G, int bid) {
    const int tid = threadIdx.x, lane = tid & 63, w = __builtin_amdgcn_readfirstlane(tid >> 6), r = lane & 31, h2 = lane >> 5;
    const int dvb = w & 3, tb = w >> 2;
    constexpr int O_Q = 0, O_K = 9216, O_V = 18432, O_C = 38912, O_VEC = 57344, O_GN = 58368, O_PART = 58880, SETB = 59904;
    u32x4 pq, pk, pv0, pv1, pc0, pc1; float pvec = 0.f, pgn = 0.f, pmc = 0.f; u32x2 popv[4];
    pq = (u32x4){0u, 0u, 0u, 0u}; pk = pq; pv0 = pq; pv1 = pq; pc0 = pq; pc1 = pq;
#pragma unroll
    for (int gq = 0; gq < 4; ++gq) popv[gq] = (u32x2){0u, 0u};
#define OUT_LOAD(it) do { const int c_ = (it) & 31, h_ = ((it) >> 5) & 7, b_ = (it) >> 8; const size_t t0_ = (size_t)b_ * SEQ + 64 * c_; const size_t gb_ = (size_t)(b_ * 8 + h_) * SEQ + 64 * c_; \
        { const bf16* p_ = QKc + (t0_ + (tid >> 3)) * 1024 + h_ * 64 + 8 * (tid & 7); pq = *(const u32x4*)p_; pk = *(const u32x4*)(p_ + 512); } \
        { const bf16* p_ = P2 + (t0_ + (tid >> 4)) * 2048 + 1024 + h_ * 128 + 8 * (tid & 15); pv0 = *(const u32x4*)p_; pv1 = *(const u32x4*)(p_ + (size_t)32 * 2048); } \
        { const bf16* p_ = Cst + ((size_t)(it) * 128 + (tid >> 3)) * 64 + 8 * (tid & 7); pc0 = *(const u32x4*)p_; pc1 = *(const u32x4*)(p_ + 64 * 64); } \
        { const int wh_ = tid >> 6, ix_ = tid & 63; const float* src_ = (wh_ == 0) ? (GA + gb_) : (wh_ == 1) ? (GB + gb_) : (wh_ == 2) ? (GP + gb_) : (wh_ == 3) ? (nst + (size_t)(it) * 64) : (hgain + h_ * 128 + ((wh_ & 1) << 6)); pvec = src_[ix_]; } \
        pmc = mst[(it)]; \
        { const size_t orow_ = (t0_ + 32 * tb + r) * 1024 + h_ * 128 + 32 * dvb + 4 * h2; _Pragma("unroll") for (int gq = 0; gq < 4; ++gq) popv[gq] = *(const u32x2*)(OP + orow_ + 8 * gq); } } while (0)
    { const int fit = (bid < 4096) ? bid : 0; OUT_LOAD(fit); }
    int par = 0;
    for (int item = bid; item < 4096; item += G, par ^= 1) {
        const int c = item & 31, h = (item >> 5) & 7, b = item >> 8;
        const size_t t0 = (size_t)b * SEQ + 64 * c;
        LAS unsigned char* L = lds + par * SETB;
        LAS float* vec = (LAS float*)(L + O_VEC); LAS float* gnl = (LAS float*)(L + O_GN); LAS float* part = (LAS float*)(L + O_PART);
        *(LAS u32x4*)(L + O_Q + (tid >> 3) * 144 + (tid & 7) * 16) = pq; *(LAS u32x4*)(L + O_K + (tid >> 3) * 144 + (tid & 7) * 16) = pk;
        *(LAS u32x4*)(L + O_V + (tid >> 4) * 320 + (tid & 15) * 16) = pv0; *(LAS u32x4*)(L + O_V + (32 + (tid >> 4)) * 320 + (tid & 15) * 16) = pv1;
        *(LAS u32x4*)(L + O_C + (tid >> 3) * 144 + (tid & 7) * 16) = pc0; *(LAS u32x4*)(L + O_C + (64 + (tid >> 3)) * 144 + (tid & 7) * 16) = pc1;
        if (tid < 384) vec[tid] = pvec;
        const float mc = pmc; u32x2 opv[4];
#pragma unroll
        for (int gq = 0; gq < 4; ++gq) opv[gq] = popv[gq];
        __syncthreads();
        { const int nit = (item + G < 4096) ? item + G : item; OUT_LOAD(nit); }
        const int t = 32 * tb + r;
        const float Mt = fmaxf(mc, vec[128 + t]), bt = vec[64 + t];
        bf16x8 qf[4];
#pragma unroll
        for (int st = 0; st < 4; ++st) qf[st] = *(const LAS bf16x8*)(L + O_Q + t * 144 + (16 * st + 8 * h2) * 2);
        float qn = 0.f;
#pragma unroll
        for (int st = 0; st < 4; ++st) { const u32x4 qq = __builtin_bit_cast(u32x4, qf[st]); const f32x4 n0 = *(const LAS f32x4*)(vec + 192 + 16 * st + 8 * h2), n1 = *(const LAS f32x4*)(vec + 192 + 16 * st + 8 * h2 + 4);
#pragma unroll
            for (int e = 0; e < 2; ++e) { qn += bf_lo(qq[e]) * n0[2 * e] + bf_hi(qq[e]) * n0[2 * e + 1]; qn += bf_lo(qq[2 + e]) * n1[2 * e] + bf_hi(qq[2 + e]) * n1[2 * e + 1]; } }
        qn += __shfl_xor(qn, 32);
        f32x16 acc1, acc2;
#pragma unroll
        for (int i = 0; i < 16; ++i) { acc1[i] = 0.f; acc2[i] = 0.f; }
        float dsum = 0.f;
#pragma unroll
        for (int sb = 0; sb < 2; ++sb) {
            if (sb <= tb) {
                f32x16 S;
#pragma unroll
                for (int i = 0; i < 16; ++i) S[i] = 0.f;
#pragma unroll
                for (int st = 0; st < 4; ++st) { const bf16x8 kf = *(const LAS bf16x8*)(L + O_K + (32 * sb + r) * 144 + (16 * st + 8 * h2) * 2); S = MFMA32(kf, qf[st], S); }
#pragma unroll
                for (int gq = 0; gq < 4; ++gq) { const f32x4 a4 = *(const LAS f32x4*)(vec + 32 * sb + 8 * gq + 4 * h2);
#pragma unroll
                    for (int k = 0; k < 4; ++k) { const int i = 4 * gq + k, s = 32 * sb + 8 * gq + 4 * h2 + k; const float ev = __builtin_amdgcn_exp2f(fminf(a4[k] - Mt, 0.f) * 1.4426950408889634f);
                        const float wgt = (s <= t) ? ev : 0.f; S[i] = wgt * S[i]; dsum += S[i]; } }
#pragma unroll
                for (int sp = 0; sp < 2; ++sp) {
                    u32x4 wv; wv.x = pk2(S[8 * sp + 0], S[8 * sp + 1]); wv.y = pk2(S[8 * sp + 2], S[8 * sp + 3]); wv.z = pk2(S[8 * sp + 4], S[8 * sp + 5]); wv.w = pk2(S[8 * sp + 6], S[8 * sp + 7]);
                    const bf16x8 pfr = __builtin_bit_cast(bf16x8, wv);
                    const LAS unsigned char* vp = L + O_V + (32 * sb + 16 * sp + 4 * h2 + ((lane & 15) >> 2)) * 320 + (32 * dvb + 16 * ((lane >> 4) & 1) + 4 * (lane & 3)) * 2;
                    const s16x4 lo = tr_read(vp), hi = tr_read(vp + 8 * 320);
                    const bf16x8 af = __builtin_shufflevector(lo, hi, 0, 1, 2, 3, 4, 5, 6, 7);
                    acc1 = MFMA32(af, pfr, acc1);
                }
            }
        }
        dsum += __shfl_xor(dsum, 32);
#pragma unroll
        for (int st = 0; st < 4; ++st) { const bf16x8 cf = *(const LAS bf16x8*)(L + O_C + (32 * dvb + r) * 144 + (16 * st + 8 * h2) * 2); acc2 = MFMA32(cf, qf[st], acc2); }
        const float winter = __expf(mc - Mt);
        const float den = dsum + winter * qn;
        const float dnm = fmaxf(fabsf(den), __expf(-(bt + Mt)));
        const float idn = __builtin_amdgcn_rcpf(dnm);
        float hsq = 0.f;
#pragma unroll
        for (int i = 0; i < 16; ++i) { acc1[i] = (acc1[i] + winter * acc2[i]) * idn; hsq += acc1[i] * acc1[i]; }
        hsq += __shfl_xor(hsq, 32);
        if (h2 == 0) part[dvb * 64 + t] = hsq;
        __syncthreads();
        const float tot = (part[t] + part[64 + t]) + (part[128 + t] + part[192 + t]);
        const float rsn = __builtin_amdgcn_rsqf(tot * (1.0f / 128.0f) + RMS_EPS);
        const size_t orow = (t0 + t) * 1024 + h * 128 + 32 * dvb + 4 * h2;
#pragma unroll
        for (int gq = 0; gq < 4; ++gq) {
            const u32x2 op = opv[gq]; const f32x4 gn = *(const LAS f32x4*)(gnl + 32 * dvb + 4 * h2 + 8 * gq);
            const float y0 = acc1[4 * gq + 0] * rsn * gn[0] * sigmoid_f(bf_lo(op.x)), y1 = acc1[4 * gq + 1] * rsn * gn[1] * sigmoid_f(bf_hi(op.x));
            const float y2 = acc1[4 * gq + 2] * rsn * gn[2] * sigmoid_f(bf_lo(op.y)), y3 = acc1[4 * gq + 3] * rsn * gn[3] * sigmoid_f(bf_hi(op.y));
            u32x2 wv; wv.x = pk2(y0, y1); wv.y = pk2(y2, y3); *(u32x2*)(MX + orow + 8 * gq) = wv;
        }
    }
    __syncthreads();
#undef OUT_LOAD
}
__device__ __forceinline__ void final_phase(float* __restrict__ out, const float* __restrict__ ss, const float* __restrict__ gain, int G, int bid) {
    const int gt = bid * 512 + threadIdx.x, NGT = G * 512;
    for (int i = gt; i < T_TOK * 256; i += NGT) { const int t = i >> 8, c4 = i & 255; const float rs = rs_from_ss(ss[t]);
        f32x4 v = *(f32x4*)(out + (size_t)t * 1024 + 4 * c4); const f32x4 gn = *(const f32x4*)(gain + 4 * c4); v = v * rs * gn; *(f32x4*)(out + (size_t)t * 1024 + 4 * c4) = v; }
}

__global__ void __launch_bounds__(NWAVES * 64, 2) mega_fwd(Args A) {
    extern __shared__ __attribute__((aligned(16))) unsigned char lds_raw[];
    LAS unsigned char* lds = (LAS unsigned char*)lds_raw;
    cg::grid_group grid = cg::this_grid();
    const int G = gridDim.x, bid = blockIdx.x;
    unsigned char* ws = A.ws;
    float* ss = (float*)(ws + WS_SS);
    bf16* hb = (bf16*)(ws + WS_HB); bf16* MX = (bf16*)(ws + WS_MX);
    bf16* QKVh = (bf16*)(ws + WS_BIG); float* H = (float*)(ws + WS_H); bf16* ACT = (bf16*)(ws + WS_ACT); bf16* P2 = (bf16*)(ws + WS_ACT);
    bf16* Oh = (bf16*)A.out; bf16* Cst = (bf16*)A.out; bf16* OP = (bf16*)A.out + (size_t)32 * 1024 * 1024;
    float* lse = (float*)(ws + WS_LSE); float* gates = (float*)(ws + WS_GATES); float* rope = (float*)(ws + WS_ROPE);
    float* mst = (float*)(ws + WS_MST); float* nst = (float*)(ws + WS_NST);
    bf16* QKc = hb;
    float* GA = (float*)(ws + 460 * MiB); float* GB = GA + (size_t)T_TOK * 8; float* GP = GB + (size_t)T_TOK * 8; float* CH = GP + (size_t)T_TOK * 8;
    const int lo = A.ph_lo, hi = A.ph_hi;
    volatile LAS unsigned* MISC = (volatile LAS unsigned*)(lds + LDS_BYTES - 256);
    if (threadIdx.x < 16) MISC[threadIdx.x] = 0u;
    __syncthreads();
    const XcdBarrier bar = xcd_barrier_post((unsigned*)(ws + WS_BAR), MISC + 8);
#ifndef PROBE_MASK
#define PROBE_MASK 0u
#endif
#define PROBE_K 4ull
    unsigned long long pr_sum = 0ull, pr_t0 = 0ull, pr_s0 = 0ull;
#define PB(k) do { if (PROBE_MASK & (1u << (k))) pr_t0 = __builtin_amdgcn_s_memrealtime(); } while (0)
#define PE(k) do { if (PROBE_MASK & (1u << (k))) pr_sum += __builtin_amdgcn_s_memrealtime() - pr_t0; } while (0)
#define IN(k) (lo <= (k) && (k) < hi)
#define SYNC(k) do { if (IN(k) && IN((k) + 1)) { if (PROBE_MASK & (1u << 30)) pr_s0 = __builtin_amdgcn_s_memrealtime(); if (hi < 0) { __threadfence(); grid.sync(); __threadfence(); } else xcd_barrier(bar); if (PROBE_MASK & (1u << 30)) pr_sum += __builtin_amdgcn_s_memrealtime() - pr_s0; if (PROBE_MASK & (1u << 29)) { pr_s0 = __builtin_amdgcn_s_memrealtime(); xcd_barrier(bar); pr_sum += __builtin_amdgcn_s_memrealtime() - pr_s0; } } PE(k); } while (0)
    PB(0); if (IN(0)) p0_prologue(A, lds, G, bid);
    SYNC(0);
    PB(1); if (IN(1)) { pg8::Gemm g{hb, (const bf16*)(ws + WS_WQKV), THALF, 9216, 1024}; pg8::StaticOrder S; S.init(THALF, 9216, G, bid);
        pg8::EpiQKV E{QKVh, ss, rope}; pg8::gemm_phase<pg8::EpiQKV, pg8::StaticOrder, true, true>(lds, g, S, E); }
    SYNC(1);
    PB(2); if (IN(2)) attn_phase(lds, QKVh, Oh, lse, 0, G, bid);
    SYNC(2);
    PB(3); if (IN(3)) { merge_phase(Oh, lse, MX, 0, G, bid);
        pg8::Gemm g{hb + (size_t)THALF * 1024, (const bf16*)(ws + WS_WQKV), THALF, 9216, 1024}; pg8::StaticOrder S; S.init(THALF, 9216, G, bid);
        pg8::EpiQKV E{QKVh, ss + THALF, rope + (size_t)THALF * 32}; pg8::gemm_phase<pg8::EpiQKV, pg8::StaticOrder, true, true>(lds, g, S, E); }
    SYNC(3);
    PB(4); if (IN(4)) attn_phase(lds, QKVh, Oh, lse, 1, G, bid);
    SYNC(4);
    PB(5); if (IN(5)) merge_phase(Oh, lse, MX, 1, G, bid);
    SYNC(5);
    PB(6); if (IN(6)) { pg8::Gemm g{MX, (const bf16*)(ws + WS_WAO), T_TOK, 1024, 1024}; pg8::StaticOrder S; S.init(T_TOK, 1024, G, bid);
        pg8::EpiResid E{A.x, H, hb, ss + T_TOK}; pg8::gemm_phase<pg8::EpiResid, pg8::StaticOrder, true, true>(lds, g, S, E); }
    SYNC(6);
    PB(7); if (IN(7)) { pg8::Gemm g{hb, (const bf16*)(ws + WS_WFFIN), T_TOK, 5632, 1024}; pg8::StaticOrder S; S.init(T_TOK, 5632, G, bid);
        pg8::EpiSwiGLU E{ACT, ss + T_TOK}; pg8::gemm_phase<pg8::EpiSwiGLU, pg8::StaticOrder, true, true>(lds, g, S, E); }
    SYNC(7);
    PB(8); if (IN(8)) { pg8::Gemm g{ACT, (const bf16*)(ws + WS_WFFOUT), T_TOK, 1024, DFF}; pg8::StaticOrder S; S.init(T_TOK, 1024, G, bid);
        pg8::EpiResid E{H, H, hb, ss + 2 * T_TOK}; pg8::gemm_phase<pg8::EpiResid, pg8::StaticOrder, true, true>(lds, g, S, E); }
    SYNC(8);
    PB(9); if (IN(9)) { pg8::Gemm g{hb, (const bf16*)(ws + WS_WMIN), T_TOK, 3328, 1024}; pg8::StaticOrder S; S.init(T_TOK, 3328, G, bid);
        pg8::EpiMlstmIn E{P2, OP, gates, ss + 2 * T_TOK}; pg8::gemm_phase<pg8::EpiMlstmIn, pg8::StaticOrder, true, true>(lds, g, S, E); }
    SYNC(9);
    PB(10); if (IN(10)) { mlstm_pre_phase(P2, gates, A.conv_w, A.conv_b, A.ig_bias, A.fg_bias, QKc, GA, GB, GP, CH, G, bid); xcd_barrier(bar);
        mlstm_scan_phase(lds, P2, QKc, GA, CH, Cst, nst, mst, G, bid); }
    SYNC(10);
    PB(11); if (IN(11)) mlstm_out_phase(lds, P2, QKc, OP, GA, GB, GP, A.head_gain, Cst, nst, mst, MX, G, bid);
    SYNC(11);
    PB(12); if (IN(12)) { pg8::Gemm g{MX, (const bf16*)(ws + WS_WMOUT), T_TOK, 1024, 1024}; pg8::StaticOrder S; S.init(T_TOK, 1024, G, bid);
        pg8::EpiResid E{H, H, hb, ss + 3 * T_TOK}; pg8::gemm_phase<pg8::EpiResid, pg8::StaticOrder, true, true>(lds, g, S, E); }
    SYNC(12);
    PB(13); if (IN(13)) { pg8::Gemm g{hb, (const bf16*)(ws + WS_WFFIN) + (size_t)5632 * 1024, T_TOK, 5632, 1024}; pg8::StaticOrder S; S.init(T_TOK, 5632, G, bid);
        pg8::EpiSwiGLU E{ACT, ss + 3 * T_TOK}; pg8::gemm_phase<pg8::EpiSwiGLU, pg8::StaticOrder, true, true>(lds, g, S, E); }
    SYNC(13);
    PB(14); if (IN(14)) { pg8::Gemm g{ACT, (const bf16*)(ws + WS_WFFOUT) + (size_t)1024 * DFF, T_TOK, 1024, DFF}; pg8::StaticOrder S; S.init(T_TOK, 1024, G, bid);
        pg8::EpiResid E{H, A.out, nullptr, ss + 4 * T_TOK}; pg8::gemm_phase<pg8::EpiResid, pg8::StaticOrder, true, true>(lds, g, S, E); }
    SYNC(14);
    PB(15); if (IN(15)) final_phase(A.out, ss + 4 * T_TOK, A.final_norm, G, bid);
    PE(15);
    if (PROBE_MASK != 0u && bid == 0 && threadIdx.x == 0) { const unsigned long long te = __builtin_amdgcn_s_memrealtime(); while (__builtin_amdgcn_s_memrealtime() - te < PROBE_K * pr_sum) __builtin_amdgcn_s_sleep(8); }
#undef IN
#undef SYNC
}

extern "C" void kernel_launch(void* const* d_in, const int* in_sizes, int n_in, void* d_out, int out_size, void* d_ws, size_t ws_size, hipStream_t stream) {
    static int grid = 0;
    if (grid == 0) {
        if (n_in != 17 || in_sizes[0] != T_TOK * DM || out_size != T_TOK * DM || ws_size < WS_END) { fprintf(stderr, "kernel_launch: unexpected shapes (n_in %d, in0 %d, out %d, ws %zu); nothing launched\n", n_in, n_in > 0 ? in_sizes[0] : -1, out_size, ws_size); grid = -1; return; }
        int dev = 0, cus = 0, per_cu = 0;
        if (hipGetDevice(&dev) != hipSuccess || hipDeviceGetAttribute(&cus, hipDeviceAttributeMultiprocessorCount, dev) != hipSuccess) { grid = -1; return; }
        if (hipFuncSetAttribute((const void*)mega_fwd, hipFuncAttributeMaxDynamicSharedMemorySize, LDS_BYTES) != hipSuccess) { fprintf(stderr, "kernel_launch: hipFuncSetAttribute failed\n"); grid = -1; return; }
        if (hipOccupancyMaxActiveBlocksPerMultiprocessor(&per_cu, (const void*)mega_fwd, NWAVES * 64, LDS_BYTES) != hipSuccess || per_cu < 1) { fprintf(stderr, "kernel_launch: occupancy query says %d\n", per_cu); per_cu = 1; }
        (void)hipGetLastError();
        grid = cus;
    }
    if (grid < 0) return;
    Args a{};
    a.x = (const float*)d_in[0]; a.pos = (const int*)d_in[1]; a.attn_norm = (const float*)d_in[2]; a.attn_w_in = (const float*)d_in[3]; a.attn_w_out = (const float*)d_in[4];
    a.mlstm_norm = (const float*)d_in[5]; a.mlstm_w_in = (const float*)d_in[6]; a.conv_w = (const float*)d_in[7]; a.conv_b = (const float*)d_in[8]; a.ig_bias = (const float*)d_in[9];
    a.fg_bias = (const float*)d_in[10]; a.head_gain = (const float*)d_in[11]; a.mlstm_w_out = (const float*)d_in[12]; a.ffn_norm = (const float*)d_in[13]; a.ffn_w_in = (const float*)d_in[14];
    a.ffn_w_out = (const float*)d_in[15]; a.final_norm = (const float*)d_in[16];
    a.out = (float*)d_out; a.ws = (unsigned char*)d_ws; a.ph_lo = 0; a.ph_hi = 16;
    if (hipMemsetAsync((char*)d_ws + WS_BAR, 0, 16384, stream) != hipSuccess) { fprintf(stderr, "kernel_launch: hipMemsetAsync failed\n"); return; }
    void* args[] = {&a};
    const hipError_t e = hipLaunchCooperativeKernel((const void*)mega_fwd, dim3(grid), dim3(NWAVES * 64), args, LDS_BYTES, stream);
    if (e != hipSuccess) fprintf(stderr, "kernel_launch: cooperative launch failed: %s (grid %d)\n", hipGetErrorString(e), grid);
}
```

```cpp
#include <hip/hip_runtime.h>
#include <hip/hip_cooperative_groups.h>
#include <cstdio>
#include <cstdint>
namespace cg = cooperative_groups;

constexpr float RMS_EPS = 1e-6f;
__device__ __forceinline__ float rs_from_ss(float ss) { return __builtin_amdgcn_rsqf(ss * (1.0f / 1024.0f) + RMS_EPS); }
__device__ __forceinline__ float silu_f(float x) { return x * __builtin_amdgcn_rcpf(1.0f + __builtin_amdgcn_exp2f(x * -1.4426950408889634f)); }
__device__ __forceinline__ float sigmoid_f(float x) { return __builtin_amdgcn_rcpf(1.0f + __builtin_amdgcn_exp2f(x * -1.4426950408889634f)); }

namespace pg8 {
#define PG8_LAS __attribute__((address_space(3)))
typedef unsigned short bf16_t;
typedef short bf16x8 __attribute__((ext_vector_type(8)));
typedef float f32x4 __attribute__((ext_vector_type(4)));
typedef unsigned u32x4 __attribute__((ext_vector_type(4)));
constexpr int BM = 256, BK = 64, HALF = 128, HTB = HALF * BK * 2  , STAGE_BYTES = 8 * HTB, NXCD = 8, WGM = 8;

__host__ __device__ __forceinline__ int lds_byte(int r, int c) { const int st = (r >> 4) * 2 + (c >> 5), rr = r & 15, cc = c & 31, ob = rr * 64 + cc * 2; return st * 1024 + (ob ^ (((ob >> 9) & 1) << 5)); }
__host__ __device__ __forceinline__ void stage_rc(int b, int& R, int& C) { const int st = b / 1024, sb = b % 1024, swz = sb ^ (((sb >> 9) & 1) << 5); R = (st >> 1) * 16 + swz / 64; C = (st & 1) * 32 + (swz % 64) / 2; }
__host__ __device__ __forceinline__ int perm32(int rho) { const int n = rho >> 4, i = rho & 15; return 8 * (i >> 2) + 4 * n + (i & 3); }

typedef unsigned u32x2 __attribute__((ext_vector_type(2)));
struct Unit { int pm, pn; };
struct Gemm { const bf16_t* A; const bf16_t* Bt; int M, N, K; };

struct StaticOrder {
    int nM, nN, nwg, G, c;
    __host__ __device__ void init(int M, int N, int G_, int c_) { nM = M / BM; nN = N / BM; nwg = nM * nN; G = G_; c = c_; }
    __host__ __device__ bool next(int i, Unit& u) const {
        const long L = (long)i * G + c; if (L >= nwg) return false;
        int wgid = (int)L; { const int q = nwg / NXCD, r = nwg % NXCD, xcd = wgid % NXCD, off = wgid / NXCD; wgid = (xcd < r ? xcd * (q + 1) : r * (q + 1) + (xcd - r) * q) + off; }
        const int nig = WGM * nN, gid = wgid / nig, fm = gid * WGM, gsz = (nM - fm) < WGM ? (nM - fm) : WGM;
        u.pm = fm + ((wgid % nig) % gsz); u.pn = (wgid % nig) / gsz; return true;
    }
    __device__ __forceinline__ void a_ready(const Unit&) const {}
    __device__ __forceinline__ void done(const Unit&) const {}
};
__device__ __forceinline__ unsigned cvt_pk_bf16(float lo, float hi) { unsigned r; asm volatile("v_cvt_pk_bf16_f32 %0, %1, %2" : "=v"(r) : "v"(lo), "v"(hi)); return r; }

#define EPI_FENCE() asm volatile("" ::: "memory")
struct EpiQKV {
    static constexpr bool PERM = true, AFTER_DRAIN = false;
    bf16_t* O; const float* ss; const float* cs;
    __device__ __forceinline__ void operator()(const f32x4 (&acc)[2][2][4][2], const Unit& u, int wr, int wc, int fr, int fq) const {
        const int row0 = u.pm * BM + wr * 64 + fr; const int colt = u.pn * BM;
        const int tsel = (colt % 3072) / 1024;
        const bool rope = (tsel < 2) && (wc == 0);
        const int gsel = colt / 3072, lg = 2 * gsel, dil = 1 << lg;
        const int hb0 = (gsel * 3 + tsel) * 8 + (colt % 1024) / 128;
        float rsv[8];
#pragma unroll
        for (int k = 0; k < 8; ++k) rsv[k] = ss[row0 + (k >> 2) * HALF + (k & 3) * 16];
        f32x4 cA = {0.f, 0.f, 0.f, 0.f}, sA = cA;
        if (rope) { const float* p = cs + (size_t)row0 * 32 + 4 * fq; cA = *(const f32x4*)p; sA = *(const f32x4*)(p + 16); }
#pragma unroll
        for (int k = 0; k < 8; ++k) {
            const int ai = k >> 2, m = k & 3;
            const int row = row0 + ai * HALF + m * 16;
            f32x4 cN = cA, sN = sA;
            if (rope && k + 1 < 8) { const int rown = row0 + ((k + 1) >> 2) * HALF + ((k + 1) & 3) * 16; const float* p = cs + (size_t)rown * 32 + 4 * fq; cN = *(const f32x4*)p; sN = *(const f32x4*)(p + 16); }
            EPI_FENCE();
            const float rs = rs_from_ss(rsv[k]);
            const int sq = row & 2047, perm = ((sq & (dil - 1)) << (11 - lg)) + (sq >> lg);
            bf16_t* rowp = O + ((size_t)hb0 * 17408 + (row >> 11) * 2176 + perm) * 128;
            if (rope) {
                const f32x4 cr = cA * rs, sr = sA * rs;
#pragma unroll
                for (int bj = 0; bj < 2; ++bj) {
                    const f32x4 v0 = acc[ai][bj][m][0], v1 = acc[ai][bj][m][1];
                    const f32x4 o0 = v0 * cr - v1 * sr, o1 = v1 * cr + v0 * sr;
                    u32x2 w0, w1; w0.x = cvt_pk_bf16(o0[0], o0[1]); w0.y = cvt_pk_bf16(o0[2], o0[3]); w1.x = cvt_pk_bf16(o1[0], o1[1]); w1.y = cvt_pk_bf16(o1[2], o1[3]);
                    bf16_t* hp = rowp + (size_t)bj * 17408 * 128 + 4 * fq;
                    *(u32x2*)hp = w0; *(u32x2*)(hp + 16) = w1;
                }
            } else {
#pragma unroll
                for (int bj = 0; bj < 2; ++bj) {
                    const f32x4 v0 = acc[ai][bj][m][0] * rs, v1 = acc[ai][bj][m][1] * rs;
                    u32x4 wv; wv.x = cvt_pk_bf16(v0[0], v0[1]); wv.y = cvt_pk_bf16(v0[2], v0[3]); wv.z = cvt_pk_bf16(v1[0], v1[1]); wv.w = cvt_pk_bf16(v1[2], v1[3]);
                    *(u32x4*)(rowp + (size_t)bj * 17408 * 128 + wc * 32 + 8 * fq) = wv;
                }
            }
            cA = cN; sA = sN;
        }
    }
};
struct EpiResid {
    static constexpr bool PERM = true, AFTER_DRAIN = false;
    const float* base; float* out; bf16_t* outb; float* ssn;
    __device__ __forceinline__ void operator()(const f32x4 (&acc)[2][2][4][2], const Unit& u, int wr, int wc, int fr, int fq) const {
        const int row0 = u.pm * BM + wr * 64 + fr; const int col0 = u.pn * BM + wc * 32 + 8 * fq;
        f32x4 bA[4];
        { const float* p = base + (size_t)row0 * 1024 + col0; bA[0] = *(const f32x4*)p; bA[1] = *(const f32x4*)(p + 4); bA[2] = *(const f32x4*)(p + HALF); bA[3] = *(const f32x4*)(p + HALF + 4); }
#pragma unroll
        for (int k = 0; k < 8; ++k) {
            const int ai = k >> 2, m = k & 3;
            const int row = row0 + ai * HALF + m * 16;
            f32x4 bN[4];
#pragma unroll
            for (int q = 0; q < 4; ++q) bN[q] = bA[q];
            if (k + 1 < 8) { const int rown = row0 + ((k + 1) >> 2) * HALF + ((k + 1) & 3) * 16; const float* p = base + (size_t)rown * 1024 + col0;
                bN[0] = *(const f32x4*)p; bN[1] = *(const f32x4*)(p + 4); bN[2] = *(const f32x4*)(p + HALF); bN[3] = *(const f32x4*)(p + HALF + 4); }
            EPI_FENCE();
            float sq = 0.f;
#pragma unroll
            for (int bj = 0; bj < 2; ++bj) {
                const size_t off = (size_t)row * 1024 + col0 + bj * HALF;
                const f32x4 v0 = acc[ai][bj][m][0] + bA[2 * bj], v1 = acc[ai][bj][m][1] + bA[2 * bj + 1];
                *(f32x4*)(out + off) = v0; *(f32x4*)(out + off + 4) = v1;
                if (outb) { u32x4 wv; wv.x = cvt_pk_bf16(v0[0], v0[1]); wv.y = cvt_pk_bf16(v0[2], v0[3]); wv.z = cvt_pk_bf16(v1[0], v1[1]); wv.w = cvt_pk_bf16(v1[2], v1[3]); *(u32x4*)(outb + off) = wv; }
                sq += (v0[0] * v0[0] + v0[1] * v0[1]) + (v0[2] * v0[2] + v0[3] * v0[3]) + (v1[0] * v1[0] + v1[1] * v1[1]) + (v1[2] * v1[2] + v1[3] * v1[3]);
            }
            sq += __shfl_xor(sq, 16); sq += __shfl_xor(sq, 32);
            if (fq == 0) atomicAdd(ssn + row, sq);
#pragma unroll
            for (int q = 0; q < 4; ++q) bA[q] = bN[q];
        }
    }
};
struct EpiSwiGLU {
    static constexpr bool PERM = true, AFTER_DRAIN = false;
    bf16_t* O; const float* ss;
    __device__ __forceinline__ void operator()(const f32x4 (&acc)[2][2][4][2], const Unit& u, int wr, int wc, int fr, int fq) const {
        const int row0 = u.pm * BM + wr * 64 + fr; const int col0 = u.pn * HALF + wc * 32 + 8 * fq;
        float rsv[8];
#pragma unroll
        for (int k = 0; k < 8; ++k) rsv[k] = ss[row0 + (k >> 2) * HALF + (k & 3) * 16];
        EPI_FENCE();
#pragma unroll
        for (int ai = 0; ai < 2; ++ai)
#pragma unroll
            for (int m = 0; m < 4; ++m) {
                const int row = row0 + ai * HALF + m * 16;
                const float rs = rs_from_ss(rsv[ai * 4 + m]); const float rs2 = rs * rs, nrs = rs * -1.4426950408889634f;
                float o[8];
#pragma unroll
                for (int n = 0; n < 2; ++n)
#pragma unroll
                    for (int e = 0; e < 4; ++e) { const float g = acc[ai][0][m][n][e], uu = acc[ai][1][m][n][e] * rs2;
                        o[4 * n + e] = (g * uu) * __builtin_amdgcn_rcpf(1.0f + __builtin_amdgcn_exp2f(g * nrs)); }
                u32x4 wv; wv.x = cvt_pk_bf16(o[0], o[1]); wv.y = cvt_pk_bf16(o[2], o[3]); wv.z = cvt_pk_bf16(o[4], o[5]); wv.w = cvt_pk_bf16(o[6], o[7]);
                *(u32x4*)(O + (size_t)row * 2816 + col0) = wv;
            }
    }
};
struct EpiMlstmIn {
    static constexpr bool PERM = true, AFTER_DRAIN = false;
    bf16_t* P2; bf16_t* OP; float* gates; const float* ss;
    __device__ __forceinline__ void operator()(const f32x4 (&acc)[2][2][4][2], const Unit& u, int wr, int wc, int fr, int fq) const {
        const int row0 = u.pm * BM + wr * 64 + fr;
        float rsv[8];
#pragma unroll
        for (int k = 0; k < 8; ++k) rsv[k] = ss[row0 + (k >> 2) * HALF + (k & 3) * 16];
        EPI_FENCE();
#pragma unroll
        for (int ai = 0; ai < 2; ++ai)
#pragma unroll
            for (int m = 0; m < 4; ++m) {
                const int row = row0 + ai * HALF + m * 16;
                const float rs = rs_from_ss(rsv[ai * 4 + m]);
#pragma unroll
                for (int bj = 0; bj < 2; ++bj) {
                    const int cb = u.pn * BM + bj * HALF;
                    const f32x4 v0 = acc[ai][bj][m][0] * rs, v1 = acc[ai][bj][m][1] * rs;
                    const int cc = wc * 32 + 8 * fq;
                    if (cb < 3072) {
                        u32x4 wv; wv.x = cvt_pk_bf16(v0[0], v0[1]); wv.y = cvt_pk_bf16(v0[2], v0[3]); wv.z = cvt_pk_bf16(v1[0], v1[1]); wv.w = cvt_pk_bf16(v1[2], v1[3]);
                        bf16_t* dst = (cb < 2048) ? (P2 + (size_t)row * 2048 + cb + cc) : (OP + (size_t)row * 1024 + (cb - 2048) + cc);
                        *(u32x4*)dst = wv;
                    } else if (cb == 3072 && cc < 16) {
                        float* dst = gates + (size_t)row * 16 + cc;
                        *(f32x4*)dst = v0; *(f32x4*)(dst + 4) = v1;
                    }
                }
            }
    }
};

template <class Epi, class Sched, bool ALIGN_EPI = false, bool SP2 = false>
__device__ __forceinline__ void gemm_phase(PG8_LAS unsigned char* lds, const Gemm g, const Sched& S, const Epi& E) {
    const int tid = threadIdx.x, wid = __builtin_amdgcn_readfirstlane(tid >> 6), lane = tid & 63, wr = wid >> 2, wc = wid & 3, fr = lane & 15, fq = lane >> 4;
    const int K = g.K, nt = K / BK;
    unsigned voffA[2], voffB[2];
#pragma unroll
    for (int i = 0; i < 2; ++i) { int R, C; stage_rc(tid * 16 + i * 8192, R, C); const int Rb = Epi::PERM ? ((R & ~31) + perm32(R & 31)) : R;
        voffA[i] = (unsigned)(R * K + C) * 2u; voffB[i] = (unsigned)(Rb * K + C) * 2u; }
    const size_t kstep = (size_t)(BK * 2);
    const size_t hstep = (size_t)HALF * K * 2;
    const size_t tstep = 2 * hstep;
    const unsigned ldsw = (unsigned)wid * 1024u;
    const int aoff = lds_byte(wr * 64 + fr, fq * 8), boff = lds_byte(wc * 32 + fr, fq * 8);
#define PG8_SA(b, h) (((b) * 2 + (h)) * HTB)
#define PG8_SB(b, h) ((4 + (b) * 2 + (h)) * HTB)
#define PG8_STAGE(bufoff, gbase, voff) do { _Pragma("unroll") for (int _i = 0; _i < 2; ++_i) \
        __builtin_amdgcn_global_load_lds((const unsigned*)((const char*)(gbase) + (voff)[_i]), (PG8_LAS unsigned*)(lds + (bufoff) + ldsw + _i * 8192), 16, 0, 0); } while (0)
#define PG8_LDA(dst, b, h) do { _Pragma("unroll") for (int m = 0; m < 4; ++m) _Pragma("unroll") for (int k = 0; k < 2; ++k) dst[m][k] = *(const PG8_LAS bf16x8*)(lds + PG8_SA(b, h) + aoff + m * 2048 + k * 1024); } while (0)
#define PG8_LDB(dst, b, h) do { _Pragma("unroll") for (int n = 0; n < 2; ++n) _Pragma("unroll") for (int k = 0; k < 2; ++k) dst[n][k] = *(const PG8_LAS bf16x8*)(lds + PG8_SB(b, h) + boff + n * 2048 + k * 1024); } while (0)
#define PG8_MMA(ai, bj, At, Bt) do { __builtin_amdgcn_s_setprio(1); _Pragma("unroll") for (int m = 0; m < 4; ++m) _Pragma("unroll") for (int n = 0; n < 2; ++n) _Pragma("unroll") for (int k = 0; k < 2; ++k) \
        acc[ai][bj][m][n] = __builtin_amdgcn_mfma_f32_16x16x32_bf16(Bt[n][k], At[m][k], acc[ai][bj][m][n], 0, 0, 0); __builtin_amdgcn_s_setprio(0); } while (0)
#define PG8_WAIT_V(n) asm volatile("s_waitcnt vmcnt(" #n ")" ::: "memory")
#define PG8_WAIT_L(n) asm volatile("s_waitcnt lgkmcnt(" #n ")" ::: "memory")
#define PG8_BAR __builtin_amdgcn_s_barrier()
#define PG8_SCHED __builtin_amdgcn_sched_barrier(0)
    Unit cur, nxt; int ui = 0;
    if (!S.next(0, cur)) return;
    f32x4 acc[2][2][4][2];
#pragma unroll
    for (int a = 0; a < 2; ++a)
#pragma unroll
        for (int b = 0; b < 2; ++b)
#pragma unroll
            for (int m = 0; m < 4; ++m)
#pragma unroll
                for (int n = 0; n < 2; ++n) acc[a][b][m][n] = (f32x4){0.f, 0.f, 0.f, 0.f};
    bf16x8 At[4][2], B0[2][2], B1[2][2];
    const char* cA = (const char*)g.A + (size_t)cur.pm * tstep; const char* cB = (const char*)g.Bt + (size_t)cur.pn * tstep;
    S.a_ready(cur);
    if constexpr (SP2) {
        PG8_STAGE(PG8_SB(0, 0), cB, voffB); PG8_STAGE(PG8_SB(0, 1), cB + hstep, voffB); PG8_STAGE(PG8_SA(0, 0), cA, voffA); PG8_STAGE(PG8_SA(0, 1), cA + hstep, voffA);
        if (wr == 1) PG8_BAR;
        PG8_WAIT_V(2); PG8_BAR;
        PG8_STAGE(PG8_SB(1, 0), cB + kstep, voffB); PG8_STAGE(PG8_SA(1, 0), cA + kstep, voffA); PG8_STAGE(PG8_SB(1, 1), cB + hstep + kstep, voffB);
        PG8_WAIT_V(6); PG8_BAR;
    } else {
        PG8_STAGE(PG8_SB(0, 0), cB, voffB); PG8_STAGE(PG8_SA(0, 0), cA, voffA); PG8_STAGE(PG8_SB(0, 1), cB + hstep, voffB); PG8_STAGE(PG8_SA(0, 1), cA + hstep, voffA);
        if (wr == 1) PG8_BAR;
        PG8_WAIT_V(4); PG8_BAR;
        PG8_STAGE(PG8_SB(1, 0), cB + kstep, voffB); PG8_STAGE(PG8_SA(1, 0), cA + kstep, voffA); PG8_STAGE(PG8_SB(1, 1), cB + hstep + kstep, voffB);
        PG8_WAIT_V(6); PG8_BAR;
    }
    for (;;) {
        const bool has_next = S.next(ui + 1, nxt);
        const char* nA = has_next ? (const char*)g.A + (size_t)nxt.pm * tstep : cA; const char* nB = has_next ? (const char*)g.Bt + (size_t)nxt.pn * tstep : cB;
        for (int t = 0; t < nt; t += 2) {
            const bool last = (t == nt - 2);
            const char* a1 = cA + (size_t)(t + 1) * kstep;
            const char* a2 = last ? nA : cA + (size_t)(t + 2) * kstep; const char* b2 = last ? nB : cB + (size_t)(t + 2) * kstep;
            const char* a3 = a2 + kstep; const char* b3 = b2 + kstep;
            if (last && has_next) S.a_ready(nxt);
            if constexpr (SP2) {
            PG8_LDB(B0, 0, 0); PG8_LDB(B1, 0, 1); PG8_SCHED; PG8_LDA(At, 0, 0); PG8_STAGE(PG8_SA(1, 1), a1 + hstep, voffA);
            PG8_WAIT_V(8); PG8_WAIT_L(0); PG8_BAR; PG8_MMA(0, 0, At, B0); PG8_MMA(0, 1, At, B1); PG8_BAR; PG8_SCHED;
            PG8_LDA(At, 0, 1); PG8_STAGE(PG8_SB(0, 0), b2, voffB); PG8_STAGE(PG8_SB(0, 1), b2 + hstep, voffB); PG8_STAGE(PG8_SA(0, 0), a2, voffA);
            PG8_WAIT_V(8); PG8_WAIT_L(0); PG8_BAR; PG8_MMA(1, 0, At, B0); PG8_MMA(1, 1, At, B1); PG8_BAR; PG8_SCHED;
            PG8_LDB(B0, 1, 0); PG8_LDB(B1, 1, 1); PG8_SCHED; PG8_LDA(At, 1, 0); PG8_STAGE(PG8_SA(0, 1), a2 + hstep, voffA);
            PG8_WAIT_V(8); PG8_WAIT_L(0); PG8_BAR; PG8_MMA(0, 0, At, B0); PG8_MMA(0, 1, At, B1); PG8_BAR; PG8_SCHED;
            PG8_LDA(At, 1, 1); PG8_STAGE(PG8_SB(1, 0), b3, voffB); PG8_STAGE(PG8_SB(1, 1), b3 + hstep, voffB); PG8_STAGE(PG8_SA(1, 0), a3, voffA);
            PG8_WAIT_V(8); PG8_WAIT_L(0); PG8_BAR; PG8_MMA(1, 0, At, B0); PG8_MMA(1, 1, At, B1); PG8_BAR; PG8_SCHED;
            } else {
            PG8_LDB(B0, 0, 0); PG8_SCHED; PG8_LDA(At, 0, 0); PG8_STAGE(PG8_SA(1, 1), a1 + hstep, voffA);
            PG8_WAIT_L(8); PG8_BAR; PG8_WAIT_L(0); PG8_MMA(0, 0, At, B0); PG8_BAR; PG8_SCHED;
            PG8_LDB(B1, 0, 1); PG8_STAGE(PG8_SB(0, 0), b2, voffB);
            PG8_BAR; PG8_WAIT_L(0); PG8_MMA(0, 1, At, B1); PG8_BAR;
            PG8_LDA(At, 0, 1); PG8_STAGE(PG8_SA(0, 0), a2, voffA);
            PG8_BAR; PG8_WAIT_L(0); PG8_MMA(1, 0, At, B0); PG8_BAR; PG8_SCHED;
            PG8_STAGE(PG8_SB(0, 1), b2 + hstep, voffB);
            PG8_WAIT_V(6); PG8_BAR; PG8_MMA(1, 1, At, B1); PG8_BAR;
            PG8_LDB(B0, 1, 0); PG8_SCHED; PG8_LDA(At, 1, 0); PG8_STAGE(PG8_SA(0, 1), a2 + hstep, voffA);
            PG8_WAIT_L(8); PG8_BAR; PG8_WAIT_L(0); PG8_MMA(0, 0, At, B0); PG8_BAR; PG8_SCHED;
            PG8_LDB(B1, 1, 1); PG8_STAGE(PG8_SB(1, 0), b3, voffB);
            PG8_BAR; PG8_WAIT_L(0); PG8_MMA(0, 1, At, B1); PG8_BAR;
            PG8_LDA(At, 1, 1); PG8_STAGE(PG8_SA(1, 0), a3, voffA);
            PG8_BAR; PG8_WAIT_L(0); PG8_MMA(1, 0, At, B0); PG8_BAR; PG8_SCHED;
            PG8_STAGE(PG8_SB(1, 1), b3 + hstep, voffB);
            PG8_WAIT_V(6); PG8_BAR; PG8_MMA(1, 1, At, B1); PG8_BAR;
            }
        }
        if constexpr (ALIGN_EPI) { if (wr == 0) PG8_BAR; }
        if constexpr (!Epi::AFTER_DRAIN) { E(acc, cur, wr, wc, fr, fq); S.done(cur); }
        if (!has_next) break;
#pragma unroll
        for (int a = 0; a < 2; ++a)
#pragma unroll
            for (int b = 0; b < 2; ++b)
#pragma unroll
                for (int m = 0; m < 4; ++m)
#pragma unroll
                    for (int n = 0; n < 2; ++n) acc[a][b][m][n] = (f32x4){0.f, 0.f, 0.f, 0.f};
        cur = nxt; cA = nA; cB = nB; ++ui;
        if constexpr (ALIGN_EPI) { if (wr == 1) PG8_BAR; }
    }
    PG8_WAIT_V(0);
    if constexpr (!ALIGN_EPI) { if (wr == 0) PG8_BAR; }
    PG8_BAR;
    if constexpr (Epi::AFTER_DRAIN) { E.fused(acc, cur, wr, wc, fr, fq, lds, wid, lane); S.done(cur); }
#undef PG8_SA
#undef PG8_SB
#undef PG8_STAGE
#undef PG8_LDA
#undef PG8_LDB
#undef PG8_MMA
#undef PG8_WAIT_V
#undef PG8_WAIT_L
#undef PG8_BAR
#undef PG8_SCHED
}
}

constexpr int T_TOK = 32768, DM = 1024, SEQ = 2048, NB = 16, DFF = 2816, THALF = 16384;
constexpr int NWAVES = 8;
constexpr int RB = 2176, HBR = 8 * RB;
constexpr int LDS_BYTES = 147456;
constexpr size_t MiB = 1u << 20;
constexpr size_t WS_SS = 0;
constexpr size_t WS_MST = 1 * MiB;
constexpr size_t WS_NST = 1 * MiB + 65536;
constexpr size_t WS_BAR = 3 * MiB;
constexpr size_t WS_WQKV = 4 * MiB;
constexpr size_t WS_WAO = 22 * MiB;
constexpr size_t WS_WFFIN = 24 * MiB;
constexpr size_t WS_WFFOUT = 46 * MiB;
constexpr size_t WS_WMIN = 57 * MiB;
constexpr size_t WS_WMOUT = 64 * MiB;
constexpr size_t WS_ROPE = 66 * MiB;
constexpr size_t WS_LSE = 70 * MiB;
constexpr size_t WS_GATES = 73 * MiB;
constexpr size_t WS_HB = 76 * MiB;
constexpr size_t WS_MX = 140 * MiB;
constexpr size_t WS_BIG = 204 * MiB;
constexpr size_t WS_H = WS_BIG;
constexpr size_t WS_ACT = WS_BIG + 128 * MiB;
constexpr size_t WS_END = 512 * MiB;
static_assert(WS_ACT + (size_t)T_TOK * DFF * 2 <= WS_END && WS_BIG + (size_t)72 * 8 * 2176 * 256 <= WS_END, "d_ws map");

#define LAS __attribute__((address_space(3)))
typedef unsigned short bf16;
typedef unsigned u32x4 __attribute__((ext_vector_type(4)));
typedef unsigned u32x2 __attribute__((ext_vector_type(2)));
typedef float f32x4 __attribute__((ext_vector_type(4)));
typedef float f32x16 __attribute__((ext_vector_type(16)));
typedef short bf16x8 __attribute__((ext_vector_type(8)));
typedef short s16x4 __attribute__((ext_vector_type(4)));
typedef float f32x2_t __attribute__((ext_vector_type(2)));
typedef __bf16 bf16x2_t __attribute__((ext_vector_type(2)));
__device__ __forceinline__ unsigned pk2(float lo, float hi) { f32x2_t v = {lo, hi}; bf16x2_t b = __builtin_convertvector(v, bf16x2_t); return __builtin_bit_cast(unsigned, b); }
__device__ __forceinline__ float bf_lo(unsigned w) { return __uint_as_float(w << 16); }
__device__ __forceinline__ float bf_hi(unsigned w) { return __uint_as_float(w & 0xffff0000u); }
__device__ __forceinline__ float wave_sum(float v) {
#pragma unroll
    for (int o = 1; o < 64; o <<= 1) v += __shfl_xor(v, o);
    return v;
}
__device__ __forceinline__ float wave_max(float v) {
#pragma unroll
    for (int o = 1; o < 64; o <<= 1) v = fmaxf(v, __shfl_xor(v, o));
    return v;
}
#define MFMA16(a, b, c) __builtin_amdgcn_mfma_f32_16x16x32_bf16((a), (b), (c), 0, 0, 0)
#define MFMA32(a, b, c) __builtin_amdgcn_mfma_f32_32x32x16_bf16((a), (b), (c), 0, 0, 0)

#define XB_TMO      128
#define XB_XCNT(j)  (256  + 64 * (j))
#define XB_XSUB(j)  (1280 + 64 * (j))
#define XB_XGEN(j)  (2304 + 64 * (j))
#define XB_TOP      3328
#define XB_TOPGEN   3392
#define XCD_BAR_WORDS 3456
#define XB_SPIN_CAP (1u << 18)

__device__ __forceinline__ unsigned xb_ld(unsigned* p)              { return __hip_atomic_load(p, __ATOMIC_RELAXED, __HIP_MEMORY_SCOPE_AGENT); }
__device__ __forceinline__ unsigned xb_add(unsigned* p, unsigned v) { return __hip_atomic_fetch_add(p, v, __ATOMIC_RELAXED, __HIP_MEMORY_SCOPE_AGENT); }
__device__ __forceinline__ unsigned xb_xcc_id() { return (unsigned)__builtin_amdgcn_s_getreg((3 << 11) | 20) & 0xFu; }
#define XB_SPIN(cond, bar) do { unsigned _sp = 0; while (cond) { __builtin_amdgcn_s_sleep(1); \
    if ((++_sp & 255u) == 0u) { if (xb_ld(&(bar)[XB_TMO])) break; if (_sp > XB_SPIN_CAP) { atomicAdd(&(bar)[XB_TMO], 1u); break; } } } } while (0)

struct XcdBarrier {
    unsigned* bar; unsigned x;
    volatile LAS unsigned* st;
};

__device__ __forceinline__ XcdBarrier xcd_barrier_post(unsigned* bar, volatile LAS unsigned* st) {
    XcdBarrier b; b.bar = bar; b.x = xb_xcc_id(); b.st = st;
    if (threadIdx.x == 0) (void)xb_add(&bar[XB_XCNT(b.x)], 1u);
    return b;
}
__device__ __forceinline__ void xcd_barrier_complete(unsigned* bar, unsigned x, unsigned& nloc, unsigned& nx) {
    const unsigned G = gridDim.x * gridDim.y * gridDim.z;
    unsigned sum, cnt, mine, sp = 0u;
    for (;;) {
        sum = 0u; cnt = 0u; mine = 0u;
#pragma unroll
        for (unsigned j = 0; j < 16; ++j) { const unsigned c = xb_ld(&bar[XB_XCNT(j)]); sum += c; cnt += (c > 0u) ? 1u : 0u; mine = (j == x) ? c : mine; }
        if (sum == G) break;
        __builtin_amdgcn_s_sleep(1);
        if ((++sp & 255u) == 0u) { if (xb_ld(&bar[XB_TMO])) break; if (sp > XB_SPIN_CAP) { atomicAdd(&bar[XB_TMO], 1u); break; } }
    }
    nloc = mine > 0u ? mine : 1u; nx = cnt > 0u ? cnt : 1u;
}

__device__ __forceinline__ void xcd_barrier(const XcdBarrier& b) {
    asm volatile("s_waitcnt vmcnt(0)" ::: "memory");
    __syncthreads();
    if (threadIdx.x == 0) {
        unsigned* bar = b.bar;
        __builtin_amdgcn_s_waitcnt(0);
        unsigned nloc = b.st[0], nx = b.st[1];
        if (nloc == 0u) { xcd_barrier_complete(bar, b.x, nloc, nx); b.st[0] = nloc; b.st[1] = nx; }
        const unsigned old = xb_add(&bar[XB_XSUB(b.x)], 1u);
        const unsigned gen = old / nloc;
        if (old + 1u == (gen + 1u) * nloc) {
            __builtin_amdgcn_fence(__ATOMIC_RELEASE, "agent");
            asm volatile("s_waitcnt vmcnt(0)" ::: "memory");
            const unsigned og = xb_add(&bar[XB_TOP], 1u);
            const unsigned tg = og / nx;
            if (og + 1u == (tg + 1u) * nx) xb_add(&bar[XB_TOPGEN], 1u);
            else XB_SPIN(xb_ld(&bar[XB_TOPGEN]) == tg, bar);
            __builtin_amdgcn_fence(__ATOMIC_ACQUIRE, "agent");
            xb_add(&bar[XB_XGEN(b.x)], 1u);
            asm volatile("s_waitcnt vmcnt(0)" ::: "memory");
        } else {
            XB_SPIN(xb_ld(&bar[XB_XGEN(b.x)]) == gen, bar);
            __builtin_amdgcn_fence(__ATOMIC_ACQUIRE, "agent");
            asm volatile("s_waitcnt vmcnt(0)" ::: "memory");
        }
    }
    __syncthreads();
}


struct Args {
    const float* x; const int* pos; const float* attn_norm; const float* attn_w_in; const float* attn_w_out; const float* mlstm_norm; const float* mlstm_w_in;
    const float* conv_w; const float* conv_b; const float* ig_bias; const float* fg_bias; const float* head_gain; const float* mlstm_w_out;
    const float* ffn_norm; const float* ffn_w_in; const float* ffn_w_out; const float* final_norm;
    float* out; unsigned char* ws; int ph_lo, ph_hi;
};

__device__ __forceinline__ void tr_item(const float* __restrict__ W, int K, int Nsrc, bf16* WT, int n0_dst, int n0_src, int k0, const float* __restrict__ gain, float scale, LAS float* scr, int lane, bool ropeperm = false) {
    const int n4 = lane & 15, kq = lane >> 4; const int s4 = (ropeperm && n4 < 8) ? (((n4 & 1) << 2) + (n4 >> 1)) : n4; const int col = n0_src + 4 * s4; const bool ok = col < Nsrc;
    f32x4 v[16];
#pragma unroll
    for (int i = 0; i < 16; ++i) { v[i] = (f32x4){0.f, 0.f, 0.f, 0.f}; if (ok) v[i] = __builtin_nontemporal_load((const f32x4*)(W + (size_t)(k0 + 4 * i + kq) * Nsrc + col)); }
#pragma unroll
    for (int i = 0; i < 16; ++i) { const int kk = 4 * i + kq; const float g = gain ? gain[k0 + kk] * scale : scale; LAS float* d = scr + kk * 65 + 4 * n4;
        d[0] = v[i][0] * g; d[1] = v[i][1] * g; d[2] = v[i][2] * g; d[3] = v[i][3] * g; }
    asm volatile("s_waitcnt lgkmcnt(0)" ::: "memory");
    const int c = lane & 7;
#pragma unroll
    for (int j = 0; j < 8; ++j) { const int n = (lane >> 3) + 8 * j; const LAS float* sp = scr + (8 * c) * 65 + n;
        u32x4 o; o.x = pk2(sp[0 * 65], sp[1 * 65]); o.y = pk2(sp[2 * 65], sp[3 * 65]); o.z = pk2(sp[4 * 65], sp[5 * 65]); o.w = pk2(sp[6 * 65], sp[7 * 65]);
        *(u32x4*)(WT + (size_t)(n0_dst + n) * K + k0 + 8 * c) = o; }
    asm volatile("s_waitcnt lgkmcnt(0)" ::: "memory");
}
__device__ __forceinline__ void p0_prologue(const Args& A, LAS unsigned char* lds, int G, int bid) {
    const int tid = threadIdx.x, lane = tid & 63, wave = tid >> 6;
    LAS float* scr = (LAS float*)(lds + wave * 16640);
    const int gw = bid * NWAVES + wave, NGW = G * NWAVES;
    unsigned char* ws = A.ws;
    constexpr int I_QKV = 16 * 144, I_AO = 16 * 16, I_FFIN = 16 * 88, I_FFOUT = 44 * 16, I_MIN = 16 * 52, I_MOUT = 16 * 16;
    constexpr int NITEMS = I_QKV + I_AO + 2 * I_FFIN + 2 * I_FFOUT + I_MIN + I_MOUT;
    constexpr float QSCALE = 0.08838834764831845f * 1.4426950408889634f;
    for (int it = gw; it < NITEMS; it += NGW) {
        int r = it;
        if (r < I_QKV) { const int kb = r / 144, nb = r % 144, n0 = 64 * nb; const int tsel = (n0 % 3072) / 1024;
            tr_item(A.attn_w_in, 1024, 9216, (bf16*)(ws + WS_WQKV), n0, n0, 64 * kb, A.attn_norm, tsel == 0 ? QSCALE : 1.f, scr, lane, tsel < 2 && (n0 & 127) == 0); continue; } r -= I_QKV;
        if (r < I_AO) { const int kb = r / 16, nb = r % 16; tr_item(A.attn_w_out, 1024, 1024, (bf16*)(ws + WS_WAO), 64 * nb, 64 * nb, 64 * kb, nullptr, 1.f, scr, lane); continue; } r -= I_AO;
        if (r < 2 * I_FFIN) { const int l = r / I_FFIN; r -= l * I_FFIN; const int kb = r / 88, nb = r % 88, n0 = 64 * nb;
            const int pn = n0 >> 8, bj = (n0 >> 7) & 1, jj = n0 & 127; const int nsrc = (bj ? DFF : 0) + 128 * pn + jj;
            tr_item(A.ffn_w_in + (size_t)l * 1024 * 5632, 1024, 5632, (bf16*)(ws + WS_WFFIN) + (size_t)l * 5632 * 1024, n0, nsrc, 64 * kb, A.ffn_norm + l * 1024, 1.f, scr, lane); continue; } r -= 2 * I_FFIN;
        if (r < 2 * I_FFOUT) { const int l = r / I_FFOUT; r -= l * I_FFOUT; const int kb = r / 16, nb = r % 16;
            tr_item(A.ffn_w_out + (size_t)l * DFF * 1024, DFF, 1024, (bf16*)(ws + WS_WFFOUT) + (size_t)l * 1024 * DFF, 64 * nb, 64 * nb, 64 * kb, nullptr, 1.f, scr, lane); continue; } r -= 2 * I_FFOUT;
        if (r < I_MIN) { const int kb = r / 52, nb = r % 52; tr_item(A.mlstm_w_in, 1024, 3088, (bf16*)(ws + WS_WMIN), 64 * nb, 64 * nb, 64 * kb, A.mlstm_norm, 1.f, scr, lane); continue; } r -= I_MIN;
        { const int kb = r / 16, nb = r % 16; tr_item(A.mlstm_w_out, 1024, 1024, (bf16*)(ws + WS_WMOUT), 64 * nb, 64 * nb, 64 * kb, nullptr, 1.f, scr, lane); }
    }
    float* ss = (float*)(ws + WS_SS); bf16* hb = (bf16*)(ws + WS_HB);
    for (int m4 = gw; m4 < T_TOK / 4; m4 += NGW) {
        f32x4 v[4][4];
#pragma unroll
        for (int q = 0; q < 4; ++q) { const f32x4* xr = (const f32x4*)(A.x + (size_t)(4 * m4 + q) * DM) + lane;
#pragma unroll
            for (int j = 0; j < 4; ++j) v[q][j] = __builtin_nontemporal_load(xr + 64 * j); }
#pragma unroll
        for (int q = 0; q < 4; ++q) { const int m = 4 * m4 + q; float sq = 0.f;
#pragma unroll
            for (int j = 0; j < 4; ++j) sq += (v[q][j].x * v[q][j].x + v[q][j].y * v[q][j].y) + (v[q][j].z * v[q][j].z + v[q][j].w * v[q][j].w);
            sq = wave_sum(sq);
            u32x2* o8 = (u32x2*)(hb + (size_t)m * DM) + lane;
#pragma unroll
            for (int j = 0; j < 4; ++j) { u32x2 o; o.x = pk2(v[q][j].x, v[q][j].y); o.y = pk2(v[q][j].z, v[q][j].w); o8[64 * j] = o; }
            if (lane == 0) ss[m] = sq; }
    }
    const int gt = bid * 512 + tid, NGT = G * 512;
    for (int i = gt; i < 4 * T_TOK; i += NGT) ss[T_TOK + i] = 0.f;
    float* rope = (float*)(ws + WS_ROPE);
    for (int i = gt; i < T_TOK * 16; i += NGT) {
        const int t = i >> 4, f = i & 15;
        const float invf = __builtin_amdgcn_exp2f((float)f * -1.1832230355827609f);
        const float ang = (float)A.pos[t] * invf;
        const double rev = (double)ang * 0.15915494309189535; const float fr = (float)(rev - rint(rev));
        rope[(size_t)t * 32 + f] = __builtin_amdgcn_cosf(fr); rope[(size_t)t * 32 + 16 + f] = __builtin_amdgcn_sinf(fr);
    }
}

struct AStep { const bf16* base; size_t rowstride; int blk, g, h, dil, rr, b; bool valid, compute; };
__device__ __forceinline__ AStep attn_step(int u, int s, const bf16* QKVh) {
    AStep t; t.valid = true; t.compute = true;
    if (s < 5) { t.g = 0; t.dil = 1; t.rr = 0; const int qt = u & 3; t.h = (u >> 2) & 7; t.b = u >> 5; t.blk = 4 * qt + s - 1; if (s == 0) { t.compute = false; t.valid = qt > 0; if (!t.valid) t.blk = 0; } }
    else if (s < 9) { t.g = 1; t.dil = 4; t.h = u & 7; t.rr = (u >> 3) & 3; t.b = u >> 5; t.blk = s - 5; }
    else { t.g = 2; t.dil = 16; const int v = 4 * u + (s - 9); t.h = v & 7; t.rr = (v >> 3) & 15; t.b = v >> 7; t.blk = 0; }
    t.rowstride = 128;
    t.base = QKVh + ((size_t)(t.g * 24 + t.h) * HBR + t.b * RB + t.rr * (SEQ / t.dil)) * 128;
    return t;
}
typedef short v4i16_t __attribute__((ext_vector_type(4)));
__device__ __forceinline__ s16x4 tr_read(const LAS unsigned char* p) { return __builtin_bit_cast(s16x4, __builtin_amdgcn_ds_read_tr16_b64_v4i16((LAS v4i16_t*)p)); }
__device__ __forceinline__ void attn_phase(LAS unsigned char* lds, const bf16* __restrict__ QKVh, bf16* __restrict__ Oh, float* __restrict__ lse, int half, int G, int bid) {
    const int tid = threadIdx.x, lane = tid & 63, w = __builtin_amdgcn_readfirstlane(tid >> 6), r = lane & 15, q4 = lane >> 4;
    constexpr int SLOT = 34816, VSLOT = 36864;
#define ATT_LOAD(st) do { \
        _Pragma("unroll") for (int i = 0; i < 4; ++i) { const int chunk = tid + 512 * i, c = chunk >> 4, ch = chunk & 15; const bf16* gp = (st).base + (size_t)(128 * (st).blk + c) * (st).rowstride + 8 * ch; \
            kr[i] = *(const u32x4*)(gp + (size_t)8 * HBR * 128); vr[i] = *(const u32x4*)(gp + (size_t)16 * HBR * 128); } \
        { const bf16* qrow = (st).base + (size_t)(128 * (st).blk + 16 * w + r) * (st).rowstride; \
            _Pragma("unroll") for (int q = 0; q < 4; ++q) qn[q] = *(const bf16x8*)(qrow + 32 * q + 8 * q4); } } while (0)
    for (int u = bid; u < 256; u += G) {
        AStep nx = attn_step(u, 0, QKVh);
        u32x4 kr[4], vr[4]; bf16x8 qn[4];
#pragma unroll
        for (int i = 0; i < 4; ++i) { kr[i] = (u32x4){0u, 0u, 0u, 0u}; vr[i] = kr[i]; qn[i] = (bf16x8){0, 0, 0, 0, 0, 0, 0, 0}; }
        ATT_LOAD(nx);
        for (int s = 0; s < 13; ++s) {
            const AStep cu = nx; const int cs = s & 1;
            LAS unsigned char* Kc = lds + cs * SLOT; LAS unsigned char* Vc = lds + 2 * SLOT + cs * VSLOT;
#pragma unroll
            for (int i = 0; i < 4; ++i) { const int chunk = tid + 512 * i, c = chunk >> 4, ch = chunk & 15; *(LAS u32x4*)(Kc + c * 272 + ch * 16) = kr[i]; *(LAS u32x4*)(Vc + c * 288 + ch * 16) = vr[i]; }
            bf16x8 qf[4];
#pragma unroll
            for (int q = 0; q < 4; ++q) qf[q] = qn[q];
            __syncthreads();
            { nx = attn_step(u, (s + 1 < 13) ? s + 1 : 12, QKVh); ATT_LOAD(nx); }
            if (cu.compute) {
                const bool first = (cu.blk == 0);
                const LAS unsigned char* Kp = first ? Kc : lds + (cs ^ 1) * SLOT; const LAS unsigned char* Vp = first ? Vc : lds + 2 * SLOT + (cs ^ 1) * VSLOT;
                const int a = 16 * w + r;
                const int jlo = first ? 8 : 0;
                f32x4 S[9]; float mx = -INFINITY;
#pragma unroll
                for (int jj = 0; jj < 9; ++jj) { const int j = w + jj; S[jj] = (f32x4){0.f, 0.f, 0.f, 0.f};
                    if (j >= jlo) { const LAS unsigned char* kp = (j >= 8 ? Kc : Kp) + ((j & 7) * 16 + r) * 272 + 16 * q4;
#pragma unroll
                        for (int st = 0; st < 4; ++st) { const bf16x8 kf = *(const LAS bf16x8*)(kp + 64 * st); S[jj] = MFMA16(kf, qf[st], S[jj]); } }
#pragma unroll
                    for (int i = 0; i < 4; ++i) { bool valid = (j >= jlo);
                        if (jj == 0) valid = valid && (4 * q4 + i >= r);
                        if (jj == 8) valid = valid && (4 * q4 + i <= r);
                        S[jj][i] = valid ? S[jj][i] : -INFINITY; mx = fmaxf(mx, S[jj][i]); } }
                mx = fmaxf(mx, __shfl_xor(mx, 16)); mx = fmaxf(mx, __shfl_xor(mx, 32));
                float den = 0.f;
#pragma unroll
                for (int jj = 0; jj < 9; ++jj)
#pragma unroll
                    for (int i = 0; i < 4; ++i) { const float pe = __builtin_amdgcn_exp2f(S[jj][i] - mx); S[jj][i] = pe; den += pe; }
                den += __shfl_xor(den, 16); den += __shfl_xor(den, 32);
                bf16x8 pf[5];
#pragma unroll
                for (int p = 0; p < 5; ++p) { u32x4 wv; wv.x = pk2(S[2 * p][0], S[2 * p][1]); wv.y = pk2(S[2 * p][2], S[2 * p][3]);
                    if (2 * p + 1 < 9) { wv.z = pk2(S[(2 * p + 1) % 9][0], S[(2 * p + 1) % 9][1]); wv.w = pk2(S[(2 * p + 1) % 9][2], S[(2 * p + 1) % 9][3]); } else { wv.z = 0u; wv.w = 0u; }
                    pf[p] = __builtin_bit_cast(bf16x8, wv); }
                f32x4 o[8];
#pragma unroll
                for (int db = 0; db < 8; ++db) o[db] = (f32x4){0.f, 0.f, 0.f, 0.f};
#pragma unroll
                for (int p = 0; p < 5; ++p) { const int j0 = w + 2 * p, j1 = (j0 + 1 > 15) ? 15 : j0 + 1;
                    if (j0 + 1 >= jlo) {
                        const LAS unsigned char* v0p = (j0 >= 8 ? Vc : Vp) + ((j0 & 7) * 16 + 4 * q4 + (r >> 2)) * 288 + 8 * (r & 3);
                        const LAS unsigned char* v1p = (j1 >= 8 ? Vc : Vp) + ((j1 & 7) * 16 + 4 * q4 + (r >> 2)) * 288 + 8 * (r & 3);
#pragma unroll
                        for (int db = 0; db < 8; ++db) {
                            const s16x4 lo = tr_read(v0p + 32 * db), hi = tr_read(v1p + 32 * db);
                            const bf16x8 af = __builtin_shufflevector(lo, hi, 0, 1, 2, 3, 4, 5, 6, 7);
                            o[db] = MFMA16(af, pf[p], o[db]); } } }
                const float inv = __builtin_amdgcn_rcpf(den);
                const int tl = cu.b * SEQ + (128 * cu.blk + a) * cu.dil + cu.rr;
                bf16* orow = Oh + ((size_t)(cu.g * 8 + cu.h) * HBR + cu.b * RB + cu.rr * (SEQ / cu.dil) + 128 * cu.blk + a) * 128 + 4 * q4;
#pragma unroll
                for (int db = 0; db < 8; ++db) { u32x2 wv; wv.x = pk2(o[db][0] * inv, o[db][1] * inv); wv.y = pk2(o[db][2] * inv, o[db][3] * inv); *(u32x2*)(orow + 16 * db) = wv; }
                if (q4 == 0) lse[((size_t)cu.g * T_TOK + (size_t)half * THALF + tl) * 8 + cu.h] = mx * 0.6931471805599453f + __logf(den);
            }
            __syncthreads();
        }
    }
#undef ATT_LOAD
}
__device__ __forceinline__ void merge_phase(const bf16* __restrict__ Oh, const float* __restrict__ lse, bf16* __restrict__ MX, int half, int G, int bid) {
    const int gt = bid * 512 + threadIdx.x, NGT = G * 512;
    for (int i = gt; i < THALF * 128; i += NGT) {
        const int tl = i >> 7, ch = i & 127, h = ch >> 4; const size_t tg = (size_t)half * THALF + tl;
        const float l0 = lse[((size_t)0 * T_TOK + tg) * 8 + h], l1 = lse[((size_t)1 * T_TOK + tg) * 8 + h], l2 = lse[((size_t)2 * T_TOK + tg) * 8 + h];
        const float mxl = fmaxf(l0, fmaxf(l1, l2)); float w0 = __expf(l0 - mxl), w1 = __expf(l1 - mxl), w2 = __expf(l2 - mxl); const float inv = 1.0f / (w0 + w1 + w2); w0 *= inv; w1 *= inv; w2 *= inv;
        const int sq = tl & 2047, bb = (tl >> 11) * RB, dch = ch & 15;
        const int p1 = ((sq & 3) << 9) + (sq >> 2), p2 = ((sq & 15) << 7) + (sq >> 4);
        const u32x4 a = *(const u32x4*)(Oh + ((size_t)(0 + h) * HBR + bb + sq) * 128 + 8 * dch), b = *(const u32x4*)(Oh + ((size_t)(8 + h) * HBR + bb + p1) * 128 + 8 * dch), c = *(const u32x4*)(Oh + ((size_t)(16 + h) * HBR + bb + p2) * 128 + 8 * dch);
        u32x4 o;
#pragma unroll
        for (int e = 0; e < 4; ++e) o[e] = pk2(w0 * bf_lo(a[e]) + w1 * bf_lo(b[e]) + w2 * bf_lo(c[e]), w0 * bf_hi(a[e]) + w1 * bf_hi(b[e]) + w2 * bf_hi(c[e]));
        *(u32x4*)(MX + tg * 1024 + 8 * ch) = o;
    }
}
__device__ __forceinline__ float logsigmoid_f(float x) { return fminf(x, 0.f) - __logf(1.0f + __expf(-fabsf(x))); }
__device__ __forceinline__ void mlstm_pre_phase(const bf16* __restrict__ P2, const float* __restrict__ gates, const float* __restrict__ convw, const float* __restrict__ convb, const float* __restrict__ igb, const float* __restrict__ fgb,
                                                bf16* __restrict__ QKc, float* __restrict__ GA, float* __restrict__ GB, float* __restrict__ GP, float* __restrict__ CH, int G, int bid) {
    const int tid = threadIdx.x, lane = tid & 63, wave = tid >> 6;
    const int gt = bid * 512 + tid, NGT = G * 512;
    for (int it = gt; it < (T_TOK / 8) * 128; it += NGT) {
        const int ch = it & 127, tg = it >> 7; const int t0 = 8 * tg, sq0 = t0 & 2047; const int col = 8 * ch;
        float cw[4][8], cb[8];
#pragma unroll
        for (int q = 0; q < 2; ++q) { const f32x4 b4 = *(const f32x4*)(convb + col + 4 * q);
#pragma unroll
            for (int e = 0; e < 4; ++e) cb[4 * q + e] = b4[e];
#pragma unroll
            for (int j = 0; j < 4; ++j) { const f32x4 w4 = *(const f32x4*)(convw + j * 1024 + col + 4 * q);
#pragma unroll
                for (int e = 0; e < 4; ++e) cw[j][4 * q + e] = w4[e]; } }
        u32x4 rw[11];
#pragma unroll
        for (int i = 0; i < 11; ++i) { rw[i] = (u32x4){0u, 0u, 0u, 0u}; if (sq0 + i - 3 >= 0) rw[i] = *(const u32x4*)(P2 + (size_t)(t0 + i - 3) * 2048 + col); }
        const float ksc = (ch >= 64) ? 0.125f : 1.0f;
#pragma unroll
        for (int i = 0; i < 8; ++i) { u32x4 o;
#pragma unroll
            for (int e = 0; e < 4; ++e) { float x0 = cb[2 * e], x1 = cb[2 * e + 1];
#pragma unroll
                for (int j = 0; j < 4; ++j) { x0 += cw[j][2 * e] * bf_lo(rw[i + j][e]); x1 += cw[j][2 * e + 1] * bf_hi(rw[i + j][e]); }
                o[e] = pk2(silu_f(x0) * ksc, silu_f(x1) * ksc); }
            *(u32x4*)(QKc + (size_t)(t0 + i) * 1024 + col) = o; }
    }
    const int gw = bid * NWAVES + wave, NGW = G * NWAVES;
    for (int it = gw; it < NB * 32; it += NGW) {
        const int c = it & 31, b = it >> 5; const size_t t = (size_t)b * SEQ + 64 * c + lane;
        f32x4 g4[4];
#pragma unroll
        for (int q = 0; q < 4; ++q) g4[q] = *(const f32x4*)(gates + t * 16 + 4 * q);
        float bs[8], av[8], pm[8];
#pragma unroll
        for (int h = 0; h < 8; ++h) bs[h] = logsigmoid_f(g4[2 + (h >> 2)][h & 3] + fgb[h]);
#pragma unroll
        for (int o = 1; o < 64; o <<= 1) {
#pragma unroll
            for (int h = 0; h < 8; ++h) { const float v = __shfl_up(bs[h], o); if (lane >= o) bs[h] += v; } }
#pragma unroll
        for (int h = 0; h < 8; ++h) { av[h] = g4[h >> 2][h & 3] + igb[h] - bs[h]; pm[h] = av[h]; }
#pragma unroll
        for (int o = 1; o < 64; o <<= 1) {
#pragma unroll
            for (int h = 0; h < 8; ++h) { const float v = __shfl_up(pm[h], o); if (lane >= o) pm[h] = fmaxf(pm[h], v); } }
#pragma unroll
        for (int h = 0; h < 8; ++h) { const size_t o = (size_t)(b * 8 + h) * SEQ + 64 * c + lane; GA[o] = av[h]; GB[o] = bs[h]; GP[o] = pm[h];
            if (lane == 63) { const size_t cid = (size_t)(b * 8 + h) * 32 + c; CH[2 * cid] = bs[h]; CH[2 * cid + 1] = bs[h] + pm[h]; } }
    }
}
__device__ __forceinline__ void mlstm_scan_phase(LAS unsigned char* lds, const bf16* __restrict__ P2, const bf16* __restrict__ QKc, const float* __restrict__ GA, const float* __restrict__ CH,
                                                 bf16* __restrict__ Cst, float* __restrict__ nst, float* __restrict__ mst, int G, int bid) {
    const int tid = threadIdx.x, lane = tid & 63, w = __builtin_amdgcn_readfirstlane(tid >> 6), r = lane & 15, q4 = lane >> 4;
    const int dvb = w & 3, dkh = w >> 2;
    const bf16x8 ones = {0x3F80, 0x3F80, 0x3F80, 0x3F80, 0x3F80, 0x3F80, 0x3F80, 0x3F80};
    for (int item = bid; item < 256; item += G) {
        const int dvh = item & 1, h = (item >> 1) & 7, b = item >> 4;
        const size_t cid0 = (size_t)(b * 8 + h) * 32;
        f32x4 acc[2], accn[2]; acc[0] = (f32x4){0.f, 0.f, 0.f, 0.f}; acc[1] = acc[0]; accn[0] = acc[0]; accn[1] = acc[0];
        float mcar = 0.f;
        u32x4 nk, nv; float na, nbl, nml;
#define MSCAN_LOAD(c) do { const size_t t_ = (size_t)b * SEQ + 64 * (c) + lane; nk = *(const u32x4*)(QKc + t_ * 1024 + 512 + h * 64 + 8 * w); nv = *(const u32x4*)(P2 + t_ * 2048 + 1024 + h * 128 + 64 * dvh + 8 * w); \
            na = GA[(size_t)(b * 8 + h) * SEQ + 64 * (c) + lane]; nbl = CH[2 * (cid0 + (c))]; nml = CH[2 * (cid0 + (c)) + 1]; } while (0)
        MSCAN_LOAD(0);
        for (int c = 0; c < 32; ++c) {
            const u32x4 ck = nk, cv = nv; const float as = na, blast = nbl, mloc = nml;
            if (c + 1 < 32) MSCAN_LOAD(c + 1);
            const float mnew = fmaxf(blast + mcar, mloc);
            const float wsv = __expf(blast + as - mnew), carry = __expf(blast + mcar - mnew);
            const size_t cid = cid0 + c;
#pragma unroll
            for (int nb = 0; nb < 2; ++nb)
#pragma unroll
                for (int i = 0; i < 4; ++i) { const int dv = 64 * dvh + 16 * dvb + 4 * q4 + i, dk = 32 * dkh + 16 * nb + r;
                    Cst[(cid * 128 + dv) * 64 + dk] = (bf16)(pk2(acc[nb][i], 0.f) & 0xffffu); }
            if (dvh == 0 && dvb == 0 && q4 == 0) { nst[cid * 64 + 32 * dkh + r] = accn[0][0]; nst[cid * 64 + 32 * dkh + 16 + r] = accn[1][0]; }
            if (dvh == 0 && tid == 0) mst[cid] = mcar;
            LAS unsigned char* Kw = lds + (c & 1) * 18432; LAS unsigned char* Vs = Kw + 9216;
            u32x4 kw;
#pragma unroll
            for (int e = 0; e < 4; ++e) kw[e] = pk2(bf_lo(ck[e]) * wsv, bf_hi(ck[e]) * wsv);
            *(LAS u32x4*)(Kw + lane * 144 + 16 * w) = kw; *(LAS u32x4*)(Vs + lane * 144 + 16 * w) = cv;
            __syncthreads();
            acc[0] = acc[0] * carry; acc[1] = acc[1] * carry; accn[0] = accn[0] * carry; accn[1] = accn[1] * carry;
#pragma unroll
            for (int st = 0; st < 2; ++st) {
                const int rowb = (32 * st + 8 * q4 + (r >> 2)) * 144 + 8 * (r & 3);
                const s16x4 alo = tr_read(Vs + rowb + 32 * dvb), ahi = tr_read(Vs + rowb + 4 * 144 + 32 * dvb);
                const bf16x8 af = __builtin_shufflevector(alo, ahi, 0, 1, 2, 3, 4, 5, 6, 7);
#pragma unroll
                for (int nb = 0; nb < 2; ++nb) {
                    const s16x4 blo = tr_read(Kw + rowb + 64 * dkh + 32 * nb), bhi = tr_read(Kw + rowb + 4 * 144 + 64 * dkh + 32 * nb);
                    const bf16x8 bfr = __builtin_shufflevector(blo, bhi, 0, 1, 2, 3, 4, 5, 6, 7);
                    acc[nb] = MFMA16(af, bfr, acc[nb]);
                    if (dvb == 0) accn[nb] = MFMA16(ones, bfr, accn[nb]); }
            }
            mcar = mnew;
        }
        __syncthreads();
#undef MSCAN_LOAD
    }
}
__device__ __forceinline__ void mlstm_out_phase(LAS unsigned char* lds, const bf16* __restrict__ P2, const bf16* __restrict__ QKc, const bf16* __restrict__ OP, const float* __restrict__ GA, const float* __restrict__ GB, const float* __restrict__ GP,
                                                const float* __restrict__ hgain, const bf16* __restrict__ Cst, const float* __restrict__ nst, const float* __restrict__ mst, bf16* __restrict__ MX, int G, int bid) {
    const int tid = threadIdx.x, lane = tid & 63, w = __builtin_amdgcn_readfirstlane(tid >> 6), r = lane & 31, h2 = lane >> 5;
    const int dvb = w & 3, tb = w >> 2;
    constexpr int O_Q = 0, O_K = 9216, O_V = 18432, O_C = 38912, O_VEC = 57344, O_GN = 58368, O_PART = 58880, SETB = 59904;
    u32x4 pq, pk, pv0, pv1, pc0, pc1; float pvec = 0.f, pgn = 0.f, pmc = 0.f; u32x2 popv[4];
    pq = (u32x4){0u, 0u, 0u, 0u}; pk = pq; pv0 = pq; pv1 = pq; pc0 = pq; pc1 = pq;
#pragma unroll
    for (int gq = 0; gq < 4; ++gq) popv[gq] = (u32x2){0u, 0u};
#define OUT_LOAD(it) do { const int c_ = (it) & 31, h_ = ((it) >> 5) & 7, b_ = (it) >> 8; const size_t t0_ = (size_t)b_ * SEQ + 64 * c_; const size_t gb_ = (size_t)(b_ * 8 + h_) * SEQ + 64 * c_; \
        { const bf16* p_ = QKc + (t0_ + (tid >> 3)) * 1024 + h_ * 64 + 8 * (tid & 7); pq = *(const u32x4*)p_; pk = *(const u32x4*)(p_ + 512); } \
        { const bf16* p_ = P2 + (t0_ + (tid >> 4)) * 2048 + 1024 + h_ * 128 + 8 * (tid & 15); pv0 = *(const u32x4*)p_; pv1 = *(const u32x4*)(p_ + (size_t)32 * 2048); } \
        { const bf16* p_ = Cst + ((size_t)(it) * 128 + (tid >> 3)) * 64 + 8 * (tid & 7); pc0 = *(const u32x4*)p_; pc1 = *(const u32x4*)(p_ + 64 * 64); } \
        { const int wh_ = tid >> 6, ix_ = tid & 63; const float* src_ = (wh_ == 0) ? (GA + gb_) : (wh_ == 1) ? (GB + gb_) : (wh_ == 2) ? (GP + gb_) : (wh_ == 3) ? (nst + (size_t)(it) * 64) : (hgain + h_ * 128 + ((wh_ & 1) << 6)); pvec = src_[ix_]; } \
        pmc = mst[(it)]; \
        { const size_t orow_ = (t0_ + 32 * tb + r) * 1024 + h_ * 128 + 32 * dvb + 4 * h2; _Pragma("unroll") for (int gq = 0; gq < 4; ++gq) popv[gq] = *(const u32x2*)(OP + orow_ + 8 * gq); } } while (0)
    { const int fit = (bid < 4096) ? bid : 0; OUT_LOAD(fit); }
    int par = 0;
    for (int item = bid; item < 4096; item += G, par ^= 1) {
        const int c = item & 31, h = (item >> 5) & 7, b = item >> 8;
        const size_t t0 = (size_t)b * SEQ + 64 * c;
        LAS unsigned char* L = lds + par * SETB;
        LAS float* vec = (LAS float*)(L + O_VEC); LAS float* gnl = (LAS float*)(L + O_GN); LAS float* part = (LAS float*)(L + O_PART);
        *(LAS u32x4*)(L + O_Q + (tid >> 3) * 144 + (tid & 7) * 16) = pq; *(LAS u32x4*)(L + O_K + (tid >> 3) * 144 + (tid & 7) * 16) = pk;
        *(LAS u32x4*)(L + O_V + (tid >> 4) * 320 + (tid & 15) * 16) = pv0; *(LAS u32x4*)(L + O_V + (32 + (tid >> 4)) * 320 + (tid & 15) * 16) = pv1;
        *(LAS u32x4*)(L + O_C + (tid >> 3) * 144 + (tid & 7) * 16) = pc0; *(LAS u32x4*)(L + O_C + (64 + (tid >> 3)) * 144 + (tid & 7) * 16) = pc1;
        if (tid < 384) vec[tid] = pvec;
        const float mc = pmc; u32x2 opv[4];
#pragma unroll
        for (int gq = 0; gq < 4; ++gq) opv[gq] = popv[gq];
        __syncthreads();
        { const int nit = (item + G < 4096) ? item + G : item; OUT_LOAD(nit); }
        const int t = 32 * tb + r;
        const float Mt = fmaxf(mc, vec[128 + t]), bt = vec[64 + t];
        bf16x8 qf[4];
#pragma unroll
        for (int st = 0; st < 4; ++st) qf[st] = *(const LAS bf16x8*)(L + O_Q + t * 144 + (16 * st + 8 * h2) * 2);
        float qn = 0.f;
#pragma unroll
        for (int st = 0; st < 4; ++st) { const u32x4 qq = __builtin_bit_cast(u32x4, qf[st]); const f32x4 n0 = *(const LAS f32x4*)(vec + 192 + 16 * st + 8 * h2), n1 = *(const LAS f32x4*)(vec + 192 + 16 * st + 8 * h2 + 4);
#pragma unroll
            for (int e = 0; e < 2; ++e) { qn += bf_lo(qq[e]) * n0[2 * e] + bf_hi(qq[e]) * n0[2 * e + 1]; qn += bf_lo(qq[2 + e]) * n1[2 * e] + bf_hi(qq[2 + e]) * n1[2 * e + 1]; } }
        qn += __shfl_xor(qn, 32);
        f32x16 acc1, acc2;
#pragma unroll
        for (int i = 0; i < 16; ++i) { acc1[i] = 0.f; acc2[i] = 0.f; }
        float dsum = 0.f;
#pragma unroll
        for (int sb = 0; sb < 2; ++sb) {
            if (sb <= tb) {
                f32x16 S;
#pragma unroll
                for (int i = 0; i < 16; ++i) S[i] = 0.f;
#pragma unroll
                for (int st = 0; st < 4; ++st) { const bf16x8 kf = *(const LAS bf16x8*)(L + O_K + (32 * sb + r) * 144 + (16 * st + 8 * h2) * 2); S = MFMA32(kf, qf[st], S); }
#pragma unroll
                for (int gq = 0; gq < 4; ++gq) { const f32x4 a4 = *(const LAS f32x4*)(vec + 32 * sb + 8 * gq + 4 * h2);
#pragma unroll
                    for (int k = 0; k < 4; ++k) { const int i = 4 * gq + k, s = 32 * sb + 8 * gq + 4 * h2 + k; const float ev = __builtin_amdgcn_exp2f(fminf(a4[k] - Mt, 0.f) * 1.4426950408889634f);
                        const float wgt = (s <= t) ? ev : 0.f; S[i] = wgt * S[i]; dsum += S[i]; } }
#pragma unroll
                for (int sp = 0; sp < 2; ++sp) {
                    u32x4 wv; wv.x = pk2(S[8 * sp + 0], S[8 * sp + 1]); wv.y = pk2(S[8 * sp + 2], S[8 * sp + 3]); wv.z = pk2(S[8 * sp + 4], S[8 * sp + 5]); wv.w = pk2(S[8 * sp + 6], S[8 * sp + 7]);
                    const bf16x8 pfr = __builtin_bit_cast(bf16x8, wv);
                    const LAS unsigned char* vp = L + O_V + (32 * sb + 16 * sp + 4 * h2 + ((lane & 15) >> 2)) * 320 + (32 * dvb + 16 * ((lane >> 4) & 1) + 4 * (lane & 3)) * 2;
                    const s16x4 lo = tr_read(vp), hi = tr_read(vp + 8 * 320);
                    const bf16x8 af = __builtin_shufflevector(lo, hi, 0, 1, 2, 3, 4, 5, 6, 7);
                    acc1 = MFMA32(af, pfr, acc1);
                }
            }
        }
        dsum += __shfl_xor(dsum, 32);
#pragma unroll
        for (int st = 0; st < 4; ++st) { const bf16x8 cf = *(const LAS bf16x8*)(L + O_C + (32 * dvb + r) * 144 + (16 * st + 8 * h2) * 2); acc2 = MFMA32(cf, qf[st], acc2); }
        const float winter = __expf(mc - Mt);
        const float den = dsum + winter * qn;
        const float dnm = fmaxf(fabsf(den), __expf(-(bt + Mt)));
        const float idn = __builtin_amdgcn_rcpf(dnm);
        float hsq = 0.f;
#pragma unroll
        for (int i = 0; i < 16; ++i) { acc1[i] = (acc1[i] + winter * acc2[i]) * idn; hsq += acc1[i] * acc1[i]; }
        hsq += __shfl_xor(hsq, 32);
        if (h2 == 0) part[dvb * 64 + t] = hsq;
        __syncthreads();
        const float tot = (part[t] + part[64 + t]) + (part[128 + t] + part[192 + t]);
        const float rsn = __builtin_amdgcn_rsqf(tot * (1.0f / 128.0f) + RMS_EPS);
        const size_t orow = (t0 + t) * 1024 + h * 128 + 32 * dvb + 4 * h2;
#pragma unroll
        for (int gq = 0; gq < 4; ++gq) {
            const u32x2 op = opv[gq]; const f32x4 gn = *(const LAS f32x4*)(gnl + 32 * dvb + 4 * h2 + 8 * gq);
            const float y0 = acc1[4 * gq + 0] * rsn * gn[0] * sigmoid_f(bf_lo(op.x)), y1 = acc1[4 * gq + 1] * rsn * gn[1] * sigmoid_f(bf_hi(op.x));
            const float y2 = acc1[4 * gq + 2] * rsn * gn[2] * sigmoid_f(bf_lo(op.y)), y3 = acc1[4 * gq + 3] * rsn * gn[3] * sigmoid_f(bf_hi(op.y));
            u32x2 wv; wv.x = pk2(y0, y1); wv.y = pk2(y2, y3); *(u32x2*)(MX + orow + 8 * gq) = wv;
        }
    }
    __syncthreads();
#undef OUT_LOAD
}
__device__ __forceinline__ void final_phase(float* __restrict__ out, const float* __restrict__ ss, const float* __restrict__ gain, int G, int bid) {
    const int gt = bid * 512 + threadIdx.x, NGT = G * 512;
    for (int i = gt; i < T_TOK * 256; i += NGT) { const int t = i >> 8, c4 = i & 255; const float rs = rs_from_ss(ss[t]);
        f32x4 v = *(f32x4*)(out + (size_t)t * 1024 + 4 * c4); const f32x4 gn = *(const f32x4*)(gain + 4 * c4); v = v * rs * gn; *(f32x4*)(out + (size_t)t * 1024 + 4 * c4) = v; }
}

__global__ void __launch_bounds__(NWAVES * 64, 2) mega_fwd(Args A) {
    extern __shared__ __attribute__((aligned(16))) unsigned char lds_raw[];
    LAS unsigned char* lds = (LAS unsigned char*)lds_raw;
    cg::grid_group grid = cg::this_grid();
    const int G = gridDim.x, bid = blockIdx.x;
    unsigned char* ws = A.ws;
    float* ss = (float*)(ws + WS_SS);
    bf16* hb = (bf16*)(ws + WS_HB); bf16* MX = (bf16*)(ws + WS_MX);
    bf16* QKVh = (bf16*)(ws + WS_BIG); float* H = (float*)(ws + WS_H); bf16* ACT = (bf16*)(ws + WS_ACT); bf16* P2 = (bf16*)(ws + WS_ACT);
    bf16* Oh = (bf16*)A.out; bf16* Cst = (bf16*)A.out; bf16* OP = (bf16*)A.out + (size_t)32 * 1024 * 1024;
    float* lse = (float*)(ws + WS_LSE); float* gates = (float*)(ws + WS_GATES); float* rope = (float*)(ws + WS_ROPE);
    float* mst = (float*)(ws + WS_MST); float* nst = (float*)(ws + WS_NST);
    bf16* QKc = hb;
    float* GA = (float*)(ws + 460 * MiB); float* GB = GA + (size_t)T_TOK * 8; float* GP = GB + (size_t)T_TOK * 8; float* CH = GP + (size_t)T_TOK * 8;
    const int lo = A.ph_lo, hi = A.ph_hi;
    volatile LAS unsigned* MISC = (volatile LAS unsigned*)(lds + LDS_BYTES - 256);
    if (threadIdx.x < 16) MISC[threadIdx.x] = 0u;
    __syncthreads();
    const XcdBarrier bar = xcd_barrier_post((unsigned*)(ws + WS_BAR), MISC + 8);
#ifndef PROBE_MASK
#define PROBE_MASK 0u
#endif
#define PROBE_K 4ull
    unsigned long long pr_sum = 0ull, pr_t0 = 0ull, pr_s0 = 0ull;
#define PB(k) do { if (PROBE_MASK & (1u << (k))) pr_t0 = __builtin_amdgcn_s_memrealtime(); } while (0)
#define PE(k) do { if (PROBE_MASK & (1u << (k))) pr_sum += __builtin_amdgcn_s_memrealtime() - pr_t0; } while (0)
#define IN(k) (lo <= (k) && (k) < hi)
#define SYNC(k) do { if (IN(k) && IN((k) + 1)) { if (PROBE_MASK & (1u << 30)) pr_s0 = __builtin_amdgcn_s_memrealtime(); if (hi < 0) { __threadfence(); grid.sync(); __threadfence(); } else xcd_barrier(bar); if (PROBE_MASK & (1u << 30)) pr_sum += __builtin_amdgcn_s_memrealtime() - pr_s0; if (PROBE_MASK & (1u << 29)) { pr_s0 = __builtin_amdgcn_s_memrealtime(); xcd_barrier(bar); pr_sum += __builtin_amdgcn_s_memrealtime() - pr_s0; } } PE(k); } while (0)
    PB(0); if (IN(0)) p0_prologue(A, lds, G, bid);
    SYNC(0);
    PB(1); if (IN(1)) { pg8::Gemm g{hb, (const bf16*)(ws + WS_WQKV), THALF, 9216, 1024}; pg8::StaticOrder S; S.init(THALF, 9216, G, bid);
        pg8::EpiQKV E{QKVh, ss, rope}; pg8::gemm_phase<pg8::EpiQKV, pg8::StaticOrder, true, true>(lds, g, S, E); }
    SYNC(1);
    PB(2); if (IN(2)) attn_phase(lds, QKVh, Oh, lse, 0, G, bid);
    SYNC(2);
    PB(3); if (IN(3)) { merge_phase(Oh, lse, MX, 0, G, bid);
        pg8::Gemm g{hb + (size_t)THALF * 1024, (const bf16*)(ws + WS_WQKV), THALF, 9216, 1024}; pg8::StaticOrder S; S.init(THALF, 9216, G, bid);
        pg8::EpiQKV E{QKVh, ss + THALF, rope + (size_t)THALF * 32}; pg8::gemm_phase<pg8::EpiQKV, pg8::StaticOrder, true, true>(lds, g, S, E); }
    SYNC(3);
    PB(4); if (IN(4)) attn_phase(lds, QKVh, Oh, lse, 1, G, bid);
    SYNC(4);
    PB(5); if (IN(5)) merge_phase(Oh, lse, MX, 1, G, bid);
    SYNC(5);
    PB(6); if (IN(6)) { pg8::Gemm g{MX, (const bf16*)(ws + WS_WAO), T_TOK, 1024, 1024}; pg8::StaticOrder S; S.init(T_TOK, 1024, G, bid);
        pg8::EpiResid E{A.x, H, hb, ss + T_TOK}; pg8::gemm_phase<pg8::EpiResid, pg8::StaticOrder, true, true>(lds, g, S, E); }
    SYNC(6);
    PB(7); if (IN(7)) { pg8::Gemm g{hb, (const bf16*)(ws + WS_WFFIN), T_TOK, 5632, 1024}; pg8::StaticOrder S; S.init(T_TOK, 5632, G, bid);
        pg8::EpiSwiGLU E{ACT, ss + T_TOK}; pg8::gemm_phase<pg8::EpiSwiGLU, pg8::StaticOrder, true, true>(lds, g, S, E); }
    SYNC(7);
    PB(8); if (IN(8)) { pg8::Gemm g{ACT, (const bf16*)(ws + WS_WFFOUT), T_TOK, 1024, DFF}; pg8::StaticOrder S; S.init(T_TOK, 1024, G, bid);
        pg8::EpiResid E{H, H, hb, ss + 2 * T_TOK}; pg8::gemm_phase<pg8::EpiResid, pg8::StaticOrder, true, true>(lds, g, S, E); }
    SYNC(8);
    PB(9); if (IN(9)) { pg8::Gemm g{hb, (const bf16*)(ws + WS_WMIN), T_TOK, 3328, 1024}; pg8::StaticOrder S; S.init(T_TOK, 3328, G, bid);
        pg8::EpiMlstmIn E{P2, OP, gates, ss + 2 * T_TOK}; pg8::gemm_phase<pg8::EpiMlstmIn, pg8::StaticOrder, true, true>(lds, g, S, E); }
    SYNC(9);
    PB(10); if (IN(10)) { mlstm_pre_phase(P2, gates, A.conv_w, A.conv_b, A.ig_bias, A.fg_bias, QKc, GA, GB, GP, CH, G, bid); xcd_barrier(bar);
        mlstm_scan_phase(lds, P2, QKc, GA, CH, Cst, nst, mst, G, bid); }
    SYNC(10);
    PB(11); if (IN(11)) mlstm_out_phase(lds, P2, QKc, OP, GA, GB, GP, A.head_gain, Cst, nst, mst, MX, G, bid);
    SYNC(11);
    PB(12); if (IN(12)) { pg8::Gemm g{MX, (const bf16*)(ws + WS_WMOUT), T_TOK, 1024, 1024}; pg8::StaticOrder S; S.init(T_TOK, 1024, G, bid);
        pg8::EpiResid E{H, H, hb, ss + 3 * T_TOK}; pg8::gemm_phase<pg8::EpiResid, pg8::StaticOrder, true, true>(lds, g, S, E); }
    SYNC(12);
    PB(13); if (IN(13)) { pg8::Gemm g{hb, (const bf16*)(ws + WS_WFFIN) + (size_t)5632 * 1024, T_TOK, 5632, 1024}; pg8::StaticOrder S; S.init(T_TOK, 5632, G, bid);
        pg8::EpiSwiGLU E{ACT, ss + 3 * T_TOK}; pg8::gemm_phase<pg8::EpiSwiGLU, pg8::StaticOrder, true, true>(lds, g, S, E); }
    SYNC(13);
    PB(14); if (IN(14)) { pg8::Gemm g{ACT, (const bf16*)(ws + WS_WFFOUT) + (size_t)1024 * DFF, T_TOK, 1024, DFF}; pg8::StaticOrder S; S.init(T_TOK, 1024, G, bid);
        pg8::EpiResid E{H, A.out, nullptr, ss + 4 * T_TOK}; pg8::gemm_phase<pg8::EpiResid, pg8::StaticOrder, true, true>(lds, g, S, E); }
    SYNC(14);
    PB(15); if (IN(15)) final_phase(A.out, ss + 4 * T_TOK, A.final_norm, G, bid);
    PE(15);
    if (PROBE_MASK != 0u && bid == 0 && threadIdx.x == 0) { const unsigned long long te = __builtin_amdgcn_s_memrealtime(); while (__builtin_amdgcn_s_memrealtime() - te < PROBE_K * pr_sum) __builtin_amdgcn_s_sleep(8); }
#undef IN
#undef SYNC
}

extern "C" void kernel_launch(void* const* d_in, const int* in_sizes, int n_in, void* d_out, int out_size, void* d_ws, size_t ws_size, hipStream_t stream) {
    static int grid = 0;
    if (grid == 0) {
        if (n_in != 17 || in_sizes[0] != T_TOK * DM || out_size != T_TOK * DM || ws_size < WS_END) { fprintf(stderr, "kernel_launch: unexpected shapes (n_in %d, in0 %d, out %d, ws %zu); nothing launched\n", n_in, n_in > 0 ? in_sizes[0] : -1, out_size, ws_size); grid = -1; return; }
        int dev = 0, cus = 0, per_cu = 0;
        if (hipGetDevice(&dev) != hipSuccess || hipDeviceGetAttribute(&cus, hipDeviceAttributeMultiprocessorCount, dev) != hipSuccess) { grid = -1; return; }
        if (hipFuncSetAttribute((const void*)mega_fwd, hipFuncAttributeMaxDynamicSharedMemorySize, LDS_BYTES) != hipSuccess) { fprintf(stderr, "kernel_launch: hipFuncSetAttribute failed\n"); grid = -1; return; }
        if (hipOccupancyMaxActiveBlocksPerMultiprocessor(&per_cu, (const void*)mega_fwd, NWAVES * 64, LDS_BYTES) != hipSuccess || per_cu < 1) { fprintf(stderr, "kernel_launch: occupancy query says %d\n", per_cu); per_cu = 1; }
        (void)hipGetLastError();
        grid = cus;
    }
    if (grid < 0) return;
    Args a{};
    a.x = (const float*)d_in[0]; a.pos = (const int*)d_in[1]; a.attn_norm = (const float*)d_in[2]; a.attn_w_in = (const float*)d_in[3]; a.attn_w_out = (const float*)d_in[4];
    a.mlstm_norm = (const float*)d_in[5]; a.mlstm_w_in = (const float*)d_in[6]; a.conv_w = (const float*)d_in[7]; a.conv_b = (const float*)d_in[8]; a.ig_bias = (const float*)d_in[9];
    a.fg_bias = (const float*)d_in[10]; a.head_gain = (const float*)d_in[11]; a.mlstm_w_out = (const float*)d_in[12]; a.ffn_norm = (const float*)d_in[13]; a.ffn_w_in = (const float*)d_in[14];
    a.ffn_w_out = (const float*)d_in[15]; a.final_norm = (const float*)d_in[16];
    a.out = (float*)d_out; a.ws = (unsigned char*)d_ws; a.ph_lo = 0; a.ph_hi = 16;
    if (hipMemsetAsync((char*)d_ws + WS_BAR, 0, 16384, stream) != hipSuccess) { fprintf(stderr, "kernel_launch: hipMemsetAsync failed\n"); return; }
    void* args[] = {&a};
    const hipError_t e = hipLaunchCooperativeKernel((const void*)mega_fwd, dim3(grid), dim3(NWAVES * 64), args, LDS_BYTES, stream);
    if (e != hipSuccess) fprintf(stderr, "kernel_launch: cooperative launch failed: %s (grid %d)\n", hipGetErrorString(e), grid);
}
```

```cpp
#include <hip/hip_runtime.h>
#include <hip/hip_cooperative_groups.h>
#include <cstdio>
#include <cstdint>
namespace cg = cooperative_groups;

constexpr float RMS_EPS = 1e-6f;
__device__ __forceinline__ float rs_from_ss(float ss) { return __builtin_amdgcn_rsqf(ss * (1.0f / 1024.0f) + RMS_EPS); }
__device__ __forceinline__ float silu_f(float x) { return x * __builtin_amdgcn_rcpf(1.0f + __builtin_amdgcn_exp2f(x * -1.4426950408889634f)); }
__device__ __forceinline__ float sigmoid_f(float x) { return __builtin_amdgcn_rcpf(1.0f + __builtin_amdgcn_exp2f(x * -1.4426950408889634f)); }

namespace pg8 {
#define PG8_LAS __attribute__((address_space(3)))
typedef unsigned short bf16_t;
typedef short bf16x8 __attribute__((ext_vector_type(8)));
typedef float f32x4 __attribute__((ext_vector_type(4)));
typedef unsigned u32x4 __attribute__((ext_vector_type(4)));
constexpr int BM = 256, BK = 64, HALF = 128, HTB = HALF * BK * 2  , STAGE_BYTES = 8 * HTB, NXCD = 8, WGM = 8;

__host__ __device__ __forceinline__ int lds_byte(int r, int c) { const int st = (r >> 4) * 2 + (c >> 5), rr = r & 15, cc = c & 31, ob = rr * 64 + cc * 2; return st * 1024 + (ob ^ (((ob >> 9) & 1) << 5)); }
__host__ __device__ __forceinline__ void stage_rc(int b, int& R, int& C) { const int st = b / 1024, sb = b % 1024, swz = sb ^ (((sb >> 9) & 1) << 5); R = (st >> 1) * 16 + swz / 64; C = (st & 1) * 32 + (swz % 64) / 2; }
__host__ __device__ __forceinline__ int perm32(int rho) { const int n = rho >> 4, i = rho & 15; return 8 * (i >> 2) + 4 * n + (i & 3); }

typedef unsigned u32x2 __attribute__((ext_vector_type(2)));
struct Unit { int pm, pn; };
struct Gemm { const bf16_t* A; const bf16_t* Bt; int M, N, K; };

struct StaticOrder {
    int nM, nN, nwg, G, c;
    __host__ __device__ void init(int M, int N, int G_, int c_) { nM = M / BM; nN = N / BM; nwg = nM * nN; G = G_; c = c_; }
    __host__ __device__ bool next(int i, Unit& u) const {
        const long L = (long)i * G + c; if (L >= nwg) return false;
        int wgid = (int)L; { const int q = nwg / NXCD, r = nwg % NXCD, xcd = wgid % NXCD, off = wgid / NXCD; wgid = (xcd < r ? xcd * (q + 1) : r * (q + 1) + (xcd - r) * q) + off; }
        const int nig = WGM * nN, gid = wgid / nig, fm = gid * WGM, gsz = (nM - fm) < WGM ? (nM - fm) : WGM;
        u.pm = fm + ((wgid % nig) % gsz); u.pn = (wgid % nig) / gsz; return true;
    }
    __device__ __forceinline__ void a_ready(const Unit&) const {}
    __device__ __forceinline__ void done(const Unit&) const {}
};
__device__ __forceinline__ unsigned cvt_pk_bf16(float lo, float hi) { unsigned r; asm volatile("v_cvt_pk_bf16_f32 %0, %1, %2" : "=v"(r) : "v"(lo), "v"(hi)); return r; }

#define EPI_FENCE() asm volatile("" ::: "memory")
struct EpiQKV {
    static constexpr bool PERM = true, AFTER_DRAIN = false;
    bf16_t* O; const float* ss; const float* cs;
    __device__ __forceinline__ void operator()(const f32x4 (&acc)[2][2][4][2], const Unit& u, int wr, int wc, int fr, int fq) const {
        const int row0 = u.pm * BM + wr * 64 + fr; const int colt = u.pn * BM;
        const int tsel = (colt % 3072) / 1024;
        const bool rope = (tsel < 2) && (wc == 0);
        const int gsel = colt / 3072, lg = 2 * gsel, dil = 1 << lg;
        const int hb0 = (gsel * 3 + tsel) * 8 + (colt % 1024) / 128;
        float rsv[8];
#pragma unroll
        for (int k = 0; k < 8; ++k) rsv[k] = ss[row0 + (k >> 2) * HALF + (k & 3) * 16];
        f32x4 cA = {0.f, 0.f, 0.f, 0.f}, sA = cA;
        if (rope) { const float* p = cs + (size_t)row0 * 32 + 4 * fq; cA = *(const f32x4*)p; sA = *(const f32x4*)(p + 16); }
#pragma unroll
        for (int k = 0; k < 8; ++k) {
            const int ai = k >> 2, m = k & 3;
            const int row = row0 + ai * HALF + m * 16;
            f32x4 cN = cA, sN = sA;
            if (rope && k + 1 < 8) { const int rown = row0 + ((k + 1) >> 2) * HALF + ((k + 1) & 3) * 16; const float* p = cs + (size_t)rown * 32 + 4 * fq; cN = *(const f32x4*)p; sN = *(const f32x4*)(p + 16); }
            EPI_FENCE();
            const float rs = rs_from_ss(rsv[k]);
            const int sq = row & 2047, perm = ((sq & (dil - 1)) << (11 - lg)) + (sq >> lg);
            bf16_t* rowp = O + ((size_t)hb0 * 17408 + (row >> 11) * 2176 + perm) * 128;
            if (rope) {
                const f32x4 cr = cA * rs, sr = sA * rs;
#pragma unroll
                for (int bj = 0; bj < 2; ++bj) {
                    const f32x4 v0 = acc[ai][bj][m][0], v1 = acc[ai][bj][m][1];
                    const f32x4 o0 = v0 * cr - v1 * sr, o1 = v1 * cr + v0 * sr;
                    u32x2 w0, w1; w0.x = cvt_pk_bf16(o0[0], o0[1]); w0.y = cvt_pk_bf16(o0[2], o0[3]); w1.x = cvt_pk_bf16(o1[0], o1[1]); w1.y = cvt_pk_bf16(o1[2], o1[3]);
                    bf16_t* hp = rowp + (size_t)bj * 17408 * 128 + 4 * fq;
                    *(u32x2*)hp = w0; *(u32x2*)(hp + 16) = w1;
                }
            } else {
#pragma unroll
                for (int bj = 0; bj < 2; ++bj) {
                    const f32x4 v0 = acc[ai][bj][m][0] * rs, v1 = acc[ai][bj][m][1] * rs;
                    u32x4 wv; wv.x = cvt_pk_bf16(v0[0], v0[1]); wv.y = cvt_pk_bf16(v0[2], v0[3]); wv.z = cvt_pk_bf16(v1[0], v1[1]); wv.w = cvt_pk_bf16(v1[2], v1[3]);
                    *(u32x4*)(rowp + (size_t)bj * 17408 * 128 + wc * 32 + 8 * fq) = wv;
                }
            }
            cA = cN; sA = sN;
        }
    }
};
struct EpiResid {
    static constexpr bool PERM = true, AFTER_DRAIN = false;
    const float* base; float* out; bf16_t* outb; float* ssn;
    __device__ __forceinline__ void operator()(const f32x4 (&acc)[2][2][4][2], const Unit& u, int wr, int wc, int fr, int fq) const {
        const int row0 = u.pm * BM + wr * 64 + fr; const int col0 = u.pn * BM + wc * 32 + 8 * fq;
        f32x4 bA[4];
        { const float* p = base + (size_t)row0 * 1024 + col0; bA[0] = *(const f32x4*)p; bA[1] = *(const f32x4*)(p + 4); bA[2] = *(const f32x4*)(p + HALF); bA[3] = *(const f32x4*)(p + HALF + 4); }
#pragma unroll
        for (int k = 0; k < 8; ++k) {
            const int ai = k >> 2, m = k & 3;
            const int row = row0 + ai * HALF + m * 16;
            f32x4 bN[4];
#pragma unroll
            for (int q = 0; q < 4; ++q) bN[q] = bA[q];
            if (k + 1 < 8) { const int rown = row0 + ((k + 1) >> 2) * HALF + ((k + 1) & 3) * 16; const float* p = base + (size_t)rown * 1024 + col0;
                bN[0] = *(const f32x4*)p; bN[1] = *(const f32x4*)(p + 4); bN[2] = *(const f32x4*)(p + HALF); bN[3] = *(const f32x4*)(p + HALF + 4); }
            EPI_FENCE();
            float sq = 0.f;
#pragma unroll
            for (int bj = 0; bj < 2; ++bj) {
                const size_t off = (size_t)row * 1024 + col0 + bj * HALF;
                const f32x4 v0 = acc[ai][bj][m][0] + bA[2 * bj], v1 = acc[ai][bj][m][1] + bA[2 * bj + 1];
                *(f32x4*)(out + off) = v0; *(f32x4*)(out + off + 4) = v1;
                if (outb) { u32x4 wv; wv.x = cvt_pk_bf16(v0[0], v0[1]); wv.y = cvt_pk_bf16(v0[2], v0[3]); wv.z = cvt_pk_bf16(v1[0], v1[1]); wv.w = cvt_pk_bf16(v1[2], v1[3]); *(u32x4*)(outb + off) = wv; }
                sq += (v0[0] * v0[0] + v0[1] * v0[1]) + (v0[2] * v0[2] + v0[3] * v0[3]) + (v1[0] * v1[0] + v1[1] * v1[1]) + (v1[2] * v1[2] + v1[3] * v1[3]);
            }
            sq += __shfl_xor(sq, 16); sq += __shfl_xor(sq, 32);
            if (fq == 0) atomicAdd(ssn + row, sq);
#pragma unroll
            for (int q = 0; q < 4; ++q) bA[q] = bN[q];
        }
    }
};
struct EpiSwiGLU {
    static constexpr bool PERM = true, AFTER_DRAIN = false;
    bf16_t* O; const float* ss;
    __device__ __forceinline__ void operator()(const f32x4 (&acc)[2][2][4][2], const Unit& u, int wr, int wc, int fr, int fq) const {
        const int row0 = u.pm * BM + wr * 64 + fr; const int col0 = u.pn * HALF + wc * 32 + 8 * fq;
        float rsv[8];
#pragma unroll
        for (int k = 0; k < 8; ++k) rsv[k] = ss[row0 + (k >> 2) * HALF + (k & 3) * 16];
        EPI_FENCE();
#pragma unroll
        for (int ai = 0; ai < 2; ++ai)
#pragma unroll
            for (int m = 0; m < 4; ++m) {
                const int row = row0 + ai * HALF + m * 16;
                const float rs = rs_from_ss(rsv[ai * 4 + m]); const float rs2 = rs * rs, nrs = rs * -1.4426950408889634f;
                float o[8];
#pragma unroll
                for (int n = 0; n < 2; ++n)
#pragma unroll
                    for (int e = 0; e < 4; ++e) { const float g = acc[ai][0][m][n][e], uu = acc[ai][1][m][n][e] * rs2;
                        o[4 * n + e] = (g * uu) * __builtin_amdgcn_rcpf(1.0f + __builtin_amdgcn_exp2f(g * nrs)); }
                u32x4 wv; wv.x = cvt_pk_bf16(o[0], o[1]); wv.y = cvt_pk_bf16(o[2], o[3]); wv.z = cvt_pk_bf16(o[4], o[5]); wv.w = cvt_pk_bf16(o[6], o[7]);
                *(u32x4*)(O + (size_t)row * 2816 + col0) = wv;
            }
    }
};
struct EpiMlstmIn {
    static constexpr bool PERM = true, AFTER_DRAIN = false;
    bf16_t* P2; bf16_t* OP; float* gates; const float* ss;
    __device__ __forceinline__ void operator()(const f32x4 (&acc)[2][2][4][2], const Unit& u, int wr, int wc, int fr, int fq) const {
        const int row0 = u.pm * BM + wr * 64 + fr;
        float rsv[8];
#pragma unroll
        for (int k = 0; k < 8; ++k) rsv[k] = ss[row0 + (k >> 2) * HALF + (k & 3) * 16];
        EPI_FENCE();
#pragma unroll
        for (int ai = 0; ai < 2; ++ai)
#pragma unroll
            for (int m = 0; m < 4; ++m) {
                const int row = row0 + ai * HALF + m * 16;
                const float rs = rs_from_ss(rsv[ai * 4 + m]);
#pragma unroll
                for (int bj = 0; bj < 2; ++bj) {
                    const int cb = u.pn * BM + bj * HALF;
                    const f32x4 v0 = acc[ai][bj][m][0] * rs, v1 = acc[ai][bj][m][1] * rs;
                    const int cc = wc * 32 + 8 * fq;
                    if (cb < 3072) {
                        u32x4 wv; wv.x = cvt_pk_bf16(v0[0], v0[1]); wv.y = cvt_pk_bf16(v0[2], v0[3]); wv.z = cvt_pk_bf16(v1[0], v1[1]); wv.w = cvt_pk_bf16(v1[2], v1[3]);
                        bf16_t* dst = (cb < 2048) ? (P2 + (size_t)row * 2048 + cb + cc) : (OP + (size_t)row * 1024 + (cb - 2048) + cc);
                        *(u32x4*)dst = wv;
                    } else if (cb == 3072 && cc < 16) {
                        float* dst = gates + (size_t)row * 16 + cc;
                        *(f32x4*)dst = v0; *(f32x4*)(dst + 4) = v1;
                    }
                }
            }
    }
};

template <class Epi, class Sched, bool ALIGN_EPI = false, bool SP2 = false>
__device__ __forceinline__ void gemm_phase(PG8_LAS unsigned char* lds, const Gemm g, const Sched& S, const Epi& E) {
    const int tid = threadIdx.x, wid = __builtin_amdgcn_readfirstlane(tid >> 6), lane = tid & 63, wr = wid >> 2, wc = wid & 3, fr = lane & 15, fq = lane >> 4;
    const int K = g.K, nt = K / BK;
    unsigned voffA[2], voffB[2];
#pragma unroll
    for (int i = 0; i < 2; ++i) { int R, C; stage_rc(tid * 16 + i * 8192, R, C); const int Rb = Epi::PERM ? ((R & ~31) + perm32(R & 31)) : R;
        voffA[i] = (unsigned)(R * K + C) * 2u; voffB[i] = (unsigned)(Rb * K + C) * 2u; }
    const size_t kstep = (size_t)(BK * 2);
    const size_t hstep = (size_t)HALF * K * 2;
    const size_t tstep = 2 * hstep;
    const unsigned ldsw = (unsigned)wid * 1024u;
    const int aoff = lds_byte(wr * 64 + fr, fq * 8), boff = lds_byte(wc * 32 + fr, fq * 8);
#define PG8_SA(b, h) (((b) * 2 + (h)) * HTB)
#define PG8_SB(b, h) ((4 + (b) * 2 + (h)) * HTB)
#define PG8_STAGE(bufoff, gbase, voff) do { _Pragma("unroll") for (int _i = 0; _i < 2; ++_i) \
        __builtin_amdgcn_global_load_lds((const unsigned*)((const char*)(gbase) + (voff)[_i]), (PG8_LAS unsigned*)(lds + (bufoff) + ldsw + _i * 8192), 16, 0, 0); } while (0)
#define PG8_LDA(dst, b, h) do { _Pragma("unroll") for (int m = 0; m < 4; ++m) _Pragma("unroll") for (int k = 0; k < 2; ++k) dst[m][k] = *(const PG8_LAS bf16x8*)(lds + PG8_SA(b, h) + aoff + m * 2048 + k * 1024); } while (0)
#define PG8_LDB(dst, b, h) do { _Pragma("unroll") for (int n = 0; n < 2; ++n) _Pragma("unroll") for (int k = 0; k < 2; ++k) dst[n][k] = *(const PG8_LAS bf16x8*)(lds + PG8_SB(b, h) + boff + n * 2048 + k * 1024); } while (0)
#define PG8_MMA(ai, bj, At, Bt) do { __builtin_amdgcn_s_setprio(1); _Pragma("unroll") for (int m = 0; m < 4; ++m) _Pragma("unroll") for (int n = 0; n < 2; ++n) _Pragma("unroll") for (int k = 0; k < 2; ++k) \
        acc[ai][bj][m][n] = __builtin_amdgcn_mfma_f32_16x16x32_bf16(Bt[n][k], At[m][k], acc[ai][bj][m][n], 0, 0, 0); __builtin_amdgcn_s_setprio(0); } while (0)
#define PG8_WAIT_V(n) asm volatile("s_waitcnt vmcnt(" #n ")" ::: "memory")
#define PG8_WAIT_L(n) asm volatile("s_waitcnt lgkmcnt(" #n ")" ::: "memory")
#define PG8_BAR __builtin_amdgcn_s_barrier()
#define PG8_SCHED __builtin_amdgcn_sched_barrier(0)
    Unit cur, nxt; int ui = 0;
    if (!S.next(0, cur)) return;
    f32x4 acc[2][2][4][2];
#pragma unroll
    for (int a = 0; a < 2; ++a)
#pragma unroll
        for (int b = 0; b < 2; ++b)
#pragma unroll
            for (int m = 0; m < 4; ++m)
#pragma unroll
                for (int n = 0; n < 2; ++n) acc[a][b][m][n] = (f32x4){0.f, 0.f, 0.f, 0.f};
    bf16x8 At[4][2], B0[2][2], B1[2][2];
    const char* cA = (const char*)g.A + (size_t)cur.pm * tstep; const char* cB = (const char*)g.Bt + (size_t)cur.pn * tstep;
    S.a_ready(cur);
    if constexpr (SP2) {
        PG8_STAGE(PG8_SB(0, 0), cB, voffB); PG8_STAGE(PG8_SB(0, 1), cB + hstep, voffB); PG8_STAGE(PG8_SA(0, 0), cA, voffA); PG8_STAGE(PG8_SA(0, 1), cA + hstep, voffA);
        if (wr == 1) PG8_BAR;
        PG8_WAIT_V(2); PG8_BAR;
        PG8_STAGE(PG8_SB(1, 0), cB + kstep, voffB); PG8_STAGE(PG8_SA(1, 0), cA + kstep, voffA); PG8_STAGE(PG8_SB(1, 1), cB + hstep + kstep, voffB);
        PG8_WAIT_V(6); PG8_BAR;
    } else {
        PG8_STAGE(PG8_SB(0, 0), cB, voffB); PG8_STAGE(PG8_SA(0, 0), cA, voffA); PG8_STAGE(PG8_SB(0, 1), cB + hstep, voffB); PG8_STAGE(PG8_SA(0, 1), cA + hstep, voffA);
        if (wr == 1) PG8_BAR;
        PG8_WAIT_V(4); PG8_BAR;
        PG8_STAGE(PG8_SB(1, 0), cB + kstep, voffB); PG8_STAGE(PG8_SA(1, 0), cA + kstep, voffA); PG8_STAGE(PG8_SB(1, 1), cB + hstep + kstep, voffB);
        PG8_WAIT_V(6); PG8_BAR;
    }
    for (;;) {
        const bool has_next = S.next(ui + 1, nxt);
        const char* nA = has_next ? (const char*)g.A + (size_t)nxt.pm * tstep : cA; const char* nB = has_next ? (const char*)g.Bt + (size_t)nxt.pn * tstep : cB;
        for (int t = 0; t < nt; t += 2) {
            const bool last = (t == nt - 2);
            const char* a1 = cA + (size_t)(t + 1) * kstep;
            const char* a2 = last ? nA : cA + (size_t)(t + 2) * kstep; const char* b2 = last ? nB : cB + (size_t)(t + 2) * kstep;
            const char* a3 = a2 + kstep; const char* b3 = b2 + kstep;
            if (last && has_next) S.a_ready(nxt);
            if constexpr (SP2) {
            PG8_LDB(B0, 0, 0); PG8_LDB(B1, 0, 1); PG8_SCHED; PG8_LDA(At, 0, 0); PG8_STAGE(PG8_SA(1, 1), a1 + hstep, voffA);
            PG8_WAIT_V(8); PG8_WAIT_L(0); PG8_BAR; PG8_MMA(0, 0, At, B0); PG8_MMA(0, 1, At, B1); PG8_BAR; PG8_SCHED;
            PG8_LDA(At, 0, 1); PG8_STAGE(PG8_SB(0, 0), b2, voffB); PG8_STAGE(PG8_SB(0, 1), b2 + hstep, voffB); PG8_STAGE(PG8_SA(0, 0), a2, voffA);
            PG8_WAIT_V(8); PG8_WAIT_L(0); PG8_BAR; PG8_MMA(1, 0, At, B0); PG8_MMA(1, 1, At, B1); PG8_BAR; PG8_SCHED;
            PG8_LDB(B0, 1, 0); PG8_LDB(B1, 1, 1); PG8_SCHED; PG8_LDA(At, 1, 0); PG8_STAGE(PG8_SA(0, 1), a2 + hstep, voffA);
            PG8_WAIT_V(8); PG8_WAIT_L(0); PG8_BAR; PG8_MMA(0, 0, At, B0); PG8_MMA(0, 1, At, B1); PG8_BAR; PG8_SCHED;
            PG8_LDA(At, 1, 1); PG8_STAGE(PG8_SB(1, 0), b3, voffB); PG8_STAGE(PG8_SB(1, 1), b3 + hstep, voffB); PG8_STAGE(PG8_SA(1, 0), a3, voffA);
            PG8_WAIT_V(8); PG8_WAIT_L(0); PG8_BAR; PG8_MMA(1, 0, At, B0); PG8_MMA(1, 1, At, B1); PG8_BAR; PG8_SCHED;
            } else {
            PG8_LDB(B0, 0, 0); PG8_SCHED; PG8_LDA(At, 0, 0); PG8_STAGE(PG8_SA(1, 1), a1 + hstep, voffA);
            PG8_WAIT_L(8); PG8_BAR; PG8_WAIT_L(0); PG8_MMA(0, 0, At, B0); PG8_BAR; PG8_SCHED;
            PG8_LDB(B1, 0, 1); PG8_STAGE(PG8_SB(0, 0), b2, voffB);
            PG8_BAR; PG8_WAIT_L(0); PG8_MMA(0, 1, At, B1); PG8_BAR;
            PG8_LDA(At, 0, 1); PG8_STAGE(PG8_SA(0, 0), a2, voffA);
            PG8_BAR; PG8_WAIT_L(0); PG8_MMA(1, 0, At, B0); PG8_BAR; PG8_SCHED;
            PG8_STAGE(PG8_SB(0, 1), b2 + hstep, voffB);
            PG8_WAIT_V(6); PG8_BAR; PG8_MMA(1, 1, At, B1); PG8_BAR;
            PG8_LDB(B0, 1, 0); PG8_SCHED; PG8_LDA(At, 1, 0); PG8_STAGE(PG8_SA(0, 1), a2 + hstep, voffA);
            PG8_WAIT_L(8); PG8_BAR; PG8_WAIT_L(0); PG8_MMA(0, 0, At, B0); PG8_BAR; PG8_SCHED;
            PG8_LDB(B1, 1, 1); PG8_STAGE(PG8_SB(1, 0), b3, voffB);
            PG8_BAR; PG8_WAIT_L(0); PG8_MMA(0, 1, At, B1); PG8_BAR;
            PG8_LDA(At, 1, 1); PG8_STAGE(PG8_SA(1, 0), a3, voffA);
            PG8_BAR; PG8_WAIT_L(0); PG8_MMA(1, 0, At, B0); PG8_BAR; PG8_SCHED;
            PG8_STAGE(PG8_SB(1, 1), b3 + hstep, voffB);
            PG8_WAIT_V(6); PG8_BAR; PG8_MMA(1, 1, At, B1); PG8_BAR;
            }
        }
        if constexpr (ALIGN_EPI) { if (wr == 0) PG8_BAR; }
        if constexpr (!Epi::AFTER_DRAIN) { E(acc, cur, wr, wc, fr, fq); S.done(cur); }
        if (!has_next) break;
#pragma unroll
        for (int a = 0; a < 2; ++a)
#pragma unroll
            for (int b = 0; b < 2; ++b)
#pragma unroll
                for (int m = 0; m < 4; ++m)
#pragma unroll
                    for (int n = 0; n < 2; ++n) acc[a][b][m][n] = (f32x4){0.f, 0.f, 0.f, 0.f};
        cur = nxt; cA = nA; cB = nB; ++ui;
        if constexpr (ALIGN_EPI) { if (wr == 1) PG8_BAR; }
    }
    PG8_WAIT_V(0);
    if constexpr (!ALIGN_EPI) { if (wr == 0) PG8_BAR; }
    PG8_BAR;
    if constexpr (Epi::AFTER_DRAIN) { E.fused(acc, cur, wr, wc, fr, fq, lds, wid, lane); S.done(cur); }
#undef PG8_SA
#undef PG8_SB
#undef PG8_STAGE
#undef PG8_LDA
#undef PG8_LDB
#undef PG8_MMA
#undef PG8_WAIT_V
#undef PG8_WAIT_L
#undef PG8_BAR
#undef PG8_SCHED
}
}

constexpr int T_TOK = 32768, DM = 1024, SEQ = 2048, NB = 16, DFF = 2816, THALF = 16384;
constexpr int NWAVES = 8;
constexpr int RB = 2176, HBR = 8 * RB;
constexpr int LDS_BYTES = 147456;
constexpr size_t MiB = 1u << 20;
constexpr size_t WS_SS = 0;
constexpr size_t WS_MST = 1 * MiB;
constexpr size_t WS_NST = 1 * MiB + 65536;
constexpr size_t WS_BAR = 3 * MiB;
constexpr size_t WS_WQKV = 4 * MiB;
constexpr size_t WS_WAO = 22 * MiB;
constexpr size_t WS_WFFIN = 24 * MiB;
constexpr size_t WS_WFFOUT = 46 * MiB;
constexpr size_t WS_WMIN = 57 * MiB;
constexpr size_t WS_WMOUT = 64 * MiB;
constexpr size_t WS_ROPE = 66 * MiB;
constexpr size_t WS_LSE = 70 * MiB;
constexpr size_t WS_GATES = 73 * MiB;
constexpr size_t WS_HB = 76 * MiB;
constexpr size_t WS_MX = 140 * MiB;
constexpr size_t WS_BIG = 204 * MiB;
constexpr size_t WS_H = WS_BIG;
constexpr size_t WS_ACT = WS_BIG + 128 * MiB;
constexpr size_t WS_END = 512 * MiB;
static_assert(WS_ACT + (size_t)T_TOK * DFF * 2 <= WS_END && WS_BIG + (size_t)72 * 8 * 2176 * 256 <= WS_END, "d_ws map");

#define LAS __attribute__((address_space(3)))
typedef unsigned short bf16;
typedef unsigned u32x4 __attribute__((ext_vector_type(4)));
typedef unsigned u32x2 __attribute__((ext_vector_type(2)));
typedef float f32x4 __attribute__((ext_vector_type(4)));
typedef float f32x16 __attribute__((ext_vector_type(16)));
typedef short bf16x8 __attribute__((ext_vector_type(8)));
typedef short s16x4 __attribute__((ext_vector_type(4)));
typedef float f32x2_t __attribute__((ext_vector_type(2)));
typedef __bf16 bf16x2_t __attribute__((ext_vector_type(2)));
__device__ __forceinline__ unsigned pk2(float lo, float hi) { f32x2_t v = {lo, hi}; bf16x2_t b = __builtin_convertvector(v, bf16x2_t); return __builtin_bit_cast(unsigned, b); }
__device__ __forceinline__ float bf_lo(unsigned w) { return __uint_as_float(w << 16); }
__device__ __forceinline__ float bf_hi(unsigned w) { return __uint_as_float(w & 0xffff0000u); }
__device__ __forceinline__ float wave_sum(float v) {
#pragma unroll
    for (int o = 1; o < 64; o <<= 1) v += __shfl_xor(v, o);
    return v;
}
__device__ __forceinline__ float wave_max(float v) {
#pragma unroll
    for (int o = 1; o < 64; o <<= 1) v = fmaxf(v, __shfl_xor(v, o));
    return v;
}
#define MFMA16(a, b, c) __builtin_amdgcn_mfma_f32_16x16x32_bf16((a), (b), (c), 0, 0, 0)
#define MFMA32(a, b, c) __builtin_amdgcn_mfma_f32_32x32x16_bf16((a), (b), (c), 0, 0, 0)

#define XB_TMO      128
#define XB_XCNT(j)  (256  + 64 * (j))
#define XB_XSUB(j)  (1280 + 64 * (j))
#define XB_XGEN(j)  (2304 + 64 * (j))
#define XB_TOP      3328
#define XB_TOPGEN   3392
#define XCD_BAR_WORDS 3456
#define XB_SPIN_CAP (1u << 18)

__device__ __forceinline__ unsigned xb_ld(unsigned* p)              { return __hip_atomic_load(p, __ATOMIC_RELAXED, __HIP_MEMORY_SCOPE_AGENT); }
__device__ __forceinline__ unsigned xb_add(unsigned* p, unsigned v) { return __hip_atomic_fetch_add(p, v, __ATOMIC_RELAXED, __HIP_MEMORY_SCOPE_AGENT); }
__device__ __forceinline__ unsigned xb_xcc_id() { return (unsigned)__builtin_amdgcn_s_getreg((3 << 11) | 20) & 0xFu; }
#define XB_SPIN(cond, bar) do { unsigned _sp = 0; while (cond) { __builtin_amdgcn_s_sleep(1); \
    if ((++_sp & 255u) == 0u) { if (xb_ld(&(bar)[XB_TMO])) break; if (_sp > XB_SPIN_CAP) { atomicAdd(&(bar)[XB_TMO], 1u); break; } } } } while (0)

struct XcdBarrier {
    unsigned* bar; unsigned x;
    volatile LAS unsigned* st;
};

__device__ __forceinline__ XcdBarrier xcd_barrier_post(unsigned* bar, volatile LAS unsigned* st) {
    XcdBarrier b; b.bar = bar; b.x = xb_xcc_id(); b.st = st;
    if (threadIdx.x == 0) (void)xb_add(&bar[XB_XCNT(b.x)], 1u);
    return b;
}
__device__ __forceinline__ void xcd_barrier_complete(unsigned* bar, unsigned x, unsigned& nloc, unsigned& nx) {
    const unsigned G = gridDim.x * gridDim.y * gridDim.z;
    unsigned sum, cnt, mine, sp = 0u;
    for (;;) {
        sum = 0u; cnt = 0u; mine = 0u;
#pragma unroll
        for (unsigned j = 0; j < 16; ++j) { const unsigned c = xb_ld(&bar[XB_XCNT(j)]); sum += c; cnt += (c > 0u) ? 1u : 0u; mine = (j == x) ? c : mine; }
        if (sum == G) break;
        __builtin_amdgcn_s_sleep(1);
        if ((++sp & 255u) == 0u) { if (xb_ld(&bar[XB_TMO])) break; if (sp > XB_SPIN_CAP) { atomicAdd(&bar[XB_TMO], 1u); break; } }
    }
    nloc = mine > 0u ? mine : 1u; nx = cnt > 0u ? cnt : 1u;
}

__device__ __forceinline__ void xcd_barrier(const XcdBarrier& b) {
    asm volatile("s_waitcnt vmcnt(0)" ::: "memory");
    __syncthreads();
    if (threadIdx.x == 0) {
        unsigned* bar = b.bar;
        __builtin_amdgcn_s_waitcnt(0);
        unsigned nloc = b.st[0], nx = b.st[1];
        if (nloc == 0u) { xcd_barrier_complete(bar, b.x, nloc, nx); b.st[0] = nloc; b.st[1] = nx; }
        const unsigned old = xb_add(&bar[XB_XSUB(b.x)], 1u);
        const unsigned gen = old / nloc;
        if (old + 1u == (gen + 1u) * nloc) {
            __builtin_amdgcn_fence(__ATOMIC_RELEASE, "agent");
            asm volatile("s_waitcnt vmcnt(0)" ::: "memory");
            const unsigned og = xb_add(&bar[XB_TOP], 1u);
            const unsigned tg = og / nx;
            if (og + 1u == (tg + 1u) * nx) xb_add(&bar[XB_TOPGEN], 1u);
            else XB_SPIN(xb_ld(&bar[XB_TOPGEN]) == tg, bar);
            __builtin_amdgcn_fence(__ATOMIC_ACQUIRE, "agent");
            xb_add(&bar[XB_XGEN(b.x)], 1u);
            asm volatile("s_waitcnt vmcnt(0)" ::: "memory");
        } else {
            XB_SPIN(xb_ld(&bar[XB_XGEN(b.x)]) == gen, bar);
            __builtin_amdgcn_fence(__ATOMIC_ACQUIRE, "agent");
            asm volatile("s_waitcnt vmcnt(0)" ::: "memory");
        }
    }
    __syncthreads();
}


struct Args {
    const float* x; const int* pos; const float* attn_norm; const float* attn_w_in; const float* attn_w_out; const float* mlstm_norm; const float* mlstm_w_in;
    const float* conv_w; const float* conv_b; const float* ig_bias; const float* fg_bias; const float* head_gain; const float* mlstm_w_out;
    const float* ffn_norm; const float* ffn_w_in; const float* ffn_w_out; const float* final_norm;
    float* out; unsigned char* ws; int ph_lo, ph_hi;
};

__device__ __forceinline__ void tr_item(const float* __restrict__ W, int K, int Nsrc, bf16* WT, int n0_dst, int n0_src, int k0, const float* __restrict__ gain, float scale, LAS float* scr, int lane, bool ropeperm = false) {
    const int n4 = lane & 15, kq = lane >> 4; const int s4 = (ropeperm && n4 < 8) ? (((n4 & 1) << 2) + (n4 >> 1)) : n4; const int col = n0_src + 4 * s4; const bool ok = col < Nsrc;
    f32x4 v[16];
#pragma unroll
    for (int i = 0; i < 16; ++i) { v[i] = (f32x4){0.f, 0.f, 0.f, 0.f}; if (ok) v[i] = __builtin_nontemporal_load((const f32x4*)(W + (size_t)(k0 + 4 * i + kq) * Nsrc + col)); }
#pragma unroll
    for (int i = 0; i < 16; ++i) { const int kk = 4 * i + kq; const float g = gain ? gain[k0 + kk] * scale : scale; LAS float* d = scr + kk * 65 + 4 * n4;
        d[0] = v[i][0] * g; d[1] = v[i][1] * g; d[2] = v[i][2] * g; d[3] = v[i][3] * g; }
    asm volatile("s_waitcnt lgkmcnt(0)" ::: "memory");
    const int c = lane & 7;
#pragma unroll
    for (int j = 0; j < 8; ++j) { const int n = (lane >> 3) + 8 * j; const LAS float* sp = scr + (8 * c) * 65 + n;
        u32x4 o; o.x = pk2(sp[0 * 65], sp[1 * 65]); o.y = pk2(sp[2 * 65], sp[3 * 65]); o.z = pk2(sp[4 * 65], sp[5 * 65]); o.w = pk2(sp[6 * 65], sp[7 * 65]);
        *(u32x4*)(WT + (size_t)(n0_dst + n) * K + k0 + 8 * c) = o; }
    asm volatile("s_waitcnt lgkmcnt(0)" ::: "memory");
}
__device__ __forceinline__ void p0_prologue(const Args& A, LAS unsigned char* lds, int G, int bid) {
    const int tid = threadIdx.x, lane = tid & 63, wave = tid >> 6;
    LAS float* scr = (LAS float*)(lds + wave * 16640);
    const int gw = bid * NWAVES + wave, NGW = G * NWAVES;
    unsigned char* ws = A.ws;
    constexpr int I_QKV = 16 * 144, I_AO = 16 * 16, I_FFIN = 16 * 88, I_FFOUT = 44 * 16, I_MIN = 16 * 52, I_MOUT = 16 * 16;
    constexpr int NITEMS = I_QKV + I_AO + 2 * I_FFIN + 2 * I_FFOUT + I_MIN + I_MOUT;
    constexpr float QSCALE = 0.08838834764831845f * 1.4426950408889634f;
    for (int it = gw; it < NITEMS; it += NGW) {
        int r = it;
        if (r < I_QKV) { const int kb = r / 144, nb = r % 144, n0 = 64 * nb; const int tsel = (n0 % 3072) / 1024;
            tr_item(A.attn_w_in, 1024, 9216, (bf16*)(ws + WS_WQKV), n0, n0, 64 * kb, A.attn_norm, tsel == 0 ? QSCALE : 1.f, scr, lane, tsel < 2 && (n0 & 127) == 0); continue; } r -= I_QKV;
        if (r < I_AO) { const int kb = r / 16, nb = r % 16; tr_item(A.attn_w_out, 1024, 1024, (bf16*)(ws + WS_WAO), 64 * nb, 64 * nb, 64 * kb, nullptr, 1.f, scr, lane); continue; } r -= I_AO;
        if (r < 2 * I_FFIN) { const int l = r / I_FFIN; r -= l * I_FFIN; const int kb = r / 88, nb = r % 88, n0 = 64 * nb;
            const int pn = n0 >> 8, bj = (n0 >> 7) & 1, jj = n0 & 127; const int nsrc = (bj ? DFF : 0) + 128 * pn + jj;
            tr_item(A.ffn_w_in + (size_t)l * 1024 * 5632, 1024, 5632, (bf16*)(ws + WS_WFFIN) + (size_t)l * 5632 * 1024, n0, nsrc, 64 * kb, A.ffn_norm + l * 1024, 1.f, scr, lane); continue; } r -= 2 * I_FFIN;
        if (r < 2 * I_FFOUT) { const int l = r / I_FFOUT; r -= l * I_FFOUT; const int kb = r / 16, nb = r % 16;
            tr_item(A.ffn_w_out + (size_t)l * DFF * 1024, DFF, 1024, (bf16*)(ws + WS_WFFOUT) + (size_t)l * 1024 * DFF, 64 * nb, 64 * nb, 64 * kb, nullptr, 1.f, scr, lane); continue; } r -= 2 * I_FFOUT;
        if (r < I_MIN) { const int kb = r / 52, nb = r % 52; tr_item(A.mlstm_w_in, 1024, 3088, (bf16*)(ws + WS_WMIN), 64 * nb, 64 * nb, 64 * kb, A.mlstm_norm, 1.f, scr, lane); continue; } r -= I_MIN;
        { const int kb = r / 16, nb = r % 16; tr_item(A.mlstm_w_out, 1024, 1024, (bf16*)(ws + WS_WMOUT), 64 * nb, 64 * nb, 64 * kb, nullptr, 1.f, scr, lane); }
    }
    float* ss = (float*)(ws + WS_SS); bf16* hb = (bf16*)(ws + WS_HB);
    for (int m4 = gw; m4 < T_TOK / 4; m4 += NGW) {
        f32x4 v[4][4];
#pragma unroll
        for (int q = 0; q < 4; ++q) { const f32x4* xr = (const f32x4*)(A.x + (size_t)(4 * m4 + q) * DM) + lane;
#pragma unroll
            for (int j = 0; j < 4; ++j) v[q][j] = __builtin_nontemporal_load(xr + 64 * j); }
#pragma unroll
        for (int q = 0; q < 4; ++q) { const int m = 4 * m4 + q; float sq = 0.f;
#pragma unroll
            for (int j = 0; j < 4; ++j) sq += (v[q][j].x * v[q][j].x + v[q][j].y * v[q][j].y) + (v[q][j].z * v[q][j].z + v[q][j].w * v[q][j].w);
            sq = wave_sum(sq);
            u32x2* o8 = (u32x2*)(hb + (size_t)m * DM) + lane;
#pragma unroll
            for (int j = 0; j < 4; ++j) { u32x2 o; o.x = pk2(v[q][j].x, v[q][j].y); o.y = pk2(v[q][j].z, v[q][j].w); o8[64 * j] = o; }
            if (lane == 0) ss[m] = sq; }
    }
    const int gt = bid * 512 + tid, NGT = G * 512;
    for (int i = gt; i < 4 * T_TOK; i += NGT) ss[T_TOK + i] = 0.f;
    float* rope = (float*)(ws + WS_ROPE);
    for (int i = gt; i < T_TOK * 16; i += NGT) {
        const int t = i >> 4, f = i & 15;
        const float invf = __builtin_amdgcn_exp2f((float)f * -1.1832230355827609f);
        const float ang = (float)A.pos[t] * invf;
        const double rev = (double)ang * 0.15915494309189535; const float fr = (float)(rev - rint(rev));
        rope[(size_t)t * 32 + f] = __builtin_amdgcn_cosf(fr); rope[(size_t)t * 32 + 16 + f] = __builtin_amdgcn_sinf(fr);
    }
}

struct AStep { const bf16* base; size_t rowstride; int blk, g, h, dil, rr, b; bool valid, compute; };
__device__ __forceinline__ AStep attn_step(int u, int s, const bf16* QKVh) {
    AStep t; t.valid = true; t.compute = true;
    if (s < 5) { t.g = 0; t.dil = 1; t.rr = 0; const int qt = u & 3; t.h = (u >> 2) & 7; t.b = u >> 5; t.blk = 4 * qt + s - 1; if (s == 0) { t.compute = false; t.valid = qt > 0; if (!t.valid) t.blk = 0; } }
    else if (s < 9) { t.g = 1; t.dil = 4; t.h = u & 7; t.rr = (u >> 3) & 3; t.b = u >> 5; t.blk = s - 5; }
    else { t.g = 2; t.dil = 16; const int v = 4 * u + (s - 9); t.h = v & 7; t.rr = (v >> 3) & 15; t.b = v >> 7; t.blk = 0; }
    t.rowstride = 128;
    t.base = QKVh + ((size_t)(t.g * 24 + t.h) * HBR + t.b * RB + t.rr * (SEQ / t.dil)) * 128;
    return t;
}
typedef short v4i16_t __attribute__((ext_vector_type(4)));
__device__ __forceinline__ s16x4 tr_read(const LAS unsigned char* p) { return __builtin_bit_cast(s16x4, __builtin_amdgcn_ds_read_tr16_b64_v4i16((LAS v4i16_t*)p)); }
__device__ __forceinline__ void attn_phase(LAS unsigned char* lds, const bf16* __restrict__ QKVh, bf16* __restrict__ Oh, float* __restrict__ lse, int half, int G, int bid) {
    const int tid = threadIdx.x, lane = tid & 63, w = __builtin_amdgcn_readfirstlane(tid >> 6), r = lane & 15, q4 = lane >> 4;
    constexpr int SLOT = 34816, VSLOT = 36864;
#define ATT_LOAD(st) do { \
        _Pragma("unroll") for (int i = 0; i < 4; ++i) { const int chunk = tid + 512 * i, c = chunk >> 4, ch = chunk & 15; const bf16* gp = (st).base + (size_t)(128 * (st).blk + c) * (st).rowstride + 8 * ch; \
            kr[i] = __builtin_nontemporal_load((const u32x4*)(gp + (size_t)8 * HBR * 128)); vr[i] = __builtin_nontemporal_load((const u32x4*)(gp + (size_t)16 * HBR * 128)); } \
        { const bf16* qrow = (st).base + (size_t)(128 * (st).blk + 16 * w + r) * (st).rowstride; \
            _Pragma("unroll") for (int q = 0; q < 4; ++q) qn[q] = *(const bf16x8*)(qrow + 32 * q + 8 * q4); } } while (0)
    for (int u = bid; u < 256; u += G) {
        AStep nx = attn_step(u, 0, QKVh);
        u32x4 kr[4], vr[4]; bf16x8 qn[4];
#pragma unroll
        for (int i = 0; i < 4; ++i) { kr[i] = (u32x4){0u, 0u, 0u, 0u}; vr[i] = kr[i]; qn[i] = (bf16x8){0, 0, 0, 0, 0, 0, 0, 0}; }
        ATT_LOAD(nx);
        for (int s = 0; s < 13; ++s) {
            const AStep cu = nx; const int cs = s & 1;
            LAS unsigned char* Kc = lds + cs * SLOT; LAS unsigned char* Vc = lds + 2 * SLOT + cs * VSLOT;
#pragma unroll
            for (int i = 0; i < 4; ++i) { const int chunk = tid + 512 * i, c = chunk >> 4, ch = chunk & 15; *(LAS u32x4*)(Kc + c * 272 + ch * 16) = kr[i]; *(LAS u32x4*)(Vc + c * 288 + ch * 16) = vr[i]; }
            bf16x8 qf[4];
#pragma unroll
            for (int q = 0; q < 4; ++q) qf[q] = qn[q];
            __syncthreads();
            { nx = attn_step(u, (s + 1 < 13) ? s + 1 : 12, QKVh); ATT_LOAD(nx); }
            if (cu.compute) {
                const bool first = (cu.blk == 0);
                const LAS unsigned char* Kp = first ? Kc : lds + (cs ^ 1) * SLOT; const LAS unsigned char* Vp = first ? Vc : lds + 2 * SLOT + (cs ^ 1) * VSLOT;
                const int a = 16 * w + r;
                const int jlo = first ? 8 : 0;
                f32x4 S[9]; float mx = -INFINITY;
#pragma unroll
                for (int jj = 0; jj < 9; ++jj) { const int j = w + jj; S[jj] = (f32x4){0.f, 0.f, 0.f, 0.f};
                    if (j >= jlo) { const LAS unsigned char* kp = (j >= 8 ? Kc : Kp) + ((j & 7) * 16 + r) * 272 + 16 * q4;
#pragma unroll
                        for (int st = 0; st < 4; ++st) { const bf16x8 kf = *(const LAS bf16x8*)(kp + 64 * st); S[jj] = MFMA16(kf, qf[st], S[jj]); } }
#pragma unroll
                    for (int i = 0; i < 4; ++i) { bool valid = (j >= jlo);
                        if (jj == 0) valid = valid && (4 * q4 + i >= r);
                        if (jj == 8) valid = valid && (4 * q4 + i <= r);
                        S[jj][i] = valid ? S[jj][i] : -INFINITY; mx = fmaxf(mx, S[jj][i]); } }
                mx = fmaxf(mx, __shfl_xor(mx, 16)); mx = fmaxf(mx, __shfl_xor(mx, 32));
                float den = 0.f;
#pragma unroll
                for (int jj = 0; jj < 9; ++jj)
#pragma unroll
                    for (int i = 0; i < 4; ++i) { const float pe = __builtin_amdgcn_exp2f(S[jj][i] - mx); S[jj][i] = pe; den += pe; }
                den += __shfl_xor(den, 16); den += __shfl_xor(den, 32);
                bf16x8 pf[5];
#pragma unroll
                for (int p = 0; p < 5; ++p) { u32x4 wv; wv.x = pk2(S[2 * p][0], S[2 * p][1]); wv.y = pk2(S[2 * p][2], S[2 * p][3]);
                    if (2 * p + 1 < 9) { wv.z = pk2(S[(2 * p + 1) % 9][0], S[(2 * p + 1) % 9][1]); wv.w = pk2(S[(2 * p + 1) % 9][2], S[(2 * p + 1) % 9][3]); } else { wv.z = 0u; wv.w = 0u; }
                    pf[p] = __builtin_bit_cast(bf16x8, wv); }
                f32x4 o[8];
#pragma unroll
                for (int db = 0; db < 8; ++db) o[db] = (f32x4){0.f, 0.f, 0.f, 0.f};
#pragma unroll
                for (int p = 0; p < 5; ++p) { const int j0 = w + 2 * p, j1 = (j0 + 1 > 15) ? 15 : j0 + 1;
                    if (j0 + 1 >= jlo) {
                        const LAS unsigned char* v0p = (j0 >= 8 ? Vc : Vp) + ((j0 & 7) * 16 + 4 * q4 + (r >> 2)) * 288 + 8 * (r & 3);
                        const LAS unsigned char* v1p = (j1 >= 8 ? Vc : Vp) + ((j1 & 7) * 16 + 4 * q4 + (r >> 2)) * 288 + 8 * (r & 3);
#pragma unroll
                        for (int db = 0; db < 8; ++db) {
                            const s16x4 lo = tr_read(v0p + 32 * db), hi = tr_read(v1p + 32 * db);
                            const bf16x8 af = __builtin_shufflevector(lo, hi, 0, 1, 2, 3, 4, 5, 6, 7);
                            o[db] = MFMA16(af, pf[p], o[db]); } } }
                const float inv = __builtin_amdgcn_rcpf(den);
                const int tl = cu.b * SEQ + (128 * cu.blk + a) * cu.dil + cu.rr;
                bf16* orow = Oh + ((size_t)(cu.g * 8 + cu.h) * HBR + cu.b * RB + cu.rr * (SEQ / cu.dil) + 128 * cu.blk + a) * 128 + 4 * q4;
#pragma unroll
                for (int db = 0; db < 8; ++db) { u32x2 wv; wv.x = pk2(o[db][0] * inv, o[db][1] * inv); wv.y = pk2(o[db][2] * inv, o[db][3] * inv); *(u32x2*)(orow + 16 * db) = wv; }
                if (q4 == 0) lse[((size_t)cu.g * T_TOK + (size_t)half * THALF + tl) * 8 + cu.h] = mx * 0.6931471805599453f + __logf(den);
            }
            __syncthreads();
        }
    }
#undef ATT_LOAD
}
__device__ __forceinline__ void merge_phase(const bf16* __restrict__ Oh, const float* __restrict__ lse, bf16* __restrict__ MX, int half, int G, int bid) {
    const int gt = bid * 512 + threadIdx.x, NGT = G * 512;
    for (int i = gt; i < THALF * 128; i += NGT) {
        const int tl = i >> 7, ch = i & 127, h = ch >> 4; const size_t tg = (size_t)half * THALF + tl;
        const float l0 = lse[((size_t)0 * T_TOK + tg) * 8 + h], l1 = lse[((size_t)1 * T_TOK + tg) * 8 + h], l2 = lse[((size_t)2 * T_TOK + tg) * 8 + h];
        const float mxl = fmaxf(l0, fmaxf(l1, l2)); float w0 = __expf(l0 - mxl), w1 = __expf(l1 - mxl), w2 = __expf(l2 - mxl); const float inv = 1.0f / (w0 + w1 + w2); w0 *= inv; w1 *= inv; w2 *= inv;
        const int sq = tl & 2047, bb = (tl >> 11) * RB, dch = ch & 15;
        const int p1 = ((sq & 3) << 9) + (sq >> 2), p2 = ((sq & 15) << 7) + (sq >> 4);
        const u32x4 a = __builtin_nontemporal_load((const u32x4*)(Oh + ((size_t)(0 + h) * HBR + bb + sq) * 128 + 8 * dch)), b = __builtin_nontemporal_load((const u32x4*)(Oh + ((size_t)(8 + h) * HBR + bb + p1) * 128 + 8 * dch)), c = __builtin_nontemporal_load((const u32x4*)(Oh + ((size_t)(16 + h) * HBR + bb + p2) * 128 + 8 * dch));
        u32x4 o;
#pragma unroll
        for (int e = 0; e < 4; ++e) o[e] = pk2(w0 * bf_lo(a[e]) + w1 * bf_lo(b[e]) + w2 * bf_lo(c[e]), w0 * bf_hi(a[e]) + w1 * bf_hi(b[e]) + w2 * bf_hi(c[e]));
        *(u32x4*)(MX + tg * 1024 + 8 * ch) = o;
    }
}
__device__ __forceinline__ float logsigmoid_f(float x) { return fminf(x, 0.f) - __logf(1.0f + __expf(-fabsf(x))); }
__device__ __forceinline__ void mlstm_pre_phase(const bf16* __restrict__ P2, const float* __restrict__ gates, const float* __restrict__ convw, const float* __restrict__ convb, const float* __restrict__ igb, const float* __restrict__ fgb,
                                                bf16* __restrict__ QKc, float* __restrict__ GA, float* __restrict__ GB, float* __restrict__ GP, float* __restrict__ CH, int G, int bid) {
    const int tid = threadIdx.x, lane = tid & 63, wave = tid >> 6;
    const int gt = bid * 512 + tid, NGT = G * 512;
    for (int it = gt; it < (T_TOK / 8) * 128; it += NGT) {
        const int ch = it & 127, tg = it >> 7; const int t0 = 8 * tg, sq0 = t0 & 2047; const int col = 8 * ch;
        float cw[4][8], cb[8];
#pragma unroll
        for (int q = 0; q < 2; ++q) { const f32x4 b4 = *(const f32x4*)(convb + col + 4 * q);
#pragma unroll
            for (int e = 0; e < 4; ++e) cb[4 * q + e] = b4[e];
#pragma unroll
            for (int j = 0; j < 4; ++j) { const f32x4 w4 = *(const f32x4*)(convw + j * 1024 + col + 4 * q);
#pragma unroll
                for (int e = 0; e < 4; ++e) cw[j][4 * q + e] = w4[e]; } }
        u32x4 rw[11];
#pragma unroll
        for (int i = 0; i < 11; ++i) { rw[i] = (u32x4){0u, 0u, 0u, 0u}; if (sq0 + i - 3 >= 0) rw[i] = *(const u32x4*)(P2 + (size_t)(t0 + i - 3) * 2048 + col); }
        const float ksc = (ch >= 64) ? 0.125f : 1.0f;
#pragma unroll
        for (int i = 0; i < 8; ++i) { u32x4 o;
#pragma unroll
            for (int e = 0; e < 4; ++e) { float x0 = cb[2 * e], x1 = cb[2 * e + 1];
#pragma unroll
                for (int j = 0; j < 4; ++j) { x0 += cw[j][2 * e] * bf_lo(rw[i + j][e]); x1 += cw[j][2 * e + 1] * bf_hi(rw[i + j][e]); }
                o[e] = pk2(silu_f(x0) * ksc, silu_f(x1) * ksc); }
            *(u32x4*)(QKc + (size_t)(t0 + i) * 1024 + col) = o; }
    }
    const int gw = bid * NWAVES + wave, NGW = G * NWAVES;
    for (int it = gw; it < NB * 32; it += NGW) {
        const int c = it & 31, b = it >> 5; const size_t t = (size_t)b * SEQ + 64 * c + lane;
        f32x4 g4[4];
#pragma unroll
        for (int q = 0; q < 4; ++q) g4[q] = *(const f32x4*)(gates + t * 16 + 4 * q);
        float bs[8], av[8], pm[8];
#pragma unroll
        for (int h = 0; h < 8; ++h) bs[h] = logsigmoid_f(g4[2 + (h >> 2)][h & 3] + fgb[h]);
#pragma unroll
        for (int o = 1; o < 64; o <<= 1) {
#pragma unroll
            for (int h = 0; h < 8; ++h) { const float v = __shfl_up(bs[h], o); if (lane >= o) bs[h] += v; } }
#pragma unroll
        for (int h = 0; h < 8; ++h) { av[h] = g4[h >> 2][h & 3] + igb[h] - bs[h]; pm[h] = av[h]; }
#pragma unroll
        for (int o = 1; o < 64; o <<= 1) {
#pragma unroll
            for (int h = 0; h < 8; ++h) { const float v = __shfl_up(pm[h], o); if (lane >= o) pm[h] = fmaxf(pm[h], v); } }
#pragma unroll
        for (int h = 0; h < 8; ++h) { const size_t o = (size_t)(b * 8 + h) * SEQ + 64 * c + lane; GA[o] = av[h]; GB[o] = bs[h]; GP[o] = pm[h];
            if (lane == 63) { const size_t cid = (size_t)(b * 8 + h) * 32 + c; CH[2 * cid] = bs[h]; CH[2 * cid + 1] = bs[h] + pm[h]; } }
    }
}
__device__ __forceinline__ void mlstm_scan_phase(LAS unsigned char* lds, const bf16* __restrict__ P2, const bf16* __restrict__ QKc, const float* __restrict__ GA, const float* __restrict__ CH,
                                                 bf16* __restrict__ Cst, float* __restrict__ nst, float* __restrict__ mst, int G, int bid) {
    const int tid = threadIdx.x, lane = tid & 63, w = __builtin_amdgcn_readfirstlane(tid >> 6), r = lane & 15, q4 = lane >> 4;
    const int dvb = w & 3, dkh = w >> 2;
    const bf16x8 ones = {0x3F80, 0x3F80, 0x3F80, 0x3F80, 0x3F80, 0x3F80, 0x3F80, 0x3F80};
    for (int item = bid; item < 256; item += G) {
        const int dvh = item & 1, h = (item >> 1) & 7, b = item >> 4;
        const size_t cid0 = (size_t)(b * 8 + h) * 32;
        f32x4 acc[2], accn[2]; acc[0] = (f32x4){0.f, 0.f, 0.f, 0.f}; acc[1] = acc[0]; accn[0] = acc[0]; accn[1] = acc[0];
        float mcar = 0.f;
        u32x4 nk, nv; float na, nbl, nml;
#define MSCAN_LOAD(c) do { const size_t t_ = (size_t)b * SEQ + 64 * (c) + lane; nk = *(const u32x4*)(QKc + t_ * 1024 + 512 + h * 64 + 8 * w); nv = *(const u32x4*)(P2 + t_ * 2048 + 1024 + h * 128 + 64 * dvh + 8 * w); \
            na = GA[(size_t)(b * 8 + h) * SEQ + 64 * (c) + lane]; nbl = CH[2 * (cid0 + (c))]; nml = CH[2 * (cid0 + (c)) + 1]; } while (0)
        MSCAN_LOAD(0);
        for (int c = 0; c < 32; ++c) {
            const u32x4 ck = nk, cv = nv; const float as = na, blast = nbl, mloc = nml;
            if (c + 1 < 32) MSCAN_LOAD(c + 1);
            const float mnew = fmaxf(blast + mcar, mloc);
            const float wsv = __expf(blast + as - mnew), carry = __expf(blast + mcar - mnew);
            const size_t cid = cid0 + c;
#pragma unroll
            for (int nb = 0; nb < 2; ++nb)
#pragma unroll
                for (int i = 0; i < 4; ++i) { const int dv = 64 * dvh + 16 * dvb + 4 * q4 + i, dk = 32 * dkh + 16 * nb + r;
                    Cst[(cid * 128 + dv) * 64 + dk] = (bf16)(pk2(acc[nb][i], 0.f) & 0xffffu); }
            if (dvh == 0 && dvb == 0 && q4 == 0) { nst[cid * 64 + 32 * dkh + r] = accn[0][0]; nst[cid * 64 + 32 * dkh + 16 + r] = accn[1][0]; }
            if (dvh == 0 && tid == 0) mst[cid] = mcar;
            LAS unsigned char* Kw = lds + (c & 1) * 18432; LAS unsigned char* Vs = Kw + 9216;
            u32x4 kw;
#pragma unroll
            for (int e = 0; e < 4; ++e) kw[e] = pk2(bf_lo(ck[e]) * wsv, bf_hi(ck[e]) * wsv);
            *(LAS u32x4*)(Kw + lane * 144 + 16 * w) = kw; *(LAS u32x4*)(Vs + lane * 144 + 16 * w) = cv;
            __syncthreads();
            acc[0] = acc[0] * carry; acc[1] = acc[1] * carry; accn[0] = accn[0] * carry; accn[1] = accn[1] * carry;
#pragma unroll
            for (int st = 0; st < 2; ++st) {
                const int rowb = (32 * st + 8 * q4 + (r >> 2)) * 144 + 8 * (r & 3);
                const s16x4 alo = tr_read(Vs + rowb + 32 * dvb), ahi = tr_read(Vs + rowb + 4 * 144 + 32 * dvb);
                const bf16x8 af = __builtin_shufflevector(alo, ahi, 0, 1, 2, 3, 4, 5, 6, 7);
#pragma unroll
                for (int nb = 0; nb < 2; ++nb) {
                    const s16x4 blo = tr_read(Kw + rowb + 64 * dkh + 32 * nb), bhi = tr_read(Kw + rowb + 4 * 144 + 64 * dkh + 32 * nb);
                    const bf16x8 bfr = __builtin_shufflevector(blo, bhi, 0, 1, 2, 3, 4, 5, 6, 7);
                    acc[nb] = MFMA16(af, bfr, acc[nb]);
                    if (dvb == 0) accn[nb] = MFMA16(ones, bfr, accn[nb]); }
            }
            mcar = mnew;
        }
        __syncthreads();
#undef MSCAN_LOAD
    }
}
__device__ __forceinline__ void mlstm_out_phase(LAS unsigned char* lds, const bf16* __restrict__ P2, const bf16* __restrict__ QKc, const bf16* __restrict__ OP, const float* __restrict__ GA, const float* __restrict__ GB, const float* __restrict__ GP,
                                                const float* __restrict__ hgain, const bf16* __restrict__ Cst, const float* __restrict__ nst, const float* __restrict__ mst, bf16* __restrict__ MX, int G, int bid) {
    const int tid = threadIdx.x, lane = tid & 63, w = __builtin_amdgcn_readfirstlane(tid >> 6), r = lane & 31, h2 = lane >> 5;
    const int dvb = w & 3, tb = w >> 2;
    constexpr int O_Q = 0, O_K = 9216, O_V = 18432, O_C = 38912, O_VEC = 57344, O_GN = 58368, O_PART = 58880, SETB = 59904;
    u32x4 pq, pk, pv0, pv1, pc0, pc1; float pvec = 0.f, pgn = 0.f, pmc = 0.f; u32x2 popv[4];
    pq = (u32x4){0u, 0u, 0u, 0u}; pk = pq; pv0 = pq; pv1 = pq; pc0 = pq; pc1 = pq;
#pragma unroll
    for (int gq = 0; gq < 4; ++gq) popv[gq] = (u32x2){0u, 0u};
#define OUT_LOAD(it) do { const int c_ = (it) & 31, h_ = ((it) >> 5) & 7, b_ = (it) >> 8; const size_t t0_ = (size_t)b_ * SEQ + 64 * c_; const size_t gb_ = (size_t)(b_ * 8 + h_) * SEQ + 64 * c_; \
        { const bf16* p_ = QKc + (t0_ + (tid >> 3)) * 1024 + h_ * 64 + 8 * (tid & 7); pq = *(const u32x4*)p_; pk = *(const u32x4*)(p_ + 512); } \
        { const bf16* p_ = P2 + (t0_ + (tid >> 4)) * 2048 + 1024 + h_ * 128 + 8 * (tid & 15); pv0 = *(const u32x4*)p_; pv1 = *(const u32x4*)(p_ + (size_t)32 * 2048); } \
        { const bf16* p_ = Cst + ((size_t)(it) * 128 + (tid >> 3)) * 64 + 8 * (tid & 7); pc0 = *(const u32x4*)p_; pc1 = *(const u32x4*)(p_ + 64 * 64); } \
        { const int wh_ = tid >> 6, ix_ = tid & 63; const float* src_ = (wh_ == 0) ? (GA + gb_) : (wh_ == 1) ? (GB + gb_) : (wh_ == 2) ? (GP + gb_) : (wh_ == 3) ? (nst + (size_t)(it) * 64) : (hgain + h_ * 128 + ((wh_ & 1) << 6)); pvec = src_[ix_]; } \
        pmc = mst[(it)]; \
        { const size_t orow_ = (t0_ + 32 * tb + r) * 1024 + h_ * 128 + 32 * dvb + 4 * h2; _Pragma("unroll") for (int gq = 0; gq < 4; ++gq) popv[gq] = *(const u32x2*)(OP + orow_ + 8 * gq); } } while (0)
    { const int fit = (bid < 4096) ? bid : 0; OUT_LOAD(fit); }
    int par = 0;
    for (int item = bid; item < 4096; item += G, par ^= 1) {
        const int c = item & 31, h = (item >> 5) & 7, b = item >> 8;
        const size_t t0 = (size_t)b * SEQ + 64 * c;
        LAS unsigned char* L = lds + par * SETB;
        LAS float* vec = (LAS float*)(L + O_VEC); LAS float* gnl = (LAS float*)(L + O_GN); LAS float* part = (LAS float*)(L + O_PART);
        *(LAS u32x4*)(L + O_Q + (tid >> 3) * 144 + (tid & 7) * 16) = pq; *(LAS u32x4*)(L + O_K + (tid >> 3) * 144 + (tid & 7) * 16) = pk;
        *(LAS u32x4*)(L + O_V + (tid >> 4) * 320 + (tid & 15) * 16) = pv0; *(LAS u32x4*)(L + O_V + (32 + (tid >> 4)) * 320 + (tid & 15) * 16) = pv1;
        *(LAS u32x4*)(L + O_C + (tid >> 3) * 144 + (tid & 7) * 16) = pc0; *(LAS u32x4*)(L + O_C + (64 + (tid >> 3)) * 144 + (tid & 7) * 16) = pc1;
        if (tid < 384) vec[tid] = pvec;
        const float mc = pmc; u32x2 opv[4];
#pragma unroll
        for (int gq = 0; gq < 4; ++gq) opv[gq] = popv[gq];
        __syncthreads();
        { const int nit = (item + G < 4096) ? item + G : item; OUT_LOAD(nit); }
        const int t = 32 * tb + r;
        const float Mt = fmaxf(mc, vec[128 + t]), bt = vec[64 + t];
        bf16x8 qf[4];
#pragma unroll
        for (int st = 0; st < 4; ++st) qf[st] = *(const LAS bf16x8*)(L + O_Q + t * 144 + (16 * st + 8 * h2) * 2);
        float qn = 0.f;
#pragma unroll
        for (int st = 0; st < 4; ++st) { const u32x4 qq = __builtin_bit_cast(u32x4, qf[st]); const f32x4 n0 = *(const LAS f32x4*)(vec + 192 + 16 * st + 8 * h2), n1 = *(const LAS f32x4*)(vec + 192 + 16 * st + 8 * h2 + 4);
#pragma unroll
            for (int e = 0; e < 2; ++e) { qn += bf_lo(qq[e]) * n0[2 * e] + bf_hi(qq[e]) * n0[2 * e + 1]; qn += bf_lo(qq[2 + e]) * n1[2 * e] + bf_hi(qq[2 + e]) * n1[2 * e + 1]; } }
        qn += __shfl_xor(qn, 32);
        f32x16 acc1, acc2;
#pragma unroll
        for (int i = 0; i < 16; ++i) { acc1[i] = 0.f; acc2[i] = 0.f; }
        float dsum = 0.f;
#pragma unroll
        for (int sb = 0; sb < 2; ++sb) {
            if (sb <= tb) {
                f32x16 S;
#pragma unroll
                for (int i = 0; i < 16; ++i) S[i] = 0.f;
#pragma unroll
                for (int st = 0; st < 4; ++st) { const bf16x8 kf = *(const LAS bf16x8*)(L + O_K + (32 * sb + r) * 144 + (16 * st + 8 * h2) * 2); S = MFMA32(kf, qf[st], S); }
#pragma unroll
                for (int gq = 0; gq < 4; ++gq) { const f32x4 a4 = *(const LAS f32x4*)(vec + 32 * sb + 8 * gq + 4 * h2);
#pragma unroll
                    for (int k = 0; k < 4; ++k) { const int i = 4 * gq + k, s = 32 * sb + 8 * gq + 4 * h2 + k; const float ev = __builtin_amdgcn_exp2f(fminf(a4[k] - Mt, 0.f) * 1.4426950408889634f);
                        const float wgt = (s <= t) ? ev : 0.f; S[i] = wgt * S[i]; dsum += S[i]; } }
#pragma unroll
                for (int sp = 0; sp < 2; ++sp) {
                    u32x4 wv; wv.x = pk2(S[8 * sp + 0], S[8 * sp + 1]); wv.y = pk2(S[8 * sp + 2], S[8 * sp + 3]); wv.z = pk2(S[8 * sp + 4], S[8 * sp + 5]); wv.w = pk2(S[8 * sp + 6], S[8 * sp + 7]);
                    const bf16x8 pfr = __builtin_bit_cast(bf16x8, wv);
                    const LAS unsigned char* vp = L + O_V + (32 * sb + 16 * sp + 4 * h2 + ((lane & 15) >> 2)) * 320 + (32 * dvb + 16 * ((lane >> 4) & 1) + 4 * (lane & 3)) * 2;
                    const s16x4 lo = tr_read(vp), hi = tr_read(vp + 8 * 320);
                    const bf16x8 af = __builtin_shufflevector(lo, hi, 0, 1, 2, 3, 4, 5, 6, 7);
                    acc1 = MFMA32(af, pfr, acc1);
                }
            }
        }
        dsum += __shfl_xor(dsum, 32);
#pragma unroll
        for (int st = 0; st < 4; ++st) { const bf16x8 cf = *(const LAS bf16x8*)(L + O_C + (32 * dvb + r) * 144 + (16 * st + 8 * h2) * 2); acc2 = MFMA32(cf, qf[st], acc2); }
        const float winter = __expf(mc - Mt);
        const float den = dsum + winter * qn;
        const float dnm = fmaxf(fabsf(den), __expf(-(bt + Mt)));
        const float idn = __builtin_amdgcn_rcpf(dnm);
        float hsq = 0.f;
#pragma unroll
        for (int i = 0; i < 16; ++i) { acc1[i] = (acc1[i] + winter * acc2[i]) * idn; hsq += acc1[i] * acc1[i]; }
        hsq += __shfl_xor(hsq, 32);
        if (h2 == 0) part[dvb * 64 + t] = hsq;
        __syncthreads();
        const float tot = (part[t] + part[64 + t]) + (part[128 + t] + part[192 + t]);
        const float rsn = __builtin_amdgcn_rsqf(tot * (1.0f / 128.0f) + RMS_EPS);
        const size_t orow = (t0 + t) * 1024 + h * 128 + 32 * dvb + 4 * h2;
#pragma unroll
        for (int gq = 0; gq < 4; ++gq) {
            const u32x2 op = opv[gq]; const f32x4 gn = *(const LAS f32x4*)(gnl + 32 * dvb + 4 * h2 + 8 * gq);
            const float y0 = acc1[4 * gq + 0] * rsn * gn[0] * sigmoid_f(bf_lo(op.x)), y1 = acc1[4 * gq + 1] * rsn * gn[1] * sigmoid_f(bf_hi(op.x));
            const float y2 = acc1[4 * gq + 2] * rsn * gn[2] * sigmoid_f(bf_lo(op.y)), y3 = acc1[4 * gq + 3] * rsn * gn[3] * sigmoid_f(bf_hi(op.y));
            u32x2 wv; wv.x = pk2(y0, y1); wv.y = pk2(y2, y3); *(u32x2*)(MX + orow + 8 * gq) = wv;
        }
    }
    __syncthreads();
#undef OUT_LOAD
}
__device__ __forceinline__ void final_phase(float* __restrict__ out, const float* __restrict__ ss, const float* __restrict__ gain, int G, int bid) {
    const int gt = bid * 512 + threadIdx.x, NGT = G * 512;
    for (int i = gt; i < T_TOK * 256; i += NGT) { const int t = i >> 8, c4 = i & 255; const float rs = rs_from_ss(ss[t]);
        f32x4 v = __builtin_nontemporal_load((const f32x4*)(out + (size_t)t * 1024 + 4 * c4)); const f32x4 gn = *(const f32x4*)(gain + 4 * c4); v = v * rs * gn; *(f32x4*)(out + (size_t)t * 1024 + 4 * c4) = v; }
}

__global__ void __launch_bounds__(NWAVES * 64, 2) mega_fwd(Args A) {
    extern __shared__ __attribute__((aligned(16))) unsigned char lds_raw[];
    LAS unsigned char* lds = (LAS unsigned char*)lds_raw;
    cg::grid_group grid = cg::this_grid();
    const int G = gridDim.x, bid = blockIdx.x;
    unsigned char* ws = A.ws;
    float* ss = (float*)(ws + WS_SS);
    bf16* hb = (bf16*)(ws + WS_HB); bf16* MX = (bf16*)(ws + WS_MX);
    bf16* QKVh = (bf16*)(ws + WS_BIG); float* H = (float*)(ws + WS_H); bf16* ACT = (bf16*)(ws + WS_ACT); bf16* P2 = (bf16*)(ws + WS_ACT);
    bf16* Oh = (bf16*)A.out; bf16* Cst = (bf16*)A.out; bf16* OP = (bf16*)A.out + (size_t)32 * 1024 * 1024;
    float* lse = (float*)(ws + WS_LSE); float* gates = (float*)(ws + WS_GATES); float* rope = (float*)(ws + WS_ROPE);
    float* mst = (float*)(ws + WS_MST); float* nst = (float*)(ws + WS_NST);
    bf16* QKc = hb;
    float* GA = (float*)(ws + 460 * MiB); float* GB = GA + (size_t)T_TOK * 8; float* GP = GB + (size_t)T_TOK * 8; float* CH = GP + (size_t)T_TOK * 8;
    const int lo = A.ph_lo, hi = A.ph_hi;
    volatile LAS unsigned* MISC = (volatile LAS unsigned*)(lds + LDS_BYTES - 256);
    if (threadIdx.x < 16) MISC[threadIdx.x] = 0u;
    __syncthreads();
    const XcdBarrier bar = xcd_barrier_post((unsigned*)(ws + WS_BAR), MISC + 8);
#ifndef PROBE_MASK
#define PROBE_MASK 0u
#endif
#define PROBE_K 4ull
    unsigned long long pr_sum = 0ull, pr_t0 = 0ull, pr_s0 = 0ull;
#define PB(k) do { if (PROBE_MASK & (1u << (k))) pr_t0 = __builtin_amdgcn_s_memrealtime(); } while (0)
#define PE(k) do { if (PROBE_MASK & (1u << (k))) pr_sum += __builtin_amdgcn_s_memrealtime() - pr_t0; } while (0)
#define IN(k) (lo <= (k) && (k) < hi)
#define SYNC(k) do { if (IN(k) && IN((k) + 1)) { if (PROBE_MASK & (1u << 30)) pr_s0 = __builtin_amdgcn_s_memrealtime(); if (hi < 0) { __threadfence(); grid.sync(); __threadfence(); } else xcd_barrier(bar); if (PROBE_MASK & (1u << 30)) pr_sum += __builtin_amdgcn_s_memrealtime() - pr_s0; if (PROBE_MASK & (1u << 29)) { pr_s0 = __builtin_amdgcn_s_memrealtime(); xcd_barrier(bar); pr_sum += __builtin_amdgcn_s_memrealtime() - pr_s0; } } PE(k); } while (0)
    PB(0); if (IN(0)) p0_prologue(A, lds, G, bid);
    SYNC(0);
    PB(1); if (IN(1)) { pg8::Gemm g{hb, (const bf16*)(ws + WS_WQKV), THALF, 9216, 1024}; pg8::StaticOrder S; S.init(THALF, 9216, G, bid);
        pg8::EpiQKV E{QKVh, ss, rope}; pg8::gemm_phase<pg8::EpiQKV, pg8::StaticOrder, true, true>(lds, g, S, E); }
    SYNC(1);
    PB(2); if (IN(2)) attn_phase(lds, QKVh, Oh, lse, 0, G, bid);
    SYNC(2);
    PB(3); if (IN(3)) { merge_phase(Oh, lse, MX, 0, G, bid);
        pg8::Gemm g{hb + (size_t)THALF * 1024, (const bf16*)(ws + WS_WQKV), THALF, 9216, 1024}; pg8::StaticOrder S; S.init(THALF, 9216, G, bid);
        pg8::EpiQKV E{QKVh, ss + THALF, rope + (size_t)THALF * 32}; pg8::gemm_phase<pg8::EpiQKV, pg8::StaticOrder, true, true>(lds, g, S, E); }
    SYNC(3);
    PB(4); if (IN(4)) attn_phase(lds, QKVh, Oh, lse, 1, G, bid);
    SYNC(4);
    PB(5); if (IN(5)) merge_phase(Oh, lse, MX, 1, G, bid);
    SYNC(5);
    PB(6); if (IN(6)) { pg8::Gemm g{MX, (const bf16*)(ws + WS_WAO), T_TOK, 1024, 1024}; pg8::StaticOrder S; S.init(T_TOK, 1024, G, bid);
        pg8::EpiResid E{A.x, H, hb, ss + T_TOK}; pg8::gemm_phase<pg8::EpiResid, pg8::StaticOrder, true, true>(lds, g, S, E); }
    SYNC(6);
    PB(7); if (IN(7)) { pg8::Gemm g{hb, (const bf16*)(ws + WS_WFFIN), T_TOK, 5632, 1024}; pg8::StaticOrder S; S.init(T_TOK, 5632, G, bid);
        pg8::EpiSwiGLU E{ACT, ss + T_TOK}; pg8::gemm_phase<pg8::EpiSwiGLU, pg8::StaticOrder, true, true>(lds, g, S, E); }
    SYNC(7);
    PB(8); if (IN(8)) { pg8::Gemm g{ACT, (const bf16*)(ws + WS_WFFOUT), T_TOK, 1024, DFF}; pg8::StaticOrder S; S.init(T_TOK, 1024, G, bid);
        pg8::EpiResid E{H, H, hb, ss + 2 * T_TOK}; pg8::gemm_phase<pg8::EpiResid, pg8::StaticOrder, true, true>(lds, g, S, E); }
    SYNC(8);
    PB(9); if (IN(9)) { pg8::Gemm g{hb, (const bf16*)(ws + WS_WMIN), T_TOK, 3328, 1024}; pg8::StaticOrder S; S.init(T_TOK, 3328, G, bid);
        pg8::EpiMlstmIn E{P2, OP, gates, ss + 2 * T_TOK}; pg8::gemm_phase<pg8::EpiMlstmIn, pg8::StaticOrder, true, true>(lds, g, S, E); }
    SYNC(9);
    PB(10); if (IN(10)) { mlstm_pre_phase(P2, gates, A.conv_w, A.conv_b, A.ig_bias, A.fg_bias, QKc, GA, GB, GP, CH, G, bid); xcd_barrier(bar);
        mlstm_scan_phase(lds, P2, QKc, GA, CH, Cst, nst, mst, G, bid); }
    SYNC(10);
    PB(11); if (IN(11)) mlstm_out_phase(lds, P2, QKc, OP, GA, GB, GP, A.head_gain, Cst, nst, mst, MX, G, bid);
    SYNC(11);
    PB(12); if (IN(12)) { pg8::Gemm g{MX, (const bf16*)(ws + WS_WMOUT), T_TOK, 1024, 1024}; pg8::StaticOrder S; S.init(T_TOK, 1024, G, bid);
        pg8::EpiResid E{H, H, hb, ss + 3 * T_TOK}; pg8::gemm_phase<pg8::EpiResid, pg8::StaticOrder, true, true>(lds, g, S, E); }
    SYNC(12);
    PB(13); if (IN(13)) { pg8::Gemm g{hb, (const bf16*)(ws + WS_WFFIN) + (size_t)5632 * 1024, T_TOK, 5632, 1024}; pg8::StaticOrder S; S.init(T_TOK, 5632, G, bid);
        pg8::EpiSwiGLU E{ACT, ss + 3 * T_TOK}; pg8::gemm_phase<pg8::EpiSwiGLU, pg8::StaticOrder, true, true>(lds, g, S, E); }
    SYNC(13);
    PB(14); if (IN(14)) { pg8::Gemm g{ACT, (const bf16*)(ws + WS_WFFOUT) + (size_t)1024 * DFF, T_TOK, 1024, DFF}; pg8::StaticOrder S; S.init(T_TOK, 1024, G, bid);
        pg8::EpiResid E{H, A.out, nullptr, ss + 4 * T_TOK}; pg8::gemm_phase<pg8::EpiResid, pg8::StaticOrder, true, true>(lds, g, S, E); }
    SYNC(14);
    PB(15); if (IN(15)) final_phase(A.out, ss + 4 * T_TOK, A.final_norm, G, bid);
    PE(15);
    if (PROBE_MASK != 0u && bid == 0 && threadIdx.x == 0) { const unsigned long long te = __builtin_amdgcn_s_memrealtime(); while (__builtin_amdgcn_s_memrealtime() - te < PROBE_K * pr_sum) __builtin_amdgcn_s_sleep(8); }
#undef IN
#undef SYNC
}

extern "C" void kernel_launch(void* const* d_in, const int* in_sizes, int n_in, void* d_out, int out_size, void* d_ws, size_t ws_size, hipStream_t stream) {
    static int grid = 0;
    if (grid == 0) {
        if (n_in != 17 || in_sizes[0] != T_TOK * DM || out_size != T_TOK * DM || ws_size < WS_END) { fprintf(stderr, "kernel_launch: unexpected shapes (n_in %d, in0 %d, out %d, ws %zu); nothing launched\n", n_in, n_in > 0 ? in_sizes[0] : -1, out_size, ws_size); grid = -1; return; }
        int dev = 0, cus = 0, per_cu = 0;
        if (hipGetDevice(&dev) != hipSuccess || hipDeviceGetAttribute(&cus, hipDeviceAttributeMultiprocessorCount, dev) != hipSuccess) { grid = -1; return; }
        if (hipFuncSetAttribute((const void*)mega_fwd, hipFuncAttributeMaxDynamicSharedMemorySize, LDS_BYTES) != hipSuccess) { fprintf(stderr, "kernel_launch: hipFuncSetAttribute failed\n"); grid = -1; return; }
        if (hipOccupancyMaxActiveBlocksPerMultiprocessor(&per_cu, (const void*)mega_fwd, NWAVES * 64, LDS_BYTES) != hipSuccess || per_cu < 1) { fprintf(stderr, "kernel_launch: occupancy query says %d\n", per_cu); per_cu = 1; }
        (void)hipGetLastError();
        grid = cus;
    }
    if (grid < 0) return;
    Args a{};
    a.x = (const float*)d_in[0]; a.pos = (const int*)d_in[1]; a.attn_norm = (const float*)d_in[2]; a.attn_w_in = (const float*)d_in[3]; a.attn_w_out = (const float*)d_in[4];
    a.mlstm_norm = (const float*)d_in[5]; a.mlstm_w_in = (const float*)d_in[6]; a.conv_w = (const float*)d_in[7]; a.conv_b = (const float*)d_in[8]; a.ig_bias = (const float*)d_in[9];
    a.fg_bias = (const float*)d_in[10]; a.head_gain = (const float*)d_in[11]; a.mlstm_w_out = (const float*)d_in[12]; a.ffn_norm = (const float*)d_in[13]; a.ffn_w_in = (const float*)d_in[14];
    a.ffn_w_out = (const float*)d_in[15]; a.final_norm = (const float*)d_in[16];
    a.out = (float*)d_out; a.ws = (unsigned char*)d_ws; a.ph_lo = 0; a.ph_hi = 16;
    if (hipMemsetAsync((char*)d_ws + WS_BAR, 0, 16384, stream) != hipSuccess) { fprintf(stderr, "kernel_launch: hipMemsetAsync failed\n"); return; }
    void* args[] = {&a};
    const hipError_t e = hipLaunchCooperativeKernel((const void*)mega_fwd, dim3(grid), dim3(NWAVES * 64), args, LDS_BYTES, stream);
    if (e != hipSuccess) fprintf(stderr, "kernel_launch: cooperative launch failed: %s (grid %d)\n", hipGetErrorString(e), grid);
}
```

```cpp
#include <hip/hip_runtime.h>
#include <hip/hip_cooperative_groups.h>
#include <cstdio>
#include <cstdint>
namespace cg = cooperative_groups;

constexpr float RMS_EPS = 1e-6f;
__device__ __forceinline__ float rs_from_ss(float ss) { return __builtin_amdgcn_rsqf(ss * (1.0f / 1024.0f) + RMS_EPS); }
__device__ __forceinline__ float silu_f(float x) { return x * __builtin_amdgcn_rcpf(1.0f + __builtin_amdgcn_exp2f(x * -1.4426950408889634f)); }
__device__ __forceinline__ float sigmoid_f(float x) { return __builtin_amdgcn_rcpf(1.0f + __builtin_amdgcn_exp2f(x * -1.4426950408889634f)); }

namespace pg8 {
#define PG8_LAS __attribute__((address_space(3)))
typedef unsigned short bf16_t;
typedef short bf16x8 __attribute__((ext_vector_type(8)));
typedef float f32x4 __attribute__((ext_vector_type(4)));
typedef unsigned u32x4 __attribute__((ext_vector_type(4)));
constexpr int BM = 256, BK = 64, HALF = 128, HTB = HALF * BK * 2  , STAGE_BYTES = 8 * HTB, NXCD = 8, WGM = 8;

__host__ __device__ __forceinline__ int lds_byte(int r, int c) { const int st = (r >> 4) * 2 + (c >> 5), rr = r & 15, cc = c & 31, ob = rr * 64 + cc * 2; return st * 1024 + (ob ^ (((ob >> 9) & 1) << 5)); }
__host__ __device__ __forceinline__ void stage_rc(int b, int& R, int& C) { const int st = b / 1024, sb = b % 1024, swz = sb ^ (((sb >> 9) & 1) << 5); R = (st >> 1) * 16 + swz / 64; C = (st & 1) * 32 + (swz % 64) / 2; }
__host__ __device__ __forceinline__ int perm32(int rho) { const int n = rho >> 4, i = rho & 15; return 8 * (i >> 2) + 4 * n + (i & 3); }

typedef unsigned u32x2 __attribute__((ext_vector_type(2)));
struct Unit { int pm, pn; };
struct Gemm { const bf16_t* A; const bf16_t* Bt; int M, N, K; };

struct StaticOrder {
    int nM, nN, nwg, G, c;
    __host__ __device__ void init(int M, int N, int G_, int c_) { nM = M / BM; nN = N / BM; nwg = nM * nN; G = G_; c = c_; }
    __host__ __device__ bool next(int i, Unit& u) const {
        const long L = (long)i * G + c; if (L >= nwg) return false;
        int wgid = (int)L; { const int q = nwg / NXCD, r = nwg % NXCD, xcd = wgid % NXCD, off = wgid / NXCD; wgid = (xcd < r ? xcd * (q + 1) : r * (q + 1) + (xcd - r) * q) + off; }
        const int nig = WGM * nN, gid = wgid / nig, fm = gid * WGM, gsz = (nM - fm) < WGM ? (nM - fm) : WGM;
        u.pm = fm + ((wgid % nig) % gsz); u.pn = (wgid % nig) / gsz; return true;
    }
    __device__ __forceinline__ void a_ready(const Unit&) const {}
    __device__ __forceinline__ void done(const Unit&) const {}
};
__device__ __forceinline__ unsigned cvt_pk_bf16(float lo, float hi) { unsigned r; asm volatile("v_cvt_pk_bf16_f32 %0, %1, %2" : "=v"(r) : "v"(lo), "v"(hi)); return r; }

#define EPI_FENCE() asm volatile("" ::: "memory")
struct EpiQKV {
    static constexpr bool PERM = true, AFTER_DRAIN = false;
    bf16_t* O; const float* ss; const float* cs;
    __device__ __forceinline__ void operator()(const f32x4 (&acc)[2][2][4][2], const Unit& u, int wr, int wc, int fr, int fq) const {
        const int row0 = u.pm * BM + wr * 64 + fr; const int colt = u.pn * BM;
        const int tsel = (colt % 3072) / 1024;
        const bool rope = (tsel < 2) && (wc == 0);
        const int gsel = colt / 3072, lg = 2 * gsel, dil = 1 << lg;
        const int hb0 = (gsel * 3 + tsel) * 8 + (colt % 1024) / 128;
        float rsv[8];
#pragma unroll
        for (int k = 0; k < 8; ++k) rsv[k] = ss[row0 + (k >> 2) * HALF + (k & 3) * 16];
        f32x4 cA = {0.f, 0.f, 0.f, 0.f}, sA = cA;
        if (rope) { const float* p = cs + (size_t)row0 * 32 + 4 * fq; cA = *(const f32x4*)p; sA = *(const f32x4*)(p + 16); }
#pragma unroll
        for (int k = 0; k < 8; ++k) {
            const int ai = k >> 2, m = k & 3;
            const int row = row0 + ai * HALF + m * 16;
            f32x4 cN = cA, sN = sA;
            if (rope && k + 1 < 8) { const int rown = row0 + ((k + 1) >> 2) * HALF + ((k + 1) & 3) * 16; const float* p = cs + (size_t)rown * 32 + 4 * fq; cN = *(const f32x4*)p; sN = *(const f32x4*)(p + 16); }
            EPI_FENCE();
            const float rs = rs_from_ss(rsv[k]);
            const int sq = row & 2047, perm = ((sq & (dil - 1)) << (11 - lg)) + (sq >> lg);
            bf16_t* rowp = O + ((size_t)hb0 * 17408 + (row >> 11) * 2176 + perm) * 128;
            if (rope) {
                const f32x4 cr = cA * rs, sr = sA * rs;
#pragma unroll
                for (int bj = 0; bj < 2; ++bj) {
                    const f32x4 v0 = acc[ai][bj][m][0], v1 = acc[ai][bj][m][1];
                    const f32x4 o0 = v0 * cr - v1 * sr, o1 = v1 * cr + v0 * sr;
                    u32x2 w0, w1; w0.x = cvt_pk_bf16(o0[0], o0[1]); w0.y = cvt_pk_bf16(o0[2], o0[3]); w1.x = cvt_pk_bf16(o1[0], o1[1]); w1.y = cvt_pk_bf16(o1[2], o1[3]);
                    bf16_t* hp = rowp + (size_t)bj * 17408 * 128 + 4 * fq;
                    *(u32x2*)hp = w0; *(u32x2*)(hp + 16) = w1;
                }
            } else {
#pragma unroll
                for (int bj = 0; bj < 2; ++bj) {
                    const f32x4 v0 = acc[ai][bj][m][0] * rs, v1 = acc[ai][bj][m][1] * rs;
                    u32x4 wv; wv.x = cvt_pk_bf16(v0[0], v0[1]); wv.y = cvt_pk_bf16(v0[2], v0[3]); wv.z = cvt_pk_bf16(v1[0], v1[1]); wv.w = cvt_pk_bf16(v1[2], v1[3]);
                    *(u32x4*)(rowp + (size_t)bj * 17408 * 128 + wc * 32 + 8 * fq) = wv;
                }
            }
            cA = cN; sA = sN;
        }
    }
};
struct EpiResid {
    static constexpr bool PERM = true, AFTER_DRAIN = false;
    const float* base; float* out; bf16_t* outb; float* ssn;
    __device__ __forceinline__ void operator()(const f32x4 (&acc)[2][2][4][2], const Unit& u, int wr, int wc, int fr, int fq) const {
        const int row0 = u.pm * BM + wr * 64 + fr; const int col0 = u.pn * BM + wc * 32 + 8 * fq;
        f32x4 bA[4];
        { const float* p = base + (size_t)row0 * 1024 + col0; bA[0] = __builtin_nontemporal_load((const f32x4*)p); bA[1] = __builtin_nontemporal_load((const f32x4*)(p + 4)); bA[2] = __builtin_nontemporal_load((const f32x4*)(p + HALF)); bA[3] = __builtin_nontemporal_load((const f32x4*)(p + HALF + 4)); }
#pragma unroll
        for (int k = 0; k < 8; ++k) {
            const int ai = k >> 2, m = k & 3;
            const int row = row0 + ai * HALF + m * 16;
            f32x4 bN[4];
#pragma unroll
            for (int q = 0; q < 4; ++q) bN[q] = bA[q];
            if (k + 1 < 8) { const int rown = row0 + ((k + 1) >> 2) * HALF + ((k + 1) & 3) * 16; const float* p = base + (size_t)rown * 1024 + col0;
                bN[0] = __builtin_nontemporal_load((const f32x4*)p); bN[1] = __builtin_nontemporal_load((const f32x4*)(p + 4)); bN[2] = __builtin_nontemporal_load((const f32x4*)(p + HALF)); bN[3] = __builtin_nontemporal_load((const f32x4*)(p + HALF + 4)); }
            EPI_FENCE();
            float sq = 0.f;
#pragma unroll
            for (int bj = 0; bj < 2; ++bj) {
                const size_t off = (size_t)row * 1024 + col0 + bj * HALF;
                const f32x4 v0 = acc[ai][bj][m][0] + bA[2 * bj], v1 = acc[ai][bj][m][1] + bA[2 * bj + 1];
                *(f32x4*)(out + off) = v0; *(f32x4*)(out + off + 4) = v1;
                if (outb) { u32x4 wv; wv.x = cvt_pk_bf16(v0[0], v0[1]); wv.y = cvt_pk_bf16(v0[2], v0[3]); wv.z = cvt_pk_bf16(v1[0], v1[1]); wv.w = cvt_pk_bf16(v1[2], v1[3]); *(u32x4*)(outb + off) = wv; }
                sq += (v0[0] * v0[0] + v0[1] * v0[1]) + (v0[2] * v0[2] + v0[3] * v0[3]) + (v1[0] * v1[0] + v1[1] * v1[1]) + (v1[2] * v1[2] + v1[3] * v1[3]);
            }
            sq += __shfl_xor(sq, 16); sq += __shfl_xor(sq, 32);
            if (fq == 0) atomicAdd(ssn + row, sq);
#pragma unroll
            for (int q = 0; q < 4; ++q) bA[q] = bN[q];
        }
    }
};
struct EpiSwiGLU {
    static constexpr bool PERM = true, AFTER_DRAIN = false;
    bf16_t* O; const float* ss;
    __device__ __forceinline__ void operator()(const f32x4 (&acc)[2][2][4][2], const Unit& u, int wr, int wc, int fr, int fq) const {
        const int row0 = u.pm * BM + wr * 64 + fr; const int col0 = u.pn * HALF + wc * 32 + 8 * fq;
        float rsv[8];
#pragma unroll
        for (int k = 0; k < 8; ++k) rsv[k] = ss[row0 + (k >> 2) * HALF + (k & 3) * 16];
        EPI_FENCE();
#pragma unroll
        for (int ai = 0; ai < 2; ++ai)
#pragma unroll
            for (int m = 0; m < 4; ++m) {
                const int row = row0 + ai * HALF + m * 16;
                const float rs = rs_from_ss(rsv[ai * 4 + m]); const float rs2 = rs * rs, nrs = rs * -1.4426950408889634f;
                float o[8];
#pragma unroll
                for (int n = 0; n < 2; ++n)
#pragma unroll
                    for (int e = 0; e < 4; ++e) { const float g = acc[ai][0][m][n][e], uu = acc[ai][1][m][n][e] * rs2;
                        o[4 * n + e] = (g * uu) * __builtin_amdgcn_rcpf(1.0f + __builtin_amdgcn_exp2f(g * nrs)); }
                u32x4 wv; wv.x = cvt_pk_bf16(o[0], o[1]); wv.y = cvt_pk_bf16(o[2], o[3]); wv.z = cvt_pk_bf16(o[4], o[5]); wv.w = cvt_pk_bf16(o[6], o[7]);
                *(u32x4*)(O + (size_t)row * 2816 + col0) = wv;
            }
    }
};
struct EpiMlstmIn {
    static constexpr bool PERM = true, AFTER_DRAIN = false;
    bf16_t* P2; bf16_t* OP; float* gates; const float* ss;
    __device__ __forceinline__ void operator()(const f32x4 (&acc)[2][2][4][2], const Unit& u, int wr, int wc, int fr, int fq) const {
        const int row0 = u.pm * BM + wr * 64 + fr;
        float rsv[8];
#pragma unroll
        for (int k = 0; k < 8; ++k) rsv[k] = ss[row0 + (k >> 2) * HALF + (k & 3) * 16];
        EPI_FENCE();
#pragma unroll
        for (int ai = 0; ai < 2; ++ai)
#pragma unroll
            for (int m = 0; m < 4; ++m) {
                const int row = row0 + ai * HALF + m * 16;
                const float rs = rs_from_ss(rsv[ai * 4 + m]);
#pragma unroll
                for (int bj = 0; bj < 2; ++bj) {
                    const int cb = u.pn * BM + bj * HALF;
                    const f32x4 v0 = acc[ai][bj][m][0] * rs, v1 = acc[ai][bj][m][1] * rs;
                    const int cc = wc * 32 + 8 * fq;
                    if (cb < 3072) {
                        u32x4 wv; wv.x = cvt_pk_bf16(v0[0], v0[1]); wv.y = cvt_pk_bf16(v0[2], v0[3]); wv.z = cvt_pk_bf16(v1[0], v1[1]); wv.w = cvt_pk_bf16(v1[2], v1[3]);
                        bf16_t* dst = (cb < 2048) ? (P2 + (size_t)row * 2048 + cb + cc) : (OP + (size_t)row * 1024 + (cb - 2048) + cc);
                        *(u32x4*)dst = wv;
                    } else if (cb == 3072 && cc < 16) {
                        float* dst = gates + (size_t)row * 16 + cc;
                        *(f32x4*)dst = v0; *(f32x4*)(dst + 4) = v1;
                    }
                }
            }
    }
};

template <class Epi, class Sched, bool ALIGN_EPI = false, bool SP2 = false>
__device__ __forceinline__ void gemm_phase(PG8_LAS unsigned char* lds, const Gemm g, const Sched& S, const Epi& E) {
    const int tid = threadIdx.x, wid = __builtin_amdgcn_readfirstlane(tid >> 6), lane = tid & 63, wr = wid >> 2, wc = wid & 3, fr = lane & 15, fq = lane >> 4;
    const int K = g.K, nt = K / BK;
    unsigned voffA[2], voffB[2];
#pragma unroll
    for (int i = 0; i < 2; ++i) { int R, C; stage_rc(tid * 16 + i * 8192, R, C); const int Rb = Epi::PERM ? ((R & ~31) + perm32(R & 31)) : R;
        voffA[i] = (unsigned)(R * K + C) * 2u; voffB[i] = (unsigned)(Rb * K + C) * 2u; }
    const size_t kstep = (size_t)(BK * 2);
    const size_t hstep = (size_t)HALF * K * 2;
    const size_t tstep = 2 * hstep;
    const unsigned ldsw = (unsigned)wid * 1024u;
    const int aoff = lds_byte(wr * 64 + fr, fq * 8), boff = lds_byte(wc * 32 + fr, fq * 8);
#define PG8_SA(b, h) (((b) * 2 + (h)) * HTB)
#define PG8_SB(b, h) ((4 + (b) * 2 + (h)) * HTB)
#define PG8_STAGE(bufoff, gbase, voff) do { _Pragma("unroll") for (int _i = 0; _i < 2; ++_i) \
        __builtin_amdgcn_global_load_lds((const unsigned*)((const char*)(gbase) + (voff)[_i]), (PG8_LAS unsigned*)(lds + (bufoff) + ldsw + _i * 8192), 16, 0, 0); } while (0)
#define PG8_LDA(dst, b, h) do { _Pragma("unroll") for (int m = 0; m < 4; ++m) _Pragma("unroll") for (int k = 0; k < 2; ++k) dst[m][k] = *(const PG8_LAS bf16x8*)(lds + PG8_SA(b, h) + aoff + m * 2048 + k * 1024); } while (0)
#define PG8_LDB(dst, b, h) do { _Pragma("unroll") for (int n = 0; n < 2; ++n) _Pragma("unroll") for (int k = 0; k < 2; ++k) dst[n][k] = *(const PG8_LAS bf16x8*)(lds + PG8_SB(b, h) + boff + n * 2048 + k * 1024); } while (0)
#define PG8_MMA(ai, bj, At, Bt) do { __builtin_amdgcn_s_setprio(1); _Pragma("unroll") for (int m = 0; m < 4; ++m) _Pragma("unroll") for (int n = 0; n < 2; ++n) _Pragma("unroll") for (int k = 0; k < 2; ++k) \
        acc[ai][bj][m][n] = __builtin_amdgcn_mfma_f32_16x16x32_bf16(Bt[n][k], At[m][k], acc[ai][bj][m][n], 0, 0, 0); __builtin_amdgcn_s_setprio(0); } while (0)
#define PG8_WAIT_V(n) asm volatile("s_waitcnt vmcnt(" #n ")" ::: "memory")
#define PG8_WAIT_L(n) asm volatile("s_waitcnt lgkmcnt(" #n ")" ::: "memory")
#define PG8_BAR __builtin_amdgcn_s_barrier()
#define PG8_SCHED __builtin_amdgcn_sched_barrier(0)
    Unit cur, nxt; int ui = 0;
    if (!S.next(0, cur)) return;
    f32x4 acc[2][2][4][2];
#pragma unroll
    for (int a = 0; a < 2; ++a)
#pragma unroll
        for (int b = 0; b < 2; ++b)
#pragma unroll
            for (int m = 0; m < 4; ++m)
#pragma unroll
                for (int n = 0; n < 2; ++n) acc[a][b][m][n] = (f32x4){0.f, 0.f, 0.f, 0.f};
    bf16x8 At[4][2], B0[2][2], B1[2][2];
    const char* cA = (const char*)g.A + (size_t)cur.pm * tstep; const char* cB = (const char*)g.Bt + (size_t)cur.pn * tstep;
    S.a_ready(cur);
    if constexpr (SP2) {
        PG8_STAGE(PG8_SB(0, 0), cB, voffB); PG8_STAGE(PG8_SB(0, 1), cB + hstep, voffB); PG8_STAGE(PG8_SA(0, 0), cA, voffA); PG8_STAGE(PG8_SA(0, 1), cA + hstep, voffA);
        if (wr == 1) PG8_BAR;
        PG8_WAIT_V(2); PG8_BAR;
        PG8_STAGE(PG8_SB(1, 0), cB + kstep, voffB); PG8_STAGE(PG8_SA(1, 0), cA + kstep, voffA); PG8_STAGE(PG8_SB(1, 1), cB + hstep + kstep, voffB);
        PG8_WAIT_V(6); PG8_BAR;
    } else {
        PG8_STAGE(PG8_SB(0, 0), cB, voffB); PG8_STAGE(PG8_SA(0, 0), cA, voffA); PG8_STAGE(PG8_SB(0, 1), cB + hstep, voffB); PG8_STAGE(PG8_SA(0, 1), cA + hstep, voffA);
        if (wr == 1) PG8_BAR;
        PG8_WAIT_V(4); PG8_BAR;
        PG8_STAGE(PG8_SB(1, 0), cB + kstep, voffB); PG8_STAGE(PG8_SA(1, 0), cA + kstep, voffA); PG8_STAGE(PG8_SB(1, 1), cB + hstep + kstep, voffB);
        PG8_WAIT_V(6); PG8_BAR;
    }
    for (;;) {
        const bool has_next = S.next(ui + 1, nxt);
        const char* nA = has_next ? (const char*)g.A + (size_t)nxt.pm * tstep : cA; const char* nB = has_next ? (const char*)g.Bt + (size_t)nxt.pn * tstep : cB;
        for (int t = 0; t < nt; t += 2) {
            const bool last = (t == nt - 2);
            const char* a1 = cA + (size_t)(t + 1) * kstep;
            const char* a2 = last ? nA : cA + (size_t)(t + 2) * kstep; const char* b2 = last ? nB : cB + (size_t)(t + 2) * kstep;
            const char* a3 = a2 + kstep; const char* b3 = b2 + kstep;
            if (last && has_next) S.a_ready(nxt);
            if constexpr (SP2) {
            PG8_LDB(B0, 0, 0); PG8_LDB(B1, 0, 1); PG8_SCHED; PG8_LDA(At, 0, 0); PG8_STAGE(PG8_SA(1, 1), a1 + hstep, voffA);
            PG8_WAIT_V(8); PG8_WAIT_L(0); PG8_BAR; PG8_MMA(0, 0, At, B0); PG8_MMA(0, 1, At, B1); PG8_BAR; PG8_SCHED;
            PG8_LDA(At, 0, 1); PG8_STAGE(PG8_SB(0, 0), b2, voffB); PG8_STAGE(PG8_SB(0, 1), b2 + hstep, voffB); PG8_STAGE(PG8_SA(0, 0), a2, voffA);
            PG8_WAIT_V(8); PG8_WAIT_L(0); PG8_BAR; PG8_MMA(1, 0, At, B0); PG8_MMA(1, 1, At, B1); PG8_BAR; PG8_SCHED;
            PG8_LDB(B0, 1, 0); PG8_LDB(B1, 1, 1); PG8_SCHED; PG8_LDA(At, 1, 0); PG8_STAGE(PG8_SA(0, 1), a2 + hstep, voffA);
            PG8_WAIT_V(8); PG8_WAIT_L(0); PG8_BAR; PG8_MMA(0, 0, At, B0); PG8_MMA(0, 1, At, B1); PG8_BAR; PG8_SCHED;
            PG8_LDA(At, 1, 1); PG8_STAGE(PG8_SB(1, 0), b3, voffB); PG8_STAGE(PG8_SB(1, 1), b3 + hstep, voffB); PG8_STAGE(PG8_SA(1, 0), a3, voffA);
            PG8_WAIT_V(8); PG8_WAIT_L(0); PG8_BAR; PG8_MMA(1, 0, At, B0); PG8_MMA(1, 1, At, B1); PG8_BAR; PG8_SCHED;
            } else {
            PG8_LDB(B0, 0, 0); PG8_SCHED; PG8_LDA(At, 0, 0); PG8_STAGE(PG8_SA(1, 1), a1 + hstep, voffA);
            PG8_WAIT_L(8); PG8_BAR; PG8_WAIT_L(0); PG8_MMA(0, 0, At, B0); PG8_BAR; PG8_SCHED;
            PG8_LDB(B1, 0, 1); PG8_STAGE(PG8_SB(0, 0), b2, voffB);
            PG8_BAR; PG8_WAIT_L(0); PG8_MMA(0, 1, At, B1); PG8_BAR;
            PG8_LDA(At, 0, 1); PG8_STAGE(PG8_SA(0, 0), a2, voffA);
            PG8_BAR; PG8_WAIT_L(0); PG8_MMA(1, 0, At, B0); PG8_BAR; PG8_SCHED;
            PG8_STAGE(PG8_SB(0, 1), b2 + hstep, voffB);
            PG8_WAIT_V(6); PG8_BAR; PG8_MMA(1, 1, At, B1); PG8_BAR;
            PG8_LDB(B0, 1, 0); PG8_SCHED; PG8_LDA(At, 1, 0); PG8_STAGE(PG8_SA(0, 1), a2 + hstep, voffA);
            PG8_WAIT_L(8); PG8_BAR; PG8_WAIT_L(0); PG8_MMA(0, 0, At, B0); PG8_BAR; PG8_SCHED;
            PG8_LDB(B1, 1, 1); PG8_STAGE(PG8_SB(1, 0), b3, voffB);
            PG8_BAR; PG8_WAIT_L(0); PG8_MMA(0, 1, At, B1); PG8_BAR;
            PG8_LDA(At, 1, 1); PG8_STAGE(PG8_SA(1, 0), a3, voffA);
            PG8_BAR; PG8_WAIT_L(0); PG8_MMA(1, 0, At, B0); PG8_BAR; PG8_SCHED;
            PG8_STAGE(PG8_SB(1, 1), b3 + hstep, voffB);
            PG8_WAIT_V(6); PG8_BAR; PG8_MMA(1, 1, At, B1); PG8_BAR;
            }
        }
        if constexpr (ALIGN_EPI) { if (wr == 0) PG8_BAR; }
        if constexpr (!Epi::AFTER_DRAIN) { E(acc, cur, wr, wc, fr, fq); S.done(cur); }
        if (!has_next) break;
#pragma unroll
        for (int a = 0; a < 2; ++a)
#pragma unroll
            for (int b = 0; b < 2; ++b)
#pragma unroll
                for (int m = 0; m < 4; ++m)
#pragma unroll
                    for (int n = 0; n < 2; ++n) acc[a][b][m][n] = (f32x4){0.f, 0.f, 0.f, 0.f};
        cur = nxt; cA = nA; cB = nB; ++ui;
        if constexpr (ALIGN_EPI) { if (wr == 1) PG8_BAR; }
    }
    PG8_WAIT_V(0);
    if constexpr (!ALIGN_EPI) { if (wr == 0) PG8_BAR; }
    PG8_BAR;
    if constexpr (Epi::AFTER_DRAIN) { E.fused(acc, cur, wr, wc, fr, fq, lds, wid, lane); S.done(cur); }
#undef PG8_SA
#undef PG8_SB
#undef PG8_STAGE
#undef PG8_LDA
#undef PG8_LDB
#undef PG8_MMA
#undef PG8_WAIT_V
#undef PG8_WAIT_L
#undef PG8_BAR
#undef PG8_SCHED
}
}

constexpr int T_TOK = 32768, DM = 1024, SEQ = 2048, NB = 16, DFF = 2816, THALF = 16384;
constexpr int NWAVES = 8;
constexpr int RB = 2176, HBR = 8 * RB;
constexpr int LDS_BYTES = 147456;
constexpr size_t MiB = 1u << 20;
constexpr size_t WS_SS = 0;
constexpr size_t WS_MST = 1 * MiB;
constexpr size_t WS_NST = 1 * MiB + 65536;
constexpr size_t WS_BAR = 3 * MiB;
constexpr size_t WS_WQKV = 4 * MiB;
constexpr size_t WS_WAO = 22 * MiB;
constexpr size_t WS_WFFIN = 24 * MiB;
constexpr size_t WS_WFFOUT = 46 * MiB;
constexpr size_t WS_WMIN = 57 * MiB;
constexpr size_t WS_WMOUT = 64 * MiB;
constexpr size_t WS_ROPE = 66 * MiB;
constexpr size_t WS_LSE = 70 * MiB;
constexpr size_t WS_GATES = 73 * MiB;
constexpr size_t WS_HB = 76 * MiB;
constexpr size_t WS_MX = 140 * MiB;
constexpr size_t WS_BIG = 204 * MiB;
constexpr size_t WS_H = WS_BIG;
constexpr size_t WS_ACT = WS_BIG + 128 * MiB;
constexpr size_t WS_END = 512 * MiB;
static_assert(WS_ACT + (size_t)T_TOK * DFF * 2 <= WS_END && WS_BIG + (size_t)72 * 8 * 2176 * 256 <= WS_END, "d_ws map");

#define LAS __attribute__((address_space(3)))
typedef unsigned short bf16;
typedef unsigned u32x4 __attribute__((ext_vector_type(4)));
typedef unsigned u32x2 __attribute__((ext_vector_type(2)));
typedef float f32x4 __attribute__((ext_vector_type(4)));
typedef float f32x16 __attribute__((ext_vector_type(16)));
typedef short bf16x8 __attribute__((ext_vector_type(8)));
typedef short s16x4 __attribute__((ext_vector_type(4)));
typedef float f32x2_t __attribute__((ext_vector_type(2)));
typedef __bf16 bf16x2_t __attribute__((ext_vector_type(2)));
__device__ __forceinline__ unsigned pk2(float lo, float hi) { f32x2_t v = {lo, hi}; bf16x2_t b = __builtin_convertvector(v, bf16x2_t); return __builtin_bit_cast(unsigned, b); }
__device__ __forceinline__ float bf_lo(unsigned w) { return __uint_as_float(w << 16); }
__device__ __forceinline__ float bf_hi(unsigned w) { return __uint_as_float(w & 0xffff0000u); }
__device__ __forceinline__ float wave_sum(float v) {
#pragma unroll
    for (int o = 1; o < 64; o <<= 1) v += __shfl_xor(v, o);
    return v;
}
__device__ __forceinline__ float wave_max(float v) {
#pragma unroll
    for (int o = 1; o < 64; o <<= 1) v = fmaxf(v, __shfl_xor(v, o));
    return v;
}
#define MFMA16(a, b, c) __builtin_amdgcn_mfma_f32_16x16x32_bf16((a), (b), (c), 0, 0, 0)
#define MFMA32(a, b, c) __builtin_amdgcn_mfma_f32_32x32x16_bf16((a), (b), (c), 0, 0, 0)

#define XB_TMO      128
#define XB_XCNT(j)  (256  + 64 * (j))
#define XB_XSUB(j)  (1280 + 64 * (j))
#define XB_XGEN(j)  (2304 + 64 * (j))
#define XB_TOP      3328
#define XB_TOPGEN   3392
#define XCD_BAR_WORDS 3456
#define XB_SPIN_CAP (1u << 18)

__device__ __forceinline__ unsigned xb_ld(unsigned* p)              { return __hip_atomic_load(p, __ATOMIC_RELAXED, __HIP_MEMORY_SCOPE_AGENT); }
__device__ __forceinline__ unsigned xb_add(unsigned* p, unsigned v) { return __hip_atomic_fetch_add(p, v, __ATOMIC_RELAXED, __HIP_MEMORY_SCOPE_AGENT); }
__device__ __forceinline__ unsigned xb_xcc_id() { return (unsigned)__builtin_amdgcn_s_getreg((3 << 11) | 20) & 0xFu; }
#define XB_SPIN(cond, bar) do { unsigned _sp = 0; while (cond) { __builtin_amdgcn_s_sleep(1); \
    if ((++_sp & 255u) == 0u) { if (xb_ld(&(bar)[XB_TMO])) break; if (_sp > XB_SPIN_CAP) { atomicAdd(&(bar)[XB_TMO], 1u); break; } } } } while (0)

struct XcdBarrier {
    unsigned* bar; unsigned x;
    volatile LAS unsigned* st;
};

__device__ __forceinline__ XcdBarrier xcd_barrier_post(unsigned* bar, volatile LAS unsigned* st) {
    XcdBarrier b; b.bar = bar; b.x = xb_xcc_id(); b.st = st;
    if (threadIdx.x == 0) (void)xb_add(&bar[XB_XCNT(b.x)], 1u);
    return b;
}
__device__ __forceinline__ void xcd_barrier_complete(unsigned* bar, unsigned x, unsigned& nloc, unsigned& nx) {
    const unsigned G = gridDim.x * gridDim.y * gridDim.z;
    unsigned sum, cnt, mine, sp = 0u;
    for (;;) {
        sum = 0u; cnt = 0u; mine = 0u;
#pragma unroll
        for (unsigned j = 0; j < 16; ++j) { const unsigned c = xb_ld(&bar[XB_XCNT(j)]); sum += c; cnt += (c > 0u) ? 1u : 0u; mine = (j == x) ? c : mine; }
        if (sum == G) break;
        __builtin_amdgcn_s_sleep(1);
        if ((++sp & 255u) == 0u) { if (xb_ld(&bar[XB_TMO])) break; if (sp > XB_SPIN_CAP) { atomicAdd(&bar[XB_TMO], 1u); break; } }
    }
    nloc = mine > 0u ? mine : 1u; nx = cnt > 0u ? cnt : 1u;
}

__device__ __forceinline__ void xcd_barrier(const XcdBarrier& b) {
    asm volatile("s_waitcnt vmcnt(0)" ::: "memory");
    __syncthreads();
    if (threadIdx.x == 0) {
        unsigned* bar = b.bar;
        __builtin_amdgcn_s_waitcnt(0);
        unsigned nloc = b.st[0], nx = b.st[1];
        if (nloc == 0u) { xcd_barrier_complete(bar, b.x, nloc, nx); b.st[0] = nloc; b.st[1] = nx; }
        const unsigned old = xb_add(&bar[XB_XSUB(b.x)], 1u);
        const unsigned gen = old / nloc;
        if (old + 1u == (gen + 1u) * nloc) {
            __builtin_amdgcn_fence(__ATOMIC_RELEASE, "agent");
            asm volatile("s_waitcnt vmcnt(0)" ::: "memory");
            const unsigned og = xb_add(&bar[XB_TOP], 1u);
            const unsigned tg = og / nx;
            if (og + 1u == (tg + 1u) * nx) xb_add(&bar[XB_TOPGEN], 1u);
            else XB_SPIN(xb_ld(&bar[XB_TOPGEN]) == tg, bar);
            __builtin_amdgcn_fence(__ATOMIC_ACQUIRE, "agent");
            xb_add(&bar[XB_XGEN(b.x)], 1u);
            asm volatile("s_waitcnt vmcnt(0)" ::: "memory");
        } else {
            XB_SPIN(xb_ld(&bar[XB_XGEN(b.x)]) == gen, bar);
            __builtin_amdgcn_fence(__ATOMIC_ACQUIRE, "agent");
            asm volatile("s_waitcnt vmcnt(0)" ::: "memory");
        }
    }
    __syncthreads();
}


struct Args {
    const float* x; const int* pos; const float* attn_norm; const float* attn_w_in; const float* attn_w_out; const float* mlstm_norm; const float* mlstm_w_in;
    const float* conv_w; const float* conv_b; const float* ig_bias; const float* fg_bias; const float* head_gain; const float* mlstm_w_out;
    const float* ffn_norm; const float* ffn_w_in; const float* ffn_w_out; const float* final_norm;
    float* out; unsigned char* ws; int ph_lo, ph_hi;
};

__device__ __forceinline__ void tr_item(const float* __restrict__ W, int K, int Nsrc, bf16* WT, int n0_dst, int n0_src, int k0, const float* __restrict__ gain, float scale, LAS float* scr, int lane, bool ropeperm = false) {
    const int n4 = lane & 15, kq = lane >> 4; const int s4 = (ropeperm && n4 < 8) ? (((n4 & 1) << 2) + (n4 >> 1)) : n4; const int col = n0_src + 4 * s4; const bool ok = col < Nsrc;
    f32x4 v[16];
#pragma unroll
    for (int i = 0; i < 16; ++i) { v[i] = (f32x4){0.f, 0.f, 0.f, 0.f}; if (ok) v[i] = __builtin_nontemporal_load((const f32x4*)(W + (size_t)(k0 + 4 * i + kq) * Nsrc + col)); }
#pragma unroll
    for (int i = 0; i < 16; ++i) { const int kk = 4 * i + kq; const float g = gain ? gain[k0 + kk] * scale : scale; LAS float* d = scr + kk * 65 + 4 * n4;
        d[0] = v[i][0] * g; d[1] = v[i][1] * g; d[2] = v[i][2] * g; d[3] = v[i][3] * g; }
    asm volatile("s_waitcnt lgkmcnt(0)" ::: "memory");
    const int c = lane & 7;
#pragma unroll
    for (int j = 0; j < 8; ++j) { const int n = (lane >> 3) + 8 * j; const LAS float* sp = scr + (8 * c) * 65 + n;
        u32x4 o; o.x = pk2(sp[0 * 65], sp[1 * 65]); o.y = pk2(sp[2 * 65], sp[3 * 65]); o.z = pk2(sp[4 * 65], sp[5 * 65]); o.w = pk2(sp[6 * 65], sp[7 * 65]);
        *(u32x4*)(WT + (size_t)(n0_dst + n) * K + k0 + 8 * c) = o; }
    asm volatile("s_waitcnt lgkmcnt(0)" ::: "memory");
}
__device__ __forceinline__ void p0_prologue(const Args& A, LAS unsigned char* lds, int G, int bid) {
    const int tid = threadIdx.x, lane = tid & 63, wave = tid >> 6;
    LAS float* scr = (LAS float*)(lds + wave * 16640);
    const int gw = bid * NWAVES + wave, NGW = G * NWAVES;
    unsigned char* ws = A.ws;
    constexpr int I_QKV = 16 * 144, I_AO = 16 * 16, I_FFIN = 16 * 88, I_FFOUT = 44 * 16, I_MIN = 16 * 52, I_MOUT = 16 * 16;
    constexpr int NITEMS = I_QKV + I_AO + 2 * I_FFIN + 2 * I_FFOUT + I_MIN + I_MOUT;
    constexpr float QSCALE = 0.08838834764831845f * 1.4426950408889634f;
    for (int it = gw; it < NITEMS; it += NGW) {
        int r = it;
        if (r < I_QKV) { const int kb = r / 144, nb = r % 144, n0 = 64 * nb; const int tsel = (n0 % 3072) / 1024;
            tr_item(A.attn_w_in, 1024, 9216, (bf16*)(ws + WS_WQKV), n0, n0, 64 * kb, A.attn_norm, tsel == 0 ? QSCALE : 1.f, scr, lane, tsel < 2 && (n0 & 127) == 0); continue; } r -= I_QKV;
        if (r < I_AO) { const int kb = r / 16, nb = r % 16; tr_item(A.attn_w_out, 1024, 1024, (bf16*)(ws + WS_WAO), 64 * nb, 64 * nb, 64 * kb, nullptr, 1.f, scr, lane); continue; } r -= I_AO;
        if (r < 2 * I_FFIN) { const int l = r / I_FFIN; r -= l * I_FFIN; const int kb = r / 88, nb = r % 88, n0 = 64 * nb;
            const int pn = n0 >> 8, bj = (n0 >> 7) & 1, jj = n0 & 127; const int nsrc = (bj ? DFF : 0) + 128 * pn + jj;
            tr_item(A.ffn_w_in + (size_t)l * 1024 * 5632, 1024, 5632, (bf16*)(ws + WS_WFFIN) + (size_t)l * 5632 * 1024, n0, nsrc, 64 * kb, A.ffn_norm + l * 1024, 1.f, scr, lane); continue; } r -= 2 * I_FFIN;
        if (r < 2 * I_FFOUT) { const int l = r / I_FFOUT; r -= l * I_FFOUT; const int kb = r / 16, nb = r % 16;
            tr_item(A.ffn_w_out + (size_t)l * DFF * 1024, DFF, 1024, (bf16*)(ws + WS_WFFOUT) + (size_t)l * 1024 * DFF, 64 * nb, 64 * nb, 64 * kb, nullptr, 1.f, scr, lane); continue; } r -= 2 * I_FFOUT;
        if (r < I_MIN) { const int kb = r / 52, nb = r % 52; tr_item(A.mlstm_w_in, 1024, 3088, (bf16*)(ws + WS_WMIN), 64 * nb, 64 * nb, 64 * kb, A.mlstm_norm, 1.f, scr, lane); continue; } r -= I_MIN;
        { const int kb = r / 16, nb = r % 16; tr_item(A.mlstm_w_out, 1024, 1024, (bf16*)(ws + WS_WMOUT), 64 * nb, 64 * nb, 64 * kb, nullptr, 1.f, scr, lane); }
    }
    float* ss = (float*)(ws + WS_SS); bf16* hb = (bf16*)(ws + WS_HB);
    for (int m4 = gw; m4 < T_TOK / 4; m4 += NGW) {
        f32x4 v[4][4];
#pragma unroll
        for (int q = 0; q < 4; ++q) { const f32x4* xr = (const f32x4*)(A.x + (size_t)(4 * m4 + q) * DM) + lane;
#pragma unroll
            for (int j = 0; j < 4; ++j) v[q][j] = __builtin_nontemporal_load(xr + 64 * j); }
#pragma unroll
        for (int q = 0; q < 4; ++q) { const int m = 4 * m4 + q; float sq = 0.f;
#pragma unroll
            for (int j = 0; j < 4; ++j) sq += (v[q][j].x * v[q][j].x + v[q][j].y * v[q][j].y) + (v[q][j].z * v[q][j].z + v[q][j].w * v[q][j].w);
            sq = wave_sum(sq);
            u32x2* o8 = (u32x2*)(hb + (size_t)m * DM) + lane;
#pragma unroll
            for (int j = 0; j < 4; ++j) { u32x2 o; o.x = pk2(v[q][j].x, v[q][j].y); o.y = pk2(v[q][j].z, v[q][j].w); o8[64 * j] = o; }
            if (lane == 0) ss[m] = sq; }
    }
    const int gt = bid * 512 + tid, NGT = G * 512;
    for (int i = gt; i < 4 * T_TOK; i += NGT) ss[T_TOK + i] = 0.f;
    float* rope = (float*)(ws + WS_ROPE);
    for (int i = gt; i < T_TOK * 16; i += NGT) {
        const int t = i >> 4, f = i & 15;
        const float invf = __builtin_amdgcn_exp2f((float)f * -1.1832230355827609f);
        const float ang = (float)A.pos[t] * invf;
        const double rev = (double)ang * 0.15915494309189535; const float fr = (float)(rev - rint(rev));
        rope[(size_t)t * 32 + f] = __builtin_amdgcn_cosf(fr); rope[(size_t)t * 32 + 16 + f] = __builtin_amdgcn_sinf(fr);
    }
}

struct AStep { const bf16* base; size_t rowstride; int blk, g, h, dil, rr, b; bool valid, compute; };
__device__ __forceinline__ AStep attn_step(int u, int s, const bf16* QKVh) {
    AStep t; t.valid = true; t.compute = true;
    if (s < 5) { t.g = 0; t.dil = 1; t.rr = 0; const int qt = u & 3; t.h = (u >> 2) & 7; t.b = u >> 5; t.blk = 4 * qt + s - 1; if (s == 0) { t.compute = false; t.valid = qt > 0; if (!t.valid) t.blk = 0; } }
    else if (s < 9) { t.g = 1; t.dil = 4; t.h = u & 7; t.rr = (u >> 3) & 3; t.b = u >> 5; t.blk = s - 5; }
    else { t.g = 2; t.dil = 16; const int v = 4 * u + (s - 9); t.h = v & 7; t.rr = (v >> 3) & 15; t.b = v >> 7; t.blk = 0; }
    t.rowstride = 128;
    t.base = QKVh + ((size_t)(t.g * 24 + t.h) * HBR + t.b * RB + t.rr * (SEQ / t.dil)) * 128;
    return t;
}
typedef short v4i16_t __attribute__((ext_vector_type(4)));
__device__ __forceinline__ s16x4 tr_read(const LAS unsigned char* p) { return __builtin_bit_cast(s16x4, __builtin_amdgcn_ds_read_tr16_b64_v4i16((LAS v4i16_t*)p)); }
__device__ __forceinline__ void attn_phase(LAS unsigned char* lds, const bf16* __restrict__ QKVh, bf16* __restrict__ Oh, float* __restrict__ lse, int half, int G, int bid) {
    const int tid = threadIdx.x, lane = tid & 63, w = __builtin_amdgcn_readfirstlane(tid >> 6), r = lane & 15, q4 = lane >> 4;
    constexpr int SLOT = 34816, VSLOT = 36864;
#define ATT_LOAD(st) do { \
        _Pragma("unroll") for (int i = 0; i < 4; ++i) { const int chunk = tid + 512 * i, c = chunk >> 4, ch = chunk & 15; const bf16* gp = (st).base + (size_t)(128 * (st).blk + c) * (st).rowstride + 8 * ch; \
            kr[i] = __builtin_nontemporal_load((const u32x4*)(gp + (size_t)8 * HBR * 128)); vr[i] = __builtin_nontemporal_load((const u32x4*)(gp + (size_t)16 * HBR * 128)); } \
        { const bf16* qrow = (st).base + (size_t)(128 * (st).blk + 16 * w + r) * (st).rowstride; \
            _Pragma("unroll") for (int q = 0; q < 4; ++q) qn[q] = *(const bf16x8*)(qrow + 32 * q + 8 * q4); } } while (0)
    for (int u = bid; u < 256; u += G) {
        AStep nx = attn_step(u, 0, QKVh);
        u32x4 kr[4], vr[4]; bf16x8 qn[4];
#pragma unroll
        for (int i = 0; i < 4; ++i) { kr[i] = (u32x4){0u, 0u, 0u, 0u}; vr[i] = kr[i]; qn[i] = (bf16x8){0, 0, 0, 0, 0, 0, 0, 0}; }
        ATT_LOAD(nx);
        for (int s = 0; s < 13; ++s) {
            const AStep cu = nx; const int cs = s & 1;
            LAS unsigned char* Kc = lds + cs * SLOT; LAS unsigned char* Vc = lds + 2 * SLOT + cs * VSLOT;
#pragma unroll
            for (int i = 0; i < 4; ++i) { const int chunk = tid + 512 * i, c = chunk >> 4, ch = chunk & 15; *(LAS u32x4*)(Kc + c * 272 + ch * 16) = kr[i]; *(LAS u32x4*)(Vc + c * 288 + ch * 16) = vr[i]; }
            bf16x8 qf[4];
#pragma unroll
            for (int q = 0; q < 4; ++q) qf[q] = qn[q];
            __syncthreads();
            { nx = attn_step(u, (s + 1 < 13) ? s + 1 : 12, QKVh); ATT_LOAD(nx); }
            if (cu.compute) {
                const bool first = (cu.blk == 0);
                const LAS unsigned char* Kp = first ? Kc : lds + (cs ^ 1) * SLOT; const LAS unsigned char* Vp = first ? Vc : lds + 2 * SLOT + (cs ^ 1) * VSLOT;
                const int a = 16 * w + r;
                const int jlo = first ? 8 : 0;
                f32x4 S[9]; float mx = -INFINITY;
#pragma unroll
                for (int jj = 0; jj < 9; ++jj) { const int j = w + jj; S[jj] = (f32x4){0.f, 0.f, 0.f, 0.f};
                    if (j >= jlo) { const LAS unsigned char* kp = (j >= 8 ? Kc : Kp) + ((j & 7) * 16 + r) * 272 + 16 * q4;
#pragma unroll
                        for (int st = 0; st < 4; ++st) { const bf16x8 kf = *(const LAS bf16x8*)(kp + 64 * st); S[jj] = MFMA16(kf, qf[st], S[jj]); } }
#pragma unroll
                    for (int i = 0; i < 4; ++i) { bool valid = (j >= jlo);
                        if (jj == 0) valid = valid && (4 * q4 + i >= r);
                        if (jj == 8) valid = valid && (4 * q4 + i <= r);
                        S[jj][i] = valid ? S[jj][i] : -INFINITY; mx = fmaxf(mx, S[jj][i]); } }
                mx = fmaxf(mx, __shfl_xor(mx, 16)); mx = fmaxf(mx, __shfl_xor(mx, 32));
                float den = 0.f;
#pragma unroll
                for (int jj = 0; jj < 9; ++jj)
#pragma unroll
                    for (int i = 0; i < 4; ++i) { const float pe = __builtin_amdgcn_exp2f(S[jj][i] - mx); S[jj][i] = pe; den += pe; }
                den += __shfl_xor(den, 16); den += __shfl_xor(den, 32);
                bf16x8 pf[5];
#pragma unroll
                for (int p = 0; p < 5; ++p) { u32x4 wv; wv.x = pk2(S[2 * p][0], S[2 * p][1]); wv.y = pk2(S[2 * p][2], S[2 * p][3]);
                    if (2 * p + 1 < 9) { wv.z = pk2(S[(2 * p + 1) % 9][0], S[(2 * p + 1) % 9][1]); wv.w = pk2(S[(2 * p + 1) % 9][2], S[(2 * p + 1) % 9][3]); } else { wv.z = 0u; wv.w = 0u; }
                    pf[p] = __builtin_bit_cast(bf16x8, wv); }
                f32x4 o[8];
#pragma unroll
                for (int db = 0; db < 8; ++db) o[db] = (f32x4){0.f, 0.f, 0.f, 0.f};
#pragma unroll
                for (int p = 0; p < 5; ++p) { const int j0 = w + 2 * p, j1 = (j0 + 1 > 15) ? 15 : j0 + 1;
                    if (j0 + 1 >= jlo) {
                        const LAS unsigned char* v0p = (j0 >= 8 ? Vc : Vp) + ((j0 & 7) * 16 + 4 * q4 + (r >> 2)) * 288 + 8 * (r & 3);
                        const LAS unsigned char* v1p = (j1 >= 8 ? Vc : Vp) + ((j1 & 7) * 16 + 4 * q4 + (r >> 2)) * 288 + 8 * (r & 3);
#pragma unroll
                        for (int db = 0; db < 8; ++db) {
                            const s16x4 lo = tr_read(v0p + 32 * db), hi = tr_read(v1p + 32 * db);
                            const bf16x8 af = __builtin_shufflevector(lo, hi, 0, 1, 2, 3, 4, 5, 6, 7);
                            o[db] = MFMA16(af, pf[p], o[db]); } } }
                const float inv = __builtin_amdgcn_rcpf(den);
                const int tl = cu.b * SEQ + (128 * cu.blk + a) * cu.dil + cu.rr;
                bf16* orow = Oh + ((size_t)(cu.g * 8 + cu.h) * HBR + cu.b * RB + cu.rr * (SEQ / cu.dil) + 128 * cu.blk + a) * 128 + 4 * q4;
#pragma unroll
                for (int db = 0; db < 8; ++db) { u32x2 wv; wv.x = pk2(o[db][0] * inv, o[db][1] * inv); wv.y = pk2(o[db][2] * inv, o[db][3] * inv); *(u32x2*)(orow + 16 * db) = wv; }
                if (q4 == 0) lse[((size_t)cu.g * T_TOK + (size_t)half * THALF + tl) * 8 + cu.h] = mx * 0.6931471805599453f + __logf(den);
            }
            __syncthreads();
        }
    }
#undef ATT_LOAD
}
__device__ __forceinline__ void merge_phase(const bf16* __restrict__ Oh, const float* __restrict__ lse, bf16* __restrict__ MX, int half, int G, int bid) {
    const int gt = bid * 512 + threadIdx.x, NGT = G * 512;
    for (int i = gt; i < THALF * 128; i += NGT) {
        const int tl = i >> 7, ch = i & 127, h = ch >> 4; const size_t tg = (size_t)half * THALF + tl;
        const float l0 = lse[((size_t)0 * T_TOK + tg) * 8 + h], l1 = lse[((size_t)1 * T_TOK + tg) * 8 + h], l2 = lse[((size_t)2 * T_TOK + tg) * 8 + h];
        const float mxl = fmaxf(l0, fmaxf(l1, l2)); float w0 = __expf(l0 - mxl), w1 = __expf(l1 - mxl), w2 = __expf(l2 - mxl); const float inv = 1.0f / (w0 + w1 + w2); w0 *= inv; w1 *= inv; w2 *= inv;
        const int sq = tl & 2047, bb = (tl >> 11) * RB, dch = ch & 15;
        const int p1 = ((sq & 3) << 9) + (sq >> 2), p2 = ((sq & 15) << 7) + (sq >> 4);
        const u32x4 a = __builtin_nontemporal_load((const u32x4*)(Oh + ((size_t)(0 + h) * HBR + bb + sq) * 128 + 8 * dch)), b = __builtin_nontemporal_load((const u32x4*)(Oh + ((size_t)(8 + h) * HBR + bb + p1) * 128 + 8 * dch)), c = __builtin_nontemporal_load((const u32x4*)(Oh + ((size_t)(16 + h) * HBR + bb + p2) * 128 + 8 * dch));
        u32x4 o;
#pragma unroll
        for (int e = 0; e < 4; ++e) o[e] = pk2(w0 * bf_lo(a[e]) + w1 * bf_lo(b[e]) + w2 * bf_lo(c[e]), w0 * bf_hi(a[e]) + w1 * bf_hi(b[e]) + w2 * bf_hi(c[e]));
        *(u32x4*)(MX + tg * 1024 + 8 * ch) = o;
    }
}
__device__ __forceinline__ float logsigmoid_f(float x) { return fminf(x, 0.f) - __logf(1.0f + __expf(-fabsf(x))); }
__device__ __forceinline__ void mlstm_pre_phase(const bf16* __restrict__ P2, const float* __restrict__ gates, const float* __restrict__ convw, const float* __restrict__ convb, const float* __restrict__ igb, const float* __restrict__ fgb,
                                                bf16* __restrict__ QKc, float* __restrict__ GA, float* __restrict__ GB, float* __restrict__ GP, float* __restrict__ CH, int G, int bid) {
    const int tid = threadIdx.x, lane = tid & 63, wave = tid >> 6;
    const int gt = bid * 512 + tid, NGT = G * 512;
    for (int it = gt; it < (T_TOK / 8) * 128; it += NGT) {
        const int ch = it & 127, tg = it >> 7; const int t0 = 8 * tg, sq0 = t0 & 2047; const int col = 8 * ch;
        float cw[4][8], cb[8];
#pragma unroll
        for (int q = 0; q < 2; ++q) { const f32x4 b4 = *(const f32x4*)(convb + col + 4 * q);
#pragma unroll
            for (int e = 0; e < 4; ++e) cb[4 * q + e] = b4[e];
#pragma unroll
            for (int j = 0; j < 4; ++j) { const f32x4 w4 = *(const f32x4*)(convw + j * 1024 + col + 4 * q);
#pragma unroll
                for (int e = 0; e < 4; ++e) cw[j][4 * q + e] = w4[e]; } }
        u32x4 rw[11];
#pragma unroll
        for (int i = 0; i < 11; ++i) { rw[i] = (u32x4){0u, 0u, 0u, 0u}; if (sq0 + i - 3 >= 0) rw[i] = *(const u32x4*)(P2 + (size_t)(t0 + i - 3) * 2048 + col); }
        const float ksc = (ch >= 64) ? 0.125f : 1.0f;
#pragma unroll
        for (int i = 0; i < 8; ++i) { u32x4 o;
#pragma unroll
            for (int e = 0; e < 4; ++e) { float x0 = cb[2 * e], x1 = cb[2 * e + 1];
#pragma unroll
                for (int j = 0; j < 4; ++j) { x0 += cw[j][2 * e] * bf_lo(rw[i + j][e]); x1 += cw[j][2 * e + 1] * bf_hi(rw[i + j][e]); }
                o[e] = pk2(silu_f(x0) * ksc, silu_f(x1) * ksc); }
            *(u32x4*)(QKc + (size_t)(t0 + i) * 1024 + col) = o; }
    }
    const int gw = bid * NWAVES + wave, NGW = G * NWAVES;
    for (int it = gw; it < NB * 32; it += NGW) {
        const int c = it & 31, b = it >> 5; const size_t t = (size_t)b * SEQ + 64 * c + lane;
        f32x4 g4[4];
#pragma unroll
        for (int q = 0; q < 4; ++q) g4[q] = *(const f32x4*)(gates + t * 16 + 4 * q);
        float bs[8], av[8], pm[8];
#pragma unroll
        for (int h = 0; h < 8; ++h) bs[h] = logsigmoid_f(g4[2 + (h >> 2)][h & 3] + fgb[h]);
#pragma unroll
        for (int o = 1; o < 64; o <<= 1) {
#pragma unroll
            for (int h = 0; h < 8; ++h) { const float v = __shfl_up(bs[h], o); if (lane >= o) bs[h] += v; } }
#pragma unroll
        for (int h = 0; h < 8; ++h) { av[h] = g4[h >> 2][h & 3] + igb[h] - bs[h]; pm[h] = av[h]; }
#pragma unroll
        for (int o = 1; o < 64; o <<= 1) {
#pragma unroll
            for (int h = 0; h < 8; ++h) { const float v = __shfl_up(pm[h], o); if (lane >= o) pm[h] = fmaxf(pm[h], v); } }
#pragma unroll
        for (int h = 0; h < 8; ++h) { const size_t o = (size_t)(b * 8 + h) * SEQ + 64 * c + lane; GA[o] = av[h]; GB[o] = bs[h]; GP[o] = pm[h];
            if (lane == 63) { const size_t cid = (size_t)(b * 8 + h) * 32 + c; CH[2 * cid] = bs[h]; CH[2 * cid + 1] = bs[h] + pm[h]; } }
    }
}
__device__ __forceinline__ void mlstm_scan_phase(LAS unsigned char* lds, const bf16* __restrict__ P2, const bf16* __restrict__ QKc, const float* __restrict__ GA, const float* __restrict__ CH,
                                                 bf16* __restrict__ Cst, float* __restrict__ nst, float* __restrict__ mst, int G, int bid) {
    const int tid = threadIdx.x, lane = tid & 63, w = __builtin_amdgcn_readfirstlane(tid >> 6), r = lane & 15, q4 = lane >> 4;
    const int dvb = w & 3, dkh = w >> 2;
    const bf16x8 ones = {0x3F80, 0x3F80, 0x3F80, 0x3F80, 0x3F80, 0x3F80, 0x3F80, 0x3F80};
    for (int item = bid; item < 256; item += G) {
        const int dvh = item & 1, h = (item >> 1) & 7, b = item >> 4;
        const size_t cid0 = (size_t)(b * 8 + h) * 32;
        f32x4 acc[2], accn[2]; acc[0] = (f32x4){0.f, 0.f, 0.f, 0.f}; acc[1] = acc[0]; accn[0] = acc[0]; accn[1] = acc[0];
        float mcar = 0.f;
        u32x4 nk, nv; float na, nbl, nml;
#define MSCAN_LOAD(c) do { const size_t t_ = (size_t)b * SEQ + 64 * (c) + lane; nk = *(const u32x4*)(QKc + t_ * 1024 + 512 + h * 64 + 8 * w); nv = *(const u32x4*)(P2 + t_ * 2048 + 1024 + h * 128 + 64 * dvh + 8 * w); \
            na = GA[(size_t)(b * 8 + h) * SEQ + 64 * (c) + lane]; nbl = CH[2 * (cid0 + (c))]; nml = CH[2 * (cid0 + (c)) + 1]; } while (0)
        MSCAN_LOAD(0);
        for (int c = 0; c < 32; ++c) {
            const u32x4 ck = nk, cv = nv; const float as = na, blast = nbl, mloc = nml;
            if (c + 1 < 32) MSCAN_LOAD(c + 1);
            const float mnew = fmaxf(blast + mcar, mloc);
            const float wsv = __expf(blast + as - mnew), carry = __expf(blast + mcar - mnew);
            const size_t cid = cid0 + c;
#pragma unroll
            for (int nb = 0; nb < 2; ++nb)
#pragma unroll
                for (int i = 0; i < 4; ++i) { const int dv = 64 * dvh + 16 * dvb + 4 * q4 + i, dk = 32 * dkh + 16 * nb + r;
                    Cst[(cid * 128 + dv) * 64 + dk] = (bf16)(pk2(acc[nb][i], 0.f) & 0xffffu); }
            if (dvh == 0 && dvb == 0 && q4 == 0) { nst[cid * 64 + 32 * dkh + r] = accn[0][0]; nst[cid * 64 + 32 * dkh + 16 + r] = accn[1][0]; }
            if (dvh == 0 && tid == 0) mst[cid] = mcar;
            LAS unsigned char* Kw = lds + (c & 1) * 18432; LAS unsigned char* Vs = Kw + 9216;
            u32x4 kw;
#pragma unroll
            for (int e = 0; e < 4; ++e) kw[e] = pk2(bf_lo(ck[e]) * wsv, bf_hi(ck[e]) * wsv);
            *(LAS u32x4*)(Kw + lane * 144 + 16 * w) = kw; *(LAS u32x4*)(Vs + lane * 144 + 16 * w) = cv;
            __syncthreads();
            acc[0] = acc[0] * carry; acc[1] = acc[1] * carry; accn[0] = accn[0] * carry; accn[1] = accn[1] * carry;
#pragma unroll
            for (int st = 0; st < 2; ++st) {
                const int rowb = (32 * st + 8 * q4 + (r >> 2)) * 144 + 8 * (r & 3);
                const s16x4 alo = tr_read(Vs + rowb + 32 * dvb), ahi = tr_read(Vs + rowb + 4 * 144 + 32 * dvb);
                const bf16x8 af = __builtin_shufflevector(alo, ahi, 0, 1, 2, 3, 4, 5, 6, 7);
#pragma unroll
                for (int nb = 0; nb < 2; ++nb) {
                    const s16x4 blo = tr_read(Kw + rowb + 64 * dkh + 32 * nb), bhi = tr_read(Kw + rowb + 4 * 144 + 64 * dkh + 32 * nb);
                    const bf16x8 bfr = __builtin_shufflevector(blo, bhi, 0, 1, 2, 3, 4, 5, 6, 7);
                    acc[nb] = MFMA16(af, bfr, acc[nb]);
                    if (dvb == 0) accn[nb] = MFMA16(ones, bfr, accn[nb]); }
            }
            mcar = mnew;
        }
        __syncthreads();
#undef MSCAN_LOAD
    }
}
__device__ __forceinline__ void mlstm_out_phase(LAS unsigned char* lds, const bf16* __restrict__ P2, const bf16* __restrict__ QKc, const bf16* __restrict__ OP, const float* __restrict__ GA, const float* __restrict__ GB, const float* __restrict__ GP,
                                                const float* __restrict__ hgain, const bf16* __restrict__ Cst, const float* __restrict__ nst, const float* __restrict__ mst, bf16* __restrict__ MX, int G, int bid) {
    const int tid = threadIdx.x, lane = tid & 63, w = __builtin_amdgcn_readfirstlane(tid >> 6), r = lane & 31, h2 = lane >> 5;
    const int dvb = w & 3, tb = w >> 2;
    constexpr int O_Q = 0, O_K = 9216, O_V = 18432, O_C = 38912, O_VEC = 57344, O_GN = 58368, O_PART = 58880, SETB = 59904;
    u32x4 pq, pk, pv0, pv1, pc0, pc1; float pvec = 0.f, pgn = 0.f, pmc = 0.f; u32x2 popv[4];
    pq = (u32x4){0u, 0u, 0u, 0u}; pk = pq; pv0 = pq; pv1 = pq; pc0 = pq; pc1 = pq;
#pragma unroll
    for (int gq = 0; gq < 4; ++gq) popv[gq] = (u32x2){0u, 0u};
#define OUT_LOAD(it) do { const int c_ = (it) & 31, h_ = ((it) >> 5) & 7, b_ = (it) >> 8; const size_t t0_ = (size_t)b_ * SEQ + 64 * c_; const size_t gb_ = (size_t)(b_ * 8 + h_) * SEQ + 64 * c_; \
        { const bf16* p_ = QKc + (t0_ + (tid >> 3)) * 1024 + h_ * 64 + 8 * (tid & 7); pq = *(const u32x4*)p_; pk = *(const u32x4*)(p_ + 512); } \
        { const bf16* p_ = P2 + (t0_ + (tid >> 4)) * 2048 + 1024 + h_ * 128 + 8 * (tid & 15); pv0 = *(const u32x4*)p_; pv1 = *(const u32x4*)(p_ + (size_t)32 * 2048); } \
        { const bf16* p_ = Cst + ((size_t)(it) * 128 + (tid >> 3)) * 64 + 8 * (tid & 7); pc0 = *(const u32x4*)p_; pc1 = *(const u32x4*)(p_ + 64 * 64); } \
        { const int wh_ = tid >> 6, ix_ = tid & 63; const float* src_ = (wh_ == 0) ? (GA + gb_) : (wh_ == 1) ? (GB + gb_) : (wh_ == 2) ? (GP + gb_) : (wh_ == 3) ? (nst + (size_t)(it) * 64) : (hgain + h_ * 128 + ((wh_ & 1) << 6)); pvec = src_[ix_]; } \
        pmc = mst[(it)]; \
        { const size_t orow_ = (t0_ + 32 * tb + r) * 1024 + h_ * 128 + 32 * dvb + 4 * h2; _Pragma("unroll") for (int gq = 0; gq < 4; ++gq) popv[gq] = *(const u32x2*)(OP + orow_ + 8 * gq); } } while (0)
    { const int fit = (bid < 4096) ? bid : 0; OUT_LOAD(fit); }
    int par = 0;
    for (int item = bid; item < 4096; item += G, par ^= 1) {
        const int c = item & 31, h = (item >> 5) & 7, b = item >> 8;
        const size_t t0 = (size_t)b * SEQ + 64 * c;
        LAS unsigned char* L = lds + par * SETB;
        LAS float* vec = (LAS float*)(L + O_VEC); LAS float* gnl = (LAS float*)(L + O_GN); LAS float* part = (LAS float*)(L + O_PART);
        *(LAS u32x4*)(L + O_Q + (tid >> 3) * 144 + (tid & 7) * 16) = pq; *(LAS u32x4*)(L + O_K + (tid >> 3) * 144 + (tid & 7) * 16) = pk;
        *(LAS u32x4*)(L + O_V + (tid >> 4) * 320 + (tid & 15) * 16) = pv0; *(LAS u32x4*)(L + O_V + (32 + (tid >> 4)) * 320 + (tid & 15) * 16) = pv1;
        *(LAS u32x4*)(L + O_C + (tid >> 3) * 144 + (tid & 7) * 16) = pc0; *(LAS u32x4*)(L + O_C + (64 + (tid >> 3)) * 144 + (tid & 7) * 16) = pc1;
        if (tid < 384) vec[tid] = pvec;
        const float mc = pmc; u32x2 opv[4];
#pragma unroll
        for (int gq = 0; gq < 4; ++gq) opv[gq] = popv[gq];
        __syncthreads();
        { const int nit = (item + G < 4096) ? item + G : item; OUT_LOAD(nit); }
        const int t = 32 * tb + r;
        const float Mt = fmaxf(mc, vec[128 + t]), bt = vec[64 + t];
        bf16x8 qf[4];
#pragma unroll
        for (int st = 0; st < 4; ++st) qf[st] = *(const LAS bf16x8*)(L + O_Q + t * 144 + (16 * st + 8 * h2) * 2);
        float qn = 0.f;
#pragma unroll
        for (int st = 0; st < 4; ++st) { const u32x4 qq = __builtin_bit_cast(u32x4, qf[st]); const f32x4 n0 = *(const LAS f32x4*)(vec + 192 + 16 * st + 8 * h2), n1 = *(const LAS f32x4*)(vec + 192 + 16 * st + 8 * h2 + 4);
#pragma unroll
            for (int e = 0; e < 2; ++e) { qn += bf_lo(qq[e]) * n0[2 * e] + bf_hi(qq[e]) * n0[2 * e + 1]; qn += bf_lo(qq[2 + e]) * n1[2 * e] + bf_hi(qq[2 + e]) * n1[2 * e + 1]; } }
        qn += __shfl_xor(qn, 32);
        f32x16 acc1, acc2;
#pragma unroll
        for (int i = 0; i < 16; ++i) { acc1[i] = 0.f; acc2[i] = 0.f; }
        float dsum = 0.f;
#pragma unroll
        for (int sb = 0; sb < 2; ++sb) {
            if (sb <= tb) {
                f32x16 S;
#pragma unroll
                for (int i = 0; i < 16; ++i) S[i] = 0.f;
#pragma unroll
                for (int st = 0; st < 4; ++st) { const bf16x8 kf = *(const LAS bf16x8*)(L + O_K + (32 * sb + r) * 144 + (16 * st + 8 * h2) * 2); S = MFMA32(kf, qf[st], S); }
#pragma unroll
                for (int gq = 0; gq < 4; ++gq) { const f32x4 a4 = *(const LAS f32x4*)(vec + 32 * sb + 8 * gq + 4 * h2);
#pragma unroll
                    for (int k = 0; k < 4; ++k) { const int i = 4 * gq + k, s = 32 * sb + 8 * gq + 4 * h2 + k; const float ev = __builtin_amdgcn_exp2f(fminf(a4[k] - Mt, 0.f) * 1.4426950408889634f);
                        const float wgt = (s <= t) ? ev : 0.f; S[i] = wgt * S[i]; dsum += S[i]; } }
#pragma unroll
                for (int sp = 0; sp < 2; ++sp) {
                    u32x4 wv; wv.x = pk2(S[8 * sp + 0], S[8 * sp + 1]); wv.y = pk2(S[8 * sp + 2], S[8 * sp + 3]); wv.z = pk2(S[8 * sp + 4], S[8 * sp + 5]); wv.w = pk2(S[8 * sp + 6], S[8 * sp + 7]);
                    const bf16x8 pfr = __builtin_bit_cast(bf16x8, wv);
                    const LAS unsigned char* vp = L + O_V + (32 * sb + 16 * sp + 4 * h2 + ((lane & 15) >> 2)) * 320 + (32 * dvb + 16 * ((lane >> 4) & 1) + 4 * (lane & 3)) * 2;
                    const s16x4 lo = tr_read(vp), hi = tr_read(vp + 8 * 320);
                    const bf16x8 af = __builtin_shufflevector(lo, hi, 0, 1, 2, 3, 4, 5, 6, 7);
                    acc1 = MFMA32(af, pfr, acc1);
                }
            }
        }
        dsum += __shfl_xor(dsum, 32);
#pragma unroll
        for (int st = 0; st < 4; ++st) { const bf16x8 cf = *(const LAS bf16x8*)(L + O_C + (32 * dvb + r) * 144 + (16 * st + 8 * h2) * 2); acc2 = MFMA32(cf, qf[st], acc2); }
        const float winter = __expf(mc - Mt);
        const float den = dsum + winter * qn;
        const float dnm = fmaxf(fabsf(den), __expf(-(bt + Mt)));
        const float idn = __builtin_amdgcn_rcpf(dnm);
        float hsq = 0.f;
#pragma unroll
        for (int i = 0; i < 16; ++i) { acc1[i] = (acc1[i] + winter * acc2[i]) * idn; hsq += acc1[i] * acc1[i]; }
        hsq += __shfl_xor(hsq, 32);
        if (h2 == 0) part[dvb * 64 + t] = hsq;
        __syncthreads();
        const float tot = (part[t] + part[64 + t]) + (part[128 + t] + part[192 + t]);
        const float rsn = __builtin_amdgcn_rsqf(tot * (1.0f / 128.0f) + RMS_EPS);
        const size_t orow = (t0 + t) * 1024 + h * 128 + 32 * dvb + 4 * h2;
#pragma unroll
        for (int gq = 0; gq < 4; ++gq) {
            const u32x2 op = opv[gq]; const f32x4 gn = *(const LAS f32x4*)(gnl + 32 * dvb + 4 * h2 + 8 * gq);
            const float y0 = acc1[4 * gq + 0] * rsn * gn[0] * sigmoid_f(bf_lo(op.x)), y1 = acc1[4 * gq + 1] * rsn * gn[1] * sigmoid_f(bf_hi(op.x));
            const float y2 = acc1[4 * gq + 2] * rsn * gn[2] * sigmoid_f(bf_lo(op.y)), y3 = acc1[4 * gq + 3] * rsn * gn[3] * sigmoid_f(bf_hi(op.y));
            u32x2 wv; wv.x = pk2(y0, y1); wv.y = pk2(y2, y3); *(u32x2*)(MX + orow + 8 * gq) = wv;
        }
    }
    __syncthreads();
#undef OUT_LOAD
}
__device__ __forceinline__ void final_phase(float* __restrict__ out, const float* __restrict__ ss, const float* __restrict__ gain, int G, int bid) {
    const int gt = bid * 512 + threadIdx.x, NGT = G * 512;
    for (int i = gt; i < T_TOK * 256; i += NGT) { const int t = i >> 8, c4 = i & 255; const float rs = rs_from_ss(ss[t]);
        f32x4 v = __builtin_nontemporal_load((const f32x4*)(out + (size_t)t * 1024 + 4 * c4)); const f32x4 gn = *(const f32x4*)(gain + 4 * c4); v = v * rs * gn; *(f32x4*)(out + (size_t)t * 1024 + 4 * c4) = v; }
}

__global__ void __launch_bounds__(NWAVES * 64, 2) mega_fwd(Args A) {
    extern __shared__ __attribute__((aligned(16))) unsigned char lds_raw[];
    LAS unsigned char* lds = (LAS unsigned char*)lds_raw;
    cg::grid_group grid = cg::this_grid();
    const int G = gridDim.x, bid = blockIdx.x;
    unsigned char* ws = A.ws;
    float* ss = (float*)(ws + WS_SS);
    bf16* hb = (bf16*)(ws + WS_HB); bf16* MX = (bf16*)(ws + WS_MX);
    bf16* QKVh = (bf16*)(ws + WS_BIG); float* H = (float*)(ws + WS_H); bf16* ACT = (bf16*)(ws + WS_ACT); bf16* P2 = (bf16*)(ws + WS_ACT);
    bf16* Oh = (bf16*)A.out; bf16* Cst = (bf16*)A.out; bf16* OP = (bf16*)A.out + (size_t)32 * 1024 * 1024;
    float* lse = (float*)(ws + WS_LSE); float* gates = (float*)(ws + WS_GATES); float* rope = (float*)(ws + WS_ROPE);
    float* mst = (float*)(ws + WS_MST); float* nst = (float*)(ws + WS_NST);
    bf16* QKc = hb;
    float* GA = (float*)(ws + 460 * MiB); float* GB = GA + (size_t)T_TOK * 8; float* GP = GB + (size_t)T_TOK * 8; float* CH = GP + (size_t)T_TOK * 8;
    const int lo = A.ph_lo, hi = A.ph_hi;
    volatile LAS unsigned* MISC = (volatile LAS unsigned*)(lds + LDS_BYTES - 256);
    if (threadIdx.x < 16) MISC[threadIdx.x] = 0u;
    __syncthreads();
    const XcdBarrier bar = xcd_barrier_post((unsigned*)(ws + WS_BAR), MISC + 8);
#ifndef PROBE_MASK
#define PROBE_MASK 0u
#endif
#define PROBE_K 4ull
    unsigned long long pr_sum = 0ull, pr_t0 = 0ull, pr_s0 = 0ull;
#define PB(k) do { if (PROBE_MASK & (1u << (k))) pr_t0 = __builtin_amdgcn_s_memrealtime(); } while (0)
#define PE(k) do { if (PROBE_MASK & (1u << (k))) pr_sum += __builtin_amdgcn_s_memrealtime() - pr_t0; } while (0)
#define IN(k) (lo <= (k) && (k) < hi)
#define SYNC(k) do { if (IN(k) && IN((k) + 1)) { if (PROBE_MASK & (1u << 30)) pr_s0 = __builtin_amdgcn_s_memrealtime(); if (hi < 0) { __threadfence(); grid.sync(); __threadfence(); } else xcd_barrier(bar); if (PROBE_MASK & (1u << 30)) pr_sum += __builtin_amdgcn_s_memrealtime() - pr_s0; if (PROBE_MASK & (1u << 29)) { pr_s0 = __builtin_amdgcn_s_memrealtime(); xcd_barrier(bar); pr_sum += __builtin_amdgcn_s_memrealtime() - pr_s0; } } PE(k); } while (0)
    PB(0); if (IN(0)) p0_prologue(A, lds, G, bid);
    SYNC(0);
    PB(1); if (IN(1)) { pg8::Gemm g{hb, (const bf16*)(ws + WS_WQKV), THALF, 9216, 1024}; pg8::StaticOrder S; S.init(THALF, 9216, G, bid);
        pg8::EpiQKV E{QKVh, ss, rope}; pg8::gemm_phase<pg8::EpiQKV, pg8::StaticOrder, true, true>(lds, g, S, E); }
    SYNC(1);
    PB(2); if (IN(2)) attn_phase(lds, QKVh, Oh, lse, 0, G, bid);
    SYNC(2);
    PB(3); if (IN(3)) { merge_phase(Oh, lse, MX, 0, G, bid);
        pg8::Gemm g{hb + (size_t)THALF * 1024, (const bf16*)(ws + WS_WQKV), THALF, 9216, 1024}; pg8::StaticOrder S; S.init(THALF, 9216, G, bid);
        pg8::EpiQKV E{QKVh, ss + THALF, rope + (size_t)THALF * 32}; pg8::gemm_phase<pg8::EpiQKV, pg8::StaticOrder, true, true>(lds, g, S, E); }
    SYNC(3);
    PB(4); if (IN(4)) attn_phase(lds, QKVh, Oh, lse, 1, G, bid);
    SYNC(4);
    PB(5); if (IN(5)) merge_phase(Oh, lse, MX, 1, G, bid);
    SYNC(5);
    PB(6); if (IN(6)) { pg8::Gemm g{MX, (const bf16*)(ws + WS_WAO), T_TOK, 1024, 1024}; pg8::StaticOrder S; S.init(T_TOK, 1024, G, bid);
        pg8::EpiResid E{A.x, H, hb, ss + T_TOK}; pg8::gemm_phase<pg8::EpiResid, pg8::StaticOrder, true, true>(lds, g, S, E); }
    SYNC(6);
    PB(7); if (IN(7)) { pg8::Gemm g{hb, (const bf16*)(ws + WS_WFFIN), T_TOK, 5632, 1024}; pg8::StaticOrder S; S.init(T_TOK, 5632, G, bid);
        pg8::EpiSwiGLU E{ACT, ss + T_TOK}; pg8::gemm_phase<pg8::EpiSwiGLU, pg8::StaticOrder, true, true>(lds, g, S, E); }
    SYNC(7);
    PB(8); if (IN(8)) { pg8::Gemm g{ACT, (const bf16*)(ws + WS_WFFOUT), T_TOK, 1024, DFF}; pg8::StaticOrder S; S.init(T_TOK, 1024, G, bid);
        pg8::EpiResid E{H, H, hb, ss + 2 * T_TOK}; pg8::gemm_phase<pg8::EpiResid, pg8::StaticOrder, true, true>(lds, g, S, E); }
    SYNC(8);
    PB(9); if (IN(9)) { pg8::Gemm g{hb, (const bf16*)(ws + WS_WMIN), T_TOK, 3328, 1024}; pg8::StaticOrder S; S.init(T_TOK, 3328, G, bid);
        pg8::EpiMlstmIn E{P2, OP, gates, ss + 2 * T_TOK}; pg8::gemm_phase<pg8::EpiMlstmIn, pg8::StaticOrder, true, true>(lds, g, S, E); }
    SYNC(9);
    PB(10); if (IN(10)) { mlstm_pre_phase(P2, gates, A.conv_w, A.conv_b, A.ig_bias, A.fg_bias, QKc, GA, GB, GP, CH, G, bid); xcd_barrier(bar);
        mlstm_scan_phase(lds, P2, QKc, GA, CH, Cst, nst, mst, G, bid); }
    SYNC(10);
    PB(11); if (IN(11)) mlstm_out_phase(lds, P2, QKc, OP, GA, GB, GP, A.head_gain, Cst, nst, mst, MX, G, bid);
    SYNC(11);
    PB(12); if (IN(12)) { pg8::Gemm g{MX, (const bf16*)(ws + WS_WMOUT), T_TOK, 1024, 1024}; pg8::StaticOrder S; S.init(T_TOK, 1024, G, bid);
        pg8::EpiResid E{H, H, hb, ss + 3 * T_TOK}; pg8::gemm_phase<pg8::EpiResid, pg8::StaticOrder, true, true>(lds, g, S, E); }
    SYNC(12);
    PB(13); if (IN(13)) { pg8::Gemm g{hb, (const bf16*)(ws + WS_WFFIN) + (size_t)5632 * 1024, T_TOK, 5632, 1024}; pg8::StaticOrder S; S.init(T_TOK, 5632, G, bid);
        pg8::EpiSwiGLU E{ACT, ss + 3 * T_TOK}; pg8::gemm_phase<pg8::EpiSwiGLU, pg8::StaticOrder, true, true>(lds, g, S, E); }
    SYNC(13);
    PB(14); if (IN(14)) { pg8::Gemm g{ACT, (const bf16*)(ws + WS_WFFOUT) + (size_t)1024 * DFF, T_TOK, 1024, DFF}; pg8::StaticOrder S; S.init(T_TOK, 1024, G, bid);
        pg8::EpiResid E{H, A.out, nullptr, ss + 4 * T_TOK}; pg8::gemm_phase<pg8::EpiResid, pg8::StaticOrder, true, true>(lds, g, S, E); }
    SYNC(14);
    PB(15); if (IN(15)) final_phase(A.out, ss + 4 * T_TOK, A.final_norm, G, bid);
    PE(15);
    if (PROBE_MASK != 0u && bid == 0 && threadIdx.x == 0) { const unsigned long long te = __builtin_amdgcn_s_memrealtime(); while (__builtin_amdgcn_s_memrealtime() - te < PROBE_K * pr_sum) __builtin_amdgcn_s_sleep(8); }
#undef IN
#undef SYNC
}

extern "C" void kernel_launch(void* const* d_in, const int* in_sizes, int n_in, void* d_out, int out_size, void* d_ws, size_t ws_size, hipStream_t stream) {
    static int grid = 0;
    if (grid == 0) {
        if (n_in != 17 || in_sizes[0] != T_TOK * DM || out_size != T_TOK * DM || ws_size < WS_END) { fprintf(stderr, "kernel_launch: unexpected shapes (n_in %d, in0 %d, out %d, ws %zu); nothing launched\n", n_in, n_in > 0 ? in_sizes[0] : -1, out_size, ws_size); grid = -1; return; }
        int dev = 0, cus = 0, per_cu = 0;
        if (hipGetDevice(&dev) != hipSuccess || hipDeviceGetAttribute(&cus, hipDeviceAttributeMultiprocessorCount, dev) != hipSuccess) { grid = -1; return; }
        if (hipFuncSetAttribute((const void*)mega_fwd, hipFuncAttributeMaxDynamicSharedMemorySize, LDS_BYTES) != hipSuccess) { fprintf(stderr, "kernel_launch: hipFuncSetAttribute failed\n"); grid = -1; return; }
        if (hipOccupancyMaxActiveBlocksPerMultiprocessor(&per_cu, (const void*)mega_fwd, NWAVES * 64, LDS_BYTES) != hipSuccess || per_cu < 1) { fprintf(stderr, "kernel_launch: occupancy query says %d\n", per_cu); per_cu = 1; }
        (void)hipGetLastError();
        grid = cus;
    }
    if (grid < 0) return;
    Args a{};
    a.x = (const float*)d_in[0]; a.pos = (const int*)d_in[1]; a.attn_norm = (const float*)d_in[2]; a.attn_w_in = (const float*)d_in[3]; a.attn_w_out = (const float*)d_in[4];
    a.mlstm_norm = (const float*)d_in[5]; a.mlstm_w_in = (const float*)d_in[6]; a.conv_w = (const float*)d_in[7]; a.conv_b = (const float*)d_in[8]; a.ig_bias = (const float*)d_in[9];
    a.fg_bias = (const float*)d_in[10]; a.head_gain = (const float*)d_in[11]; a.mlstm_w_out = (const float*)d_in[12]; a.ffn_norm = (const float*)d_in[13]; a.ffn_w_in = (const float*)d_in[14];
    a.ffn_w_out = (const float*)d_in[15]; a.final_norm = (const float*)d_in[16];
    a.out = (float*)d_out; a.ws = (unsigned char*)d_ws; a.ph_lo = 0; a.ph_hi = 16;
    if (hipMemsetAsync((char*)d_ws + WS_BAR, 0, 16384, stream) != hipSuccess) { fprintf(stderr, "kernel_launch: hipMemsetAsync failed\n"); return; }
    void* args[] = {&a};
    const hipError_t e = hipLaunchCooperativeKernel((const void*)mega_fwd, dim3(grid), dim3(NWAVES * 64), args, LDS_BYTES, stream);
    if (e != hipSuccess) fprintf(stderr, "kernel_launch: cooperative launch failed: %s (grid %d)\n", hipGetErrorString(e), grid);
}
```

```cpp
#include <hip/hip_runtime.h>
#include <hip/hip_cooperative_groups.h>
#include <cstdio>
#include <cstdint>
namespace cg = cooperative_groups;

constexpr float RMS_EPS = 1e-6f;
__device__ __forceinline__ float rs_from_ss(float ss) { return __builtin_amdgcn_rsqf(ss * (1.0f / 1024.0f) + RMS_EPS); }
__device__ __forceinline__ float silu_f(float x) { return x * __builtin_amdgcn_rcpf(1.0f + __builtin_amdgcn_exp2f(x * -1.4426950408889634f)); }
__device__ __forceinline__ float sigmoid_f(float x) { return __builtin_amdgcn_rcpf(1.0f + __builtin_amdgcn_exp2f(x * -1.4426950408889634f)); }

namespace pg8 {
#define PG8_LAS __attribute__((address_space(3)))
typedef unsigned short bf16_t;
typedef short bf16x8 __attribute__((ext_vector_type(8)));
typedef float f32x4 __attribute__((ext_vector_type(4)));
typedef unsigned u32x4 __attribute__((ext_vector_type(4)));
constexpr int BM = 256, BK = 64, HALF = 128, HTB = HALF * BK * 2  , STAGE_BYTES = 8 * HTB, NXCD = 8, WGM = 8;

__host__ __device__ __forceinline__ int lds_byte(int r, int c) { const int st = (r >> 4) * 2 + (c >> 5), rr = r & 15, cc = c & 31, ob = rr * 64 + cc * 2; return st * 1024 + (ob ^ (((ob >> 9) & 1) << 5)); }
__host__ __device__ __forceinline__ void stage_rc(int b, int& R, int& C) { const int st = b / 1024, sb = b % 1024, swz = sb ^ (((sb >> 9) & 1) << 5); R = (st >> 1) * 16 + swz / 64; C = (st & 1) * 32 + (swz % 64) / 2; }
__host__ __device__ __forceinline__ int perm32(int rho) { const int n = rho >> 4, i = rho & 15; return 8 * (i >> 2) + 4 * n + (i & 3); }

typedef unsigned u32x2 __attribute__((ext_vector_type(2)));
struct Unit { int pm, pn; };
struct Gemm { const bf16_t* A; const bf16_t* Bt; int M, N, K; };

struct StaticOrder {
    int nM, nN, nwg, G, c;
    __host__ __device__ void init(int M, int N, int G_, int c_) { nM = M / BM; nN = N / BM; nwg = nM * nN; G = G_; c = c_; }
    __host__ __device__ bool next(int i, Unit& u) const {
        const long L = (long)i * G + c; if (L >= nwg) return false;
        int wgid = (int)L; { const int q = nwg / NXCD, r = nwg % NXCD, xcd = wgid % NXCD, off = wgid / NXCD; wgid = (xcd < r ? xcd * (q + 1) : r * (q + 1) + (xcd - r) * q) + off; }
        const int nig = WGM * nN, gid = wgid / nig, fm = gid * WGM, gsz = (nM - fm) < WGM ? (nM - fm) : WGM;
        u.pm = fm + ((wgid % nig) % gsz); u.pn = (wgid % nig) / gsz; return true;
    }
    __device__ __forceinline__ void a_ready(const Unit&) const {}
    __device__ __forceinline__ void done(const Unit&) const {}
};
__device__ __forceinline__ unsigned cvt_pk_bf16(float lo, float hi) { unsigned r; asm volatile("v_cvt_pk_bf16_f32 %0, %1, %2" : "=v"(r) : "v"(lo), "v"(hi)); return r; }

#define EPI_FENCE() asm volatile("" ::: "memory")
struct EpiQKV {
    static constexpr bool PERM = true, AFTER_DRAIN = false;
    bf16_t* O; const float* ss; const float* cs;
    __device__ __forceinline__ void operator()(const f32x4 (&acc)[2][2][4][2], const Unit& u, int wr, int wc, int fr, int fq) const {
        const int row0 = u.pm * BM + wr * 64 + fr; const int colt = u.pn * BM;
        const int tsel = (colt % 3072) / 1024;
        const bool rope = (tsel < 2) && (wc == 0);
        const int gsel = colt / 3072, lg = 2 * gsel, dil = 1 << lg;
        const int hb0 = (gsel * 3 + tsel) * 8 + (colt % 1024) / 128;
        float rsv[8];
#pragma unroll
        for (int k = 0; k < 8; ++k) rsv[k] = ss[row0 + (k >> 2) * HALF + (k & 3) * 16];
        f32x4 cA = {0.f, 0.f, 0.f, 0.f}, sA = cA;
        if (rope) { const float* p = cs + (size_t)row0 * 32 + 4 * fq; cA = *(const f32x4*)p; sA = *(const f32x4*)(p + 16); }
#pragma unroll
        for (int k = 0; k < 8; ++k) {
            const int ai = k >> 2, m = k & 3;
            const int row = row0 + ai * HALF + m * 16;
            f32x4 cN = cA, sN = sA;
            if (rope && k + 1 < 8) { const int rown = row0 + ((k + 1) >> 2) * HALF + ((k + 1) & 3) * 16; const float* p = cs + (size_t)rown * 32 + 4 * fq; cN = *(const f32x4*)p; sN = *(const f32x4*)(p + 16); }
            EPI_FENCE();
            const float rs = rs_from_ss(rsv[k]);
            const int sq = row & 2047, perm = ((sq & (dil - 1)) << (11 - lg)) + (sq >> lg);
            bf16_t* rowp = O + ((size_t)hb0 * 17408 + (row >> 11) * 2176 + perm) * 128;
            if (rope) {
                const f32x4 cr = cA * rs, sr = sA * rs;
#pragma unroll
                for (int bj = 0; bj < 2; ++bj) {
                    const f32x4 v0 = acc[ai][bj][m][0], v1 = acc[ai][bj][m][1];
                    const f32x4 o0 = v0 * cr - v1 * sr, o1 = v1 * cr + v0 * sr;
                    u32x2 w0, w1; w0.x = cvt_pk_bf16(o0[0], o0[1]); w0.y = cvt_pk_bf16(o0[2], o0[3]); w1.x = cvt_pk_bf16(o1[0], o1[1]); w1.y = cvt_pk_bf16(o1[2], o1[3]);
                    bf16_t* hp = rowp + (size_t)bj * 17408 * 128 + 4 * fq;
                    *(u32x2*)hp = w0; *(u32x2*)(hp + 16) = w1;
                }
            } else {
#pragma unroll
                for (int bj = 0; bj < 2; ++bj) {
                    const f32x4 v0 = acc[ai][bj][m][0] * rs, v1 = acc[ai][bj][m][1] * rs;
                    u32x4 wv; wv.x = cvt_pk_bf16(v0[0], v0[1]); wv.y = cvt_pk_bf16(v0[2], v0[3]); wv.z = cvt_pk_bf16(v1[0], v1[1]); wv.w = cvt_pk_bf16(v1[2], v1[3]);
                    *(u32x4*)(rowp + (size_t)bj * 17408 * 128 + wc * 32 + 8 * fq) = wv;
                }
            }
            cA = cN; sA = sN;
        }
    }
};
struct EpiResid {
    static constexpr bool PERM = true, AFTER_DRAIN = false;
    const float* base; float* out; bf16_t* outb; float* ssn;
    __device__ __forceinline__ void operator()(const f32x4 (&acc)[2][2][4][2], const Unit& u, int wr, int wc, int fr, int fq) const {
        const int row0 = u.pm * BM + wr * 64 + fr; const int col0 = u.pn * BM + wc * 32 + 8 * fq;
        f32x4 bA[4];
        { const float* p = base + (size_t)row0 * 1024 + col0; bA[0] = __builtin_nontemporal_load((const f32x4*)p); bA[1] = __builtin_nontemporal_load((const f32x4*)(p + 4)); bA[2] = __builtin_nontemporal_load((const f32x4*)(p + HALF)); bA[3] = __builtin_nontemporal_load((const f32x4*)(p + HALF + 4)); }
#pragma unroll
        for (int k = 0; k < 8; ++k) {
            const int ai = k >> 2, m = k & 3;
            const int row = row0 + ai * HALF + m * 16;
            f32x4 bN[4];
#pragma unroll
            for (int q = 0; q < 4; ++q) bN[q] = bA[q];
            if (k + 1 < 8) { const int rown = row0 + ((k + 1) >> 2) * HALF + ((k + 1) & 3) * 16; const float* p = base + (size_t)rown * 1024 + col0;
                bN[0] = __builtin_nontemporal_load((const f32x4*)p); bN[1] = __builtin_nontemporal_load((const f32x4*)(p + 4)); bN[2] = __builtin_nontemporal_load((const f32x4*)(p + HALF)); bN[3] = __builtin_nontemporal_load((const f32x4*)(p + HALF + 4)); }
            EPI_FENCE();
            float sq = 0.f;
#pragma unroll
            for (int bj = 0; bj < 2; ++bj) {
                const size_t off = (size_t)row * 1024 + col0 + bj * HALF;
                const f32x4 v0 = acc[ai][bj][m][0] + bA[2 * bj], v1 = acc[ai][bj][m][1] + bA[2 * bj + 1];
                *(f32x4*)(out + off) = v0; *(f32x4*)(out + off + 4) = v1;
                if (outb) { u32x4 wv; wv.x = cvt_pk_bf16(v0[0], v0[1]); wv.y = cvt_pk_bf16(v0[2], v0[3]); wv.z = cvt_pk_bf16(v1[0], v1[1]); wv.w = cvt_pk_bf16(v1[2], v1[3]); *(u32x4*)(outb + off) = wv; }
                sq += (v0[0] * v0[0] + v0[1] * v0[1]) + (v0[2] * v0[2] + v0[3] * v0[3]) + (v1[0] * v1[0] + v1[1] * v1[1]) + (v1[2] * v1[2] + v1[3] * v1[3]);
            }
            sq += __shfl_xor(sq, 16); sq += __shfl_xor(sq, 32);
            if (fq == 0) atomicAdd(ssn + row, sq);
#pragma unroll
            for (int q = 0; q < 4; ++q) bA[q] = bN[q];
        }
    }
};
struct EpiSwiGLU {
    static constexpr bool PERM = true, AFTER_DRAIN = false;
    bf16_t* O; const float* ss;
    __device__ __forceinline__ void operator()(const f32x4 (&acc)[2][2][4][2], const Unit& u, int wr, int wc, int fr, int fq) const {
        const int row0 = u.pm * BM + wr * 64 + fr; const int col0 = u.pn * HALF + wc * 32 + 8 * fq;
        float rsv[8];
#pragma unroll
        for (int k = 0; k < 8; ++k) rsv[k] = ss[row0 + (k >> 2) * HALF + (k & 3) * 16];
        EPI_FENCE();
#pragma unroll
        for (int ai = 0; ai < 2; ++ai)
#pragma unroll
            for (int m = 0; m < 4; ++m) {
                const int row = row0 + ai * HALF + m * 16;
                const float rs = rs_from_ss(rsv[ai * 4 + m]); const float rs2 = rs * rs, nrs = rs * -1.4426950408889634f;
                float o[8];
#pragma unroll
                for (int n = 0; n < 2; ++n)
#pragma unroll
                    for (int e = 0; e < 4; ++e) { const float g = acc[ai][0][m][n][e], uu = acc[ai][1][m][n][e] * rs2;
                        o[4 * n + e] = (g * uu) * __builtin_amdgcn_rcpf(1.0f + __builtin_amdgcn_exp2f(g * nrs)); }
                u32x4 wv; wv.x = cvt_pk_bf16(o[0], o[1]); wv.y = cvt_pk_bf16(o[2], o[3]); wv.z = cvt_pk_bf16(o[4], o[5]); wv.w = cvt_pk_bf16(o[6], o[7]);
                *(u32x4*)(O + (size_t)row * 2816 + col0) = wv;
            }
    }
};
struct EpiMlstmIn {
    static constexpr bool PERM = true, AFTER_DRAIN = false;
    bf16_t* P2; bf16_t* OP; float* gates; const float* ss;
    __device__ __forceinline__ void operator()(const f32x4 (&acc)[2][2][4][2], const Unit& u, int wr, int wc, int fr, int fq) const {
        const int row0 = u.pm * BM + wr * 64 + fr;
        float rsv[8];
#pragma unroll
        for (int k = 0; k < 8; ++k) rsv[k] = ss[row0 + (k >> 2) * HALF + (k & 3) * 16];
        EPI_FENCE();
#pragma unroll
        for (int ai = 0; ai < 2; ++ai)
#pragma unroll
            for (int m = 0; m < 4; ++m) {
                const int row = row0 + ai * HALF + m * 16;
                const float rs = rs_from_ss(rsv[ai * 4 + m]);
#pragma unroll
                for (int bj = 0; bj < 2; ++bj) {
                    const int cb = u.pn * BM + bj * HALF;
                    const f32x4 v0 = acc[ai][bj][m][0] * rs, v1 = acc[ai][bj][m][1] * rs;
                    const int cc = wc * 32 + 8 * fq;
                    if (cb < 3072) {
                        u32x4 wv; wv.x = cvt_pk_bf16(v0[0], v0[1]); wv.y = cvt_pk_bf16(v0[2], v0[3]); wv.z = cvt_pk_bf16(v1[0], v1[1]); wv.w = cvt_pk_bf16(v1[2], v1[3]);
                        bf16_t* dst = (cb < 2048) ? (P2 + (size_t)row * 2048 + cb + cc) : (OP + (size_t)row * 1024 + (cb - 2048) + cc);
                        *(u32x4*)dst = wv;
                    } else if (cb == 3072 && cc < 16) {
                        float* dst = gates + (size_t)row * 16 + cc;
                        *(f32x4*)dst = v0; *(f32x4*)(dst + 4) = v1;
                    }
                }
            }
    }
};

template <class Epi, class Sched, bool ALIGN_EPI = false, bool SP2 = false>
__device__ __forceinline__ void gemm_phase(PG8_LAS unsigned char* lds, const Gemm g, const Sched& S, const Epi& E) {
    const int tid = threadIdx.x, wid = __builtin_amdgcn_readfirstlane(tid >> 6), lane = tid & 63, wr = wid >> 2, wc = wid & 3, fr = lane & 15, fq = lane >> 4;
    const int K = g.K, nt = K / BK;
    unsigned voffA[2], voffB[2];
#pragma unroll
    for (int i = 0; i < 2; ++i) { int R, C; stage_rc(tid * 16 + i * 8192, R, C); const int Rb = Epi::PERM ? ((R & ~31) + perm32(R & 31)) : R;
        voffA[i] = (unsigned)(R * K + C) * 2u; voffB[i] = (unsigned)(Rb * K + C) * 2u; }
    const size_t kstep = (size_t)(BK * 2);
    const size_t hstep = (size_t)HALF * K * 2;
    const size_t tstep = 2 * hstep;
    const unsigned ldsw = (unsigned)wid * 1024u;
    const int aoff = lds_byte(wr * 64 + fr, fq * 8), boff = lds_byte(wc * 32 + fr, fq * 8);
#define PG8_SA(b, h) (((b) * 2 + (h)) * HTB)
#define PG8_SB(b, h) ((4 + (b) * 2 + (h)) * HTB)
#define PG8_STAGE(bufoff, gbase, voff) do { _Pragma("unroll") for (int _i = 0; _i < 2; ++_i) \
        __builtin_amdgcn_global_load_lds((const unsigned*)((const char*)(gbase) + (voff)[_i]), (PG8_LAS unsigned*)(lds + (bufoff) + ldsw + _i * 8192), 16, 0, 0); } while (0)
#define PG8_LDA(dst, b, h) do { _Pragma("unroll") for (int m = 0; m < 4; ++m) _Pragma("unroll") for (int k = 0; k < 2; ++k) dst[m][k] = *(const PG8_LAS bf16x8*)(lds + PG8_SA(b, h) + aoff + m * 2048 + k * 1024); } while (0)
#define PG8_LDB(dst, b, h) do { _Pragma("unroll") for (int n = 0; n < 2; ++n) _Pragma("unroll") for (int k = 0; k < 2; ++k) dst[n][k] = *(const PG8_LAS bf16x8*)(lds + PG8_SB(b, h) + boff + n * 2048 + k * 1024); } while (0)
#define PG8_MMA(ai, bj, At, Bt) do { __builtin_amdgcn_s_setprio(1); _Pragma("unroll") for (int m = 0; m < 4; ++m) _Pragma("unroll") for (int n = 0; n < 2; ++n) _Pragma("unroll") for (int k = 0; k < 2; ++k) \
        acc[ai][bj][m][n] = __builtin_amdgcn_mfma_f32_16x16x32_bf16(Bt[n][k], At[m][k], acc[ai][bj][m][n], 0, 0, 0); __builtin_amdgcn_s_setprio(0); } while (0)
#define PG8_WAIT_V(n) asm volatile("s_waitcnt vmcnt(" #n ")" ::: "memory")
#define PG8_WAIT_L(n) asm volatile("s_waitcnt lgkmcnt(" #n ")" ::: "memory")
#define PG8_BAR __builtin_amdgcn_s_barrier()
#define PG8_SCHED __builtin_amdgcn_sched_barrier(0)
    Unit cur, nxt; int ui = 0;
    if (!S.next(0, cur)) return;
    f32x4 acc[2][2][4][2];
#pragma unroll
    for (int a = 0; a < 2; ++a)
#pragma unroll
        for (int b = 0; b < 2; ++b)
#pragma unroll
            for (int m = 0; m < 4; ++m)
#pragma unroll
                for (int n = 0; n < 2; ++n) acc[a][b][m][n] = (f32x4){0.f, 0.f, 0.f, 0.f};
    bf16x8 At[4][2], B0[2][2], B1[2][2];
    const char* cA = (const char*)g.A + (size_t)cur.pm * tstep; const char* cB = (const char*)g.Bt + (size_t)cur.pn * tstep;
    S.a_ready(cur);
    if constexpr (SP2) {
        PG8_STAGE(PG8_SB(0, 0), cB, voffB); PG8_STAGE(PG8_SB(0, 1), cB + hstep, voffB); PG8_STAGE(PG8_SA(0, 0), cA, voffA); PG8_STAGE(PG8_SA(0, 1), cA + hstep, voffA);
        if (wr == 1) PG8_BAR;
        PG8_WAIT_V(2); PG8_BAR;
        PG8_STAGE(PG8_SB(1, 0), cB + kstep, voffB); PG8_STAGE(PG8_SA(1, 0), cA + kstep, voffA); PG8_STAGE(PG8_SB(1, 1), cB + hstep + kstep, voffB);
        PG8_WAIT_V(6); PG8_BAR;
    } else {
        PG8_STAGE(PG8_SB(0, 0), cB, voffB); PG8_STAGE(PG8_SA(0, 0), cA, voffA); PG8_STAGE(PG8_SB(0, 1), cB + hstep, voffB); PG8_STAGE(PG8_SA(0, 1), cA + hstep, voffA);
        if (wr == 1) PG8_BAR;
        PG8_WAIT_V(4); PG8_BAR;
        PG8_STAGE(PG8_SB(1, 0), cB + kstep, voffB); PG8_STAGE(PG8_SA(1, 0), cA + kstep, voffA); PG8_STAGE(PG8_SB(1, 1), cB + hstep + kstep, voffB);
        PG8_WAIT_V(6); PG8_BAR;
    }
    for (;;) {
        const bool has_next = S.next(ui + 1, nxt);
        const char* nA = has_next ? (const char*)g.A + (size_t)nxt.pm * tstep : cA; const char* nB = has_next ? (const char*)g.Bt + (size_t)nxt.pn * tstep : cB;
        for (int t = 0; t < nt; t += 2) {
            const bool last = (t == nt - 2);
            const char* a1 = cA + (size_t)(t + 1) * kstep;
            const char* a2 = last ? nA : cA + (size_t)(t + 2) * kstep; const char* b2 = last ? nB : cB + (size_t)(t + 2) * kstep;
            const char* a3 = a2 + kstep; const char* b3 = b2 + kstep;
            if (last && has_next) S.a_ready(nxt);
            if constexpr (SP2) {
            PG8_LDB(B0, 0, 0); PG8_LDB(B1, 0, 1); PG8_SCHED; PG8_LDA(At, 0, 0); PG8_STAGE(PG8_SA(1, 1), a1 + hstep, voffA);
            PG8_WAIT_V(8); PG8_WAIT_L(0); PG8_BAR; PG8_MMA(0, 0, At, B0); PG8_MMA(0, 1, At, B1); PG8_BAR; PG8_SCHED;
            PG8_LDA(At, 0, 1); PG8_STAGE(PG8_SB(0, 0), b2, voffB); PG8_STAGE(PG8_SB(0, 1), b2 + hstep, voffB); PG8_STAGE(PG8_SA(0, 0), a2, voffA);
            PG8_WAIT_V(8); PG8_WAIT_L(0); PG8_BAR; PG8_MMA(1, 0, At, B0); PG8_MMA(1, 1, At, B1); PG8_BAR; PG8_SCHED;
            PG8_LDB(B0, 1, 0); PG8_LDB(B1, 1, 1); PG8_SCHED; PG8_LDA(At, 1, 0); PG8_STAGE(PG8_SA(0, 1), a2 + hstep, voffA);
            PG8_WAIT_V(8); PG8_WAIT_L(0); PG8_BAR; PG8_MMA(0, 0, At, B0); PG8_MMA(0, 1, At, B1); PG8_BAR; PG8_SCHED;
            PG8_LDA(At, 1, 1); PG8_STAGE(PG8_SB(1, 0), b3, voffB); PG8_STAGE(PG8_SB(1, 1), b3 + hstep, voffB); PG8_STAGE(PG8_SA(1, 0), a3, voffA);
            PG8_WAIT_V(8); PG8_WAIT_L(0); PG8_BAR; PG8_MMA(1, 0, At, B0); PG8_MMA(1, 1, At, B1); PG8_BAR; PG8_SCHED;
            } else {
            PG8_LDB(B0, 0, 0); PG8_SCHED; PG8_LDA(At, 0, 0); PG8_STAGE(PG8_SA(1, 1), a1 + hstep, voffA);
            PG8_WAIT_L(8); PG8_BAR; PG8_WAIT_L(0); PG8_MMA(0, 0, At, B0); PG8_BAR; PG8_SCHED;
            PG8_LDB(B1, 0, 1); PG8_STAGE(PG8_SB(0, 0), b2, voffB);
            PG8_BAR; PG8_WAIT_L(0); PG8_MMA(0, 1, At, B1); PG8_BAR;
            PG8_LDA(At, 0, 1); PG8_STAGE(PG8_SA(0, 0), a2, voffA);
            PG8_BAR; PG8_WAIT_L(0); PG8_MMA(1, 0, At, B0); PG8_BAR; PG8_SCHED;
            PG8_STAGE(PG8_SB(0, 1), b2 + hstep, voffB);
            PG8_WAIT_V(6); PG8_BAR; PG8_MMA(1, 1, At, B1); PG8_BAR;
            PG8_LDB(B0, 1, 0); PG8_SCHED; PG8_LDA(At, 1, 0); PG8_STAGE(PG8_SA(0, 1), a2 + hstep, voffA);
            PG8_WAIT_L(8); PG8_BAR; PG8_WAIT_L(0); PG8_MMA(0, 0, At, B0); PG8_BAR; PG8_SCHED;
            PG8_LDB(B1, 1, 1); PG8_STAGE(PG8_SB(1, 0), b3, voffB);
            PG8_BAR; PG8_WAIT_L(0); PG8_MMA(0, 1, At, B1); PG8_BAR;
            PG8_LDA(At, 1, 1); PG8_STAGE(PG8_SA(1, 0), a3, voffA);
            PG8_BAR; PG8_WAIT_L(0); PG8_MMA(1, 0, At, B0); PG8_BAR; PG8_SCHED;
            PG8_STAGE(PG8_SB(1, 1), b3 + hstep, voffB);
            PG8_WAIT_V(6); PG8_BAR; PG8_MMA(1, 1, At, B1); PG8_BAR;
            }
        }
        if constexpr (ALIGN_EPI) { if (wr == 0) PG8_BAR; }
        if constexpr (!Epi::AFTER_DRAIN) { E(acc, cur, wr, wc, fr, fq); S.done(cur); }
        if (!has_next) break;
#pragma unroll
        for (int a = 0; a < 2; ++a)
#pragma unroll
            for (int b = 0; b < 2; ++b)
#pragma unroll
                for (int m = 0; m < 4; ++m)
#pragma unroll
                    for (int n = 0; n < 2; ++n) acc[a][b][m][n] = (f32x4){0.f, 0.f, 0.f, 0.f};
        cur = nxt; cA = nA; cB = nB; ++ui;
        if constexpr (ALIGN_EPI) { if (wr == 1) PG8_BAR; }
    }
    PG8_WAIT_V(0);
    if constexpr (!ALIGN_EPI) { if (wr == 0) PG8_BAR; }
    PG8_BAR;
    if constexpr (Epi::AFTER_DRAIN) { E.fused(acc, cur, wr, wc, fr, fq, lds, wid, lane); S.done(cur); }
#undef PG8_SA
#undef PG8_SB
#undef PG8_STAGE
#undef PG8_LDA
#undef PG8_LDB
#undef PG8_MMA
#undef PG8_WAIT_V
#undef PG8_WAIT_L
#undef PG8_BAR
#undef PG8_SCHED
}
}

constexpr int T_TOK = 32768, DM = 1024, SEQ = 2048, NB = 16, DFF = 2816, THALF = 16384;
constexpr int NWAVES = 8;
constexpr int RB = 2176, HBR = 8 * RB;
constexpr int LDS_BYTES = 147456;
constexpr size_t MiB = 1u << 20;
constexpr size_t WS_SS = 0;
constexpr size_t WS_MST = 1 * MiB;
constexpr size_t WS_NST = 1 * MiB + 65536;
constexpr size_t WS_BAR = 3 * MiB;
constexpr size_t WS_WQKV = 4 * MiB;
constexpr size_t WS_WAO = 22 * MiB;
constexpr size_t WS_WFFIN = 24 * MiB;
constexpr size_t WS_WFFOUT = 46 * MiB;
constexpr size_t WS_WMIN = 57 * MiB;
constexpr size_t WS_WMOUT = 64 * MiB;
constexpr size_t WS_ROPE = 66 * MiB;
constexpr size_t WS_LSE = 70 * MiB;
constexpr size_t WS_GATES = 73 * MiB;
constexpr size_t WS_HB = 76 * MiB;
constexpr size_t WS_MX = 140 * MiB;
constexpr size_t WS_BIG = 204 * MiB;
constexpr size_t WS_H = WS_BIG;
constexpr size_t WS_ACT = WS_BIG + 128 * MiB;
constexpr size_t WS_END = 512 * MiB;
static_assert(WS_ACT + (size_t)T_TOK * DFF * 2 <= WS_END && WS_BIG + (size_t)72 * 8 * 2176 * 256 <= WS_END, "d_ws map");

#define LAS __attribute__((address_space(3)))
typedef unsigned short bf16;
typedef unsigned u32x4 __attribute__((ext_vector_type(4)));
typedef unsigned u32x2 __attribute__((ext_vector_type(2)));
typedef float f32x4 __attribute__((ext_vector_type(4)));
typedef float f32x16 __attribute__((ext_vector_type(16)));
typedef short bf16x8 __attribute__((ext_vector_type(8)));
typedef short s16x4 __attribute__((ext_vector_type(4)));
typedef float f32x2_t __attribute__((ext_vector_type(2)));
typedef __bf16 bf16x2_t __attribute__((ext_vector_type(2)));
__device__ __forceinline__ unsigned pk2(float lo, float hi) { f32x2_t v = {lo, hi}; bf16x2_t b = __builtin_convertvector(v, bf16x2_t); return __builtin_bit_cast(unsigned, b); }
__device__ __forceinline__ float bf_lo(unsigned w) { return __uint_as_float(w << 16); }
__device__ __forceinline__ float bf_hi(unsigned w) { return __uint_as_float(w & 0xffff0000u); }
__device__ __forceinline__ float wave_sum(float v) {
#pragma unroll
    for (int o = 1; o < 64; o <<= 1) v += __shfl_xor(v, o);
    return v;
}
__device__ __forceinline__ float wave_max(float v) {
#pragma unroll
    for (int o = 1; o < 64; o <<= 1) v = fmaxf(v, __shfl_xor(v, o));
    return v;
}
#define MFMA16(a, b, c) __builtin_amdgcn_mfma_f32_16x16x32_bf16((a), (b), (c), 0, 0, 0)
#define MFMA32(a, b, c) __builtin_amdgcn_mfma_f32_32x32x16_bf16((a), (b), (c), 0, 0, 0)

#define XB_TMO      128
#define XB_XCNT(j)  (256  + 64 * (j))
#define XB_XSUB(j)  (1280 + 64 * (j))
#define XB_XGEN(j)  (2304 + 64 * (j))
#define XB_TOP      3328
#define XB_TOPGEN   3392
#define XCD_BAR_WORDS 3456
#define XB_SPIN_CAP (1u << 18)

__device__ __forceinline__ unsigned xb_ld(unsigned* p)              { return __hip_atomic_load(p, __ATOMIC_RELAXED, __HIP_MEMORY_SCOPE_AGENT); }
__device__ __forceinline__ unsigned xb_add(unsigned* p, unsigned v) { return __hip_atomic_fetch_add(p, v, __ATOMIC_RELAXED, __HIP_MEMORY_SCOPE_AGENT); }
__device__ __forceinline__ unsigned xb_xcc_id() { return (unsigned)__builtin_amdgcn_s_getreg((3 << 11) | 20) & 0xFu; }
#define XB_SPIN(cond, bar) do { unsigned _sp = 0; while (cond) { __builtin_amdgcn_s_sleep(1); \
    if ((++_sp & 255u) == 0u) { if (xb_ld(&(bar)[XB_TMO])) break; if (_sp > XB_SPIN_CAP) { atomicAdd(&(bar)[XB_TMO], 1u); break; } } } } while (0)

struct XcdBarrier {
    unsigned* bar; unsigned x;
    volatile LAS unsigned* st;
};

__device__ __forceinline__ XcdBarrier xcd_barrier_post(unsigned* bar, volatile LAS unsigned* st) {
    XcdBarrier b; b.bar = bar; b.x = xb_xcc_id(); b.st = st;
    if (threadIdx.x == 0) (void)xb_add(&bar[XB_XCNT(b.x)], 1u);
    return b;
}
__device__ __forceinline__ void xcd_barrier_complete(unsigned* bar, unsigned x, unsigned& nloc, unsigned& nx) {
    const unsigned G = gridDim.x * gridDim.y * gridDim.z;
    unsigned sum, cnt, mine, sp = 0u;
    for (;;) {
        sum = 0u; cnt = 0u; mine = 0u;
#pragma unroll
        for (unsigned j = 0; j < 16; ++j) { const unsigned c = xb_ld(&bar[XB_XCNT(j)]); sum += c; cnt += (c > 0u) ? 1u : 0u; mine = (j == x) ? c : mine; }
        if (sum == G) break;
        __builtin_amdgcn_s_sleep(1);
        if ((++sp & 255u) == 0u) { if (xb_ld(&bar[XB_TMO])) break; if (sp > XB_SPIN_CAP) { atomicAdd(&bar[XB_TMO], 1u); break; } }
    }
    nloc = mine > 0u ? mine : 1u; nx = cnt > 0u ? cnt : 1u;
}

__device__ __forceinline__ void xcd_barrier(const XcdBarrier& b) {
    asm volatile("s_waitcnt vmcnt(0)" ::: "memory");
    __syncthreads();
    if (threadIdx.x == 0) {
        unsigned* bar = b.bar;
        __builtin_amdgcn_s_waitcnt(0);
        unsigned nloc = b.st[0], nx = b.st[1];
        if (nloc == 0u) { xcd_barrier_complete(bar, b.x, nloc, nx); b.st[0] = nloc; b.st[1] = nx; }
        const unsigned old = xb_add(&bar[XB_XSUB(b.x)], 1u);
        const unsigned gen = old / nloc;
        if (old + 1u == (gen + 1u) * nloc) {
            __builtin_amdgcn_fence(__ATOMIC_RELEASE, "agent");
            asm volatile("s_waitcnt vmcnt(0)" ::: "memory");
            const unsigned og = xb_add(&bar[XB_TOP], 1u);
            const unsigned tg = og / nx;
            if (og + 1u == (tg + 1u) * nx) xb_add(&bar[XB_TOPGEN], 1u);
            else XB_SPIN(xb_ld(&bar[XB_TOPGEN]) == tg, bar);
            __builtin_amdgcn_fence(__ATOMIC_ACQUIRE, "agent");
            xb_add(&bar[XB_XGEN(b.x)], 1u);
            asm volatile("s_waitcnt vmcnt(0)" ::: "memory");
        } else {
            XB_SPIN(xb_ld(&bar[XB_XGEN(b.x)]) == gen, bar);
            __builtin_amdgcn_fence(__ATOMIC_ACQUIRE, "agent");
            asm volatile("s_waitcnt vmcnt(0)" ::: "memory");
        }
    }
    __syncthreads();
}


struct Args {
    const float* x; const int* pos; const float* attn_norm; const float* attn_w_in; const float* attn_w_out; const float* mlstm_norm; const float* mlstm_w_in;
    const float* conv_w; const float* conv_b; const float* ig_bias; const float* fg_bias; const float* head_gain; const float* mlstm_w_out;
    const float* ffn_norm; const float* ffn_w_in; const float* ffn_w_out; const float* final_norm;
    float* out; unsigned char* ws; int ph_lo, ph_hi;
};

__device__ __forceinline__ void tr_item(const float* __restrict__ W, int K, int Nsrc, bf16* WT, int n0_dst, int n0_src, int k0, const float* __restrict__ gain, float scale, LAS float* scr, int lane, bool ropeperm = false) {
    const int n4 = lane & 15, kq = lane >> 4; const int s4 = (ropeperm && n4 < 8) ? (((n4 & 1) << 2) + (n4 >> 1)) : n4; const int col = n0_src + 4 * s4; const bool ok = col < Nsrc;
    f32x4 v[16];
#pragma unroll
    for (int i = 0; i < 16; ++i) { v[i] = (f32x4){0.f, 0.f, 0.f, 0.f}; if (ok) v[i] = __builtin_nontemporal_load((const f32x4*)(W + (size_t)(k0 + 4 * i + kq) * Nsrc + col)); }
#pragma unroll
    for (int i = 0; i < 16; ++i) { const int kk = 4 * i + kq; const float g = gain ? gain[k0 + kk] * scale : scale; LAS float* d = scr + kk * 65 + 4 * n4;
        d[0] = v[i][0] * g; d[1] = v[i][1] * g; d[2] = v[i][2] * g; d[3] = v[i][3] * g; }
    asm volatile("s_waitcnt lgkmcnt(0)" ::: "memory");
    const int c = lane & 7;
#pragma unroll
    for (int j = 0; j < 8; ++j) { const int n = (lane >> 3) + 8 * j; const LAS float* sp = scr + (8 * c) * 65 + n;
        u32x4 o; o.x = pk2(sp[0 * 65], sp[1 * 65]); o.y = pk2(sp[2 * 65], sp[3 * 65]); o.z = pk2(sp[4 * 65], sp[5 * 65]); o.w = pk2(sp[6 * 65], sp[7 * 65]);
        *(u32x4*)(WT + (size_t)(n0_dst + n) * K + k0 + 8 * c) = o; }
    asm volatile("s_waitcnt lgkmcnt(0)" ::: "memory");
}
__device__ __forceinline__ void p0_prologue(const Args& A, LAS unsigned char* lds, int G, int bid) {
    const int tid = threadIdx.x, lane = tid & 63, wave = tid >> 6;
    LAS float* scr = (LAS float*)(lds + wave * 16640);
    const int gw = bid * NWAVES + wave, NGW = G * NWAVES;
    unsigned char* ws = A.ws;
    constexpr int I_QKV = 16 * 144, I_AO = 16 * 16, I_FFIN = 16 * 88, I_FFOUT = 44 * 16, I_MIN = 16 * 52, I_MOUT = 16 * 16;
    constexpr int NITEMS = I_QKV + I_AO + 2 * I_FFIN + 2 * I_FFOUT + I_MIN + I_MOUT;
    constexpr float QSCALE = 0.08838834764831845f * 1.4426950408889634f;
    for (int it = gw; it < NITEMS; it += NGW) {
        int r = it;
        if (r < I_QKV) { const int kb = r / 144, nb = r % 144, n0 = 64 * nb; const int tsel = (n0 % 3072) / 1024;
            tr_item(A.attn_w_in, 1024, 9216, (bf16*)(ws + WS_WQKV), n0, n0, 64 * kb, A.attn_norm, tsel == 0 ? QSCALE : 1.f, scr, lane, tsel < 2 && (n0 & 127) == 0); continue; } r -= I_QKV;
        if (r < I_AO) { const int kb = r / 16, nb = r % 16; tr_item(A.attn_w_out, 1024, 1024, (bf16*)(ws + WS_WAO), 64 * nb, 64 * nb, 64 * kb, nullptr, 1.f, scr, lane); continue; } r -= I_AO;
        if (r < 2 * I_FFIN) { const int l = r / I_FFIN; r -= l * I_FFIN; const int kb = r / 88, nb = r % 88, n0 = 64 * nb;
            const int pn = n0 >> 8, bj = (n0 >> 7) & 1, jj = n0 & 127; const int nsrc = (bj ? DFF : 0) + 128 * pn + jj;
            tr_item(A.ffn_w_in + (size_t)l * 1024 * 5632, 1024, 5632, (bf16*)(ws + WS_WFFIN) + (size_t)l * 5632 * 1024, n0, nsrc, 64 * kb, A.ffn_norm + l * 1024, 1.f, scr, lane); continue; } r -= 2 * I_FFIN;
        if (r < 2 * I_FFOUT) { const int l = r / I_FFOUT; r -= l * I_FFOUT; const int kb = r / 16, nb = r % 16;
            tr_item(A.ffn_w_out + (size_t)l * DFF * 1024, DFF, 1024, (bf16*)(ws + WS_WFFOUT) + (size_t)l * 1024 * DFF, 64 * nb, 64 * nb, 64 * kb, nullptr, 1.f, scr, lane); continue; } r -= 2 * I_FFOUT;
        if (r < I_MIN) { const int kb = r / 52, nb = r % 52; tr_item(A.mlstm_w_in, 1024, 3088, (bf16*)(ws + WS_WMIN), 64 * nb, 64 * nb, 64 * kb, A.mlstm_norm, 1.f, scr, lane); continue; } r -= I_MIN;
        { const int kb = r / 16, nb = r % 16; tr_item(A.mlstm_w_out, 1024, 1024, (bf16*)(ws + WS_WMOUT), 64 * nb, 64 * nb, 64 * kb, nullptr, 1.f, scr, lane); }
    }
    float* ss = (float*)(ws + WS_SS); bf16* hb = (bf16*)(ws + WS_HB);
    for (int m4 = gw; m4 < T_TOK / 4; m4 += NGW) {
        f32x4 v[4][4];
#pragma unroll
        for (int q = 0; q < 4; ++q) { const f32x4* xr = (const f32x4*)(A.x + (size_t)(4 * m4 + q) * DM) + lane;
#pragma unroll
            for (int j = 0; j < 4; ++j) v[q][j] = __builtin_nontemporal_load(xr + 64 * j); }
#pragma unroll
        for (int q = 0; q < 4; ++q) { const int m = 4 * m4 + q; float sq = 0.f;
#pragma unroll
            for (int j = 0; j < 4; ++j) sq += (v[q][j].x * v[q][j].x + v[q][j].y * v[q][j].y) + (v[q][j].z * v[q][j].z + v[q][j].w * v[q][j].w);
            sq = wave_sum(sq);
            u32x2* o8 = (u32x2*)(hb + (size_t)m * DM) + lane;
#pragma unroll
            for (int j = 0; j < 4; ++j) { u32x2 o; o.x = pk2(v[q][j].x, v[q][j].y); o.y = pk2(v[q][j].z, v[q][j].w); o8[64 * j] = o; }
            if (lane == 0) ss[m] = sq; }
    }
    const int gt = bid * 512 + tid, NGT = G * 512;
    for (int i = gt; i < 4 * T_TOK; i += NGT) ss[T_TOK + i] = 0.f;
    float* rope = (float*)(ws + WS_ROPE);
    for (int i = gt; i < T_TOK * 16; i += NGT) {
        const int t = i >> 4, f = i & 15;
        const float invf = __builtin_amdgcn_exp2f((float)f * -1.1832230355827609f);
        const float ang = (float)A.pos[t] * invf;
        const double rev = (double)ang * 0.15915494309189535; const float fr = (float)(rev - rint(rev));
        rope[(size_t)t * 32 + f] = __builtin_amdgcn_cosf(fr); rope[(size_t)t * 32 + 16 + f] = __builtin_amdgcn_sinf(fr);
    }
}

struct AStep { const bf16* base; size_t rowstride; int blk, g, h, dil, rr, b; bool valid, compute; };
__device__ __forceinline__ AStep attn_step(int u, int s, const bf16* QKVh) {
    AStep t; t.valid = true; t.compute = true;
    if (s < 5) { t.g = 0; t.dil = 1; t.rr = 0; const int qt = u & 3; t.h = (u >> 2) & 7; t.b = u >> 5; t.blk = 4 * qt + s - 1; if (s == 0) { t.compute = false; t.valid = qt > 0; if (!t.valid) t.blk = 0; } }
    else if (s < 9) { t.g = 1; t.dil = 4; t.h = u & 7; t.rr = (u >> 3) & 3; t.b = u >> 5; t.blk = s - 5; }
    else { t.g = 2; t.dil = 16; const int v = 4 * u + (s - 9); t.h = v & 7; t.rr = (v >> 3) & 15; t.b = v >> 7; t.blk = 0; }
    t.rowstride = 128;
    t.base = QKVh + ((size_t)(t.g * 24 + t.h) * HBR + t.b * RB + t.rr * (SEQ / t.dil)) * 128;
    return t;
}
typedef short v4i16_t __attribute__((ext_vector_type(4)));
__device__ __forceinline__ s16x4 tr_read(const LAS unsigned char* p) { return __builtin_bit_cast(s16x4, __builtin_amdgcn_ds_read_tr16_b64_v4i16((LAS v4i16_t*)p)); }
__device__ __forceinline__ void attn_phase(LAS unsigned char* lds, const bf16* __restrict__ QKVh, bf16* __restrict__ Oh, float* __restrict__ lse, int half, int G, int bid) {
    const int tid = threadIdx.x, lane = tid & 63, w = __builtin_amdgcn_readfirstlane(tid >> 6), r = lane & 15, q4 = lane >> 4;
    constexpr int SLOT = 34816, VSLOT = 36864;
#define ATT_LOAD(st) do { \
        _Pragma("unroll") for (int i = 0; i < 4; ++i) { const int chunk = tid + 512 * i, c = chunk >> 4, ch = chunk & 15; const bf16* gp = (st).base + (size_t)(128 * (st).blk + c) * (st).rowstride + 8 * ch; \
            kr[i] = __builtin_nontemporal_load((const u32x4*)(gp + (size_t)8 * HBR * 128)); vr[i] = __builtin_nontemporal_load((const u32x4*)(gp + (size_t)16 * HBR * 128)); } \
        { const bf16* qrow = (st).base + (size_t)(128 * (st).blk + 16 * w + r) * (st).rowstride; \
            _Pragma("unroll") for (int q = 0; q < 4; ++q) qn[q] = *(const bf16x8*)(qrow + 32 * q + 8 * q4); } } while (0)
    for (int u = bid; u < 256; u += G) {
        AStep nx = attn_step(u, 0, QKVh);
        u32x4 kr[4], vr[4]; bf16x8 qn[4];
#pragma unroll
        for (int i = 0; i < 4; ++i) { kr[i] = (u32x4){0u, 0u, 0u, 0u}; vr[i] = kr[i]; qn[i] = (bf16x8){0, 0, 0, 0, 0, 0, 0, 0}; }
        ATT_LOAD(nx);
        for (int s = 0; s < 13; ++s) {
            const AStep cu = nx; const int cs = s & 1;
            LAS unsigned char* Kc = lds + cs * SLOT; LAS unsigned char* Vc = lds + 2 * SLOT + cs * VSLOT;
#pragma unroll
            for (int i = 0; i < 4; ++i) { const int chunk = tid + 512 * i, c = chunk >> 4, ch = chunk & 15; *(LAS u32x4*)(Kc + c * 272 + ch * 16) = kr[i]; *(LAS u32x4*)(Vc + c * 288 + ch * 16) = vr[i]; }
            bf16x8 qf[4];
#pragma unroll
            for (int q = 0; q < 4; ++q) qf[q] = qn[q];
            __syncthreads();
            { nx = attn_step(u, (s + 1 < 13) ? s + 1 : 12, QKVh); ATT_LOAD(nx); }
            if (cu.compute) {
                const bool first = (cu.blk == 0);
                const LAS unsigned char* Kp = first ? Kc : lds + (cs ^ 1) * SLOT; const LAS unsigned char* Vp = first ? Vc : lds + 2 * SLOT + (cs ^ 1) * VSLOT;
                const int a = 16 * w + r;
                const int jlo = first ? 8 : 0;
                f32x4 S[9]; float mx = -INFINITY;
#pragma unroll
                for (int jj = 0; jj < 9; ++jj) { const int j = w + jj; S[jj] = (f32x4){0.f, 0.f, 0.f, 0.f};
                    if (j >= jlo) { const LAS unsigned char* kp = (j >= 8 ? Kc : Kp) + ((j & 7) * 16 + r) * 272 + 16 * q4;
#pragma unroll
                        for (int st = 0; st < 4; ++st) { const bf16x8 kf = *(const LAS bf16x8*)(kp + 64 * st); S[jj] = MFMA16(kf, qf[st], S[jj]); } }
#pragma unroll
                    for (int i = 0; i < 4; ++i) { bool valid = (j >= jlo);
                        if (jj == 0) valid = valid && (4 * q4 + i >= r);
                        if (jj == 8) valid = valid && (4 * q4 + i <= r);
                        S[jj][i] = valid ? S[jj][i] : -INFINITY; mx = fmaxf(mx, S[jj][i]); } }
                mx = fmaxf(mx, __shfl_xor(mx, 16)); mx = fmaxf(mx, __shfl_xor(mx, 32));
                float den = 0.f;
#pragma unroll
                for (int jj = 0; jj < 9; ++jj)
#pragma unroll
                    for (int i = 0; i < 4; ++i) { const float pe = __builtin_amdgcn_exp2f(S[jj][i] - mx); S[jj][i] = pe; den += pe; }
                den += __shfl_xor(den, 16); den += __shfl_xor(den, 32);
                bf16x8 pf[5];
#pragma unroll
                for (int p = 0; p < 5; ++p) { u32x4 wv; wv.x = pk2(S[2 * p][0], S[2 * p][1]); wv.y = pk2(S[2 * p][2], S[2 * p][3]);
                    if (2 * p + 1 < 9) { wv.z = pk2(S[(2 * p + 1) % 9][0], S[(2 * p + 1) % 9][1]); wv.w = pk2(S[(2 * p + 1) % 9][2], S[(2 * p + 1) % 9][3]); } else { wv.z = 0u; wv.w = 0u; }
                    pf[p] = __builtin_bit_cast(bf16x8, wv); }
                f32x4 o[8];
#pragma unroll
                for (int db = 0; db < 8; ++db) o[db] = (f32x4){0.f, 0.f, 0.f, 0.f};
#pragma unroll
                for (int p = 0; p < 5; ++p) { const int j0 = w + 2 * p, j1 = (j0 + 1 > 15) ? 15 : j0 + 1;
                    if (j0 + 1 >= jlo) {
                        const LAS unsigned char* v0p = (j0 >= 8 ? Vc : Vp) + ((j0 & 7) * 16 + 4 * q4 + (r >> 2)) * 288 + 8 * (r & 3);
                        const LAS unsigned char* v1p = (j1 >= 8 ? Vc : Vp) + ((j1 & 7) * 16 + 4 * q4 + (r >> 2)) * 288 + 8 * (r & 3);
#pragma unroll
                        for (int db = 0; db < 8; ++db) {
                            const s16x4 lo = tr_read(v0p + 32 * db), hi = tr_read(v1p + 32 * db);
                            const bf16x8 af = __builtin_shufflevector(lo, hi, 0, 1, 2, 3, 4, 5, 6, 7);
                            o[db] = MFMA16(af, pf[p], o[db]); } } }
                const float inv = __builtin_amdgcn_rcpf(den);
                const int tl = cu.b * SEQ + (128 * cu.blk + a) * cu.dil + cu.rr;
                bf16* orow = Oh + ((size_t)(cu.g * 8 + cu.h) * HBR + cu.b * RB + cu.rr * (SEQ / cu.dil) + 128 * cu.blk + a) * 128 + 4 * q4;
#pragma unroll
                for (int db = 0; db < 8; ++db) { u32x2 wv; wv.x = pk2(o[db][0] * inv, o[db][1] * inv); wv.y = pk2(o[db][2] * inv, o[db][3] * inv); *(u32x2*)(orow + 16 * db) = wv; }
                if (q4 == 0) lse[((size_t)cu.g * T_TOK + (size_t)half * THALF + tl) * 8 + cu.h] = mx * 0.6931471805599453f + __logf(den);
            }
            __syncthreads();
        }
    }
#undef ATT_LOAD
}
__device__ __forceinline__ void merge_phase(const bf16* __restrict__ Oh, const float* __restrict__ lse, bf16* __restrict__ MX, int half, int G, int bid) {
    const int gt = bid * 512 + threadIdx.x, NGT = G * 512;
    for (int i = gt; i < THALF * 128; i += NGT) {
        const int tl = i >> 7, ch = i & 127, h = ch >> 4; const size_t tg = (size_t)half * THALF + tl;
        const float l0 = lse[((size_t)0 * T_TOK + tg) * 8 + h], l1 = lse[((size_t)1 * T_TOK + tg) * 8 + h], l2 = lse[((size_t)2 * T_TOK + tg) * 8 + h];
        const float mxl = fmaxf(l0, fmaxf(l1, l2)); float w0 = __expf(l0 - mxl), w1 = __expf(l1 - mxl), w2 = __expf(l2 - mxl); const float inv = 1.0f / (w0 + w1 + w2); w0 *= inv; w1 *= inv; w2 *= inv;
        const int sq = tl & 2047, bb = (tl >> 11) * RB, dch = ch & 15;
        const int p1 = ((sq & 3) << 9) + (sq >> 2), p2 = ((sq & 15) << 7) + (sq >> 4);
        const u32x4 a = __builtin_nontemporal_load((const u32x4*)(Oh + ((size_t)(0 + h) * HBR + bb + sq) * 128 + 8 * dch)), b = __builtin_nontemporal_load((const u32x4*)(Oh + ((size_t)(8 + h) * HBR + bb + p1) * 128 + 8 * dch)), c = __builtin_nontemporal_load((const u32x4*)(Oh + ((size_t)(16 + h) * HBR + bb + p2) * 128 + 8 * dch));
        u32x4 o;
#pragma unroll
        for (int e = 0; e < 4; ++e) o[e] = pk2(w0 * bf_lo(a[e]) + w1 * bf_lo(b[e]) + w2 * bf_lo(c[e]), w0 * bf_hi(a[e]) + w1 * bf_hi(b[e]) + w2 * bf_hi(c[e]));
        *(u32x4*)(MX + tg * 1024 + 8 * ch) = o;
    }
}
__device__ __forceinline__ float logsigmoid_f(float x) { return fminf(x, 0.f) - __logf(1.0f + __expf(-fabsf(x))); }
__device__ __forceinline__ void mlstm_pre_phase(const bf16* __restrict__ P2, const float* __restrict__ gates, const float* __restrict__ convw, const float* __restrict__ convb, const float* __restrict__ igb, const float* __restrict__ fgb,
                                                bf16* __restrict__ QKc, float* __restrict__ GA, float* __restrict__ GB, float* __restrict__ GP, float* __restrict__ CH, int G, int bid) {
    const int tid = threadIdx.x, lane = tid & 63, wave = tid >> 6;
    const int gt = bid * 512 + tid, NGT = G * 512;
    {
        const int ch = gt & 255, col = 4 * ch; const int tgs = NGT >> 8;
        float cw[4][4], cb[4];
        { const f32x4 b4 = *(const f32x4*)(convb + col);
#pragma unroll
          for (int e = 0; e < 4; ++e) cb[e] = b4[e];
#pragma unroll
          for (int j = 0; j < 4; ++j) { const f32x4 w4 = *(const f32x4*)(convw + j * 1024 + col);
#pragma unroll
              for (int e = 0; e < 4; ++e) cw[j][e] = w4[e]; } }
        const float ksc = (ch >= 128) ? 0.125f : 1.0f;
        u32x2 rn[11];
#define PRE_LOAD(tg_) do { const int t0_ = 8 * (tg_), sq0_ = t0_ & 2047; \
            _Pragma("unroll") for (int i = 0; i < 11; ++i) { const int dlt_ = (sq0_ + i - 3 >= 0) ? (i - 3) : -sq0_; \
                rn[i] = __builtin_nontemporal_load((const u32x2*)(P2 + (size_t)(t0_ + dlt_) * 2048 + col)); } } while (0)
        int tg = gt >> 8;
        if (tg < T_TOK / 8) PRE_LOAD(tg);
        for (; tg < T_TOK / 8; tg += tgs) {
            const int t0 = 8 * tg, sq0 = t0 & 2047;
            u32x2 rw[11];
#pragma unroll
            for (int i = 0; i < 11; ++i) rw[i] = (sq0 + i - 3 >= 0) ? rn[i] : (u32x2){0u, 0u};
            { const int tgn = (tg + tgs < T_TOK / 8) ? tg + tgs : tg; PRE_LOAD(tgn); }
#pragma unroll
            for (int i = 0; i < 8; ++i) { u32x2 o;
#pragma unroll
                for (int e = 0; e < 2; ++e) { float x0 = cb[2 * e], x1 = cb[2 * e + 1];
#pragma unroll
                    for (int j = 0; j < 4; ++j) { x0 += cw[j][2 * e] * bf_lo(rw[i + j][e]); x1 += cw[j][2 * e + 1] * bf_hi(rw[i + j][e]); }
                    o[e] = pk2(silu_f(x0) * ksc, silu_f(x1) * ksc); }
                *(u32x2*)(QKc + (size_t)(t0 + i) * 1024 + col) = o; }
        }
#undef PRE_LOAD
    }
    const int gw = bid * NWAVES + wave, NGW = G * NWAVES;
    for (int it = gw; it < NB * 32 * 8; it += NGW) {
        const int h = it & 7, c = (it >> 3) & 31, b = it >> 8; const size_t t = (size_t)b * SEQ + 64 * c + lane;
        const float gi = gates[t * 16 + h], gf = gates[t * 16 + 8 + h];
        float bs = logsigmoid_f(gf + fgb[h]);
#pragma unroll
        for (int o = 1; o < 64; o <<= 1) { const float v = __shfl_up(bs, o); if (lane >= o) bs += v; }
        const float av = gi + igb[h] - bs; float pm = av;
#pragma unroll
        for (int o = 1; o < 64; o <<= 1) { const float v = __shfl_up(pm, o); if (lane >= o) pm = fmaxf(pm, v); }
        const size_t o = (size_t)(b * 8 + h) * SEQ + 64 * c + lane; GA[o] = av; GB[o] = bs; GP[o] = pm;
        if (lane == 63) { const size_t cid = (size_t)(b * 8 + h) * 32 + c; CH[2 * cid] = bs; CH[2 * cid + 1] = bs + pm; }
    }
}
__device__ __forceinline__ void mlstm_scan_phase(LAS unsigned char* lds, const bf16* __restrict__ P2, const bf16* __restrict__ QKc, const float* __restrict__ GA, const float* __restrict__ CH,
                                                 bf16* __restrict__ Cst, float* __restrict__ nst, float* __restrict__ mst, int G, int bid) {
    const int tid = threadIdx.x, lane = tid & 63, w = __builtin_amdgcn_readfirstlane(tid >> 6), r = lane & 15, q4 = lane >> 4;
    const int dvb = w & 3, dkh = w >> 2;
    const bf16x8 ones = {0x3F80, 0x3F80, 0x3F80, 0x3F80, 0x3F80, 0x3F80, 0x3F80, 0x3F80};
    for (int item = bid; item < 256; item += G) {
        const int dvh = item & 1, h = (item >> 1) & 7, b = item >> 4;
        const size_t cid0 = (size_t)(b * 8 + h) * 32;
        f32x4 acc[2], accn[2]; acc[0] = (f32x4){0.f, 0.f, 0.f, 0.f}; acc[1] = acc[0]; accn[0] = acc[0]; accn[1] = acc[0];
        float mcar = 0.f;
        u32x4 nk, nv; float na, nbl, nml;
#define MSCAN_LOAD(c) do { const size_t t_ = (size_t)b * SEQ + 64 * (c) + lane; nk = *(const u32x4*)(QKc + t_ * 1024 + 512 + h * 64 + 8 * w); nv = *(const u32x4*)(P2 + t_ * 2048 + 1024 + h * 128 + 64 * dvh + 8 * w); \
            na = GA[(size_t)(b * 8 + h) * SEQ + 64 * (c) + lane]; nbl = CH[2 * (cid0 + (c))]; nml = CH[2 * (cid0 + (c)) + 1]; } while (0)
        MSCAN_LOAD(0);
        for (int c = 0; c < 32; ++c) {
            const u32x4 ck = nk, cv = nv; const float as = na, blast = nbl, mloc = nml;
            if (c + 1 < 32) MSCAN_LOAD(c + 1);
            const float mnew = fmaxf(blast + mcar, mloc);
            const float wsv = __expf(blast + as - mnew), carry = __expf(blast + mcar - mnew);
            const size_t cid = cid0 + c;
#pragma unroll
            for (int nb = 0; nb < 2; ++nb)
#pragma unroll
                for (int i = 0; i < 4; ++i) { const int dv = 64 * dvh + 16 * dvb + 4 * q4 + i, dk = 32 * dkh + 16 * nb + r;
                    Cst[(cid * 128 + dv) * 64 + dk] = (bf16)(pk2(acc[nb][i], 0.f) & 0xffffu); }
            if (dvh == 0 && dvb == 0 && q4 == 0) { nst[cid * 64 + 32 * dkh + r] = accn[0][0]; nst[cid * 64 + 32 * dkh + 16 + r] = accn[1][0]; }
            if (dvh == 0 && tid == 0) mst[cid] = mcar;
            LAS unsigned char* Kw = lds + (c & 1) * 18432; LAS unsigned char* Vs = Kw + 9216;
            u32x4 kw;
#pragma unroll
            for (int e = 0; e < 4; ++e) kw[e] = pk2(bf_lo(ck[e]) * wsv, bf_hi(ck[e]) * wsv);
            *(LAS u32x4*)(Kw + lane * 144 + 16 * w) = kw; *(LAS u32x4*)(Vs + lane * 144 + 16 * w) = cv;
            __syncthreads();
            acc[0] = acc[0] * carry; acc[1] = acc[1] * carry; accn[0] = accn[0] * carry; accn[1] = accn[1] * carry;
#pragma unroll
            for (int st = 0; st < 2; ++st) {
                const int rowb = (32 * st + 8 * q4 + (r >> 2)) * 144 + 8 * (r & 3);
                const s16x4 alo = tr_read(Vs + rowb + 32 * dvb), ahi = tr_read(Vs + rowb + 4 * 144 + 32 * dvb);
                const bf16x8 af = __builtin_shufflevector(alo, ahi, 0, 1, 2, 3, 4, 5, 6, 7);
#pragma unroll
                for (int nb = 0; nb < 2; ++nb) {
                    const s16x4 blo = tr_read(Kw + rowb + 64 * dkh + 32 * nb), bhi = tr_read(Kw + rowb + 4 * 144 + 64 * dkh + 32 * nb);
                    const bf16x8 bfr = __builtin_shufflevector(blo, bhi, 0, 1, 2, 3, 4, 5, 6, 7);
                    acc[nb] = MFMA16(af, bfr, acc[nb]);
                    if (dvb == 0) accn[nb] = MFMA16(ones, bfr, accn[nb]); }
            }
            mcar = mnew;
        }
        __syncthreads();
#undef MSCAN_LOAD
    }
}
__device__ __forceinline__ void mlstm_out_phase(LAS unsigned char* lds, const bf16* __restrict__ P2, const bf16* __restrict__ QKc, const bf16* __restrict__ OP, const float* __restrict__ GA, const float* __restrict__ GB, const float* __restrict__ GP,
                                                const float* __restrict__ hgain, const bf16* __restrict__ Cst, const float* __restrict__ nst, const float* __restrict__ mst, bf16* __restrict__ MX, int G, int bid) {
    const int tid = threadIdx.x, lane = tid & 63, w = __builtin_amdgcn_readfirstlane(tid >> 6), r = lane & 31, h2 = lane >> 5;
    const int dvb = w & 3, tb = w >> 2;
    constexpr int O_Q = 0, O_K = 9216, O_V = 18432, O_C = 38912, O_VEC = 57344, O_GN = 58368, O_PART = 58880, SETB = 59904;
    u32x4 pq, pk, pv0, pv1, pc0, pc1; float pvec = 0.f, pgn = 0.f, pmc = 0.f; u32x2 popv[4];
    pq = (u32x4){0u, 0u, 0u, 0u}; pk = pq; pv0 = pq; pv1 = pq; pc0 = pq; pc1 = pq;
#pragma unroll
    for (int gq = 0; gq < 4; ++gq) popv[gq] = (u32x2){0u, 0u};
#define OUT_LOAD(it) do { const int c_ = (it) & 31, h_ = ((it) >> 5) & 7, b_ = (it) >> 8; const size_t t0_ = (size_t)b_ * SEQ + 64 * c_; const size_t gb_ = (size_t)(b_ * 8 + h_) * SEQ + 64 * c_; \
        { const bf16* p_ = QKc + (t0_ + (tid >> 3)) * 1024 + h_ * 64 + 8 * (tid & 7); pq = *(const u32x4*)p_; pk = *(const u32x4*)(p_ + 512); } \
        { const bf16* p_ = P2 + (t0_ + (tid >> 4)) * 2048 + 1024 + h_ * 128 + 8 * (tid & 15); pv0 = *(const u32x4*)p_; pv1 = *(const u32x4*)(p_ + (size_t)32 * 2048); } \
        { const bf16* p_ = Cst + ((size_t)(it) * 128 + (tid >> 3)) * 64 + 8 * (tid & 7); pc0 = *(const u32x4*)p_; pc1 = *(const u32x4*)(p_ + 64 * 64); } \
        { const int wh_ = tid >> 6, ix_ = tid & 63; const float* src_ = (wh_ == 0) ? (GA + gb_) : (wh_ == 1) ? (GB + gb_) : (wh_ == 2) ? (GP + gb_) : (wh_ == 3) ? (nst + (size_t)(it) * 64) : (hgain + h_ * 128 + ((wh_ & 1) << 6)); pvec = src_[ix_]; } \
        pmc = mst[(it)]; \
        { const size_t orow_ = (t0_ + 32 * tb + r) * 1024 + h_ * 128 + 32 * dvb + 4 * h2; _Pragma("unroll") for (int gq = 0; gq < 4; ++gq) popv[gq] = *(const u32x2*)(OP + orow_ + 8 * gq); } } while (0)
    { const int fit = (bid < 4096) ? bid : 0; OUT_LOAD(fit); }
    int par = 0;
    for (int item = bid; item < 4096; item += G, par ^= 1) {
        const int c = item & 31, h = (item >> 5) & 7, b = item >> 8;
        const size_t t0 = (size_t)b * SEQ + 64 * c;
        LAS unsigned char* L = lds + par * SETB;
        LAS float* vec = (LAS float*)(L + O_VEC); LAS float* gnl = (LAS float*)(L + O_GN); LAS float* part = (LAS float*)(L + O_PART);
        *(LAS u32x4*)(L + O_Q + (tid >> 3) * 144 + (tid & 7) * 16) = pq; *(LAS u32x4*)(L + O_K + (tid >> 3) * 144 + (tid & 7) * 16) = pk;
        *(LAS u32x4*)(L + O_V + (tid >> 4) * 320 + (tid & 15) * 16) = pv0; *(LAS u32x4*)(L + O_V + (32 + (tid >> 4)) * 320 + (tid & 15) * 16) = pv1;
        *(LAS u32x4*)(L + O_C + (tid >> 3) * 144 + (tid & 7) * 16) = pc0; *(LAS u32x4*)(L + O_C + (64 + (tid >> 3)) * 144 + (tid & 7) * 16) = pc1;
        if (tid < 384) vec[tid] = pvec;
        const float mc = pmc; u32x2 opv[4];
#pragma unroll
        for (int gq = 0; gq < 4; ++gq) opv[gq] = popv[gq];
        __syncthreads();
        { const int nit = (item + G < 4096) ? item + G : item; OUT_LOAD(nit); }
        const int t = 32 * tb + r;
        const float Mt = fmaxf(mc, vec[128 + t]), bt = vec[64 + t];
        bf16x8 qf[4];
#pragma unroll
        for (int st = 0; st < 4; ++st) qf[st] = *(const LAS bf16x8*)(L + O_Q + t * 144 + (16 * st + 8 * h2) * 2);
        float qn = 0.f;
#pragma unroll
        for (int st = 0; st < 4; ++st) { const u32x4 qq = __builtin_bit_cast(u32x4, qf[st]); const f32x4 n0 = *(const LAS f32x4*)(vec + 192 + 16 * st + 8 * h2), n1 = *(const LAS f32x4*)(vec + 192 + 16 * st + 8 * h2 + 4);
#pragma unroll
            for (int e = 0; e < 2; ++e) { qn += bf_lo(qq[e]) * n0[2 * e] + bf_hi(qq[e]) * n0[2 * e + 1]; qn += bf_lo(qq[2 + e]) * n1[2 * e] + bf_hi(qq[2 + e]) * n1[2 * e + 1]; } }
        qn += __shfl_xor(qn, 32);
        f32x16 acc1, acc2;
#pragma unroll
        for (int i = 0; i < 16; ++i) { acc1[i] = 0.f; acc2[i] = 0.f; }
        float dsum = 0.f;
#pragma unroll
        for (int sb = 0; sb < 2; ++sb) {
            if (sb <= tb) {
                f32x16 S;
#pragma unroll
                for (int i = 0; i < 16; ++i) S[i] = 0.f;
#pragma unroll
                for (int st = 0; st < 4; ++st) { const bf16x8 kf = *(const LAS bf16x8*)(L + O_K + (32 * sb + r) * 144 + (16 * st + 8 * h2) * 2); S = MFMA32(kf, qf[st], S); }
#pragma unroll
                for (int gq = 0; gq < 4; ++gq) { const f32x4 a4 = *(const LAS f32x4*)(vec + 32 * sb + 8 * gq + 4 * h2);
#pragma unroll
                    for (int k = 0; k < 4; ++k) { const int i = 4 * gq + k, s = 32 * sb + 8 * gq + 4 * h2 + k; const float ev = __builtin_amdgcn_exp2f(fminf(a4[k] - Mt, 0.f) * 1.4426950408889634f);
                        const float wgt = (s <= t) ? ev : 0.f; S[i] = wgt * S[i]; dsum += S[i]; } }
#pragma unroll
                for (int sp = 0; sp < 2; ++sp) {
                    u32x4 wv; wv.x = pk2(S[8 * sp + 0], S[8 * sp + 1]); wv.y = pk2(S[8 * sp + 2], S[8 * sp + 3]); wv.z = pk2(S[8 * sp + 4], S[8 * sp + 5]); wv.w = pk2(S[8 * sp + 6], S[8 * sp + 7]);
                    const bf16x8 pfr = __builtin_bit_cast(bf16x8, wv);
                    const LAS unsigned char* vp = L + O_V + (32 * sb + 16 * sp + 4 * h2 + ((lane & 15) >> 2)) * 320 + (32 * dvb + 16 * ((lane >> 4) & 1) + 4 * (lane & 3)) * 2;
                    const s16x4 lo = tr_read(vp), hi = tr_read(vp + 8 * 320);
                    const bf16x8 af = __builtin_shufflevector(lo, hi, 0, 1, 2, 3, 4, 5, 6, 7);
                    acc1 = MFMA32(af, pfr, acc1);
                }
            }
        }
        dsum += __shfl_xor(dsum, 32);
#pragma unroll
        for (int st = 0; st < 4; ++st) { const bf16x8 cf = *(const LAS bf16x8*)(L + O_C + (32 * dvb + r) * 144 + (16 * st + 8 * h2) * 2); acc2 = MFMA32(cf, qf[st], acc2); }
        const float winter = __expf(mc - Mt);
        const float den = dsum + winter * qn;
        const float dnm = fmaxf(fabsf(den), __expf(-(bt + Mt)));
        const float idn = __builtin_amdgcn_rcpf(dnm);
        float hsq = 0.f;
#pragma unroll
        for (int i = 0; i < 16; ++i) { acc1[i] = (acc1[i] + winter * acc2[i]) * idn; hsq += acc1[i] * acc1[i]; }
        hsq += __shfl_xor(hsq, 32);
        if (h2 == 0) part[dvb * 64 + t] = hsq;
        __syncthreads();
        const float tot = (part[t] + part[64 + t]) + (part[128 + t] + part[192 + t]);
        const float rsn = __builtin_amdgcn_rsqf(tot * (1.0f / 128.0f) + RMS_EPS);
        const size_t orow = (t0 + t) * 1024 + h * 128 + 32 * dvb + 4 * h2;
#pragma unroll
        for (int gq = 0; gq < 4; ++gq) {
            const u32x2 op = opv[gq]; const f32x4 gn = *(const LAS f32x4*)(gnl + 32 * dvb + 4 * h2 + 8 * gq);
            const float y0 = acc1[4 * gq + 0] * rsn * gn[0] * sigmoid_f(bf_lo(op.x)), y1 = acc1[4 * gq + 1] * rsn * gn[1] * sigmoid_f(bf_hi(op.x));
            const float y2 = acc1[4 * gq + 2] * rsn * gn[2] * sigmoid_f(bf_lo(op.y)), y3 = acc1[4 * gq + 3] * rsn * gn[3] * sigmoid_f(bf_hi(op.y));
            u32x2 wv; wv.x = pk2(y0, y1); wv.y = pk2(y2, y3); *(u32x2*)(MX + orow + 8 * gq) = wv;
        }
    }
    __syncthreads();
#undef OUT_LOAD
}
__device__ __forceinline__ void final_phase(float* __restrict__ out, const float* __restrict__ ss, const float* __restrict__ gain, int G, int bid) {
    const int gt = bid * 512 + threadIdx.x, NGT = G * 512;
    for (int i = gt; i < T_TOK * 256; i += NGT) { const int t = i >> 8, c4 = i & 255; const float rs = rs_from_ss(ss[t]);
        f32x4 v = __builtin_nontemporal_load((const f32x4*)(out + (size_t)t * 1024 + 4 * c4)); const f32x4 gn = *(const f32x4*)(gain + 4 * c4); v = v * rs * gn; *(f32x4*)(out + (size_t)t * 1024 + 4 * c4) = v; }
}

__global__ void __launch_bounds__(NWAVES * 64, 2) mega_fwd(Args A) {
    extern __shared__ __attribute__((aligned(16))) unsigned char lds_raw[];
    LAS unsigned char* lds = (LAS unsigned char*)lds_raw;
    cg::grid_group grid = cg::this_grid();
    const int G = gridDim.x, bid = blockIdx.x;
    unsigned char* ws = A.ws;
    float* ss = (float*)(ws + WS_SS);
    bf16* hb = (bf16*)(ws + WS_HB); bf16* MX = (bf16*)(ws + WS_MX);
    bf16* QKVh = (bf16*)(ws + WS_BIG); float* H = (float*)(ws + WS_H); bf16* ACT = (bf16*)(ws + WS_ACT); bf16* P2 = (bf16*)(ws + WS_ACT);
    bf16* Oh = (bf16*)A.out; bf16* Cst = (bf16*)A.out; bf16* OP = (bf16*)A.out + (size_t)32 * 1024 * 1024;
    float* lse = (float*)(ws + WS_LSE); float* gates = (float*)(ws + WS_GATES); float* rope = (float*)(ws + WS_ROPE);
    float* mst = (float*)(ws + WS_MST); float* nst = (float*)(ws + WS_NST);
    bf16* QKc = hb;
    float* GA = (float*)(ws + 460 * MiB); float* GB = GA + (size_t)T_TOK * 8; float* GP = GB + (size_t)T_TOK * 8; float* CH = GP + (size_t)T_TOK * 8;
    const int lo = A.ph_lo, hi = A.ph_hi;
    volatile LAS unsigned* MISC = (volatile LAS unsigned*)(lds + LDS_BYTES - 256);
    if (threadIdx.x < 16) MISC[threadIdx.x] = 0u;
    __syncthreads();
    const XcdBarrier bar = xcd_barrier_post((unsigned*)(ws + WS_BAR), MISC + 8);
#ifndef PROBE_MASK
#define PROBE_MASK 0u
#endif
#define PROBE_K 4ull
    unsigned long long pr_sum = 0ull, pr_t0 = 0ull, pr_s0 = 0ull;
#define PB(k) do { if (PROBE_MASK & (1u << (k))) pr_t0 = __builtin_amdgcn_s_memrealtime(); } while (0)
#define PE(k) do { if (PROBE_MASK & (1u << (k))) pr_sum += __builtin_amdgcn_s_memrealtime() - pr_t0; } while (0)
#define IN(k) (lo <= (k) && (k) < hi)
#define SYNC(k) do { if (IN(k) && IN((k) + 1)) { if (PROBE_MASK & (1u << 30)) pr_s0 = __builtin_amdgcn_s_memrealtime(); if (hi < 0) { __threadfence(); grid.sync(); __threadfence(); } else xcd_barrier(bar); if (PROBE_MASK & (1u << 30)) pr_sum += __builtin_amdgcn_s_memrealtime() - pr_s0; if (PROBE_MASK & (1u << 29)) { pr_s0 = __builtin_amdgcn_s_memrealtime(); xcd_barrier(bar); pr_sum += __builtin_amdgcn_s_memrealtime() - pr_s0; } } PE(k); } while (0)
    PB(0); if (IN(0)) p0_prologue(A, lds, G, bid);
    SYNC(0);
    PB(1); if (IN(1)) { pg8::Gemm g{hb, (const bf16*)(ws + WS_WQKV), THALF, 9216, 1024}; pg8::StaticOrder S; S.init(THALF, 9216, G, bid);
        pg8::EpiQKV E{QKVh, ss, rope}; pg8::gemm_phase<pg8::EpiQKV, pg8::StaticOrder, true, true>(lds, g, S, E); }
    SYNC(1);
    PB(2); if (IN(2)) attn_phase(lds, QKVh, Oh, lse, 0, G, bid);
    SYNC(2);
    PB(3); if (IN(3)) { merge_phase(Oh, lse, MX, 0, G, bid);
        pg8::Gemm g{hb + (size_t)THALF * 1024, (const bf16*)(ws + WS_WQKV), THALF, 9216, 1024}; pg8::StaticOrder S; S.init(THALF, 9216, G, bid);
        pg8::EpiQKV E{QKVh, ss + THALF, rope + (size_t)THALF * 32}; pg8::gemm_phase<pg8::EpiQKV, pg8::StaticOrder, true, true>(lds, g, S, E); }
    SYNC(3);
    PB(4); if (IN(4)) attn_phase(lds, QKVh, Oh, lse, 1, G, bid);
    SYNC(4);
    PB(5); if (IN(5)) merge_phase(Oh, lse, MX, 1, G, bid);
    SYNC(5);
    PB(6); if (IN(6)) { pg8::Gemm g{MX, (const bf16*)(ws + WS_WAO), T_TOK, 1024, 1024}; pg8::StaticOrder S; S.init(T_TOK, 1024, G, bid);
        pg8::EpiResid E{A.x, H, hb, ss + T_TOK}; pg8::gemm_phase<pg8::EpiResid, pg8::StaticOrder, true, true>(lds, g, S, E); }
    SYNC(6);
    PB(7); if (IN(7)) { pg8::Gemm g{hb, (const bf16*)(ws + WS_WFFIN), T_TOK, 5632, 1024}; pg8::StaticOrder S; S.init(T_TOK, 5632, G, bid);
        pg8::EpiSwiGLU E{ACT, ss + T_TOK}; pg8::gemm_phase<pg8::EpiSwiGLU, pg8::StaticOrder, true, true>(lds, g, S, E); }
    SYNC(7);
    PB(8); if (IN(8)) { pg8::Gemm g{ACT, (const bf16*)(ws + WS_WFFOUT), T_TOK, 1024, DFF}; pg8::StaticOrder S; S.init(T_TOK, 1024, G, bid);
        pg8::EpiResid E{H, H, hb, ss + 2 * T_TOK}; pg8::gemm_phase<pg8::EpiResid, pg8::StaticOrder, true, true>(lds, g, S, E); }
    SYNC(8);
    PB(9); if (IN(9)) { pg8::Gemm g{hb, (const bf16*)(ws + WS_WMIN), T_TOK, 3328, 1024}; pg8::StaticOrder S; S.init(T_TOK, 3328, G, bid);
        pg8::EpiMlstmIn E{P2, OP, gates, ss + 2 * T_TOK}; pg8::gemm_phase<pg8::EpiMlstmIn, pg8::StaticOrder, true, true>(lds, g, S, E); }
    SYNC(9);
    PB(10); if (IN(10)) { mlstm_pre_phase(P2, gates, A.conv_w, A.conv_b, A.ig_bias, A.fg_bias, QKc, GA, GB, GP, CH, G, bid); xcd_barrier(bar);
        mlstm_scan_phase(lds, P2, QKc, GA, CH, Cst, nst, mst, G, bid); }
    SYNC(10);
    PB(11); if (IN(11)) mlstm_out_phase(lds, P2, QKc, OP, GA, GB, GP, A.head_gain, Cst, nst, mst, MX, G, bid);
    SYNC(11);
    PB(12); if (IN(12)) { pg8::Gemm g{MX, (const bf16*)(ws + WS_WMOUT), T_TOK, 1024, 1024}; pg8::StaticOrder S; S.init(T_TOK, 1024, G, bid);
        pg8::EpiResid E{H, H, hb, ss + 3 * T_TOK}; pg8::gemm_phase<pg8::EpiResid, pg8::StaticOrder, true, true>(lds, g, S, E); }
    SYNC(12);
    PB(13); if (IN(13)) { pg8::Gemm g{hb, (const bf16*)(ws + WS_WFFIN) + (size_t)5632 * 1024, T_TOK, 5632, 1024}; pg8::StaticOrder S; S.init(T_TOK, 5632, G, bid);
        pg8::EpiSwiGLU E{ACT, ss + 3 * T_TOK}; pg8::gemm_phase<pg8::EpiSwiGLU, pg8::StaticOrder, true, true>(lds, g, S, E); }
    SYNC(13);
    PB(14); if (IN(14)) { pg8::Gemm g{ACT, (const bf16*)(ws + WS_WFFOUT) + (size_t)1024 * DFF, T_TOK, 1024, DFF}; pg8::StaticOrder S; S.init(T_TOK, 1024, G, bid);
        pg8::EpiResid E{H, A.out, nullptr, ss + 4 * T_TOK}; pg8::gemm_phase<pg8::EpiResid, pg8::StaticOrder, true, true>(lds, g, S, E); }
    SYNC(14);
    PB(15); if (IN(15)) final_phase(A.out, ss + 4 * T_TOK, A.final_norm, G, bid);
    PE(15);
    if (PROBE_MASK != 0u && bid == 0 && threadIdx.x == 0) { const unsigned long long te = __builtin_amdgcn_s_memrealtime(); while (__builtin_amdgcn_s_memrealtime() - te < PROBE_K * pr_sum) __builtin_amdgcn_s_sleep(8); }
#undef IN
#undef SYNC
}

extern "C" void kernel_launch(void* const* d_in, const int* in_sizes, int n_in, void* d_out, int out_size, void* d_ws, size_t ws_size, hipStream_t stream) {
    static int grid = 0;
    if (grid == 0) {
        if (n_in != 17 || in_sizes[0] != T_TOK * DM || out_size != T_TOK * DM || ws_size < WS_END) { fprintf(stderr, "kernel_launch: unexpected shapes (n_in %d, in0 %d, out %d, ws %zu); nothing launched\n", n_in, n_in > 0 ? in_sizes[0] : -1, out_size, ws_size); grid = -1; return; }
        int dev = 0, cus = 0, per_cu = 0;
        if (hipGetDevice(&dev) != hipSuccess || hipDeviceGetAttribute(&cus, hipDeviceAttributeMultiprocessorCount, dev) != hipSuccess) { grid = -1; return; }
        if (hipFuncSetAttribute((const void*)mega_fwd, hipFuncAttributeMaxDynamicSharedMemorySize, LDS_BYTES) != hipSuccess) { fprintf(stderr, "kernel_launch: hipFuncSetAttribute failed\n"); grid = -1; return; }
        if (hipOccupancyMaxActiveBlocksPerMultiprocessor(&per_cu, (const void*)mega_fwd, NWAVES * 64, LDS_BYTES) != hipSuccess || per_cu < 1) { fprintf(stderr, "kernel_launch: occupancy query says %d\n", per_cu); per_cu = 1; }
        (void)hipGetLastError();
        grid = cus;
    }
    if (grid < 0) return;
    Args a{};
    a.x = (const float*)d_in[0]; a.pos = (const int*)d_in[1]; a.attn_norm = (const float*)d_in[2]; a.attn_w_in = (const float*)d_in[3]; a.attn_w_out = (const float*)d_in[4];
    a.mlstm_norm = (const float*)d_in[5]; a.mlstm_w_in = (const float*)d_in[6]; a.conv_w = (const float*)d_in[7]; a.conv_b = (const float*)d_in[8]; a.ig_bias = (const float*)d_in[9];
    a.fg_bias = (const float*)d_in[10]; a.head_gain = (const float*)d_in[11]; a.mlstm_w_out = (const float*)d_in[12]; a.ffn_norm = (const float*)d_in[13]; a.ffn_w_in = (const float*)d_in[14];
    a.ffn_w_out = (const float*)d_in[15]; a.final_norm = (const float*)d_in[16];
    a.out = (float*)d_out; a.ws = (unsigned char*)d_ws; a.ph_lo = 0; a.ph_hi = 16;
    if (hipMemsetAsync((char*)d_ws + WS_BAR, 0, 16384, stream) != hipSuccess) { fprintf(stderr, "kernel_launch: hipMemsetAsync failed\n"); return; }
    void* args[] = {&a};
    const hipError_t e = hipLaunchCooperativeKernel((const void*)mega_fwd, dim3(grid), dim3(NWAVES * 64), args, LDS_BYTES, stream);
    if (e != hipSuccess) fprintf(stderr, "kernel_launch: cooperative launch failed: %s (grid %d)\n", hipGetErrorString(e), grid);
}
```

```cpp
#include <hip/hip_runtime.h>
#include <hip/hip_cooperative_groups.h>
#include <cstdio>
#include <cstdint>
namespace cg = cooperative_groups;

constexpr float RMS_EPS = 1e-6f;
__device__ __forceinline__ float rs_from_ss(float ss) { return __builtin_amdgcn_rsqf(ss * (1.0f / 1024.0f) + RMS_EPS); }
__device__ __forceinline__ float silu_f(float x) { return x * __builtin_amdgcn_rcpf(1.0f + __builtin_amdgcn_exp2f(x * -1.4426950408889634f)); }
__device__ __forceinline__ float sigmoid_f(float x) { return __builtin_amdgcn_rcpf(1.0f + __builtin_amdgcn_exp2f(x * -1.4426950408889634f)); }

namespace pg8 {
#define PG8_LAS __attribute__((address_space(3)))
typedef unsigned short bf16_t;
typedef short bf16x8 __attribute__((ext_vector_type(8)));
typedef float f32x4 __attribute__((ext_vector_type(4)));
typedef unsigned u32x4 __attribute__((ext_vector_type(4)));
constexpr int BM = 256, BK = 64, HALF = 128, HTB = HALF * BK * 2  , STAGE_BYTES = 8 * HTB, NXCD = 8, WGM = 8;

__host__ __device__ __forceinline__ int lds_byte(int r, int c) { const int st = (r >> 4) * 2 + (c >> 5), rr = r & 15, cc = c & 31, ob = rr * 64 + cc * 2; return st * 1024 + (ob ^ (((ob >> 9) & 1) << 5)); }
__host__ __device__ __forceinline__ void stage_rc(int b, int& R, int& C) { const int st = b / 1024, sb = b % 1024, swz = sb ^ (((sb >> 9) & 1) << 5); R = (st >> 1) * 16 + swz / 64; C = (st & 1) * 32 + (swz % 64) / 2; }
__host__ __device__ __forceinline__ int perm32(int rho) { const int n = rho >> 4, i = rho & 15; return 8 * (i >> 2) + 4 * n + (i & 3); }

typedef unsigned u32x2 __attribute__((ext_vector_type(2)));
struct Unit { int pm, pn; };
struct Gemm { const bf16_t* A; const bf16_t* Bt; int M, N, K; };

struct StaticOrder {
    int nM, nN, nwg, G, c;
    __host__ __device__ void init(int M, int N, int G_, int c_) { nM = M / BM; nN = N / BM; nwg = nM * nN; G = G_; c = c_; }
    __host__ __device__ bool next(int i, Unit& u) const {
        const long L = (long)i * G + c; if (L >= nwg) return false;
        int wgid = (int)L; { const int q = nwg / NXCD, r = nwg % NXCD, xcd = wgid % NXCD, off = wgid / NXCD; wgid = (xcd < r ? xcd * (q + 1) : r * (q + 1) + (xcd - r) * q) + off; }
        const int nig = WGM * nN, gid = wgid / nig, fm = gid * WGM, gsz = (nM - fm) < WGM ? (nM - fm) : WGM;
        u.pm = fm + ((wgid % nig) % gsz); u.pn = (wgid % nig) / gsz; return true;
    }
    __device__ __forceinline__ void a_ready(const Unit&) const {}
    __device__ __forceinline__ void done(const Unit&) const {}
};
__device__ __forceinline__ unsigned cvt_pk_bf16(float lo, float hi) { unsigned r; asm volatile("v_cvt_pk_bf16_f32 %0, %1, %2" : "=v"(r) : "v"(lo), "v"(hi)); return r; }

#define EPI_FENCE() asm volatile("" ::: "memory")
struct EpiQKV {
    static constexpr bool PERM = true, AFTER_DRAIN = false;
    bf16_t* O; const float* ss; const float* cs;
    __device__ __forceinline__ void operator()(const f32x4 (&acc)[2][2][4][2], const Unit& u, int wr, int wc, int fr, int fq) const {
        const int row0 = u.pm * BM + wr * 64 + fr; const int colt = u.pn * BM;
        const int tsel = (colt % 3072) / 1024;
        const bool rope = (tsel < 2) && (wc == 0);
        const int gsel = colt / 3072, lg = 2 * gsel, dil = 1 << lg;
        const int hb0 = (gsel * 3 + tsel) * 8 + (colt % 1024) / 128;
        float rsv[8];
#pragma unroll
        for (int k = 0; k < 8; ++k) rsv[k] = ss[row0 + (k >> 2) * HALF + (k & 3) * 16];
        f32x4 cA = {0.f, 0.f, 0.f, 0.f}, sA = cA;
        if (rope) { const float* p = cs + (size_t)row0 * 32 + 4 * fq; cA = *(const f32x4*)p; sA = *(const f32x4*)(p + 16); }
#pragma unroll
        for (int k = 0; k < 8; ++k) {
            const int ai = k >> 2, m = k & 3;
            const int row = row0 + ai * HALF + m * 16;
            f32x4 cN = cA, sN = sA;
            if (rope && k + 1 < 8) { const int rown = row0 + ((k + 1) >> 2) * HALF + ((k + 1) & 3) * 16; const float* p = cs + (size_t)rown * 32 + 4 * fq; cN = *(const f32x4*)p; sN = *(const f32x4*)(p + 16); }
            EPI_FENCE();
            const float rs = rs_from_ss(rsv[k]);
            const int sq = row & 2047, perm = ((sq & (dil - 1)) << (11 - lg)) + (sq >> lg);
            bf16_t* rowp = O + ((size_t)hb0 * 17408 + (row >> 11) * 2176 + perm) * 128;
            if (rope) {
                const f32x4 cr = cA * rs, sr = sA * rs;
#pragma unroll
                for (int bj = 0; bj < 2; ++bj) {
                    const f32x4 v0 = acc[ai][bj][m][0], v1 = acc[ai][bj][m][1];
                    const f32x4 o0 = v0 * cr - v1 * sr, o1 = v1 * cr + v0 * sr;
                    u32x2 w0, w1; w0.x = cvt_pk_bf16(o0[0], o0[1]); w0.y = cvt_pk_bf16(o0[2], o0[3]); w1.x = cvt_pk_bf16(o1[0], o1[1]); w1.y = cvt_pk_bf16(o1[2], o1[3]);
                    bf16_t* hp = rowp + (size_t)bj * 17408 * 128 + 4 * fq;
                    *(u32x2*)hp = w0; *(u32x2*)(hp + 16) = w1;
                }
            } else {
#pragma unroll
                for (int bj = 0; bj < 2; ++bj) {
                    const f32x4 v0 = acc[ai][bj][m][0] * rs, v1 = acc[ai][bj][m][1] * rs;
                    u32x4 wv; wv.x = cvt_pk_bf16(v0[0], v0[1]); wv.y = cvt_pk_bf16(v0[2], v0[3]); wv.z = cvt_pk_bf16(v1[0], v1[1]); wv.w = cvt_pk_bf16(v1[2], v1[3]);
                    *(u32x4*)(rowp + (size_t)bj * 17408 * 128 + wc * 32 + 8 * fq) = wv;
                }
            }
            cA = cN; sA = sN;
        }
    }
};
struct EpiResid {
    static constexpr bool PERM = true, AFTER_DRAIN = false;
    const float* base; float* out; bf16_t* outb; float* ssn;
    __device__ __forceinline__ void operator()(const f32x4 (&acc)[2][2][4][2], const Unit& u, int wr, int wc, int fr, int fq) const {
        const int row0 = u.pm * BM + wr * 64 + fr; const int col0 = u.pn * BM + wc * 32 + 8 * fq;
        f32x4 bA[4];
        { const float* p = base + (size_t)row0 * 1024 + col0; bA[0] = __builtin_nontemporal_load((const f32x4*)p); bA[1] = __builtin_nontemporal_load((const f32x4*)(p + 4)); bA[2] = __builtin_nontemporal_load((const f32x4*)(p + HALF)); bA[3] = __builtin_nontemporal_load((const f32x4*)(p + HALF + 4)); }
#pragma unroll
        for (int k = 0; k < 8; ++k) {
            const int ai = k >> 2, m = k & 3;
            const int row = row0 + ai * HALF + m * 16;
            f32x4 bN[4];
#pragma unroll
            for (int q = 0; q < 4; ++q) bN[q] = bA[q];
            if (k + 1 < 8) { const int rown = row0 + ((k + 1) >> 2) * HALF + ((k + 1) & 3) * 16; const float* p = base + (size_t)rown * 1024 + col0;
                bN[0] = __builtin_nontemporal_load((const f32x4*)p); bN[1] = __builtin_nontemporal_load((const f32x4*)(p + 4)); bN[2] = __builtin_nontemporal_load((const f32x4*)(p + HALF)); bN[3] = __builtin_nontemporal_load((const f32x4*)(p + HALF + 4)); }
            EPI_FENCE();
            float sq = 0.f;
#pragma unroll
            for (int bj = 0; bj < 2; ++bj) {
                const size_t off = (size_t)row * 1024 + col0 + bj * HALF;
                const f32x4 v0 = acc[ai][bj][m][0] + bA[2 * bj], v1 = acc[ai][bj][m][1] + bA[2 * bj + 1];
                if (out) { *(f32x4*)(out + off) = v0; *(f32x4*)(out + off + 4) = v1; }
                if (outb) { u32x4 wv; wv.x = cvt_pk_bf16(v0[0], v0[1]); wv.y = cvt_pk_bf16(v0[2], v0[3]); wv.z = cvt_pk_bf16(v1[0], v1[1]); wv.w = cvt_pk_bf16(v1[2], v1[3]); *(u32x4*)(outb + off) = wv; }
                sq += (v0[0] * v0[0] + v0[1] * v0[1]) + (v0[2] * v0[2] + v0[3] * v0[3]) + (v1[0] * v1[0] + v1[1] * v1[1]) + (v1[2] * v1[2] + v1[3] * v1[3]);
            }
            sq += __shfl_xor(sq, 16); sq += __shfl_xor(sq, 32);
            if (fq == 0) atomicAdd(ssn + row, sq);
#pragma unroll
            for (int q = 0; q < 4; ++q) bA[q] = bN[q];
        }
    }
};
struct EpiSwiGLU {
    static constexpr bool PERM = true, AFTER_DRAIN = false;
    bf16_t* O; const float* ss;
    __device__ __forceinline__ void operator()(const f32x4 (&acc)[2][2][4][2], const Unit& u, int wr, int wc, int fr, int fq) const {
        const int row0 = u.pm * BM + wr * 64 + fr; const int col0 = u.pn * HALF + wc * 32 + 8 * fq;
        float rsv[8];
#pragma unroll
        for (int k = 0; k < 8; ++k) rsv[k] = ss[row0 + (k >> 2) * HALF + (k & 3) * 16];
        EPI_FENCE();
#pragma unroll
        for (int ai = 0; ai < 2; ++ai)
#pragma unroll
            for (int m = 0; m < 4; ++m) {
                const int row = row0 + ai * HALF + m * 16;
                const float rs = rs_from_ss(rsv[ai * 4 + m]); const float rs2 = rs * rs, nrs = rs * -1.4426950408889634f;
                float o[8];
#pragma unroll
                for (int n = 0; n < 2; ++n)
#pragma unroll
                    for (int e = 0; e < 4; ++e) { const float g = acc[ai][0][m][n][e], uu = acc[ai][1][m][n][e] * rs2;
                        o[4 * n + e] = (g * uu) * __builtin_amdgcn_rcpf(1.0f + __builtin_amdgcn_exp2f(g * nrs)); }
                u32x4 wv; wv.x = cvt_pk_bf16(o[0], o[1]); wv.y = cvt_pk_bf16(o[2], o[3]); wv.z = cvt_pk_bf16(o[4], o[5]); wv.w = cvt_pk_bf16(o[6], o[7]);
                *(u32x4*)(O + (size_t)row * 2816 + col0) = wv;
            }
    }
};
struct EpiMlstmIn {
    static constexpr bool PERM = true, AFTER_DRAIN = false;
    bf16_t* P2; bf16_t* OP; float* gates; const float* ss;
    __device__ __forceinline__ void operator()(const f32x4 (&acc)[2][2][4][2], const Unit& u, int wr, int wc, int fr, int fq) const {
        const int row0 = u.pm * BM + wr * 64 + fr;
        float rsv[8];
#pragma unroll
        for (int k = 0; k < 8; ++k) rsv[k] = ss[row0 + (k >> 2) * HALF + (k & 3) * 16];
        EPI_FENCE();
#pragma unroll
        for (int ai = 0; ai < 2; ++ai)
#pragma unroll
            for (int m = 0; m < 4; ++m) {
                const int row = row0 + ai * HALF + m * 16;
                const float rs = rs_from_ss(rsv[ai * 4 + m]);
#pragma unroll
                for (int bj = 0; bj < 2; ++bj) {
                    const int cb = u.pn * BM + bj * HALF;
                    const f32x4 v0 = acc[ai][bj][m][0] * rs, v1 = acc[ai][bj][m][1] * rs;
                    const int cc = wc * 32 + 8 * fq;
                    if (cb < 3072) {
                        u32x4 wv; wv.x = cvt_pk_bf16(v0[0], v0[1]); wv.y = cvt_pk_bf16(v0[2], v0[3]); wv.z = cvt_pk_bf16(v1[0], v1[1]); wv.w = cvt_pk_bf16(v1[2], v1[3]);
                        bf16_t* dst = (cb < 2048) ? (P2 + (size_t)row * 2048 + cb + cc) : (OP + (size_t)row * 1024 + (cb - 2048) + cc);
                        *(u32x4*)dst = wv;
                    } else if (cb == 3072 && cc < 16) {
                        float* dst = gates + (size_t)row * 16 + cc;
                        *(f32x4*)dst = v0; *(f32x4*)(dst + 4) = v1;
                    }
                }
            }
    }
};

template <class Epi, class Sched, bool ALIGN_EPI = false, bool SP2 = false>
__device__ __forceinline__ void gemm_phase(PG8_LAS unsigned char* lds, const Gemm g, const Sched& S, const Epi& E) {
    const int tid = threadIdx.x, wid = __builtin_amdgcn_readfirstlane(tid >> 6), lane = tid & 63, wr = wid >> 2, wc = wid & 3, fr = lane & 15, fq = lane >> 4;
    const int K = g.K, nt = K / BK;
    unsigned voffA[2], voffB[2];
#pragma unroll
    for (int i = 0; i < 2; ++i) { int R, C; stage_rc(tid * 16 + i * 8192, R, C); const int Rb = Epi::PERM ? ((R & ~31) + perm32(R & 31)) : R;
        voffA[i] = (unsigned)(R * K + C) * 2u; voffB[i] = (unsigned)(Rb * K + C) * 2u; }
    const size_t kstep = (size_t)(BK * 2);
    const size_t hstep = (size_t)HALF * K * 2;
    const size_t tstep = 2 * hstep;
    const unsigned ldsw = (unsigned)wid * 1024u;
    const int aoff = lds_byte(wr * 64 + fr, fq * 8), boff = lds_byte(wc * 32 + fr, fq * 8);
#define PG8_SA(b, h) (((b) * 2 + (h)) * HTB)
#define PG8_SB(b, h) ((4 + (b) * 2 + (h)) * HTB)
#define PG8_STAGE(bufoff, gbase, voff) do { _Pragma("unroll") for (int _i = 0; _i < 2; ++_i) \
        __builtin_amdgcn_global_load_lds((const unsigned*)((const char*)(gbase) + (voff)[_i]), (PG8_LAS unsigned*)(lds + (bufoff) + ldsw + _i * 8192), 16, 0, 0); } while (0)
#define PG8_LDA(dst, b, h) do { _Pragma("unroll") for (int m = 0; m < 4; ++m) _Pragma("unroll") for (int k = 0; k < 2; ++k) dst[m][k] = *(const PG8_LAS bf16x8*)(lds + PG8_SA(b, h) + aoff + m * 2048 + k * 1024); } while (0)
#define PG8_LDB(dst, b, h) do { _Pragma("unroll") for (int n = 0; n < 2; ++n) _Pragma("unroll") for (int k = 0; k < 2; ++k) dst[n][k] = *(const PG8_LAS bf16x8*)(lds + PG8_SB(b, h) + boff + n * 2048 + k * 1024); } while (0)
#define PG8_MMA(ai, bj, At, Bt) do { __builtin_amdgcn_s_setprio(1); _Pragma("unroll") for (int m = 0; m < 4; ++m) _Pragma("unroll") for (int n = 0; n < 2; ++n) _Pragma("unroll") for (int k = 0; k < 2; ++k) \
        acc[ai][bj][m][n] = __builtin_amdgcn_mfma_f32_16x16x32_bf16(Bt[n][k], At[m][k], acc[ai][bj][m][n], 0, 0, 0); __builtin_amdgcn_s_setprio(0); } while (0)
#define PG8_WAIT_V(n) asm volatile("s_waitcnt vmcnt(" #n ")" ::: "memory")
#define PG8_WAIT_L(n) asm volatile("s_waitcnt lgkmcnt(" #n ")" ::: "memory")
#define PG8_BAR __builtin_amdgcn_s_barrier()
#define PG8_SCHED __builtin_amdgcn_sched_barrier(0)
    Unit cur, nxt; int ui = 0;
    if (!S.next(0, cur)) return;
    f32x4 acc[2][2][4][2];
#pragma unroll
    for (int a = 0; a < 2; ++a)
#pragma unroll
        for (int b = 0; b < 2; ++b)
#pragma unroll
            for (int m = 0; m < 4; ++m)
#pragma unroll
                for (int n = 0; n < 2; ++n) acc[a][b][m][n] = (f32x4){0.f, 0.f, 0.f, 0.f};
    bf16x8 At[4][2], B0[2][2], B1[2][2];
    const char* cA = (const char*)g.A + (size_t)cur.pm * tstep; const char* cB = (const char*)g.Bt + (size_t)cur.pn * tstep;
    S.a_ready(cur);
    if constexpr (SP2) {
        PG8_STAGE(PG8_SB(0, 0), cB, voffB); PG8_STAGE(PG8_SB(0, 1), cB + hstep, voffB); PG8_STAGE(PG8_SA(0, 0), cA, voffA); PG8_STAGE(PG8_SA(0, 1), cA + hstep, voffA);
        if (wr == 1) PG8_BAR;
        PG8_WAIT_V(2); PG8_BAR;
        PG8_STAGE(PG8_SB(1, 0), cB + kstep, voffB); PG8_STAGE(PG8_SA(1, 0), cA + kstep, voffA); PG8_STAGE(PG8_SB(1, 1), cB + hstep + kstep, voffB);
        PG8_WAIT_V(6); PG8_BAR;
    } else {
        PG8_STAGE(PG8_SB(0, 0), cB, voffB); PG8_STAGE(PG8_SA(0, 0), cA, voffA); PG8_STAGE(PG8_SB(0, 1), cB + hstep, voffB); PG8_STAGE(PG8_SA(0, 1), cA + hstep, voffA);
        if (wr == 1) PG8_BAR;
        PG8_WAIT_V(4); PG8_BAR;
        PG8_STAGE(PG8_SB(1, 0), cB + kstep, voffB); PG8_STAGE(PG8_SA(1, 0), cA + kstep, voffA); PG8_STAGE(PG8_SB(1, 1), cB + hstep + kstep, voffB);
        PG8_WAIT_V(6); PG8_BAR;
    }
    for (;;) {
        const bool has_next = S.next(ui + 1, nxt);
        const char* nA = has_next ? (const char*)g.A + (size_t)nxt.pm * tstep : cA; const char* nB = has_next ? (const char*)g.Bt + (size_t)nxt.pn * tstep : cB;
        for (int t = 0; t < nt; t += 2) {
            const bool last = (t == nt - 2);
            const char* a1 = cA + (size_t)(t + 1) * kstep;
            const char* a2 = last ? nA : cA + (size_t)(t + 2) * kstep; const char* b2 = last ? nB : cB + (size_t)(t + 2) * kstep;
            const char* a3 = a2 + kstep; const char* b3 = b2 + kstep;
            if (last && has_next) S.a_ready(nxt);
            if constexpr (SP2) {
            PG8_LDB(B0, 0, 0); PG8_LDB(B1, 0, 1); PG8_SCHED; PG8_LDA(At, 0, 0); PG8_STAGE(PG8_SA(1, 1), a1 + hstep, voffA);
            PG8_WAIT_V(8); PG8_WAIT_L(0); PG8_BAR; PG8_MMA(0, 0, At, B0); PG8_MMA(0, 1, At, B1); PG8_BAR; PG8_SCHED;
            PG8_LDA(At, 0, 1); PG8_STAGE(PG8_SB(0, 0), b2, voffB); PG8_STAGE(PG8_SB(0, 1), b2 + hstep, voffB); PG8_STAGE(PG8_SA(0, 0), a2, voffA);
            PG8_WAIT_V(8); PG8_WAIT_L(0); PG8_BAR; PG8_MMA(1, 0, At, B0); PG8_MMA(1, 1, At, B1); PG8_BAR; PG8_SCHED;
            PG8_LDB(B0, 1, 0); PG8_LDB(B1, 1, 1); PG8_SCHED; PG8_LDA(At, 1, 0); PG8_STAGE(PG8_SA(0, 1), a2 + hstep, voffA);
            PG8_WAIT_V(8); PG8_WAIT_L(0); PG8_BAR; PG8_MMA(0, 0, At, B0); PG8_MMA(0, 1, At, B1); PG8_BAR; PG8_SCHED;
            PG8_LDA(At, 1, 1); PG8_STAGE(PG8_SB(1, 0), b3, voffB); PG8_STAGE(PG8_SB(1, 1), b3 + hstep, voffB); PG8_STAGE(PG8_SA(1, 0), a3, voffA);
            PG8_WAIT_V(8); PG8_WAIT_L(0); PG8_BAR; PG8_MMA(1, 0, At, B0); PG8_MMA(1, 1, At, B1); PG8_BAR; PG8_SCHED;
            } else {
            PG8_LDB(B0, 0, 0); PG8_SCHED; PG8_LDA(At, 0, 0); PG8_STAGE(PG8_SA(1, 1), a1 + hstep, voffA);
            PG8_WAIT_L(8); PG8_BAR; PG8_WAIT_L(0); PG8_MMA(0, 0, At, B0); PG8_BAR; PG8_SCHED;
            PG8_LDB(B1, 0, 1); PG8_STAGE(PG8_SB(0, 0), b2, voffB);
            PG8_BAR; PG8_WAIT_L(0); PG8_MMA(0, 1, At, B1); PG8_BAR;
            PG8_LDA(At, 0, 1); PG8_STAGE(PG8_SA(0, 0), a2, voffA);
            PG8_BAR; PG8_WAIT_L(0); PG8_MMA(1, 0, At, B0); PG8_BAR; PG8_SCHED;
            PG8_STAGE(PG8_SB(0, 1), b2 + hstep, voffB);
            PG8_WAIT_V(6); PG8_BAR; PG8_MMA(1, 1, At, B1); PG8_BAR;
            PG8_LDB(B0, 1, 0); PG8_SCHED; PG8_LDA(At, 1, 0); PG8_STAGE(PG8_SA(0, 1), a2 + hstep, voffA);
            PG8_WAIT_L(8); PG8_BAR; PG8_WAIT_L(0); PG8_MMA(0, 0, At, B0); PG8_BAR; PG8_SCHED;
            PG8_LDB(B1, 1, 1); PG8_STAGE(PG8_SB(1, 0), b3, voffB);
            PG8_BAR; PG8_WAIT_L(0); PG8_MMA(0, 1, At, B1); PG8_BAR;
            PG8_LDA(At, 1, 1); PG8_STAGE(PG8_SA(1, 0), a3, voffA);
            PG8_BAR; PG8_WAIT_L(0); PG8_MMA(1, 0, At, B0); PG8_BAR; PG8_SCHED;
            PG8_STAGE(PG8_SB(1, 1), b3 + hstep, voffB);
            PG8_WAIT_V(6); PG8_BAR; PG8_MMA(1, 1, At, B1); PG8_BAR;
            }
        }
        if constexpr (ALIGN_EPI) { if (wr == 0) PG8_BAR; }
        if constexpr (!Epi::AFTER_DRAIN) { E(acc, cur, wr, wc, fr, fq); S.done(cur); }
        if (!has_next) break;
#pragma unroll
        for (int a = 0; a < 2; ++a)
#pragma unroll
            for (int b = 0; b < 2; ++b)
#pragma unroll
                for (int m = 0; m < 4; ++m)
#pragma unroll
                    for (int n = 0; n < 2; ++n) acc[a][b][m][n] = (f32x4){0.f, 0.f, 0.f, 0.f};
        cur = nxt; cA = nA; cB = nB; ++ui;
        if constexpr (ALIGN_EPI) { if (wr == 1) PG8_BAR; }
    }
    PG8_WAIT_V(0);
    if constexpr (!ALIGN_EPI) { if (wr == 0) PG8_BAR; }
    PG8_BAR;
    if constexpr (Epi::AFTER_DRAIN) { E.fused(acc, cur, wr, wc, fr, fq, lds, wid, lane); S.done(cur); }
#undef PG8_SA
#undef PG8_SB
#undef PG8_STAGE
#undef PG8_LDA
#undef PG8_LDB
#undef PG8_MMA
#undef PG8_WAIT_V
#undef PG8_WAIT_L
#undef PG8_BAR
#undef PG8_SCHED
}
}

constexpr int T_TOK = 32768, DM = 1024, SEQ = 2048, NB = 16, DFF = 2816, THALF = 16384;
constexpr int NWAVES = 8;
constexpr int RB = 2176, HBR = 8 * RB;
constexpr int LDS_BYTES = 147456;
constexpr size_t MiB = 1u << 20;
constexpr size_t WS_SS = 0;
constexpr size_t WS_MST = 1 * MiB;
constexpr size_t WS_NST = 1 * MiB + 65536;
constexpr size_t WS_BAR = 3 * MiB;
constexpr size_t WS_WQKV = 4 * MiB;
constexpr size_t WS_WAO = 22 * MiB;
constexpr size_t WS_WFFIN = 24 * MiB;
constexpr size_t WS_WFFOUT = 46 * MiB;
constexpr size_t WS_WMIN = 57 * MiB;
constexpr size_t WS_WMOUT = 64 * MiB;
constexpr size_t WS_ROPE = 66 * MiB;
constexpr size_t WS_LSE = 70 * MiB;
constexpr size_t WS_GATES = 73 * MiB;
constexpr size_t WS_HB = 76 * MiB;
constexpr size_t WS_MX = 140 * MiB;
constexpr size_t WS_BIG = 204 * MiB;
constexpr size_t WS_H = WS_BIG;
constexpr size_t WS_ACT = WS_BIG + 128 * MiB;
constexpr size_t WS_END = 512 * MiB;
static_assert(WS_ACT + (size_t)T_TOK * DFF * 2 <= WS_END && WS_BIG + (size_t)72 * 8 * 2176 * 256 <= WS_END, "d_ws map");

#define LAS __attribute__((address_space(3)))
typedef unsigned short bf16;
typedef unsigned u32x4 __attribute__((ext_vector_type(4)));
typedef unsigned u32x2 __attribute__((ext_vector_type(2)));
typedef float f32x4 __attribute__((ext_vector_type(4)));
typedef float f32x16 __attribute__((ext_vector_type(16)));
typedef short bf16x8 __attribute__((ext_vector_type(8)));
typedef short s16x4 __attribute__((ext_vector_type(4)));
typedef float f32x2_t __attribute__((ext_vector_type(2)));
typedef __bf16 bf16x2_t __attribute__((ext_vector_type(2)));
__device__ __forceinline__ unsigned pk2(float lo, float hi) { f32x2_t v = {lo, hi}; bf16x2_t b = __builtin_convertvector(v, bf16x2_t); return __builtin_bit_cast(unsigned, b); }
__device__ __forceinline__ float bf_lo(unsigned w) { return __uint_as_float(w << 16); }
__device__ __forceinline__ float bf_hi(unsigned w) { return __uint_as_float(w & 0xffff0000u); }
__device__ __forceinline__ float wave_sum(float v) {
#pragma unroll
    for (int o = 1; o < 64; o <<= 1) v += __shfl_xor(v, o);
    return v;
}
__device__ __forceinline__ float wave_max(float v) {
#pragma unroll
    for (int o = 1; o < 64; o <<= 1) v = fmaxf(v, __shfl_xor(v, o));
    return v;
}
#define MFMA16(a, b, c) __builtin_amdgcn_mfma_f32_16x16x32_bf16((a), (b), (c), 0, 0, 0)
#define MFMA32(a, b, c) __builtin_amdgcn_mfma_f32_32x32x16_bf16((a), (b), (c), 0, 0, 0)

#define XB_TMO      128
#define XB_XCNT(j)  (256  + 64 * (j))
#define XB_XSUB(j)  (1280 + 64 * (j))
#define XB_XGEN(j)  (2304 + 64 * (j))
#define XB_TOP      3328
#define XB_TOPGEN   3392
#define XCD_BAR_WORDS 3456
#define XB_SPIN_CAP (1u << 18)

__device__ __forceinline__ unsigned xb_ld(unsigned* p)              { return __hip_atomic_load(p, __ATOMIC_RELAXED, __HIP_MEMORY_SCOPE_AGENT); }
__device__ __forceinline__ unsigned xb_add(unsigned* p, unsigned v) { return __hip_atomic_fetch_add(p, v, __ATOMIC_RELAXED, __HIP_MEMORY_SCOPE_AGENT); }
__device__ __forceinline__ unsigned xb_xcc_id() { return (unsigned)__builtin_amdgcn_s_getreg((3 << 11) | 20) & 0xFu; }
#define XB_SPIN(cond, bar) do { unsigned _sp = 0; while (cond) { __builtin_amdgcn_s_sleep(1); \
    if ((++_sp & 255u) == 0u) { if (xb_ld(&(bar)[XB_TMO])) break; if (_sp > XB_SPIN_CAP) { atomicAdd(&(bar)[XB_TMO], 1u); break; } } } } while (0)

struct XcdBarrier {
    unsigned* bar; unsigned x;
    volatile LAS unsigned* st;
};

__device__ __forceinline__ XcdBarrier xcd_barrier_post(unsigned* bar, volatile LAS unsigned* st) {
    XcdBarrier b; b.bar = bar; b.x = xb_xcc_id(); b.st = st;
    if (threadIdx.x == 0) (void)xb_add(&bar[XB_XCNT(b.x)], 1u);
    return b;
}
__device__ __forceinline__ void xcd_barrier_complete(unsigned* bar, unsigned x, unsigned& nloc, unsigned& nx) {
    const unsigned G = gridDim.x * gridDim.y * gridDim.z;
    unsigned sum, cnt, mine, sp = 0u;
    for (;;) {
        sum = 0u; cnt = 0u; mine = 0u;
#pragma unroll
        for (unsigned j = 0; j < 16; ++j) { const unsigned c = xb_ld(&bar[XB_XCNT(j)]); sum += c; cnt += (c > 0u) ? 1u : 0u; mine = (j == x) ? c : mine; }
        if (sum == G) break;
        __builtin_amdgcn_s_sleep(1);
        if ((++sp & 255u) == 0u) { if (xb_ld(&bar[XB_TMO])) break; if (sp > XB_SPIN_CAP) { atomicAdd(&bar[XB_TMO], 1u); break; } }
    }
    nloc = mine > 0u ? mine : 1u; nx = cnt > 0u ? cnt : 1u;
}

__device__ __forceinline__ void xcd_barrier(const XcdBarrier& b) {
    asm volatile("s_waitcnt vmcnt(0)" ::: "memory");
    __syncthreads();
    if (threadIdx.x == 0) {
        unsigned* bar = b.bar;
        __builtin_amdgcn_s_waitcnt(0);
        unsigned nloc = b.st[0], nx = b.st[1];
        if (nloc == 0u) { xcd_barrier_complete(bar, b.x, nloc, nx); b.st[0] = nloc; b.st[1] = nx; }
        const unsigned old = xb_add(&bar[XB_XSUB(b.x)], 1u);
        const unsigned gen = old / nloc;
        if (old + 1u == (gen + 1u) * nloc) {
            __builtin_amdgcn_fence(__ATOMIC_RELEASE, "agent");
            asm volatile("s_waitcnt vmcnt(0)" ::: "memory");
            const unsigned og = xb_add(&bar[XB_TOP], 1u);
            const unsigned tg = og / nx;
            if (og + 1u == (tg + 1u) * nx) xb_add(&bar[XB_TOPGEN], 1u);
            else XB_SPIN(xb_ld(&bar[XB_TOPGEN]) == tg, bar);
            __builtin_amdgcn_fence(__ATOMIC_ACQUIRE, "agent");
            xb_add(&bar[XB_XGEN(b.x)], 1u);
            asm volatile("s_waitcnt vmcnt(0)" ::: "memory");
        } else {
            XB_SPIN(xb_ld(&bar[XB_XGEN(b.x)]) == gen, bar);
            __builtin_amdgcn_fence(__ATOMIC_ACQUIRE, "agent");
            asm volatile("s_waitcnt vmcnt(0)" ::: "memory");
        }
    }
    __syncthreads();
}


struct Args {
    const float* x; const int* pos; const float* attn_norm; const float* attn_w_in; const float* attn_w_out; const float* mlstm_norm; const float* mlstm_w_in;
    const float* conv_w; const float* conv_b; const float* ig_bias; const float* fg_bias; const float* head_gain; const float* mlstm_w_out;
    const float* ffn_norm; const float* ffn_w_in; const float* ffn_w_out; const float* final_norm;
    float* out; unsigned char* ws; int ph_lo, ph_hi;
};

__device__ __forceinline__ void tr_item(const float* __restrict__ W, int K, int Nsrc, bf16* WT, int n0_dst, int n0_src, int k0, const float* __restrict__ gain, float scale, LAS float* scr, int lane, bool ropeperm = false) {
    const int n4 = lane & 15, kq = lane >> 4; const int s4 = (ropeperm && n4 < 8) ? (((n4 & 1) << 2) + (n4 >> 1)) : n4; const int col = n0_src + 4 * s4; const bool ok = col < Nsrc;
    f32x4 v[16];
#pragma unroll
    for (int i = 0; i < 16; ++i) { v[i] = (f32x4){0.f, 0.f, 0.f, 0.f}; if (ok) v[i] = __builtin_nontemporal_load((const f32x4*)(W + (size_t)(k0 + 4 * i + kq) * Nsrc + col)); }
#pragma unroll
    for (int i = 0; i < 16; ++i) { const int kk = 4 * i + kq; const float g = gain ? gain[k0 + kk] * scale : scale; LAS float* d = scr + kk * 65 + 4 * n4;
        d[0] = v[i][0] * g; d[1] = v[i][1] * g; d[2] = v[i][2] * g; d[3] = v[i][3] * g; }
    asm volatile("s_waitcnt lgkmcnt(0)" ::: "memory");
    const int c = lane & 7;
#pragma unroll
    for (int j = 0; j < 8; ++j) { const int n = (lane >> 3) + 8 * j; const LAS float* sp = scr + (8 * c) * 65 + n;
        u32x4 o; o.x = pk2(sp[0 * 65], sp[1 * 65]); o.y = pk2(sp[2 * 65], sp[3 * 65]); o.z = pk2(sp[4 * 65], sp[5 * 65]); o.w = pk2(sp[6 * 65], sp[7 * 65]);
        *(u32x4*)(WT + (size_t)(n0_dst + n) * K + k0 + 8 * c) = o; }
    asm volatile("s_waitcnt lgkmcnt(0)" ::: "memory");
}
__device__ __forceinline__ void p0_prologue(const Args& A, LAS unsigned char* lds, int G, int bid) {
    const int tid = threadIdx.x, lane = tid & 63, wave = tid >> 6;
    LAS float* scr = (LAS float*)(lds + wave * 16640);
    const int gw = bid * NWAVES + wave, NGW = G * NWAVES;
    unsigned char* ws = A.ws;
    constexpr int I_QKV = 16 * 144, I_AO = 16 * 16, I_FFIN = 16 * 88, I_FFOUT = 44 * 16, I_MIN = 16 * 52, I_MOUT = 16 * 16;
    constexpr int NITEMS = I_QKV + I_AO + 2 * I_FFIN + 2 * I_FFOUT + I_MIN + I_MOUT;
    constexpr float QSCALE = 0.08838834764831845f * 1.4426950408889634f;
    for (int it = gw; it < NITEMS; it += NGW) {
        int r = it;
        if (r < I_QKV) { const int kb = r / 144, nb = r % 144, n0 = 64 * nb; const int tsel = (n0 % 3072) / 1024;
            tr_item(A.attn_w_in, 1024, 9216, (bf16*)(ws + WS_WQKV), n0, n0, 64 * kb, A.attn_norm, tsel == 0 ? QSCALE : 1.f, scr, lane, tsel < 2 && (n0 & 127) == 0); continue; } r -= I_QKV;
        if (r < I_AO) { const int kb = r / 16, nb = r % 16; tr_item(A.attn_w_out, 1024, 1024, (bf16*)(ws + WS_WAO), 64 * nb, 64 * nb, 64 * kb, nullptr, 1.f, scr, lane); continue; } r -= I_AO;
        if (r < 2 * I_FFIN) { const int l = r / I_FFIN; r -= l * I_FFIN; const int kb = r / 88, nb = r % 88, n0 = 64 * nb;
            const int pn = n0 >> 8, bj = (n0 >> 7) & 1, jj = n0 & 127; const int nsrc = (bj ? DFF : 0) + 128 * pn + jj;
            tr_item(A.ffn_w_in + (size_t)l * 1024 * 5632, 1024, 5632, (bf16*)(ws + WS_WFFIN) + (size_t)l * 5632 * 1024, n0, nsrc, 64 * kb, A.ffn_norm + l * 1024, 1.f, scr, lane); continue; } r -= 2 * I_FFIN;
        if (r < 2 * I_FFOUT) { const int l = r / I_FFOUT; r -= l * I_FFOUT; const int kb = r / 16, nb = r % 16;
            tr_item(A.ffn_w_out + (size_t)l * DFF * 1024, DFF, 1024, (bf16*)(ws + WS_WFFOUT) + (size_t)l * 1024 * DFF, 64 * nb, 64 * nb, 64 * kb, nullptr, 1.f, scr, lane); continue; } r -= 2 * I_FFOUT;
        if (r < I_MIN) { const int kb = r / 52, nb = r % 52; tr_item(A.mlstm_w_in, 1024, 3088, (bf16*)(ws + WS_WMIN), 64 * nb, 64 * nb, 64 * kb, A.mlstm_norm, 1.f, scr, lane); continue; } r -= I_MIN;
        { const int kb = r / 16, nb = r % 16; tr_item(A.mlstm_w_out, 1024, 1024, (bf16*)(ws + WS_WMOUT), 64 * nb, 64 * nb, 64 * kb, nullptr, 1.f, scr, lane); }
    }
    float* ss = (float*)(ws + WS_SS); bf16* hb = (bf16*)(ws + WS_HB);
    for (int m4 = gw; m4 < T_TOK / 4; m4 += NGW) {
        f32x4 v[4][4];
#pragma unroll
        for (int q = 0; q < 4; ++q) { const f32x4* xr = (const f32x4*)(A.x + (size_t)(4 * m4 + q) * DM) + lane;
#pragma unroll
            for (int j = 0; j < 4; ++j) v[q][j] = __builtin_nontemporal_load(xr + 64 * j); }
#pragma unroll
        for (int q = 0; q < 4; ++q) { const int m = 4 * m4 + q; float sq = 0.f;
#pragma unroll
            for (int j = 0; j < 4; ++j) sq += (v[q][j].x * v[q][j].x + v[q][j].y * v[q][j].y) + (v[q][j].z * v[q][j].z + v[q][j].w * v[q][j].w);
            sq = wave_sum(sq);
            u32x2* o8 = (u32x2*)(hb + (size_t)m * DM) + lane;
#pragma unroll
            for (int j = 0; j < 4; ++j) { u32x2 o; o.x = pk2(v[q][j].x, v[q][j].y); o.y = pk2(v[q][j].z, v[q][j].w); o8[64 * j] = o; }
            if (lane == 0) ss[m] = sq; }
    }
    const int gt = bid * 512 + tid, NGT = G * 512;
    for (int i = gt; i < 4 * T_TOK; i += NGT) ss[T_TOK + i] = 0.f;
    float* rope = (float*)(ws + WS_ROPE);
    for (int i = gt; i < T_TOK * 16; i += NGT) {
        const int t = i >> 4, f = i & 15;
        const float invf = __builtin_amdgcn_exp2f((float)f * -1.1832230355827609f);
        const float ang = (float)A.pos[t] * invf;
        const double rev = (double)ang * 0.15915494309189535; const float fr = (float)(rev - rint(rev));
        rope[(size_t)t * 32 + f] = __builtin_amdgcn_cosf(fr); rope[(size_t)t * 32 + 16 + f] = __builtin_amdgcn_sinf(fr);
    }
}

struct AStep { const bf16* base; size_t rowstride; int blk, g, h, dil, rr, b; bool valid, compute; };
__device__ __forceinline__ AStep attn_step(int u, int s, const bf16* QKVh) {
    AStep t; t.valid = true; t.compute = true;
    if (s < 5) { t.g = 0; t.dil = 1; t.rr = 0; const int qt = u & 3; t.h = (u >> 2) & 7; t.b = u >> 5; t.blk = 4 * qt + s - 1; if (s == 0) { t.compute = false; t.valid = qt > 0; if (!t.valid) t.blk = 0; } }
    else if (s < 9) { t.g = 1; t.dil = 4; t.h = u & 7; t.rr = (u >> 3) & 3; t.b = u >> 5; t.blk = s - 5; }
    else { t.g = 2; t.dil = 16; const int v = 4 * u + (s - 9); t.h = v & 7; t.rr = (v >> 3) & 15; t.b = v >> 7; t.blk = 0; }
    t.rowstride = 128;
    t.base = QKVh + ((size_t)(t.g * 24 + t.h) * HBR + t.b * RB + t.rr * (SEQ / t.dil)) * 128;
    return t;
}
typedef short v4i16_t __attribute__((ext_vector_type(4)));
__device__ __forceinline__ s16x4 tr_read(const LAS unsigned char* p) { return __builtin_bit_cast(s16x4, __builtin_amdgcn_ds_read_tr16_b64_v4i16((LAS v4i16_t*)p)); }
__device__ __forceinline__ void attn_phase(LAS unsigned char* lds, const bf16* __restrict__ QKVh, bf16* __restrict__ Oh, float* __restrict__ lse, int half, int G, int bid) {
    const int tid = threadIdx.x, lane = tid & 63, w = __builtin_amdgcn_readfirstlane(tid >> 6), r = lane & 15, q4 = lane >> 4;
    constexpr int SLOT = 34816, VSLOT = 36864;
#define ATT_LOAD(st) do { \
        _Pragma("unroll") for (int i = 0; i < 4; ++i) { const int chunk = tid + 512 * i, c = chunk >> 4, ch = chunk & 15; const bf16* gp = (st).base + (size_t)(128 * (st).blk + c) * (st).rowstride + 8 * ch; \
            kr[i] = __builtin_nontemporal_load((const u32x4*)(gp + (size_t)8 * HBR * 128)); vr[i] = __builtin_nontemporal_load((const u32x4*)(gp + (size_t)16 * HBR * 128)); } \
        { const bf16* qrow = (st).base + (size_t)(128 * (st).blk + 16 * w + r) * (st).rowstride; \
            _Pragma("unroll") for (int q = 0; q < 4; ++q) qn[q] = *(const bf16x8*)(qrow + 32 * q + 8 * q4); } } while (0)
    for (int u = bid; u < 256; u += G) {
        AStep nx = attn_step(u, 0, QKVh);
        u32x4 kr[4], vr[4]; bf16x8 qn[4];
#pragma unroll
        for (int i = 0; i < 4; ++i) { kr[i] = (u32x4){0u, 0u, 0u, 0u}; vr[i] = kr[i]; qn[i] = (bf16x8){0, 0, 0, 0, 0, 0, 0, 0}; }
        ATT_LOAD(nx);
        for (int s = 0; s < 13; ++s) {
            const AStep cu = nx; const int cs = s & 1;
            LAS unsigned char* Kc = lds + cs * SLOT; LAS unsigned char* Vc = lds + 2 * SLOT + cs * VSLOT;
#pragma unroll
            for (int i = 0; i < 4; ++i) { const int chunk = tid + 512 * i, c = chunk >> 4, ch = chunk & 15; *(LAS u32x4*)(Kc + c * 272 + ch * 16) = kr[i]; *(LAS u32x4*)(Vc + c * 288 + ch * 16) = vr[i]; }
            bf16x8 qf[4];
#pragma unroll
            for (int q = 0; q < 4; ++q) qf[q] = qn[q];
            __syncthreads();
            { nx = attn_step(u, (s + 1 < 13) ? s + 1 : 12, QKVh); ATT_LOAD(nx); }
            if (cu.compute) {
                const bool first = (cu.blk == 0);
                const LAS unsigned char* Kp = first ? Kc : lds + (cs ^ 1) * SLOT; const LAS unsigned char* Vp = first ? Vc : lds + 2 * SLOT + (cs ^ 1) * VSLOT;
                const int a = 16 * w + r;
                const int jlo = first ? 8 : 0;
                f32x4 S[9]; float mx = -INFINITY;
#pragma unroll
                for (int jj = 0; jj < 9; ++jj) { const int j = w + jj; S[jj] = (f32x4){0.f, 0.f, 0.f, 0.f};
                    if (j >= jlo) { const LAS unsigned char* kp = (j >= 8 ? Kc : Kp) + ((j & 7) * 16 + r) * 272 + 16 * q4;
#pragma unroll
                        for (int st = 0; st < 4; ++st) { const bf16x8 kf = *(const LAS bf16x8*)(kp + 64 * st); S[jj] = MFMA16(kf, qf[st], S[jj]); } }
#pragma unroll
                    for (int i = 0; i < 4; ++i) { bool valid = (j >= jlo);
                        if (jj == 0) valid = valid && (4 * q4 + i >= r);
                        if (jj == 8) valid = valid && (4 * q4 + i <= r);
                        S[jj][i] = valid ? S[jj][i] : -INFINITY; mx = fmaxf(mx, S[jj][i]); } }
                mx = fmaxf(mx, __shfl_xor(mx, 16)); mx = fmaxf(mx, __shfl_xor(mx, 32));
                float den = 0.f;
#pragma unroll
                for (int jj = 0; jj < 9; ++jj)
#pragma unroll
                    for (int i = 0; i < 4; ++i) { const float pe = __builtin_amdgcn_exp2f(S[jj][i] - mx); S[jj][i] = pe; den += pe; }
                den += __shfl_xor(den, 16); den += __shfl_xor(den, 32);
                bf16x8 pf[5];
#pragma unroll
                for (int p = 0; p < 5; ++p) { u32x4 wv; wv.x = pk2(S[2 * p][0], S[2 * p][1]); wv.y = pk2(S[2 * p][2], S[2 * p][3]);
                    if (2 * p + 1 < 9) { wv.z = pk2(S[(2 * p + 1) % 9][0], S[(2 * p + 1) % 9][1]); wv.w = pk2(S[(2 * p + 1) % 9][2], S[(2 * p + 1) % 9][3]); } else { wv.z = 0u; wv.w = 0u; }
                    pf[p] = __builtin_bit_cast(bf16x8, wv); }
                f32x4 o[8];
#pragma unroll
                for (int db = 0; db < 8; ++db) o[db] = (f32x4){0.f, 0.f, 0.f, 0.f};
#pragma unroll
                for (int p = 0; p < 5; ++p) { const int j0 = w + 2 * p, j1 = (j0 + 1 > 15) ? 15 : j0 + 1;
                    if (j0 + 1 >= jlo) {
                        const LAS unsigned char* v0p = (j0 >= 8 ? Vc : Vp) + ((j0 & 7) * 16 + 4 * q4 + (r >> 2)) * 288 + 8 * (r & 3);
                        const LAS unsigned char* v1p = (j1 >= 8 ? Vc : Vp) + ((j1 & 7) * 16 + 4 * q4 + (r >> 2)) * 288 + 8 * (r & 3);
#pragma unroll
                        for (int db = 0; db < 8; ++db) {
                            const s16x4 lo = tr_read(v0p + 32 * db), hi = tr_read(v1p + 32 * db);
                            const bf16x8 af = __builtin_shufflevector(lo, hi, 0, 1, 2, 3, 4, 5, 6, 7);
                            o[db] = MFMA16(af, pf[p], o[db]); } } }
                const float inv = __builtin_amdgcn_rcpf(den);
                const int tl = cu.b * SEQ + (128 * cu.blk + a) * cu.dil + cu.rr;
                bf16* orow = Oh + ((size_t)(cu.g * 8 + cu.h) * HBR + cu.b * RB + cu.rr * (SEQ / cu.dil) + 128 * cu.blk + a) * 128 + 4 * q4;
#pragma unroll
                for (int db = 0; db < 8; ++db) { u32x2 wv; wv.x = pk2(o[db][0] * inv, o[db][1] * inv); wv.y = pk2(o[db][2] * inv, o[db][3] * inv); *(u32x2*)(orow + 16 * db) = wv; }
                if (q4 == 0) lse[((size_t)cu.g * T_TOK + (size_t)half * THALF + tl) * 8 + cu.h] = mx * 0.6931471805599453f + __logf(den);
            }
            __syncthreads();
        }
    }
#undef ATT_LOAD
}
__device__ __forceinline__ void merge_phase(const bf16* __restrict__ Oh, const float* __restrict__ lse, bf16* __restrict__ MX, int half, int G, int bid) {
    const int gt = bid * 512 + threadIdx.x, NGT = G * 512;
    for (int i = gt; i < THALF * 128; i += NGT) {
        const int tl = i >> 7, ch = i & 127, h = ch >> 4; const size_t tg = (size_t)half * THALF + tl;
        const float l0 = lse[((size_t)0 * T_TOK + tg) * 8 + h], l1 = lse[((size_t)1 * T_TOK + tg) * 8 + h], l2 = lse[((size_t)2 * T_TOK + tg) * 8 + h];
        const float mxl = fmaxf(l0, fmaxf(l1, l2)); float w0 = __expf(l0 - mxl), w1 = __expf(l1 - mxl), w2 = __expf(l2 - mxl); const float inv = 1.0f / (w0 + w1 + w2); w0 *= inv; w1 *= inv; w2 *= inv;
        const int sq = tl & 2047, bb = (tl >> 11) * RB, dch = ch & 15;
        const int p1 = ((sq & 3) << 9) + (sq >> 2), p2 = ((sq & 15) << 7) + (sq >> 4);
        const u32x4 a = __builtin_nontemporal_load((const u32x4*)(Oh + ((size_t)(0 + h) * HBR + bb + sq) * 128 + 8 * dch)), b = __builtin_nontemporal_load((const u32x4*)(Oh + ((size_t)(8 + h) * HBR + bb + p1) * 128 + 8 * dch)), c = __builtin_nontemporal_load((const u32x4*)(Oh + ((size_t)(16 + h) * HBR + bb + p2) * 128 + 8 * dch));
        u32x4 o;
#pragma unroll
        for (int e = 0; e < 4; ++e) o[e] = pk2(w0 * bf_lo(a[e]) + w1 * bf_lo(b[e]) + w2 * bf_lo(c[e]), w0 * bf_hi(a[e]) + w1 * bf_hi(b[e]) + w2 * bf_hi(c[e]));
        *(u32x4*)(MX + tg * 1024 + 8 * ch) = o;
    }
}
__device__ __forceinline__ float logsigmoid_f(float x) { return fminf(x, 0.f) - __logf(1.0f + __expf(-fabsf(x))); }
__device__ __forceinline__ void mlstm_pre_phase(const bf16* __restrict__ P2, const float* __restrict__ gates, const float* __restrict__ convw, const float* __restrict__ convb, const float* __restrict__ igb, const float* __restrict__ fgb,
                                                bf16* __restrict__ QKc, float* __restrict__ GA, float* __restrict__ GB, float* __restrict__ GP, float* __restrict__ CH, int G, int bid) {
    const int tid = threadIdx.x, lane = tid & 63, wave = tid >> 6;
    const int gt = bid * 512 + tid, NGT = G * 512;
    {
        const int ch = gt & 255, col = 4 * ch; const int tgs = NGT >> 8;
        float cw[4][4], cb[4];
        { const f32x4 b4 = *(const f32x4*)(convb + col);
#pragma unroll
          for (int e = 0; e < 4; ++e) cb[e] = b4[e];
#pragma unroll
          for (int j = 0; j < 4; ++j) { const f32x4 w4 = *(const f32x4*)(convw + j * 1024 + col);
#pragma unroll
              for (int e = 0; e < 4; ++e) cw[j][e] = w4[e]; } }
        const float ksc = (ch >= 128) ? 0.125f : 1.0f;
        u32x2 rn[11];
#define PRE_LOAD(tg_) do { const int t0_ = 8 * (tg_), sq0_ = t0_ & 2047; \
            _Pragma("unroll") for (int i = 0; i < 11; ++i) { const int dlt_ = (sq0_ + i - 3 >= 0) ? (i - 3) : -sq0_; \
                rn[i] = __builtin_nontemporal_load((const u32x2*)(P2 + (size_t)(t0_ + dlt_) * 2048 + col)); } } while (0)
        int tg = gt >> 8;
        if (tg < T_TOK / 8) PRE_LOAD(tg);
        for (; tg < T_TOK / 8; tg += tgs) {
            const int t0 = 8 * tg, sq0 = t0 & 2047;
            u32x2 rw[11];
#pragma unroll
            for (int i = 0; i < 11; ++i) rw[i] = (sq0 + i - 3 >= 0) ? rn[i] : (u32x2){0u, 0u};
            { const int tgn = (tg + tgs < T_TOK / 8) ? tg + tgs : tg; PRE_LOAD(tgn); }
#pragma unroll
            for (int i = 0; i < 8; ++i) { u32x2 o;
#pragma unroll
                for (int e = 0; e < 2; ++e) { float x0 = cb[2 * e], x1 = cb[2 * e + 1];
#pragma unroll
                    for (int j = 0; j < 4; ++j) { x0 += cw[j][2 * e] * bf_lo(rw[i + j][e]); x1 += cw[j][2 * e + 1] * bf_hi(rw[i + j][e]); }
                    o[e] = pk2(silu_f(x0) * ksc, silu_f(x1) * ksc); }
                *(u32x2*)(QKc + (size_t)(t0 + i) * 1024 + col) = o; }
        }
#undef PRE_LOAD
    }
    const int gw = bid * NWAVES + wave, NGW = G * NWAVES;
    for (int it = gw; it < NB * 32 * 8; it += NGW) {
        const int h = it & 7, c = (it >> 3) & 31, b = it >> 8; const size_t t = (size_t)b * SEQ + 64 * c + lane;
        const float gi = gates[t * 16 + h], gf = gates[t * 16 + 8 + h];
        float bs = logsigmoid_f(gf + fgb[h]);
#pragma unroll
        for (int o = 1; o < 64; o <<= 1) { const float v = __shfl_up(bs, o); if (lane >= o) bs += v; }
        const float av = gi + igb[h] - bs; float pm = av;
#pragma unroll
        for (int o = 1; o < 64; o <<= 1) { const float v = __shfl_up(pm, o); if (lane >= o) pm = fmaxf(pm, v); }
        const size_t o = (size_t)(b * 8 + h) * SEQ + 64 * c + lane; GA[o] = av; GB[o] = bs; GP[o] = pm;
        if (lane == 63) { const size_t cid = (size_t)(b * 8 + h) * 32 + c; CH[2 * cid] = bs; CH[2 * cid + 1] = bs + pm; }
    }
}
__device__ __forceinline__ void mlstm_scan_phase(LAS unsigned char* lds, const bf16* __restrict__ P2, const bf16* __restrict__ QKc, const float* __restrict__ GA, const float* __restrict__ CH,
                                                 bf16* __restrict__ Cst, float* __restrict__ nst, float* __restrict__ mst, int G, int bid) {
    const int tid = threadIdx.x, lane = tid & 63, w = __builtin_amdgcn_readfirstlane(tid >> 6), r = lane & 15, q4 = lane >> 4;
    const int dvb = w & 3, dkh = w >> 2;
    const bf16x8 ones = {0x3F80, 0x3F80, 0x3F80, 0x3F80, 0x3F80, 0x3F80, 0x3F80, 0x3F80};
    for (int item = bid; item < 256; item += G) {
        const int dvh = item & 1, h = (item >> 1) & 7, b = item >> 4;
        const size_t cid0 = (size_t)(b * 8 + h) * 32;
        f32x4 acc[2], accn[2]; acc[0] = (f32x4){0.f, 0.f, 0.f, 0.f}; acc[1] = acc[0]; accn[0] = acc[0]; accn[1] = acc[0];
        float mcar = 0.f;
        u32x4 nk, nv; float na, nbl, nml;
#define MSCAN_LOAD(c) do { const size_t t_ = (size_t)b * SEQ + 64 * (c) + lane; nk = *(const u32x4*)(QKc + t_ * 1024 + 512 + h * 64 + 8 * w); nv = *(const u32x4*)(P2 + t_ * 2048 + 1024 + h * 128 + 64 * dvh + 8 * w); \
            na = GA[(size_t)(b * 8 + h) * SEQ + 64 * (c) + lane]; nbl = CH[2 * (cid0 + (c))]; nml = CH[2 * (cid0 + (c)) + 1]; } while (0)
        MSCAN_LOAD(0);
        for (int c = 0; c < 32; ++c) {
            const u32x4 ck = nk, cv = nv; const float as = na, blast = nbl, mloc = nml;
            if (c + 1 < 32) MSCAN_LOAD(c + 1);
            const float mnew = fmaxf(blast + mcar, mloc);
            const float wsv = __expf(blast + as - mnew), carry = __expf(blast + mcar - mnew);
            const size_t cid = cid0 + c;
#pragma unroll
            for (int nb = 0; nb < 2; ++nb)
#pragma unroll
                for (int i = 0; i < 4; ++i) { const int dv = 64 * dvh + 16 * dvb + 4 * q4 + i, dk = 32 * dkh + 16 * nb + r;
                    Cst[(cid * 128 + dv) * 64 + dk] = (bf16)(pk2(acc[nb][i], 0.f) & 0xffffu); }
            if (dvh == 0 && dvb == 0 && q4 == 0) { nst[cid * 64 + 32 * dkh + r] = accn[0][0]; nst[cid * 64 + 32 * dkh + 16 + r] = accn[1][0]; }
            if (dvh == 0 && tid == 0) mst[cid] = mcar;
            LAS unsigned char* Kw = lds + (c & 1) * 18432; LAS unsigned char* Vs = Kw + 9216;
            u32x4 kw;
#pragma unroll
            for (int e = 0; e < 4; ++e) kw[e] = pk2(bf_lo(ck[e]) * wsv, bf_hi(ck[e]) * wsv);
            *(LAS u32x4*)(Kw + lane * 144 + 16 * w) = kw; *(LAS u32x4*)(Vs + lane * 144 + 16 * w) = cv;
            __syncthreads();
            acc[0] = acc[0] * carry; acc[1] = acc[1] * carry; accn[0] = accn[0] * carry; accn[1] = accn[1] * carry;
#pragma unroll
            for (int st = 0; st < 2; ++st) {
                const int rowb = (32 * st + 8 * q4 + (r >> 2)) * 144 + 8 * (r & 3);
                const s16x4 alo = tr_read(Vs + rowb + 32 * dvb), ahi = tr_read(Vs + rowb + 4 * 144 + 32 * dvb);
                const bf16x8 af = __builtin_shufflevector(alo, ahi, 0, 1, 2, 3, 4, 5, 6, 7);
#pragma unroll
                for (int nb = 0; nb < 2; ++nb) {
                    const s16x4 blo = tr_read(Kw + rowb + 64 * dkh + 32 * nb), bhi = tr_read(Kw + rowb + 4 * 144 + 64 * dkh + 32 * nb);
                    const bf16x8 bfr = __builtin_shufflevector(blo, bhi, 0, 1, 2, 3, 4, 5, 6, 7);
                    acc[nb] = MFMA16(af, bfr, acc[nb]);
                    if (dvb == 0) accn[nb] = MFMA16(ones, bfr, accn[nb]); }
            }
            mcar = mnew;
        }
        __syncthreads();
#undef MSCAN_LOAD
    }
}
__device__ __forceinline__ void mlstm_out_phase(LAS unsigned char* lds, const bf16* __restrict__ P2, const bf16* __restrict__ QKc, const bf16* __restrict__ OP, const float* __restrict__ GA, const float* __restrict__ GB, const float* __restrict__ GP,
                                                const float* __restrict__ hgain, const bf16* __restrict__ Cst, const float* __restrict__ nst, const float* __restrict__ mst, bf16* __restrict__ MX, int G, int bid) {
    const int tid = threadIdx.x, lane = tid & 63, w = __builtin_amdgcn_readfirstlane(tid >> 6), r = lane & 31, h2 = lane >> 5;
    const int dvb = w & 3, tb = w >> 2;
    constexpr int O_Q = 0, O_K = 9216, O_V = 18432, O_C = 38912, O_VEC = 57344, O_GN = 58368, O_PART = 58880, SETB = 59904;
    u32x4 pq, pk, pv0, pv1, pc0, pc1; float pvec = 0.f, pgn = 0.f, pmc = 0.f; u32x2 popv[4];
    pq = (u32x4){0u, 0u, 0u, 0u}; pk = pq; pv0 = pq; pv1 = pq; pc0 = pq; pc1 = pq;
#pragma unroll
    for (int gq = 0; gq < 4; ++gq) popv[gq] = (u32x2){0u, 0u};
#define OUT_LOAD(it) do { const int c_ = (it) & 31, h_ = ((it) >> 5) & 7, b_ = (it) >> 8; const size_t t0_ = (size_t)b_ * SEQ + 64 * c_; const size_t gb_ = (size_t)(b_ * 8 + h_) * SEQ + 64 * c_; \
        { const bf16* p_ = QKc + (t0_ + (tid >> 3)) * 1024 + h_ * 64 + 8 * (tid & 7); pq = *(const u32x4*)p_; pk = *(const u32x4*)(p_ + 512); } \
        { const bf16* p_ = P2 + (t0_ + (tid >> 4)) * 2048 + 1024 + h_ * 128 + 8 * (tid & 15); pv0 = *(const u32x4*)p_; pv1 = *(const u32x4*)(p_ + (size_t)32 * 2048); } \
        { const bf16* p_ = Cst + ((size_t)(it) * 128 + (tid >> 3)) * 64 + 8 * (tid & 7); pc0 = *(const u32x4*)p_; pc1 = *(const u32x4*)(p_ + 64 * 64); } \
        { const int wh_ = tid >> 6, ix_ = tid & 63; const float* src_ = (wh_ == 0) ? (GA + gb_) : (wh_ == 1) ? (GB + gb_) : (wh_ == 2) ? (GP + gb_) : (wh_ == 3) ? (nst + (size_t)(it) * 64) : (hgain + h_ * 128 + ((wh_ & 1) << 6)); pvec = src_[ix_]; } \
        pmc = mst[(it)]; \
        { const size_t orow_ = (t0_ + 32 * tb + r) * 1024 + h_ * 128 + 32 * dvb + 4 * h2; _Pragma("unroll") for (int gq = 0; gq < 4; ++gq) popv[gq] = *(const u32x2*)(OP + orow_ + 8 * gq); } } while (0)
    { const int fit = (bid < 4096) ? bid : 0; OUT_LOAD(fit); }
    int par = 0;
    for (int item = bid; item < 4096; item += G, par ^= 1) {
        const int c = item & 31, h = (item >> 5) & 7, b = item >> 8;
        const size_t t0 = (size_t)b * SEQ + 64 * c;
        LAS unsigned char* L = lds + par * SETB;
        LAS float* vec = (LAS float*)(L + O_VEC); LAS float* gnl = (LAS float*)(L + O_GN); LAS float* part = (LAS float*)(L + O_PART);
        *(LAS u32x4*)(L + O_Q + (tid >> 3) * 144 + (tid & 7) * 16) = pq; *(LAS u32x4*)(L + O_K + (tid >> 3) * 144 + (tid & 7) * 16) = pk;
        *(LAS u32x4*)(L + O_V + (tid >> 4) * 320 + (tid & 15) * 16) = pv0; *(LAS u32x4*)(L + O_V + (32 + (tid >> 4)) * 320 + (tid & 15) * 16) = pv1;
        *(LAS u32x4*)(L + O_C + (tid >> 3) * 144 + (tid & 7) * 16) = pc0; *(LAS u32x4*)(L + O_C + (64 + (tid >> 3)) * 144 + (tid & 7) * 16) = pc1;
        if (tid < 384) vec[tid] = pvec;
        const float mc = pmc; u32x2 opv[4];
#pragma unroll
        for (int gq = 0; gq < 4; ++gq) opv[gq] = popv[gq];
        __syncthreads();
        { const int nit = (item + G < 4096) ? item + G : item; OUT_LOAD(nit); }
        const int t = 32 * tb + r;
        const float Mt = fmaxf(mc, vec[128 + t]), bt = vec[64 + t];
        bf16x8 qf[4];
#pragma unroll
        for (int st = 0; st < 4; ++st) qf[st] = *(const LAS bf16x8*)(L + O_Q + t * 144 + (16 * st + 8 * h2) * 2);
        float qn = 0.f;
#pragma unroll
        for (int st = 0; st < 4; ++st) { const u32x4 qq = __builtin_bit_cast(u32x4, qf[st]); const f32x4 n0 = *(const LAS f32x4*)(vec + 192 + 16 * st + 8 * h2), n1 = *(const LAS f32x4*)(vec + 192 + 16 * st + 8 * h2 + 4);
#pragma unroll
            for (int e = 0; e < 2; ++e) { qn += bf_lo(qq[e]) * n0[2 * e] + bf_hi(qq[e]) * n0[2 * e + 1]; qn += bf_lo(qq[2 + e]) * n1[2 * e] + bf_hi(qq[2 + e]) * n1[2 * e + 1]; } }
        qn += __shfl_xor(qn, 32);
        f32x16 acc1, acc2;
#pragma unroll
        for (int i = 0; i < 16; ++i) { acc1[i] = 0.f; acc2[i] = 0.f; }
        float dsum = 0.f;
#pragma unroll
        for (int sb = 0; sb < 2; ++sb) {
            if (sb <= tb) {
                f32x16 S;
#pragma unroll
                for (int i = 0; i < 16; ++i) S[i] = 0.f;
#pragma unroll
                for (int st = 0; st < 4; ++st) { const bf16x8 kf = *(const LAS bf16x8*)(L + O_K + (32 * sb + r) * 144 + (16 * st + 8 * h2) * 2); S = MFMA32(kf, qf[st], S); }
#pragma unroll
                for (int gq = 0; gq < 4; ++gq) { const f32x4 a4 = *(const LAS f32x4*)(vec + 32 * sb + 8 * gq + 4 * h2);
#pragma unroll
                    for (int k = 0; k < 4; ++k) { const int i = 4 * gq + k, s = 32 * sb + 8 * gq + 4 * h2 + k; const float ev = __builtin_amdgcn_exp2f(fminf(a4[k] - Mt, 0.f) * 1.4426950408889634f);
                        const float wgt = (s <= t) ? ev : 0.f; S[i] = wgt * S[i]; dsum += S[i]; } }
#pragma unroll
                for (int sp = 0; sp < 2; ++sp) {
                    u32x4 wv; wv.x = pk2(S[8 * sp + 0], S[8 * sp + 1]); wv.y = pk2(S[8 * sp + 2], S[8 * sp + 3]); wv.z = pk2(S[8 * sp + 4], S[8 * sp + 5]); wv.w = pk2(S[8 * sp + 6], S[8 * sp + 7]);
                    const bf16x8 pfr = __builtin_bit_cast(bf16x8, wv);
                    const LAS unsigned char* vp = L + O_V + (32 * sb + 16 * sp + 4 * h2 + ((lane & 15) >> 2)) * 320 + (32 * dvb + 16 * ((lane >> 4) & 1) + 4 * (lane & 3)) * 2;
                    const s16x4 lo = tr_read(vp), hi = tr_read(vp + 8 * 320);
                    const bf16x8 af = __builtin_shufflevector(lo, hi, 0, 1, 2, 3, 4, 5, 6, 7);
                    acc1 = MFMA32(af, pfr, acc1);
                }
            }
        }
        dsum += __shfl_xor(dsum, 32);
#pragma unroll
        for (int st = 0; st < 4; ++st) { const bf16x8 cf = *(const LAS bf16x8*)(L + O_C + (32 * dvb + r) * 144 + (16 * st + 8 * h2) * 2); acc2 = MFMA32(cf, qf[st], acc2); }
        const float winter = __expf(mc - Mt);
        const float den = dsum + winter * qn;
        const float dnm = fmaxf(fabsf(den), __expf(-(bt + Mt)));
        const float idn = __builtin_amdgcn_rcpf(dnm);
        float hsq = 0.f;
#pragma unroll
        for (int i = 0; i < 16; ++i) { acc1[i] = (acc1[i] + winter * acc2[i]) * idn; hsq += acc1[i] * acc1[i]; }
        hsq += __shfl_xor(hsq, 32);
        if (h2 == 0) part[dvb * 64 + t] = hsq;
        __syncthreads();
        const float tot = (part[t] + part[64 + t]) + (part[128 + t] + part[192 + t]);
        const float rsn = __builtin_amdgcn_rsqf(tot * (1.0f / 128.0f) + RMS_EPS);
        const size_t orow = (t0 + t) * 1024 + h * 128 + 32 * dvb + 4 * h2;
#pragma unroll
        for (int gq = 0; gq < 4; ++gq) {
            const u32x2 op = opv[gq]; const f32x4 gn = *(const LAS f32x4*)(gnl + 32 * dvb + 4 * h2 + 8 * gq);
            const float y0 = acc1[4 * gq + 0] * rsn * gn[0] * sigmoid_f(bf_lo(op.x)), y1 = acc1[4 * gq + 1] * rsn * gn[1] * sigmoid_f(bf_hi(op.x));
            const float y2 = acc1[4 * gq + 2] * rsn * gn[2] * sigmoid_f(bf_lo(op.y)), y3 = acc1[4 * gq + 3] * rsn * gn[3] * sigmoid_f(bf_hi(op.y));
            u32x2 wv; wv.x = pk2(y0, y1); wv.y = pk2(y2, y3); *(u32x2*)(MX + orow + 8 * gq) = wv;
        }
    }
    __syncthreads();
#undef OUT_LOAD
}
__device__ __forceinline__ void final_phase(float* __restrict__ out, const bf16* __restrict__ hbv, const float* __restrict__ ss, const float* __restrict__ gain, int G, int bid) {
    const int gt = bid * 512 + threadIdx.x, NGT = G * 512;
    for (int i = gt; i < T_TOK * 128; i += NGT) { const int t = i >> 7, c8 = i & 127; const float rs = rs_from_ss(ss[t]);
        const u32x4 hv = __builtin_nontemporal_load((const u32x4*)(hbv + (size_t)t * 1024 + 8 * c8)); const f32x4 g0 = *(const f32x4*)(gain + 8 * c8), g1 = *(const f32x4*)(gain + 8 * c8 + 4);
        f32x4 o0, o1; o0[0] = bf_lo(hv[0]); o0[1] = bf_hi(hv[0]); o0[2] = bf_lo(hv[1]); o0[3] = bf_hi(hv[1]); o1[0] = bf_lo(hv[2]); o1[1] = bf_hi(hv[2]); o1[2] = bf_lo(hv[3]); o1[3] = bf_hi(hv[3]);
        o0 = o0 * rs * g0; o1 = o1 * rs * g1;
        *(f32x4*)(out + (size_t)t * 1024 + 8 * c8) = o0; *(f32x4*)(out + (size_t)t * 1024 + 8 * c8 + 4) = o1; }
}
__global__ void __launch_bounds__(NWAVES * 64, 2) mega_fwd(Args A) {
    extern __shared__ __attribute__((aligned(16))) unsigned char lds_raw[];
    LAS unsigned char* lds = (LAS unsigned char*)lds_raw;
    cg::grid_group grid = cg::this_grid();
    const int G = gridDim.x, bid = blockIdx.x;
    unsigned char* ws = A.ws;
    float* ss = (float*)(ws + WS_SS);
    bf16* hb = (bf16*)(ws + WS_HB); bf16* MX = (bf16*)(ws + WS_MX);
    bf16* QKVh = (bf16*)(ws + WS_BIG); float* H = (float*)(ws + WS_H); bf16* ACT = (bf16*)(ws + WS_ACT); bf16* P2 = (bf16*)(ws + WS_ACT);
    bf16* Oh = (bf16*)A.out; bf16* Cst = (bf16*)A.out; bf16* OP = (bf16*)A.out + (size_t)32 * 1024 * 1024;
    float* lse = (float*)(ws + WS_LSE); float* gates = (float*)(ws + WS_GATES); float* rope = (float*)(ws + WS_ROPE);
    float* mst = (float*)(ws + WS_MST); float* nst = (float*)(ws + WS_NST);
    bf16* QKc = hb;
    float* GA = (float*)(ws + 460 * MiB); float* GB = GA + (size_t)T_TOK * 8; float* GP = GB + (size_t)T_TOK * 8; float* CH = GP + (size_t)T_TOK * 8;
    const int lo = A.ph_lo, hi = A.ph_hi;
    volatile LAS unsigned* MISC = (volatile LAS unsigned*)(lds + LDS_BYTES - 256);
    if (threadIdx.x < 16) MISC[threadIdx.x] = 0u;
    __syncthreads();
    const XcdBarrier bar = xcd_barrier_post((unsigned*)(ws + WS_BAR), MISC + 8);
#ifndef PROBE_MASK
#define PROBE_MASK 0u
#endif
#define PROBE_K 4ull
    unsigned long long pr_sum = 0ull, pr_t0 = 0ull, pr_s0 = 0ull;
#define PB(k) do { if (PROBE_MASK & (1u << (k))) pr_t0 = __builtin_amdgcn_s_memrealtime(); } while (0)
#define PE(k) do { if (PROBE_MASK & (1u << (k))) pr_sum += __builtin_amdgcn_s_memrealtime() - pr_t0; } while (0)
#define IN(k) (lo <= (k) && (k) < hi)
#define SYNC(k) do { if (IN(k) && IN((k) + 1)) { if (PROBE_MASK & (1u << 30)) pr_s0 = __builtin_amdgcn_s_memrealtime(); if (hi < 0) { __threadfence(); grid.sync(); __threadfence(); } else xcd_barrier(bar); if (PROBE_MASK & (1u << 30)) pr_sum += __builtin_amdgcn_s_memrealtime() - pr_s0; if (PROBE_MASK & (1u << 29)) { pr_s0 = __builtin_amdgcn_s_memrealtime(); xcd_barrier(bar); pr_sum += __builtin_amdgcn_s_memrealtime() - pr_s0; } } PE(k); } while (0)
    PB(0); if (IN(0)) p0_prologue(A, lds, G, bid);
    SYNC(0);
    PB(1); if (IN(1)) { pg8::Gemm g{hb, (const bf16*)(ws + WS_WQKV), THALF, 9216, 1024}; pg8::StaticOrder S; S.init(THALF, 9216, G, bid);
        pg8::EpiQKV E{QKVh, ss, rope}; pg8::gemm_phase<pg8::EpiQKV, pg8::StaticOrder, true, true>(lds, g, S, E); }
    SYNC(1);
    PB(2); if (IN(2)) attn_phase(lds, QKVh, Oh, lse, 0, G, bid);
    SYNC(2);
    PB(3); if (IN(3)) { merge_phase(Oh, lse, MX, 0, G, bid);
        pg8::Gemm g{hb + (size_t)THALF * 1024, (const bf16*)(ws + WS_WQKV), THALF, 9216, 1024}; pg8::StaticOrder S; S.init(THALF, 9216, G, bid);
        pg8::EpiQKV E{QKVh, ss + THALF, rope + (size_t)THALF * 32}; pg8::gemm_phase<pg8::EpiQKV, pg8::StaticOrder, true, true>(lds, g, S, E); }
    SYNC(3);
    PB(4); if (IN(4)) attn_phase(lds, QKVh, Oh, lse, 1, G, bid);
    SYNC(4);
    PB(5); if (IN(5)) merge_phase(Oh, lse, MX, 1, G, bid);
    SYNC(5);
    PB(6); if (IN(6)) { pg8::Gemm g{MX, (const bf16*)(ws + WS_WAO), T_TOK, 1024, 1024}; pg8::StaticOrder S; S.init(T_TOK, 1024, G, bid);
        pg8::EpiResid E{A.x, H, hb, ss + T_TOK}; pg8::gemm_phase<pg8::EpiResid, pg8::StaticOrder, true, true>(lds, g, S, E); }
    SYNC(6);
    PB(7); if (IN(7)) { pg8::Gemm g{hb, (const bf16*)(ws + WS_WFFIN), T_TOK, 5632, 1024}; pg8::StaticOrder S; S.init(T_TOK, 5632, G, bid);
        pg8::EpiSwiGLU E{ACT, ss + T_TOK}; pg8::gemm_phase<pg8::EpiSwiGLU, pg8::StaticOrder, true, true>(lds, g, S, E); }
    SYNC(7);
    PB(8); if (IN(8)) { pg8::Gemm g{ACT, (const bf16*)(ws + WS_WFFOUT), T_TOK, 1024, DFF}; pg8::StaticOrder S; S.init(T_TOK, 1024, G, bid);
        pg8::EpiResid E{H, H, hb, ss + 2 * T_TOK}; pg8::gemm_phase<pg8::EpiResid, pg8::StaticOrder, true, true>(lds, g, S, E); }
    SYNC(8);
    PB(9); if (IN(9)) { pg8::Gemm g{hb, (const bf16*)(ws + WS_WMIN), T_TOK, 3328, 1024}; pg8::StaticOrder S; S.init(T_TOK, 3328, G, bid);
        pg8::EpiMlstmIn E{P2, OP, gates, ss + 2 * T_TOK}; pg8::gemm_phase<pg8::EpiMlstmIn, pg8::StaticOrder, true, true>(lds, g, S, E); }
    SYNC(9);
    PB(10); if (IN(10)) { mlstm_pre_phase(P2, gates, A.conv_w, A.conv_b, A.ig_bias, A.fg_bias, QKc, GA, GB, GP, CH, G, bid); xcd_barrier(bar);
        mlstm_scan_phase(lds, P2, QKc, GA, CH, Cst, nst, mst, G, bid); }
    SYNC(10);
    PB(11); if (IN(11)) mlstm_out_phase(lds, P2, QKc, OP, GA, GB, GP, A.head_gain, Cst, nst, mst, MX, G, bid);
    SYNC(11);
    PB(12); if (IN(12)) { pg8::Gemm g{MX, (const bf16*)(ws + WS_WMOUT), T_TOK, 1024, 1024}; pg8::StaticOrder S; S.init(T_TOK, 1024, G, bid);
        pg8::EpiResid E{H, H, hb, ss + 3 * T_TOK}; pg8::gemm_phase<pg8::EpiResid, pg8::StaticOrder, true, true>(lds, g, S, E); }
    SYNC(12);
    PB(13); if (IN(13)) { pg8::Gemm g{hb, (const bf16*)(ws + WS_WFFIN) + (size_t)5632 * 1024, T_TOK, 5632, 1024}; pg8::StaticOrder S; S.init(T_TOK, 5632, G, bid);
        pg8::EpiSwiGLU E{ACT, ss + 3 * T_TOK}; pg8::gemm_phase<pg8::EpiSwiGLU, pg8::StaticOrder, true, true>(lds, g, S, E); }
    SYNC(13);
    PB(14); if (IN(14)) { pg8::Gemm g{ACT, (const bf16*)(ws + WS_WFFOUT) + (size_t)1024 * DFF, T_TOK, 1024, DFF}; pg8::StaticOrder S; S.init(T_TOK, 1024, G, bid);
        pg8::EpiResid E{H, nullptr, hb, ss + 4 * T_TOK};        pg8::gemm_phase<pg8::EpiResid, pg8::StaticOrder, true, true>(lds, g, S, E); }
    SYNC(14);
    PB(15); if (IN(15)) final_phase(A.out, hb, ss + 4 * T_TOK, A.final_norm, G, bid);
    PE(15);
    if (PROBE_MASK != 0u && bid == 0 && threadIdx.x == 0) { const unsigned long long te = __builtin_amdgcn_s_memrealtime(); while (__builtin_amdgcn_s_memrealtime() - te < PROBE_K * pr_sum) __builtin_amdgcn_s_sleep(8); }
#undef IN
#undef SYNC
}

extern "C" void kernel_launch(void* const* d_in, const int* in_sizes, int n_in, void* d_out, int out_size, void* d_ws, size_t ws_size, hipStream_t stream) {
    static int grid = 0;
    if (grid == 0) {
        if (n_in != 17 || in_sizes[0] != T_TOK * DM || out_size != T_TOK * DM || ws_size < WS_END) { fprintf(stderr, "kernel_launch: unexpected shapes (n_in %d, in0 %d, out %d, ws %zu); nothing launched\n", n_in, n_in > 0 ? in_sizes[0] : -1, out_size, ws_size); grid = -1; return; }
        int dev = 0, cus = 0, per_cu = 0;
        if (hipGetDevice(&dev) != hipSuccess || hipDeviceGetAttribute(&cus, hipDeviceAttributeMultiprocessorCount, dev) != hipSuccess) { grid = -1; return; }
        if (hipFuncSetAttribute((const void*)mega_fwd, hipFuncAttributeMaxDynamicSharedMemorySize, LDS_BYTES) != hipSuccess) { fprintf(stderr, "kernel_launch: hipFuncSetAttribute failed\n"); grid = -1; return; }
        if (hipOccupancyMaxActiveBlocksPerMultiprocessor(&per_cu, (const void*)mega_fwd, NWAVES * 64, LDS_BYTES) != hipSuccess || per_cu < 1) { fprintf(stderr, "kernel_launch: occupancy query says %d\n", per_cu); per_cu = 1; }
        (void)hipGetLastError();
        grid = cus;
    }
    if (grid < 0) return;
    Args a{};
    a.x = (const float*)d_in[0]; a.pos = (const int*)d_in[1]; a.attn_norm = (const float*)d_in[2]; a.attn_w_in = (const float*)d_in[3]; a.attn_w_out = (const float*)d_in[4];
    a.mlstm_norm = (const float*)d_in[5]; a.mlstm_w_in = (const float*)d_in[6]; a.conv_w = (const float*)d_in[7]; a.conv_b = (const float*)d_in[8]; a.ig_bias = (const float*)d_in[9];
    a.fg_bias = (const float*)d_in[10]; a.head_gain = (const float*)d_in[11]; a.mlstm_w_out = (const float*)d_in[12]; a.ffn_norm = (const float*)d_in[13]; a.ffn_w_in = (const float*)d_in[14];
    a.ffn_w_out = (const float*)d_in[15]; a.final_norm = (const float*)d_in[16];
    a.out = (float*)d_out; a.ws = (unsigned char*)d_ws; a.ph_lo = 0; a.ph_hi = 16;
    if (hipMemsetAsync((char*)d_ws + WS_BAR, 0, 16384, stream) != hipSuccess) { fprintf(stderr, "kernel_launch: hipMemsetAsync failed\n"); return; }
    void* args[] = {&a};
    const hipError_t e = hipLaunchCooperativeKernel((const void*)mega_fwd, dim3(grid), dim3(NWAVES * 64), args, LDS_BYTES, stream);
    if (e != hipSuccess) fprintf(stderr, "kernel_launch: cooperative launch failed: %s (grid %d)\n", hipGetErrorString(e), grid);
}
```

```cpp
#include <hip/hip_runtime.h>
#include <hip/hip_cooperative_groups.h>
#include <cstdio>
#include <cstdint>
namespace cg = cooperative_groups;

constexpr float RMS_EPS = 1e-6f;
__device__ __forceinline__ float rs_from_ss(float ss) { return __builtin_amdgcn_rsqf(ss * (1.0f / 1024.0f) + RMS_EPS); }
__device__ __forceinline__ float silu_f(float x) { return x * __builtin_amdgcn_rcpf(1.0f + __builtin_amdgcn_exp2f(x * -1.4426950408889634f)); }
__device__ __forceinline__ float sigmoid_f(float x) { return __builtin_amdgcn_rcpf(1.0f + __builtin_amdgcn_exp2f(x * -1.4426950408889634f)); }

namespace pg8 {
#define PG8_LAS __attribute__((address_space(3)))
typedef unsigned short bf16_t;
typedef short bf16x8 __attribute__((ext_vector_type(8)));
typedef float f32x4 __attribute__((ext_vector_type(4)));
typedef unsigned u32x4 __attribute__((ext_vector_type(4)));
constexpr int BM = 256, BK = 64, HALF = 128, HTB = HALF * BK * 2  , STAGE_BYTES = 8 * HTB, NXCD = 8, WGM = 8;

__host__ __device__ __forceinline__ int lds_byte(int r, int c) { const int st = (r >> 4) * 2 + (c >> 5), rr = r & 15, cc = c & 31, ob = rr * 64 + cc * 2; return st * 1024 + (ob ^ (((ob >> 9) & 1) << 5)); }
__host__ __device__ __forceinline__ void stage_rc(int b, int& R, int& C) { const int st = b / 1024, sb = b % 1024, swz = sb ^ (((sb >> 9) & 1) << 5); R = (st >> 1) * 16 + swz / 64; C = (st & 1) * 32 + (swz % 64) / 2; }
__host__ __device__ __forceinline__ int perm32(int rho) { const int n = rho >> 4, i = rho & 15; return 8 * (i >> 2) + 4 * n + (i & 3); }

typedef unsigned u32x2 __attribute__((ext_vector_type(2)));
struct Unit { int pm, pn; };
struct Gemm { const bf16_t* A; const bf16_t* Bt; int M, N, K; };

struct StaticOrder {
    int nM, nN, nwg, G, c;
    __host__ __device__ void init(int M, int N, int G_, int c_) { nM = M / BM; nN = N / BM; nwg = nM * nN; G = G_; c = c_; }
    __host__ __device__ bool next(int i, Unit& u) const {
        const long L = (long)i * G + c; if (L >= nwg) return false;
        int wgid = (int)L; { const int q = nwg / NXCD, r = nwg % NXCD, xcd = wgid % NXCD, off = wgid / NXCD; wgid = (xcd < r ? xcd * (q + 1) : r * (q + 1) + (xcd - r) * q) + off; }
        const int nig = WGM * nN, gid = wgid / nig, fm = gid * WGM, gsz = (nM - fm) < WGM ? (nM - fm) : WGM;
        u.pm = fm + ((wgid % nig) % gsz); u.pn = (wgid % nig) / gsz; return true;
    }
    __device__ __forceinline__ void a_ready(const Unit&) const {}
    __device__ __forceinline__ void done(const Unit&) const {}
};
__device__ __forceinline__ unsigned cvt_pk_bf16(float lo, float hi) { unsigned r; asm volatile("v_cvt_pk_bf16_f32 %0, %1, %2" : "=v"(r) : "v"(lo), "v"(hi)); return r; }

#define EPI_FENCE() asm volatile("" ::: "memory")
struct EpiQKV {
    static constexpr bool PERM = true, AFTER_DRAIN = false;
    bf16_t* O; const float* ss; const float* cs;
    __device__ __forceinline__ void operator()(const f32x4 (&acc)[2][2][4][2], const Unit& u, int wr, int wc, int fr, int fq) const {
        const int row0 = u.pm * BM + wr * 64 + fr; const int colt = u.pn * BM;
        const int tsel = (colt % 3072) / 1024;
        const bool rope = (tsel < 2) && (wc == 0);
        const int gsel = colt / 3072, lg = 2 * gsel, dil = 1 << lg;
        const int hb0 = (gsel * 3 + tsel) * 8 + (colt % 1024) / 128;
        float rsv[8];
#pragma unroll
        for (int k = 0; k < 8; ++k) rsv[k] = ss[row0 + (k >> 2) * HALF + (k & 3) * 16];
        f32x4 cA = {0.f, 0.f, 0.f, 0.f}, sA = cA;
        if (rope) { const float* p = cs + (size_t)row0 * 32 + 4 * fq; cA = *(const f32x4*)p; sA = *(const f32x4*)(p + 16); }
#pragma unroll
        for (int k = 0; k < 8; ++k) {
            const int ai = k >> 2, m = k & 3;
            const int row = row0 + ai * HALF + m * 16;
            f32x4 cN = cA, sN = sA;
            if (rope && k + 1 < 8) { const int rown = row0 + ((k + 1) >> 2) * HALF + ((k + 1) & 3) * 16; const float* p = cs + (size_t)rown * 32 + 4 * fq; cN = *(const f32x4*)p; sN = *(const f32x4*)(p + 16); }
            EPI_FENCE();
            const float rs = rs_from_ss(rsv[k]);
            const int sq = row & 2047, perm = ((sq & (dil - 1)) << (11 - lg)) + (sq >> lg);
            bf16_t* rowp = O + ((size_t)hb0 * 17408 + (row >> 11) * 2176 + perm) * 128;
            if (rope) {
                const f32x4 cr = cA * rs, sr = sA * rs;
#pragma unroll
                for (int bj = 0; bj < 2; ++bj) {
                    const f32x4 v0 = acc[ai][bj][m][0], v1 = acc[ai][bj][m][1];
                    const f32x4 o0 = v0 * cr - v1 * sr, o1 = v1 * cr + v0 * sr;
                    u32x2 w0, w1; w0.x = cvt_pk_bf16(o0[0], o0[1]); w0.y = cvt_pk_bf16(o0[2], o0[3]); w1.x = cvt_pk_bf16(o1[0], o1[1]); w1.y = cvt_pk_bf16(o1[2], o1[3]);
                    bf16_t* hp = rowp + (size_t)bj * 17408 * 128 + 4 * fq;
                    *(u32x2*)hp = w0; *(u32x2*)(hp + 16) = w1;
                }
            } else {
#pragma unroll
                for (int bj = 0; bj < 2; ++bj) {
                    const f32x4 v0 = acc[ai][bj][m][0] * rs, v1 = acc[ai][bj][m][1] * rs;
                    u32x4 wv; wv.x = cvt_pk_bf16(v0[0], v0[1]); wv.y = cvt_pk_bf16(v0[2], v0[3]); wv.z = cvt_pk_bf16(v1[0], v1[1]); wv.w = cvt_pk_bf16(v1[2], v1[3]);
                    *(u32x4*)(rowp + (size_t)bj * 17408 * 128 + wc * 32 + 8 * fq) = wv;
                }
            }
            cA = cN; sA = sN;
        }
    }
};
template <bool F32B> struct EpiResidT {
    static constexpr bool PERM = true, AFTER_DRAIN = false;
    const void* base; bf16_t* outb; float* ssn;
    __device__ __forceinline__ void operator()(const f32x4 (&acc)[2][2][4][2], const Unit& u, int wr, int wc, int fr, int fq) const {
        const int row0 = u.pm * BM + wr * 64 + fr; const int col0 = u.pn * BM + wc * 32 + 8 * fq;
        f32x4 fA[4]; u32x4 hA[2];
#pragma unroll
        for (int q = 0; q < 4; ++q) fA[q] = (f32x4){0.f, 0.f, 0.f, 0.f};
        hA[0] = (u32x4){0u, 0u, 0u, 0u}; hA[1] = hA[0];
        if constexpr (F32B) { const float* p = (const float*)base + (size_t)row0 * 1024 + col0; fA[0] = __builtin_nontemporal_load((const f32x4*)p); fA[1] = __builtin_nontemporal_load((const f32x4*)(p + 4)); fA[2] = __builtin_nontemporal_load((const f32x4*)(p + HALF)); fA[3] = __builtin_nontemporal_load((const f32x4*)(p + HALF + 4)); }
        else { const bf16_t* p = (const bf16_t*)base + (size_t)row0 * 1024 + col0; hA[0] = *(const u32x4*)p; hA[1] = *(const u32x4*)(p + HALF); }
#pragma unroll
        for (int k = 0; k < 8; ++k) {
            const int ai = k >> 2, m = k & 3;
            const int row = row0 + ai * HALF + m * 16;
            f32x4 fN[4]; u32x4 hN[2];
#pragma unroll
            for (int q = 0; q < 4; ++q) fN[q] = fA[q];
            hN[0] = hA[0]; hN[1] = hA[1];
            if (k + 1 < 8) { const int rown = row0 + ((k + 1) >> 2) * HALF + ((k + 1) & 3) * 16;
                if constexpr (F32B) { const float* p = (const float*)base + (size_t)rown * 1024 + col0; fN[0] = __builtin_nontemporal_load((const f32x4*)p); fN[1] = __builtin_nontemporal_load((const f32x4*)(p + 4)); fN[2] = __builtin_nontemporal_load((const f32x4*)(p + HALF)); fN[3] = __builtin_nontemporal_load((const f32x4*)(p + HALF + 4)); }
                else { const bf16_t* p = (const bf16_t*)base + (size_t)rown * 1024 + col0; hN[0] = *(const u32x4*)p; hN[1] = *(const u32x4*)(p + HALF); } }
            EPI_FENCE();
            float sq = 0.f;
#pragma unroll
            for (int bj = 0; bj < 2; ++bj) {
                const size_t off = (size_t)row * 1024 + col0 + bj * HALF;
                f32x4 b0, b1;
                if constexpr (F32B) { b0 = fA[2 * bj]; b1 = fA[2 * bj + 1]; }
                else { const u32x4 hv = hA[bj]; b0[0] = __uint_as_float(hv[0] << 16); b0[1] = __uint_as_float(hv[0] & 0xffff0000u); b0[2] = __uint_as_float(hv[1] << 16); b0[3] = __uint_as_float(hv[1] & 0xffff0000u);
                    b1[0] = __uint_as_float(hv[2] << 16); b1[1] = __uint_as_float(hv[2] & 0xffff0000u); b1[2] = __uint_as_float(hv[3] << 16); b1[3] = __uint_as_float(hv[3] & 0xffff0000u); }
                const f32x4 v0 = acc[ai][bj][m][0] + b0, v1 = acc[ai][bj][m][1] + b1;
                u32x4 wv; wv.x = cvt_pk_bf16(v0[0], v0[1]); wv.y = cvt_pk_bf16(v0[2], v0[3]); wv.z = cvt_pk_bf16(v1[0], v1[1]); wv.w = cvt_pk_bf16(v1[2], v1[3]); *(u32x4*)(outb + off) = wv;
                sq += (v0[0] * v0[0] + v0[1] * v0[1]) + (v0[2] * v0[2] + v0[3] * v0[3]) + (v1[0] * v1[0] + v1[1] * v1[1]) + (v1[2] * v1[2] + v1[3] * v1[3]);
            }
            sq += __shfl_xor(sq, 16); sq += __shfl_xor(sq, 32);
            if (fq == 0) atomicAdd(ssn + row, sq);
#pragma unroll
            for (int q = 0; q < 4; ++q) fA[q] = fN[q];
            hA[0] = hN[0]; hA[1] = hN[1];
        }
    }
};
struct EpiSwiGLU {
    static constexpr bool PERM = true, AFTER_DRAIN = false;
    bf16_t* O; const float* ss;
    __device__ __forceinline__ void operator()(const f32x4 (&acc)[2][2][4][2], const Unit& u, int wr, int wc, int fr, int fq) const {
        const int row0 = u.pm * BM + wr * 64 + fr; const int col0 = u.pn * HALF + wc * 32 + 8 * fq;
        float rsv[8];
#pragma unroll
        for (int k = 0; k < 8; ++k) rsv[k] = ss[row0 + (k >> 2) * HALF + (k & 3) * 16];
        EPI_FENCE();
#pragma unroll
        for (int ai = 0; ai < 2; ++ai)
#pragma unroll
            for (int m = 0; m < 4; ++m) {
                const int row = row0 + ai * HALF + m * 16;
                const float rs = rs_from_ss(rsv[ai * 4 + m]); const float rs2 = rs * rs, nrs = rs * -1.4426950408889634f;
                float o[8];
#pragma unroll
                for (int n = 0; n < 2; ++n)
#pragma unroll
                    for (int e = 0; e < 4; ++e) { const float g = acc[ai][0][m][n][e], uu = acc[ai][1][m][n][e] * rs2;
                        o[4 * n + e] = (g * uu) * __builtin_amdgcn_rcpf(1.0f + __builtin_amdgcn_exp2f(g * nrs)); }
                u32x4 wv; wv.x = cvt_pk_bf16(o[0], o[1]); wv.y = cvt_pk_bf16(o[2], o[3]); wv.z = cvt_pk_bf16(o[4], o[5]); wv.w = cvt_pk_bf16(o[6], o[7]);
                *(u32x4*)(O + (size_t)row * 2816 + col0) = wv;
            }
    }
};
struct EpiMlstmIn {
    static constexpr bool PERM = true, AFTER_DRAIN = false;
    bf16_t* P2; bf16_t* OP; float* gates; const float* ss;
    __device__ __forceinline__ void operator()(const f32x4 (&acc)[2][2][4][2], const Unit& u, int wr, int wc, int fr, int fq) const {
        const int row0 = u.pm * BM + wr * 64 + fr;
        float rsv[8];
#pragma unroll
        for (int k = 0; k < 8; ++k) rsv[k] = ss[row0 + (k >> 2) * HALF + (k & 3) * 16];
        EPI_FENCE();
#pragma unroll
        for (int ai = 0; ai < 2; ++ai)
#pragma unroll
            for (int m = 0; m < 4; ++m) {
                const int row = row0 + ai * HALF + m * 16;
                const float rs = rs_from_ss(rsv[ai * 4 + m]);
#pragma unroll
                for (int bj = 0; bj < 2; ++bj) {
                    const int cb = u.pn * BM + bj * HALF;
                    const f32x4 v0 = acc[ai][bj][m][0] * rs, v1 = acc[ai][bj][m][1] * rs;
                    const int cc = wc * 32 + 8 * fq;
                    if (cb < 3072) {
                        u32x4 wv; wv.x = cvt_pk_bf16(v0[0], v0[1]); wv.y = cvt_pk_bf16(v0[2], v0[3]); wv.z = cvt_pk_bf16(v1[0], v1[1]); wv.w = cvt_pk_bf16(v1[2], v1[3]);
                        bf16_t* dst = (cb < 2048) ? (P2 + (size_t)row * 2048 + cb + cc) : (OP + (size_t)row * 1024 + (cb - 2048) + cc);
                        *(u32x4*)dst = wv;
                    } else if (cb == 3072 && cc < 16) {
                        float* dst = gates + (size_t)row * 16 + cc;
                        *(f32x4*)dst = v0; *(f32x4*)(dst + 4) = v1;
                    }
                }
            }
    }
};

template <class Epi, class Sched, bool ALIGN_EPI = false, bool SP2 = false>
__device__ __forceinline__ void gemm_phase(PG8_LAS unsigned char* lds, const Gemm g, const Sched& S, const Epi& E) {
    const int tid = threadIdx.x, wid = __builtin_amdgcn_readfirstlane(tid >> 6), lane = tid & 63, wr = wid >> 2, wc = wid & 3, fr = lane & 15, fq = lane >> 4;
    const int K = g.K, nt = K / BK;
    unsigned voffA[2], voffB[2];
#pragma unroll
    for (int i = 0; i < 2; ++i) { int R, C; stage_rc(tid * 16 + i * 8192, R, C); const int Rb = Epi::PERM ? ((R & ~31) + perm32(R & 31)) : R;
        voffA[i] = (unsigned)(R * K + C) * 2u; voffB[i] = (unsigned)(Rb * K + C) * 2u; }
    const size_t kstep = (size_t)(BK * 2);
    const size_t hstep = (size_t)HALF * K * 2;
    const size_t tstep = 2 * hstep;
    const unsigned ldsw = (unsigned)wid * 1024u;
    const int aoff = lds_byte(wr * 64 + fr, fq * 8), boff = lds_byte(wc * 32 + fr, fq * 8);
#define PG8_SA(b, h) (((b) * 2 + (h)) * HTB)
#define PG8_SB(b, h) ((4 + (b) * 2 + (h)) * HTB)
#define PG8_STAGE(bufoff, gbase, voff) do { _Pragma("unroll") for (int _i = 0; _i < 2; ++_i) \
        __builtin_amdgcn_global_load_lds((const unsigned*)((const char*)(gbase) + (voff)[_i]), (PG8_LAS unsigned*)(lds + (bufoff) + ldsw + _i * 8192), 16, 0, 0); } while (0)
#define PG8_LDA(dst, b, h) do { _Pragma("unroll") for (int m = 0; m < 4; ++m) _Pragma("unroll") for (int k = 0; k < 2; ++k) dst[m][k] = *(const PG8_LAS bf16x8*)(lds + PG8_SA(b, h) + aoff + m * 2048 + k * 1024); } while (0)
#define PG8_LDB(dst, b, h) do { _Pragma("unroll") for (int n = 0; n < 2; ++n) _Pragma("unroll") for (int k = 0; k < 2; ++k) dst[n][k] = *(const PG8_LAS bf16x8*)(lds + PG8_SB(b, h) + boff + n * 2048 + k * 1024); } while (0)
#define PG8_MMA(ai, bj, At, Bt) do { __builtin_amdgcn_s_setprio(1); _Pragma("unroll") for (int m = 0; m < 4; ++m) _Pragma("unroll") for (int n = 0; n < 2; ++n) _Pragma("unroll") for (int k = 0; k < 2; ++k) \
        acc[ai][bj][m][n] = __builtin_amdgcn_mfma_f32_16x16x32_bf16(Bt[n][k], At[m][k], acc[ai][bj][m][n], 0, 0, 0); __builtin_amdgcn_s_setprio(0); } while (0)
#define PG8_WAIT_V(n) asm volatile("s_waitcnt vmcnt(" #n ")" ::: "memory")
#define PG8_WAIT_L(n) asm volatile("s_waitcnt lgkmcnt(" #n ")" ::: "memory")
#define PG8_BAR __builtin_amdgcn_s_barrier()
#define PG8_SCHED __builtin_amdgcn_sched_barrier(0)
    Unit cur, nxt; int ui = 0;
    if (!S.next(0, cur)) return;
    f32x4 acc[2][2][4][2];
#pragma unroll
    for (int a = 0; a < 2; ++a)
#pragma unroll
        for (int b = 0; b < 2; ++b)
#pragma unroll
            for (int m = 0; m < 4; ++m)
#pragma unroll
                for (int n = 0; n < 2; ++n) acc[a][b][m][n] = (f32x4){0.f, 0.f, 0.f, 0.f};
    bf16x8 At[4][2], B0[2][2], B1[2][2];
    const char* cA = (const char*)g.A + (size_t)cur.pm * tstep; const char* cB = (const char*)g.Bt + (size_t)cur.pn * tstep;
    S.a_ready(cur);
    if constexpr (SP2) {
        PG8_STAGE(PG8_SB(0, 0), cB, voffB); PG8_STAGE(PG8_SB(0, 1), cB + hstep, voffB); PG8_STAGE(PG8_SA(0, 0), cA, voffA); PG8_STAGE(PG8_SA(0, 1), cA + hstep, voffA);
        if (wr == 1) PG8_BAR;
        PG8_WAIT_V(2); PG8_BAR;
        PG8_STAGE(PG8_SB(1, 0), cB + kstep, voffB); PG8_STAGE(PG8_SA(1, 0), cA + kstep, voffA); PG8_STAGE(PG8_SB(1, 1), cB + hstep + kstep, voffB);
        PG8_WAIT_V(6); PG8_BAR;
    } else {
        PG8_STAGE(PG8_SB(0, 0), cB, voffB); PG8_STAGE(PG8_SA(0, 0), cA, voffA); PG8_STAGE(PG8_SB(0, 1), cB + hstep, voffB); PG8_STAGE(PG8_SA(0, 1), cA + hstep, voffA);
        if (wr == 1) PG8_BAR;
        PG8_WAIT_V(4); PG8_BAR;
        PG8_STAGE(PG8_SB(1, 0), cB + kstep, voffB); PG8_STAGE(PG8_SA(1, 0), cA + kstep, voffA); PG8_STAGE(PG8_SB(1, 1), cB + hstep + kstep, voffB);
        PG8_WAIT_V(6); PG8_BAR;
    }
    for (;;) {
        const bool has_next = S.next(ui + 1, nxt);
        const char* nA = has_next ? (const char*)g.A + (size_t)nxt.pm * tstep : cA; const char* nB = has_next ? (const char*)g.Bt + (size_t)nxt.pn * tstep : cB;
        for (int t = 0; t < nt; t += 2) {
            const bool last = (t == nt - 2);
            const char* a1 = cA + (size_t)(t + 1) * kstep;
            const char* a2 = last ? nA : cA + (size_t)(t + 2) * kstep; const char* b2 = last ? nB : cB + (size_t)(t + 2) * kstep;
            const char* a3 = a2 + kstep; const char* b3 = b2 + kstep;
            if (last && has_next) S.a_ready(nxt);
            if constexpr (SP2) {
            PG8_LDB(B0, 0, 0); PG8_LDB(B1, 0, 1); PG8_SCHED; PG8_LDA(At, 0, 0); PG8_STAGE(PG8_SA(1, 1), a1 + hstep, voffA);
            PG8_WAIT_V(8); PG8_WAIT_L(0); PG8_BAR; PG8_MMA(0, 0, At, B0); PG8_MMA(0, 1, At, B1); PG8_BAR; PG8_SCHED;
            PG8_LDA(At, 0, 1); PG8_STAGE(PG8_SB(0, 0), b2, voffB); PG8_STAGE(PG8_SB(0, 1), b2 + hstep, voffB); PG8_STAGE(PG8_SA(0, 0), a2, voffA);
            PG8_WAIT_V(8); PG8_WAIT_L(0); PG8_BAR; PG8_MMA(1, 0, At, B0); PG8_MMA(1, 1, At, B1); PG8_BAR; PG8_SCHED;
            PG8_LDB(B0, 1, 0); PG8_LDB(B1, 1, 1); PG8_SCHED; PG8_LDA(At, 1, 0); PG8_STAGE(PG8_SA(0, 1), a2 + hstep, voffA);
            PG8_WAIT_V(8); PG8_WAIT_L(0); PG8_BAR; PG8_MMA(0, 0, At, B0); PG8_MMA(0, 1, At, B1); PG8_BAR; PG8_SCHED;
            PG8_LDA(At, 1, 1); PG8_STAGE(PG8_SB(1, 0), b3, voffB); PG8_STAGE(PG8_SB(1, 1), b3 + hstep, voffB); PG8_STAGE(PG8_SA(1, 0), a3, voffA);
            PG8_WAIT_V(8); PG8_WAIT_L(0); PG8_BAR; PG8_MMA(1, 0, At, B0); PG8_MMA(1, 1, At, B1); PG8_BAR; PG8_SCHED;
            } else {
            PG8_LDB(B0, 0, 0); PG8_SCHED; PG8_LDA(At, 0, 0); PG8_STAGE(PG8_SA(1, 1), a1 + hstep, voffA);
            PG8_WAIT_L(8); PG8_BAR; PG8_WAIT_L(0); PG8_MMA(0, 0, At, B0); PG8_BAR; PG8_SCHED;
            PG8_LDB(B1, 0, 1); PG8_STAGE(PG8_SB(0, 0), b2, voffB);
            PG8_BAR; PG8_WAIT_L(0); PG8_MMA(0, 1, At, B1); PG8_BAR;
            PG8_LDA(At, 0, 1); PG8_STAGE(PG8_SA(0, 0), a2, voffA);
            PG8_BAR; PG8_WAIT_L(0); PG8_MMA(1, 0, At, B0); PG8_BAR; PG8_SCHED;
            PG8_STAGE(PG8_SB(0, 1), b2 + hstep, voffB);
            PG8_WAIT_V(6); PG8_BAR; PG8_MMA(1, 1, At, B1); PG8_BAR;
            PG8_LDB(B0, 1, 0); PG8_SCHED; PG8_LDA(At, 1, 0); PG8_STAGE(PG8_SA(0, 1), a2 + hstep, voffA);
            PG8_WAIT_L(8); PG8_BAR; PG8_WAIT_L(0); PG8_MMA(0, 0, At, B0); PG8_BAR; PG8_SCHED;
            PG8_LDB(B1, 1, 1); PG8_STAGE(PG8_SB(1, 0), b3, voffB);
            PG8_BAR; PG8_WAIT_L(0); PG8_MMA(0, 1, At, B1); PG8_BAR;
            PG8_LDA(At, 1, 1); PG8_STAGE(PG8_SA(1, 0), a3, voffA);
            PG8_BAR; PG8_WAIT_L(0); PG8_MMA(1, 0, At, B0); PG8_BAR; PG8_SCHED;
            PG8_STAGE(PG8_SB(1, 1), b3 + hstep, voffB);
            PG8_WAIT_V(6); PG8_BAR; PG8_MMA(1, 1, At, B1); PG8_BAR;
            }
        }
        if constexpr (ALIGN_EPI) { if (wr == 0) PG8_BAR; }
        if constexpr (!Epi::AFTER_DRAIN) { E(acc, cur, wr, wc, fr, fq); S.done(cur); }
        if (!has_next) break;
#pragma unroll
        for (int a = 0; a < 2; ++a)
#pragma unroll
            for (int b = 0; b < 2; ++b)
#pragma unroll
                for (int m = 0; m < 4; ++m)
#pragma unroll
                    for (int n = 0; n < 2; ++n) acc[a][b][m][n] = (f32x4){0.f, 0.f, 0.f, 0.f};
        cur = nxt; cA = nA; cB = nB; ++ui;
        if constexpr (ALIGN_EPI) { if (wr == 1) PG8_BAR; }
    }
    PG8_WAIT_V(0);
    if constexpr (!ALIGN_EPI) { if (wr == 0) PG8_BAR; }
    PG8_BAR;
    if constexpr (Epi::AFTER_DRAIN) { E.fused(acc, cur, wr, wc, fr, fq, lds, wid, lane); S.done(cur); }
#undef PG8_SA
#undef PG8_SB
#undef PG8_STAGE
#undef PG8_LDA
#undef PG8_LDB
#undef PG8_MMA
#undef PG8_WAIT_V
#undef PG8_WAIT_L
#undef PG8_BAR
#undef PG8_SCHED
}
}

constexpr int T_TOK = 32768, DM = 1024, SEQ = 2048, NB = 16, DFF = 2816, THALF = 16384;
constexpr int NWAVES = 8;
constexpr int RB = 2176, HBR = 8 * RB;
constexpr int LDS_BYTES = 147456;
constexpr size_t MiB = 1u << 20;
constexpr size_t WS_SS = 0;
constexpr size_t WS_MST = 1 * MiB;
constexpr size_t WS_NST = 1 * MiB + 65536;
constexpr size_t WS_BAR = 3 * MiB;
constexpr size_t WS_WQKV = 4 * MiB;
constexpr size_t WS_WAO = 22 * MiB;
constexpr size_t WS_WFFIN = 24 * MiB;
constexpr size_t WS_WFFOUT = 46 * MiB;
constexpr size_t WS_WMIN = 57 * MiB;
constexpr size_t WS_WMOUT = 64 * MiB;
constexpr size_t WS_ROPE = 66 * MiB;
constexpr size_t WS_LSE = 70 * MiB;
constexpr size_t WS_GATES = 73 * MiB;
constexpr size_t WS_HB = 76 * MiB;
constexpr size_t WS_MX = 140 * MiB;
constexpr size_t WS_BIG = 204 * MiB;
constexpr size_t WS_H = WS_BIG;
constexpr size_t WS_ACT = WS_BIG + 128 * MiB;
constexpr size_t WS_END = 512 * MiB;
static_assert(WS_ACT + (size_t)T_TOK * DFF * 2 <= WS_END && WS_BIG + (size_t)72 * 8 * 2176 * 256 <= WS_END, "d_ws map");

#define LAS __attribute__((address_space(3)))
typedef unsigned short bf16;
typedef unsigned u32x4 __attribute__((ext_vector_type(4)));
typedef unsigned u32x2 __attribute__((ext_vector_type(2)));
typedef float f32x4 __attribute__((ext_vector_type(4)));
typedef float f32x16 __attribute__((ext_vector_type(16)));
typedef short bf16x8 __attribute__((ext_vector_type(8)));
typedef short s16x4 __attribute__((ext_vector_type(4)));
typedef float f32x2_t __attribute__((ext_vector_type(2)));
typedef __bf16 bf16x2_t __attribute__((ext_vector_type(2)));
__device__ __forceinline__ unsigned pk2(float lo, float hi) { f32x2_t v = {lo, hi}; bf16x2_t b = __builtin_convertvector(v, bf16x2_t); return __builtin_bit_cast(unsigned, b); }
__device__ __forceinline__ float bf_lo(unsigned w) { return __uint_as_float(w << 16); }
__device__ __forceinline__ float bf_hi(unsigned w) { return __uint_as_float(w & 0xffff0000u); }
__device__ __forceinline__ float wave_sum(float v) {
#pragma unroll
    for (int o = 1; o < 64; o <<= 1) v += __shfl_xor(v, o);
    return v;
}
__device__ __forceinline__ float wave_max(float v) {
#pragma unroll
    for (int o = 1; o < 64; o <<= 1) v = fmaxf(v, __shfl_xor(v, o));
    return v;
}
#define MFMA16(a, b, c) __builtin_amdgcn_mfma_f32_16x16x32_bf16((a), (b), (c), 0, 0, 0)
#define MFMA32(a, b, c) __builtin_amdgcn_mfma_f32_32x32x16_bf16((a), (b), (c), 0, 0, 0)

#define XB_TMO      128
#define XB_XCNT(j)  (256  + 64 * (j))
#define XB_XSUB(j)  (1280 + 64 * (j))
#define XB_XGEN(j)  (2304 + 64 * (j))
#define XB_TOP      3328
#define XB_TOPGEN   3392
#define XCD_BAR_WORDS 3456
#define XB_SPIN_CAP (1u << 18)

__device__ __forceinline__ unsigned xb_ld(unsigned* p)              { return __hip_atomic_load(p, __ATOMIC_RELAXED, __HIP_MEMORY_SCOPE_AGENT); }
__device__ __forceinline__ unsigned xb_add(unsigned* p, unsigned v) { return __hip_atomic_fetch_add(p, v, __ATOMIC_RELAXED, __HIP_MEMORY_SCOPE_AGENT); }
__device__ __forceinline__ unsigned xb_xcc_id() { return (unsigned)__builtin_amdgcn_s_getreg((3 << 11) | 20) & 0xFu; }
#define XB_SPIN(cond, bar) do { unsigned _sp = 0; while (cond) { __builtin_amdgcn_s_sleep(1); \
    if ((++_sp & 255u) == 0u) { if (xb_ld(&(bar)[XB_TMO])) break; if (_sp > XB_SPIN_CAP) { atomicAdd(&(bar)[XB_TMO], 1u); break; } } } } while (0)

struct XcdBarrier {
    unsigned* bar; unsigned x;
    volatile LAS unsigned* st;
};

__device__ __forceinline__ XcdBarrier xcd_barrier_post(unsigned* bar, volatile LAS unsigned* st) {
    XcdBarrier b; b.bar = bar; b.x = xb_xcc_id(); b.st = st;
    if (threadIdx.x == 0) (void)xb_add(&bar[XB_XCNT(b.x)], 1u);
    return b;
}
__device__ __forceinline__ void xcd_barrier_complete(unsigned* bar, unsigned x, unsigned& nloc, unsigned& nx) {
    const unsigned G = gridDim.x * gridDim.y * gridDim.z;
    unsigned sum, cnt, mine, sp = 0u;
    for (;;) {
        sum = 0u; cnt = 0u; mine = 0u;
#pragma unroll
        for (unsigned j = 0; j < 16; ++j) { const unsigned c = xb_ld(&bar[XB_XCNT(j)]); sum += c; cnt += (c > 0u) ? 1u : 0u; mine = (j == x) ? c : mine; }
        if (sum == G) break;
        __builtin_amdgcn_s_sleep(1);
        if ((++sp & 255u) == 0u) { if (xb_ld(&bar[XB_TMO])) break; if (sp > XB_SPIN_CAP) { atomicAdd(&bar[XB_TMO], 1u); break; } }
    }
    nloc = mine > 0u ? mine : 1u; nx = cnt > 0u ? cnt : 1u;
}

__device__ __forceinline__ void xcd_barrier(const XcdBarrier& b) {
    asm volatile("s_waitcnt vmcnt(0)" ::: "memory");
    __syncthreads();
    if (threadIdx.x == 0) {
        unsigned* bar = b.bar;
        __builtin_amdgcn_s_waitcnt(0);
        unsigned nloc = b.st[0], nx = b.st[1];
        if (nloc == 0u) { xcd_barrier_complete(bar, b.x, nloc, nx); b.st[0] = nloc; b.st[1] = nx; }
        const unsigned old = xb_add(&bar[XB_XSUB(b.x)], 1u);
        const unsigned gen = old / nloc;
        if (old + 1u == (gen + 1u) * nloc) {
            __builtin_amdgcn_fence(__ATOMIC_RELEASE, "agent");
            asm volatile("s_waitcnt vmcnt(0)" ::: "memory");
            const unsigned og = xb_add(&bar[XB_TOP], 1u);
            const unsigned tg = og / nx;
            if (og + 1u == (tg + 1u) * nx) xb_add(&bar[XB_TOPGEN], 1u);
            else XB_SPIN(xb_ld(&bar[XB_TOPGEN]) == tg, bar);
            __builtin_amdgcn_fence(__ATOMIC_ACQUIRE, "agent");
            xb_add(&bar[XB_XGEN(b.x)], 1u);
            asm volatile("s_waitcnt vmcnt(0)" ::: "memory");
        } else {
            XB_SPIN(xb_ld(&bar[XB_XGEN(b.x)]) == gen, bar);
            __builtin_amdgcn_fence(__ATOMIC_ACQUIRE, "agent");
            asm volatile("s_waitcnt vmcnt(0)" ::: "memory");
        }
    }
    __syncthreads();
}


struct Args {
    const float* x; const int* pos; const float* attn_norm; const float* attn_w_in; const float* attn_w_out; const float* mlstm_norm; const float* mlstm_w_in;
    const float* conv_w; const float* conv_b; const float* ig_bias; const float* fg_bias; const float* head_gain; const float* mlstm_w_out;
    const float* ffn_norm; const float* ffn_w_in; const float* ffn_w_out; const float* final_norm;
    float* out; unsigned char* ws; int ph_lo, ph_hi;
};

__device__ __forceinline__ void tr_item(const float* __restrict__ W, int K, int Nsrc, bf16* WT, int n0_dst, int n0_src, int k0, const float* __restrict__ gain, float scale, LAS float* scr, int lane, bool ropeperm = false) {
    const int n4 = lane & 15, kq = lane >> 4; const int s4 = (ropeperm && n4 < 8) ? (((n4 & 1) << 2) + (n4 >> 1)) : n4; const int col = n0_src + 4 * s4; const bool ok = col < Nsrc;
    f32x4 v[16];
#pragma unroll
    for (int i = 0; i < 16; ++i) { v[i] = (f32x4){0.f, 0.f, 0.f, 0.f}; if (ok) v[i] = __builtin_nontemporal_load((const f32x4*)(W + (size_t)(k0 + 4 * i + kq) * Nsrc + col)); }
#pragma unroll
    for (int i = 0; i < 16; ++i) { const int kk = 4 * i + kq; const float g = gain ? gain[k0 + kk] * scale : scale; LAS float* d = scr + kk * 65 + 4 * n4;
        d[0] = v[i][0] * g; d[1] = v[i][1] * g; d[2] = v[i][2] * g; d[3] = v[i][3] * g; }
    asm volatile("s_waitcnt lgkmcnt(0)" ::: "memory");
    const int c = lane & 7;
#pragma unroll
    for (int j = 0; j < 8; ++j) { const int n = (lane >> 3) + 8 * j; const LAS float* sp = scr + (8 * c) * 65 + n;
        u32x4 o; o.x = pk2(sp[0 * 65], sp[1 * 65]); o.y = pk2(sp[2 * 65], sp[3 * 65]); o.z = pk2(sp[4 * 65], sp[5 * 65]); o.w = pk2(sp[6 * 65], sp[7 * 65]);
        *(u32x4*)(WT + (size_t)(n0_dst + n) * K + k0 + 8 * c) = o; }
    asm volatile("s_waitcnt lgkmcnt(0)" ::: "memory");
}
__device__ __forceinline__ void p0_prologue(const Args& A, LAS unsigned char* lds, int G, int bid) {
    const int tid = threadIdx.x, lane = tid & 63, wave = tid >> 6;
    LAS float* scr = (LAS float*)(lds + wave * 16640);
    const int gw = bid * NWAVES + wave, NGW = G * NWAVES;
    unsigned char* ws = A.ws;
    constexpr int I_QKV = 16 * 144, I_AO = 16 * 16, I_FFIN = 16 * 88, I_FFOUT = 44 * 16, I_MIN = 16 * 52, I_MOUT = 16 * 16;
    constexpr int NITEMS = I_QKV + I_AO + 2 * I_FFIN + 2 * I_FFOUT + I_MIN + I_MOUT;
    constexpr float QSCALE = 0.08838834764831845f * 1.4426950408889634f;
    for (int it = gw; it < NITEMS; it += NGW) {
        int r = it;
        if (r < I_QKV) { const int kb = r / 144, nb = r % 144, n0 = 64 * nb; const int tsel = (n0 % 3072) / 1024;
            tr_item(A.attn_w_in, 1024, 9216, (bf16*)(ws + WS_WQKV), n0, n0, 64 * kb, A.attn_norm, tsel == 0 ? QSCALE : 1.f, scr, lane, tsel < 2 && (n0 & 127) == 0); continue; } r -= I_QKV;
        if (r < I_AO) { const int kb = r / 16, nb = r % 16; tr_item(A.attn_w_out, 1024, 1024, (bf16*)(ws + WS_WAO), 64 * nb, 64 * nb, 64 * kb, nullptr, 1.f, scr, lane); continue; } r -= I_AO;
        if (r < 2 * I_FFIN) { const int l = r / I_FFIN; r -= l * I_FFIN; const int kb = r / 88, nb = r % 88, n0 = 64 * nb;
            const int pn = n0 >> 8, bj = (n0 >> 7) & 1, jj = n0 & 127; const int nsrc = (bj ? DFF : 0) + 128 * pn + jj;
            tr_item(A.ffn_w_in + (size_t)l * 1024 * 5632, 1024, 5632, (bf16*)(ws + WS_WFFIN) + (size_t)l * 5632 * 1024, n0, nsrc, 64 * kb, A.ffn_norm + l * 1024, 1.f, scr, lane); continue; } r -= 2 * I_FFIN;
        if (r < 2 * I_FFOUT) { const int l = r / I_FFOUT; r -= l * I_FFOUT; const int kb = r / 16, nb = r % 16;
            tr_item(A.ffn_w_out + (size_t)l * DFF * 1024, DFF, 1024, (bf16*)(ws + WS_WFFOUT) + (size_t)l * 1024 * DFF, 64 * nb, 64 * nb, 64 * kb, nullptr, 1.f, scr, lane); continue; } r -= 2 * I_FFOUT;
        if (r < I_MIN) { const int kb = r / 52, nb = r % 52; tr_item(A.mlstm_w_in, 1024, 3088, (bf16*)(ws + WS_WMIN), 64 * nb, 64 * nb, 64 * kb, A.mlstm_norm, 1.f, scr, lane); continue; } r -= I_MIN;
        { const int kb = r / 16, nb = r % 16; tr_item(A.mlstm_w_out, 1024, 1024, (bf16*)(ws + WS_WMOUT), 64 * nb, 64 * nb, 64 * kb, nullptr, 1.f, scr, lane); }
    }
    float* ss = (float*)(ws + WS_SS); bf16* hb = (bf16*)(ws + WS_HB);
    for (int m4 = gw; m4 < T_TOK / 4; m4 += NGW) {
        f32x4 v[4][4];
#pragma unroll
        for (int q = 0; q < 4; ++q) { const f32x4* xr = (const f32x4*)(A.x + (size_t)(4 * m4 + q) * DM) + lane;
#pragma unroll
            for (int j = 0; j < 4; ++j) v[q][j] = __builtin_nontemporal_load(xr + 64 * j); }
#pragma unroll
        for (int q = 0; q < 4; ++q) { const int m = 4 * m4 + q; float sq = 0.f;
#pragma unroll
            for (int j = 0; j < 4; ++j) sq += (v[q][j].x * v[q][j].x + v[q][j].y * v[q][j].y) + (v[q][j].z * v[q][j].z + v[q][j].w * v[q][j].w);
            sq = wave_sum(sq);
            u32x2* o8 = (u32x2*)(hb + (size_t)m * DM) + lane;
#pragma unroll
            for (int j = 0; j < 4; ++j) { u32x2 o; o.x = pk2(v[q][j].x, v[q][j].y); o.y = pk2(v[q][j].z, v[q][j].w); o8[64 * j] = o; }
            if (lane == 0) ss[m] = sq; }
    }
    const int gt = bid * 512 + tid, NGT = G * 512;
    for (int i = gt; i < 4 * T_TOK; i += NGT) ss[T_TOK + i] = 0.f;
    float* rope = (float*)(ws + WS_ROPE);
    for (int i = gt; i < T_TOK * 16; i += NGT) {
        const int t = i >> 4, f = i & 15;
        const float invf = __builtin_amdgcn_exp2f((float)f * -1.1832230355827609f);
        const float ang = (float)A.pos[t] * invf;
        const double rev = (double)ang * 0.15915494309189535; const float fr = (float)(rev - rint(rev));
        rope[(size_t)t * 32 + f] = __builtin_amdgcn_cosf(fr); rope[(size_t)t * 32 + 16 + f] = __builtin_amdgcn_sinf(fr);
    }
}

struct AStep { const bf16* base; size_t rowstride; int blk, g, h, dil, rr, b; bool valid, compute; };
__device__ __forceinline__ AStep attn_step(int u, int s, const bf16* QKVh) {
    AStep t; t.valid = true; t.compute = true;
    if (s < 5) { t.g = 0; t.dil = 1; t.rr = 0; const int qt = u & 3; t.h = (u >> 2) & 7; t.b = u >> 5; t.blk = 4 * qt + s - 1; if (s == 0) { t.compute = false; t.valid = qt > 0; if (!t.valid) t.blk = 0; } }
    else if (s < 9) { t.g = 1; t.dil = 4; t.h = u & 7; t.rr = (u >> 3) & 3; t.b = u >> 5; t.blk = s - 5; }
    else { t.g = 2; t.dil = 16; const int v = 4 * u + (s - 9); t.h = v & 7; t.rr = (v >> 3) & 15; t.b = v >> 7; t.blk = 0; }
    t.rowstride = 128;
    t.base = QKVh + ((size_t)(t.g * 24 + t.h) * HBR + t.b * RB + t.rr * (SEQ / t.dil)) * 128;
    return t;
}
typedef short v4i16_t __attribute__((ext_vector_type(4)));
__device__ __forceinline__ s16x4 tr_read(const LAS unsigned char* p) { return __builtin_bit_cast(s16x4, __builtin_amdgcn_ds_read_tr16_b64_v4i16((LAS v4i16_t*)p)); }
__device__ __forceinline__ void attn_phase(LAS unsigned char* lds, const bf16* __restrict__ QKVh, bf16* __restrict__ Oh, float* __restrict__ lse, int half, int G, int bid) {
    const int tid = threadIdx.x, lane = tid & 63, w = __builtin_amdgcn_readfirstlane(tid >> 6), r = lane & 15, q4 = lane >> 4;
    constexpr int SLOT = 34816, VSLOT = 36864;
#define ATT_LOAD(st) do { \
        _Pragma("unroll") for (int i = 0; i < 4; ++i) { const int chunk = tid + 512 * i, c = chunk >> 4, ch = chunk & 15; const bf16* gp = (st).base + (size_t)(128 * (st).blk + c) * (st).rowstride + 8 * ch; \
            kr[i] = __builtin_nontemporal_load((const u32x4*)(gp + (size_t)8 * HBR * 128)); vr[i] = __builtin_nontemporal_load((const u32x4*)(gp + (size_t)16 * HBR * 128)); } \
        { const bf16* qrow = (st).base + (size_t)(128 * (st).blk + 16 * w + r) * (st).rowstride; \
            _Pragma("unroll") for (int q = 0; q < 4; ++q) qn[q] = *(const bf16x8*)(qrow + 32 * q + 8 * q4); } } while (0)
    for (int u = bid; u < 256; u += G) {
        AStep nx = attn_step(u, 0, QKVh);
        u32x4 kr[4], vr[4]; bf16x8 qn[4];
#pragma unroll
        for (int i = 0; i < 4; ++i) { kr[i] = (u32x4){0u, 0u, 0u, 0u}; vr[i] = kr[i]; qn[i] = (bf16x8){0, 0, 0, 0, 0, 0, 0, 0}; }
        ATT_LOAD(nx);
        for (int s = 0; s < 13; ++s) {
            const AStep cu = nx; const int cs = s & 1;
            LAS unsigned char* Kc = lds + cs * SLOT; LAS unsigned char* Vc = lds + 2 * SLOT + cs * VSLOT;
#pragma unroll
            for (int i = 0; i < 4; ++i) { const int chunk = tid + 512 * i, c = chunk >> 4, ch = chunk & 15; *(LAS u32x4*)(Kc + c * 272 + ch * 16) = kr[i]; *(LAS u32x4*)(Vc + c * 288 + ch * 16) = vr[i]; }
            bf16x8 qf[4];
#pragma unroll
            for (int q = 0; q < 4; ++q) qf[q] = qn[q];
            __syncthreads();
            { nx = attn_step(u, (s + 1 < 13) ? s + 1 : 12, QKVh); ATT_LOAD(nx); }
            if (cu.compute) {
                const bool first = (cu.blk == 0);
                const LAS unsigned char* Kp = first ? Kc : lds + (cs ^ 1) * SLOT; const LAS unsigned char* Vp = first ? Vc : lds + 2 * SLOT + (cs ^ 1) * VSLOT;
                const int a = 16 * w + r;
                const int jlo = first ? 8 : 0;
                f32x4 S[9]; float mx = -INFINITY;
#pragma unroll
                for (int jj = 0; jj < 9; ++jj) { const int j = w + jj; S[jj] = (f32x4){0.f, 0.f, 0.f, 0.f};
                    if (j >= jlo) { const LAS unsigned char* kp = (j >= 8 ? Kc : Kp) + ((j & 7) * 16 + r) * 272 + 16 * q4;
#pragma unroll
                        for (int st = 0; st < 4; ++st) { const bf16x8 kf = *(const LAS bf16x8*)(kp + 64 * st); S[jj] = MFMA16(kf, qf[st], S[jj]); } }
#pragma unroll
                    for (int i = 0; i < 4; ++i) { bool valid = (j >= jlo);
                        if (jj == 0) valid = valid && (4 * q4 + i >= r);
                        if (jj == 8) valid = valid && (4 * q4 + i <= r);
                        S[jj][i] = valid ? S[jj][i] : -INFINITY; mx = fmaxf(mx, S[jj][i]); } }
                mx = fmaxf(mx, __shfl_xor(mx, 16)); mx = fmaxf(mx, __shfl_xor(mx, 32));
                float den = 0.f;
#pragma unroll
                for (int jj = 0; jj < 9; ++jj)
#pragma unroll
                    for (int i = 0; i < 4; ++i) { const float pe = __builtin_amdgcn_exp2f(S[jj][i] - mx); S[jj][i] = pe; den += pe; }
                den += __shfl_xor(den, 16); den += __shfl_xor(den, 32);
                bf16x8 pf[5];
#pragma unroll
                for (int p = 0; p < 5; ++p) { u32x4 wv; wv.x = pk2(S[2 * p][0], S[2 * p][1]); wv.y = pk2(S[2 * p][2], S[2 * p][3]);
                    if (2 * p + 1 < 9) { wv.z = pk2(S[(2 * p + 1) % 9][0], S[(2 * p + 1) % 9][1]); wv.w = pk2(S[(2 * p + 1) % 9][2], S[(2 * p + 1) % 9][3]); } else { wv.z = 0u; wv.w = 0u; }
                    pf[p] = __builtin_bit_cast(bf16x8, wv); }
                f32x4 o[8];
#pragma unroll
                for (int db = 0; db < 8; ++db) o[db] = (f32x4){0.f, 0.f, 0.f, 0.f};
#pragma unroll
                for (int p = 0; p < 5; ++p) { const int j0 = w + 2 * p, j1 = (j0 + 1 > 15) ? 15 : j0 + 1;
                    if (j0 + 1 >= jlo) {
                        const LAS unsigned char* v0p = (j0 >= 8 ? Vc : Vp) + ((j0 & 7) * 16 + 4 * q4 + (r >> 2)) * 288 + 8 * (r & 3);
                        const LAS unsigned char* v1p = (j1 >= 8 ? Vc : Vp) + ((j1 & 7) * 16 + 4 * q4 + (r >> 2)) * 288 + 8 * (r & 3);
#pragma unroll
                        for (int db = 0; db < 8; ++db) {
                            const s16x4 lo = tr_read(v0p + 32 * db), hi = tr_read(v1p + 32 * db);
                            const bf16x8 af = __builtin_shufflevector(lo, hi, 0, 1, 2, 3, 4, 5, 6, 7);
                            o[db] = MFMA16(af, pf[p], o[db]); } } }
                const float inv = __builtin_amdgcn_rcpf(den);
                const int tl = cu.b * SEQ + (128 * cu.blk + a) * cu.dil + cu.rr;
                bf16* orow = Oh + ((size_t)(cu.g * 8 + cu.h) * HBR + cu.b * RB + cu.rr * (SEQ / cu.dil) + 128 * cu.blk + a) * 128 + 4 * q4;
#pragma unroll
                for (int db = 0; db < 8; ++db) { u32x2 wv; wv.x = pk2(o[db][0] * inv, o[db][1] * inv); wv.y = pk2(o[db][2] * inv, o[db][3] * inv); *(u32x2*)(orow + 16 * db) = wv; }
                if (q4 == 0) lse[((size_t)cu.g * T_TOK + (size_t)half * THALF + tl) * 8 + cu.h] = mx * 0.6931471805599453f + __logf(den);
            }
            __syncthreads();
        }
    }
#undef ATT_LOAD
}
__device__ __forceinline__ void merge_phase(const bf16* __restrict__ Oh, const float* __restrict__ lse, bf16* __restrict__ MX, int half, int G, int bid) {
    const int gt = bid * 512 + threadIdx.x, NGT = G * 512;
    for (int i = gt; i < THALF * 128; i += NGT) {
        const int tl = i >> 7, ch = i & 127, h = ch >> 4; const size_t tg = (size_t)half * THALF + tl;
        const float l0 = lse[((size_t)0 * T_TOK + tg) * 8 + h], l1 = lse[((size_t)1 * T_TOK + tg) * 8 + h], l2 = lse[((size_t)2 * T_TOK + tg) * 8 + h];
        const float mxl = fmaxf(l0, fmaxf(l1, l2)); float w0 = __expf(l0 - mxl), w1 = __expf(l1 - mxl), w2 = __expf(l2 - mxl); const float inv = 1.0f / (w0 + w1 + w2); w0 *= inv; w1 *= inv; w2 *= inv;
        const int sq = tl & 2047, bb = (tl >> 11) * RB, dch = ch & 15;
        const int p1 = ((sq & 3) << 9) + (sq >> 2), p2 = ((sq & 15) << 7) + (sq >> 4);
        const u32x4 a = __builtin_nontemporal_load((const u32x4*)(Oh + ((size_t)(0 + h) * HBR + bb + sq) * 128 + 8 * dch)), b = __builtin_nontemporal_load((const u32x4*)(Oh + ((size_t)(8 + h) * HBR + bb + p1) * 128 + 8 * dch)), c = __builtin_nontemporal_load((const u32x4*)(Oh + ((size_t)(16 + h) * HBR + bb + p2) * 128 + 8 * dch));
        u32x4 o;
#pragma unroll
        for (int e = 0; e < 4; ++e) o[e] = pk2(w0 * bf_lo(a[e]) + w1 * bf_lo(b[e]) + w2 * bf_lo(c[e]), w0 * bf_hi(a[e]) + w1 * bf_hi(b[e]) + w2 * bf_hi(c[e]));
        *(u32x4*)(MX + tg * 1024 + 8 * ch) = o;
    }
}
__device__ __forceinline__ float logsigmoid_f(float x) { return fminf(x, 0.f) - __logf(1.0f + __expf(-fabsf(x))); }
__device__ __forceinline__ void mlstm_pre_phase(const bf16* __restrict__ P2, const float* __restrict__ gates, const float* __restrict__ convw, const float* __restrict__ convb, const float* __restrict__ igb, const float* __restrict__ fgb,
                                                bf16* __restrict__ QKc, float* __restrict__ GA, float* __restrict__ GB, float* __restrict__ GP, float* __restrict__ CH, int G, int bid) {
    const int tid = threadIdx.x, lane = tid & 63, wave = tid >> 6;
    const int gt = bid * 512 + tid, NGT = G * 512;
    {
        const int ch = gt & 255, col = 4 * ch; const int tgs = NGT >> 8;
        float cw[4][4], cb[4];
        { const f32x4 b4 = *(const f32x4*)(convb + col);
#pragma unroll
          for (int e = 0; e < 4; ++e) cb[e] = b4[e];
#pragma unroll
          for (int j = 0; j < 4; ++j) { const f32x4 w4 = *(const f32x4*)(convw + j * 1024 + col);
#pragma unroll
              for (int e = 0; e < 4; ++e) cw[j][e] = w4[e]; } }
        const float ksc = (ch >= 128) ? 0.125f : 1.0f;
        u32x2 rn[11];
#define PRE_LOAD(tg_) do { const int t0_ = 8 * (tg_), sq0_ = t0_ & 2047; \
            _Pragma("unroll") for (int i = 0; i < 11; ++i) { const int dlt_ = (sq0_ + i - 3 >= 0) ? (i - 3) : -sq0_; \
                rn[i] = __builtin_nontemporal_load((const u32x2*)(P2 + (size_t)(t0_ + dlt_) * 2048 + col)); } } while (0)
        int tg = gt >> 8;
        if (tg < T_TOK / 8) PRE_LOAD(tg);
        for (; tg < T_TOK / 8; tg += tgs) {
            const int t0 = 8 * tg, sq0 = t0 & 2047;
            u32x2 rw[11];
#pragma unroll
            for (int i = 0; i < 11; ++i) rw[i] = (sq0 + i - 3 >= 0) ? rn[i] : (u32x2){0u, 0u};
            { const int tgn = (tg + tgs < T_TOK / 8) ? tg + tgs : tg; PRE_LOAD(tgn); }
#pragma unroll
            for (int i = 0; i < 8; ++i) { u32x2 o;
#pragma unroll
                for (int e = 0; e < 2; ++e) { float x0 = cb[2 * e], x1 = cb[2 * e + 1];
#pragma unroll
                    for (int j = 0; j < 4; ++j) { x0 += cw[j][2 * e] * bf_lo(rw[i + j][e]); x1 += cw[j][2 * e + 1] * bf_hi(rw[i + j][e]); }
                    o[e] = pk2(silu_f(x0) * ksc, silu_f(x1) * ksc); }
                *(u32x2*)(QKc + (size_t)(t0 + i) * 1024 + col) = o; }
        }
#undef PRE_LOAD
    }
    const int gw = bid * NWAVES + wave, NGW = G * NWAVES;
    for (int it = gw; it < NB * 32 * 8; it += NGW) {
        const int h = it & 7, c = (it >> 3) & 31, b = it >> 8; const size_t t = (size_t)b * SEQ + 64 * c + lane;
        const float gi = gates[t * 16 + h], gf = gates[t * 16 + 8 + h];
        float bs = logsigmoid_f(gf + fgb[h]);
#pragma unroll
        for (int o = 1; o < 64; o <<= 1) { const float v = __shfl_up(bs, o); if (lane >= o) bs += v; }
        const float av = gi + igb[h] - bs; float pm = av;
#pragma unroll
        for (int o = 1; o < 64; o <<= 1) { const float v = __shfl_up(pm, o); if (lane >= o) pm = fmaxf(pm, v); }
        const size_t o = (size_t)(b * 8 + h) * SEQ + 64 * c + lane; GA[o] = av; GB[o] = bs; GP[o] = pm;
        if (lane == 63) { const size_t cid = (size_t)(b * 8 + h) * 32 + c; CH[2 * cid] = bs; CH[2 * cid + 1] = bs + pm; }
    }
}
__device__ __forceinline__ void mlstm_scan_phase(LAS unsigned char* lds, const bf16* __restrict__ P2, const bf16* __restrict__ QKc, const float* __restrict__ GA, const float* __restrict__ CH,
                                                 bf16* __restrict__ Cst, float* __restrict__ nst, float* __restrict__ mst, int G, int bid) {
    const int tid = threadIdx.x, lane = tid & 63, w = __builtin_amdgcn_readfirstlane(tid >> 6), r = lane & 15, q4 = lane >> 4;
    const int dvb = w & 3, dkh = w >> 2;
    const bf16x8 ones = {0x3F80, 0x3F80, 0x3F80, 0x3F80, 0x3F80, 0x3F80, 0x3F80, 0x3F80};
    for (int item = bid; item < 256; item += G) {
        const int dvh = item & 1, h = (item >> 1) & 7, b = item >> 4;
        const size_t cid0 = (size_t)(b * 8 + h) * 32;
        f32x4 acc[2], accn[2]; acc[0] = (f32x4){0.f, 0.f, 0.f, 0.f}; acc[1] = acc[0]; accn[0] = acc[0]; accn[1] = acc[0];
        float mcar = 0.f;
        u32x4 nk, nv; float na, nbl, nml;
#define MSCAN_LOAD(c) do { const size_t t_ = (size_t)b * SEQ + 64 * (c) + lane; nk = *(const u32x4*)(QKc + t_ * 1024 + 512 + h * 64 + 8 * w); nv = *(const u32x4*)(P2 + t_ * 2048 + 1024 + h * 128 + 64 * dvh + 8 * w); \
            na = GA[(size_t)(b * 8 + h) * SEQ + 64 * (c) + lane]; nbl = CH[2 * (cid0 + (c))]; nml = CH[2 * (cid0 + (c)) + 1]; } while (0)
        MSCAN_LOAD(0);
        for (int c = 0; c < 32; ++c) {
            const u32x4 ck = nk, cv = nv; const float as = na, blast = nbl, mloc = nml;
            if (c + 1 < 32) MSCAN_LOAD(c + 1);
            const float mnew = fmaxf(blast + mcar, mloc);
            const float wsv = __expf(blast + as - mnew), carry = __expf(blast + mcar - mnew);
            const size_t cid = cid0 + c;
#pragma unroll
            for (int nb = 0; nb < 2; ++nb)
#pragma unroll
                for (int i = 0; i < 4; ++i) { const int dv = 64 * dvh + 16 * dvb + 4 * q4 + i, dk = 32 * dkh + 16 * nb + r;
                    Cst[(cid * 128 + dv) * 64 + dk] = (bf16)(pk2(acc[nb][i], 0.f) & 0xffffu); }
            if (dvh == 0 && dvb == 0 && q4 == 0) { nst[cid * 64 + 32 * dkh + r] = accn[0][0]; nst[cid * 64 + 32 * dkh + 16 + r] = accn[1][0]; }
            if (dvh == 0 && tid == 0) mst[cid] = mcar;
            LAS unsigned char* Kw = lds + (c & 1) * 18432; LAS unsigned char* Vs = Kw + 9216;
            u32x4 kw;
#pragma unroll
            for (int e = 0; e < 4; ++e) kw[e] = pk2(bf_lo(ck[e]) * wsv, bf_hi(ck[e]) * wsv);
            *(LAS u32x4*)(Kw + lane * 144 + 16 * w) = kw; *(LAS u32x4*)(Vs + lane * 144 + 16 * w) = cv;
            __syncthreads();
            acc[0] = acc[0] * carry; acc[1] = acc[1] * carry; accn[0] = accn[0] * carry; accn[1] = accn[1] * carry;
#pragma unroll
            for (int st = 0; st < 2; ++st) {
                const int rowb = (32 * st + 8 * q4 + (r >> 2)) * 144 + 8 * (r & 3);
                const s16x4 alo = tr_read(Vs + rowb + 32 * dvb), ahi = tr_read(Vs + rowb + 4 * 144 + 32 * dvb);
                const bf16x8 af = __builtin_shufflevector(alo, ahi, 0, 1, 2, 3, 4, 5, 6, 7);
#pragma unroll
                for (int nb = 0; nb < 2; ++nb) {
                    const s16x4 blo = tr_read(Kw + rowb + 64 * dkh + 32 * nb), bhi = tr_read(Kw + rowb + 4 * 144 + 64 * dkh + 32 * nb);
                    const bf16x8 bfr = __builtin_shufflevector(blo, bhi, 0, 1, 2, 3, 4, 5, 6, 7);
                    acc[nb] = MFMA16(af, bfr, acc[nb]);
                    if (dvb == 0) accn[nb] = MFMA16(ones, bfr, accn[nb]); }
            }
            mcar = mnew;
        }
        __syncthreads();
#undef MSCAN_LOAD
    }
}
__device__ __forceinline__ void mlstm_out_phase(LAS unsigned char* lds, const bf16* __restrict__ P2, const bf16* __restrict__ QKc, const bf16* __restrict__ OP, const float* __restrict__ GA, const float* __restrict__ GB, const float* __restrict__ GP,
                                                const float* __restrict__ hgain, const bf16* __restrict__ Cst, const float* __restrict__ nst, const float* __restrict__ mst, bf16* __restrict__ MX, int G, int bid) {
    const int tid = threadIdx.x, lane = tid & 63, w = __builtin_amdgcn_readfirstlane(tid >> 6), r = lane & 31, h2 = lane >> 5;
    const int dvb = w & 3, tb = w >> 2;
    constexpr int O_Q = 0, O_K = 9216, O_V = 18432, O_C = 38912, O_VEC = 57344, O_GN = 58368, O_PART = 58880, SETB = 59904;
    u32x4 pq, pk, pv0, pv1, pc0, pc1; float pvec = 0.f, pgn = 0.f, pmc = 0.f; u32x2 popv[4];
    pq = (u32x4){0u, 0u, 0u, 0u}; pk = pq; pv0 = pq; pv1 = pq; pc0 = pq; pc1 = pq;
#pragma unroll
    for (int gq = 0; gq < 4; ++gq) popv[gq] = (u32x2){0u, 0u};
#define OUT_LOAD(it) do { const int c_ = (it) & 31, h_ = ((it) >> 5) & 7, b_ = (it) >> 8; const size_t t0_ = (size_t)b_ * SEQ + 64 * c_; const size_t gb_ = (size_t)(b_ * 8 + h_) * SEQ + 64 * c_; \
        { const bf16* p_ = QKc + (t0_ + (tid >> 3)) * 1024 + h_ * 64 + 8 * (tid & 7); pq = *(const u32x4*)p_; pk = *(const u32x4*)(p_ + 512); } \
        { const bf16* p_ = P2 + (t0_ + (tid >> 4)) * 2048 + 1024 + h_ * 128 + 8 * (tid & 15); pv0 = *(const u32x4*)p_; pv1 = *(const u32x4*)(p_ + (size_t)32 * 2048); } \
        { const bf16* p_ = Cst + ((size_t)(it) * 128 + (tid >> 3)) * 64 + 8 * (tid & 7); pc0 = *(const u32x4*)p_; pc1 = *(const u32x4*)(p_ + 64 * 64); } \
        { const int wh_ = tid >> 6, ix_ = tid & 63; const float* src_ = (wh_ == 0) ? (GA + gb_) : (wh_ == 1) ? (GB + gb_) : (wh_ == 2) ? (GP + gb_) : (wh_ == 3) ? (nst + (size_t)(it) * 64) : (hgain + h_ * 128 + ((wh_ & 1) << 6)); pvec = src_[ix_]; } \
        pmc = mst[(it)]; \
        { const size_t orow_ = (t0_ + 32 * tb + r) * 1024 + h_ * 128 + 32 * dvb + 4 * h2; _Pragma("unroll") for (int gq = 0; gq < 4; ++gq) popv[gq] = *(const u32x2*)(OP + orow_ + 8 * gq); } } while (0)
    { const int fit = (bid < 4096) ? bid : 0; OUT_LOAD(fit); }
    int par = 0;
    for (int item = bid; item < 4096; item += G, par ^= 1) {
        const int c = item & 31, h = (item >> 5) & 7, b = item >> 8;
        const size_t t0 = (size_t)b * SEQ + 64 * c;
        LAS unsigned char* L = lds + par * SETB;
        LAS float* vec = (LAS float*)(L + O_VEC); LAS float* gnl = (LAS float*)(L + O_GN); LAS float* part = (LAS float*)(L + O_PART);
        *(LAS u32x4*)(L + O_Q + (tid >> 3) * 144 + (tid & 7) * 16) = pq; *(LAS u32x4*)(L + O_K + (tid >> 3) * 144 + (tid & 7) * 16) = pk;
        *(LAS u32x4*)(L + O_V + (tid >> 4) * 320 + (tid & 15) * 16) = pv0; *(LAS u32x4*)(L + O_V + (32 + (tid >> 4)) * 320 + (tid & 15) * 16) = pv1;
        *(LAS u32x4*)(L + O_C + (tid >> 3) * 144 + (tid & 7) * 16) = pc0; *(LAS u32x4*)(L + O_C + (64 + (tid >> 3)) * 144 + (tid & 7) * 16) = pc1;
        if (tid < 384) vec[tid] = pvec;
        const float mc = pmc; u32x2 opv[4];
#pragma unroll
        for (int gq = 0; gq < 4; ++gq) opv[gq] = popv[gq];
        __syncthreads();
        { const int nit = (item + G < 4096) ? item + G : item; OUT_LOAD(nit); }
        const int t = 32 * tb + r;
        const float Mt = fmaxf(mc, vec[128 + t]), bt = vec[64 + t];
        bf16x8 qf[4];
#pragma unroll
        for (int st = 0; st < 4; ++st) qf[st] = *(const LAS bf16x8*)(L + O_Q + t * 144 + (16 * st + 8 * h2) * 2);
        float qn = 0.f;
#pragma unroll
        for (int st = 0; st < 4; ++st) { const u32x4 qq = __builtin_bit_cast(u32x4, qf[st]); const f32x4 n0 = *(const LAS f32x4*)(vec + 192 + 16 * st + 8 * h2), n1 = *(const LAS f32x4*)(vec + 192 + 16 * st + 8 * h2 + 4);
#pragma unroll
            for (int e = 0; e < 2; ++e) { qn += bf_lo(qq[e]) * n0[2 * e] + bf_hi(qq[e]) * n0[2 * e + 1]; qn += bf_lo(qq[2 + e]) * n1[2 * e] + bf_hi(qq[2 + e]) * n1[2 * e + 1]; } }
        qn += __shfl_xor(qn, 32);
        f32x16 acc1, acc2;
#pragma unroll
        for (int i = 0; i < 16; ++i) { acc1[i] = 0.f; acc2[i] = 0.f; }
        float dsum = 0.f;
#pragma unroll
        for (int sb = 0; sb < 2; ++sb) {
            if (sb <= tb) {
                f32x16 S;
#pragma unroll
                for (int i = 0; i < 16; ++i) S[i] = 0.f;
#pragma unroll
                for (int st = 0; st < 4; ++st) { const bf16x8 kf = *(const LAS bf16x8*)(L + O_K + (32 * sb + r) * 144 + (16 * st + 8 * h2) * 2); S = MFMA32(kf, qf[st], S); }
#pragma unroll
                for (int gq = 0; gq < 4; ++gq) { const f32x4 a4 = *(const LAS f32x4*)(vec + 32 * sb + 8 * gq + 4 * h2);
#pragma unroll
                    for (int k = 0; k < 4; ++k) { const int i = 4 * gq + k, s = 32 * sb + 8 * gq + 4 * h2 + k; const float ev = __builtin_amdgcn_exp2f(fminf(a4[k] - Mt, 0.f) * 1.4426950408889634f);
                        const float wgt = (s <= t) ? ev : 0.f; S[i] = wgt * S[i]; dsum += S[i]; } }
#pragma unroll
                for (int sp = 0; sp < 2; ++sp) {
                    u32x4 wv; wv.x = pk2(S[8 * sp + 0], S[8 * sp + 1]); wv.y = pk2(S[8 * sp + 2], S[8 * sp + 3]); wv.z = pk2(S[8 * sp + 4], S[8 * sp + 5]); wv.w = pk2(S[8 * sp + 6], S[8 * sp + 7]);
                    const bf16x8 pfr = __builtin_bit_cast(bf16x8, wv);
                    const LAS unsigned char* vp = L + O_V + (32 * sb + 16 * sp + 4 * h2 + ((lane & 15) >> 2)) * 320 + (32 * dvb + 16 * ((lane >> 4) & 1) + 4 * (lane & 3)) * 2;
                    const s16x4 lo = tr_read(vp), hi = tr_read(vp + 8 * 320);
                    const bf16x8 af = __builtin_shufflevector(lo, hi, 0, 1, 2, 3, 4, 5, 6, 7);
                    acc1 = MFMA32(af, pfr, acc1);
                }
            }
        }
        dsum += __shfl_xor(dsum, 32);
#pragma unroll
        for (int st = 0; st < 4; ++st) { const bf16x8 cf = *(const LAS bf16x8*)(L + O_C + (32 * dvb + r) * 144 + (16 * st + 8 * h2) * 2); acc2 = MFMA32(cf, qf[st], acc2); }
        const float winter = __expf(mc - Mt);
        const float den = dsum + winter * qn;
        const float dnm = fmaxf(fabsf(den), __expf(-(bt + Mt)));
        const float idn = __builtin_amdgcn_rcpf(dnm);
        float hsq = 0.f;
#pragma unroll
        for (int i = 0; i < 16; ++i) { acc1[i] = (acc1[i] + winter * acc2[i]) * idn; hsq += acc1[i] * acc1[i]; }
        hsq += __shfl_xor(hsq, 32);
        if (h2 == 0) part[dvb * 64 + t] = hsq;
        __syncthreads();
        const float tot = (part[t] + part[64 + t]) + (part[128 + t] + part[192 + t]);
        const float rsn = __builtin_amdgcn_rsqf(tot * (1.0f / 128.0f) + RMS_EPS);
        const size_t orow = (t0 + t) * 1024 + h * 128 + 32 * dvb + 4 * h2;
#pragma unroll
        for (int gq = 0; gq < 4; ++gq) {
            const u32x2 op = opv[gq]; const f32x4 gn = *(const LAS f32x4*)(gnl + 32 * dvb + 4 * h2 + 8 * gq);
            const float y0 = acc1[4 * gq + 0] * rsn * gn[0] * sigmoid_f(bf_lo(op.x)), y1 = acc1[4 * gq + 1] * rsn * gn[1] * sigmoid_f(bf_hi(op.x));
            const float y2 = acc1[4 * gq + 2] * rsn * gn[2] * sigmoid_f(bf_lo(op.y)), y3 = acc1[4 * gq + 3] * rsn * gn[3] * sigmoid_f(bf_hi(op.y));
            u32x2 wv; wv.x = pk2(y0, y1); wv.y = pk2(y2, y3); *(u32x2*)(MX + orow + 8 * gq) = wv;
        }
    }
    __syncthreads();
#undef OUT_LOAD
}
__device__ __forceinline__ void final_phase(float* __restrict__ out, const bf16* __restrict__ hbv, const float* __restrict__ ss, const float* __restrict__ gain, int G, int bid) {
    const int gt = bid * 512 + threadIdx.x, NGT = G * 512;
    for (int i = gt; i < T_TOK * 128; i += NGT) { const int t = i >> 7, c8 = i & 127; const float rs = rs_from_ss(ss[t]);
        const u32x4 hv = __builtin_nontemporal_load((const u32x4*)(hbv + (size_t)t * 1024 + 8 * c8)); const f32x4 g0 = *(const f32x4*)(gain + 8 * c8), g1 = *(const f32x4*)(gain + 8 * c8 + 4);
        f32x4 o0, o1; o0[0] = bf_lo(hv[0]); o0[1] = bf_hi(hv[0]); o0[2] = bf_lo(hv[1]); o0[3] = bf_hi(hv[1]); o1[0] = bf_lo(hv[2]); o1[1] = bf_hi(hv[2]); o1[2] = bf_lo(hv[3]); o1[3] = bf_hi(hv[3]);
        o0 = o0 * rs * g0; o1 = o1 * rs * g1;
        *(f32x4*)(out + (size_t)t * 1024 + 8 * c8) = o0; *(f32x4*)(out + (size_t)t * 1024 + 8 * c8 + 4) = o1; }
}
__global__ void __launch_bounds__(NWAVES * 64, 2) mega_fwd(Args A) {
    extern __shared__ __attribute__((aligned(16))) unsigned char lds_raw[];
    LAS unsigned char* lds = (LAS unsigned char*)lds_raw;
    cg::grid_group grid = cg::this_grid();
    const int G = gridDim.x, bid = blockIdx.x;
    unsigned char* ws = A.ws;
    float* ss = (float*)(ws + WS_SS);
    bf16* hb = (bf16*)(ws + WS_HB); bf16* MX = (bf16*)(ws + WS_MX);
    bf16* QKVh = (bf16*)(ws + WS_BIG); bf16* R = (bf16*)(ws + WS_H);        bf16* ACT = (bf16*)(ws + WS_ACT); bf16* P2 = (bf16*)(ws + WS_ACT);
    bf16* Oh = (bf16*)A.out; bf16* Cst = (bf16*)A.out; bf16* OP = (bf16*)A.out + (size_t)32 * 1024 * 1024;
    float* lse = (float*)(ws + WS_LSE); float* gates = (float*)(ws + WS_GATES); float* rope = (float*)(ws + WS_ROPE);
    float* mst = (float*)(ws + WS_MST); float* nst = (float*)(ws + WS_NST);
    bf16* QKc = hb;
    float* GA = (float*)(ws + 460 * MiB); float* GB = GA + (size_t)T_TOK * 8; float* GP = GB + (size_t)T_TOK * 8; float* CH = GP + (size_t)T_TOK * 8;
    const int lo = A.ph_lo, hi = A.ph_hi;
    volatile LAS unsigned* MISC = (volatile LAS unsigned*)(lds + LDS_BYTES - 256);
    if (threadIdx.x < 16) MISC[threadIdx.x] = 0u;
    __syncthreads();
    const XcdBarrier bar = xcd_barrier_post((unsigned*)(ws + WS_BAR), MISC + 8);
#ifndef PROBE_MASK
#define PROBE_MASK 0u
#endif
#define PROBE_K 4ull
    unsigned long long pr_sum = 0ull, pr_t0 = 0ull, pr_s0 = 0ull;
#define PB(k) do { if (PROBE_MASK & (1u << (k))) pr_t0 = __builtin_amdgcn_s_memrealtime(); } while (0)
#define PE(k) do { if (PROBE_MASK & (1u << (k))) pr_sum += __builtin_amdgcn_s_memrealtime() - pr_t0; } while (0)
#define IN(k) (lo <= (k) && (k) < hi)
#define SYNC(k) do { if (IN(k) && IN((k) + 1)) { if (PROBE_MASK & (1u << 30)) pr_s0 = __builtin_amdgcn_s_memrealtime(); if (hi < 0) { __threadfence(); grid.sync(); __threadfence(); } else xcd_barrier(bar); if (PROBE_MASK & (1u << 30)) pr_sum += __builtin_amdgcn_s_memrealtime() - pr_s0; if (PROBE_MASK & (1u << 29)) { pr_s0 = __builtin_amdgcn_s_memrealtime(); xcd_barrier(bar); pr_sum += __builtin_amdgcn_s_memrealtime() - pr_s0; } } PE(k); } while (0)
    PB(0); if (IN(0)) p0_prologue(A, lds, G, bid);
    SYNC(0);
    PB(1); if (IN(1)) { pg8::Gemm g{hb, (const bf16*)(ws + WS_WQKV), THALF, 9216, 1024}; pg8::StaticOrder S; S.init(THALF, 9216, G, bid);
        pg8::EpiQKV E{QKVh, ss, rope}; pg8::gemm_phase<pg8::EpiQKV, pg8::StaticOrder, true, true>(lds, g, S, E); }
    SYNC(1);
    PB(2); if (IN(2)) attn_phase(lds, QKVh, Oh, lse, 0, G, bid);
    SYNC(2);
    PB(3); if (IN(3)) { merge_phase(Oh, lse, MX, 0, G, bid);
        pg8::Gemm g{hb + (size_t)THALF * 1024, (const bf16*)(ws + WS_WQKV), THALF, 9216, 1024}; pg8::StaticOrder S; S.init(THALF, 9216, G, bid);
        pg8::EpiQKV E{QKVh, ss + THALF, rope + (size_t)THALF * 32}; pg8::gemm_phase<pg8::EpiQKV, pg8::StaticOrder, true, true>(lds, g, S, E); }
    SYNC(3);
    PB(4); if (IN(4)) attn_phase(lds, QKVh, Oh, lse, 1, G, bid);
    SYNC(4);
    PB(5); if (IN(5)) merge_phase(Oh, lse, MX, 1, G, bid);
    SYNC(5);
    PB(6); if (IN(6)) { pg8::Gemm g{MX, (const bf16*)(ws + WS_WAO), T_TOK, 1024, 1024}; pg8::StaticOrder S; S.init(T_TOK, 1024, G, bid);
        pg8::EpiResidT<true> E{A.x, R, ss + T_TOK}; pg8::gemm_phase<pg8::EpiResidT<true>, pg8::StaticOrder, true, true>(lds, g, S, E); }
    SYNC(6);
    PB(7); if (IN(7)) { pg8::Gemm g{R, (const bf16*)(ws + WS_WFFIN), T_TOK, 5632, 1024}; pg8::StaticOrder S; S.init(T_TOK, 5632, G, bid);
        pg8::EpiSwiGLU E{ACT, ss + T_TOK}; pg8::gemm_phase<pg8::EpiSwiGLU, pg8::StaticOrder, true, true>(lds, g, S, E); }
    SYNC(7);
    PB(8); if (IN(8)) { pg8::Gemm g{ACT, (const bf16*)(ws + WS_WFFOUT), T_TOK, 1024, DFF}; pg8::StaticOrder S; S.init(T_TOK, 1024, G, bid);
        pg8::EpiResidT<false> E{R, R, ss + 2 * T_TOK}; pg8::gemm_phase<pg8::EpiResidT<false>, pg8::StaticOrder, true, true>(lds, g, S, E); }
    SYNC(8);
    PB(9); if (IN(9)) { pg8::Gemm g{R, (const bf16*)(ws + WS_WMIN), T_TOK, 3328, 1024}; pg8::StaticOrder S; S.init(T_TOK, 3328, G, bid);
        pg8::EpiMlstmIn E{P2, OP, gates, ss + 2 * T_TOK}; pg8::gemm_phase<pg8::EpiMlstmIn, pg8::StaticOrder, true, true>(lds, g, S, E); }
    SYNC(9);
    PB(10); if (IN(10)) { mlstm_pre_phase(P2, gates, A.conv_w, A.conv_b, A.ig_bias, A.fg_bias, QKc, GA, GB, GP, CH, G, bid); xcd_barrier(bar);
        mlstm_scan_phase(lds, P2, QKc, GA, CH, Cst, nst, mst, G, bid); }
    SYNC(10);
    PB(11); if (IN(11)) mlstm_out_phase(lds, P2, QKc, OP, GA, GB, GP, A.head_gain, Cst, nst, mst, MX, G, bid);
    SYNC(11);
    PB(12); if (IN(12)) { pg8::Gemm g{MX, (const bf16*)(ws + WS_WMOUT), T_TOK, 1024, 1024}; pg8::StaticOrder S; S.init(T_TOK, 1024, G, bid);
        pg8::EpiResidT<false> E{R, R, ss + 3 * T_TOK}; pg8::gemm_phase<pg8::EpiResidT<false>, pg8::StaticOrder, true, true>(lds, g, S, E); }
    SYNC(12);
    PB(13); if (IN(13)) { pg8::Gemm g{R, (const bf16*)(ws + WS_WFFIN) + (size_t)5632 * 1024, T_TOK, 5632, 1024}; pg8::StaticOrder S; S.init(T_TOK, 5632, G, bid);
        pg8::EpiSwiGLU E{ACT, ss + 3 * T_TOK}; pg8::gemm_phase<pg8::EpiSwiGLU, pg8::StaticOrder, true, true>(lds, g, S, E); }
    SYNC(13);
    PB(14); if (IN(14)) { pg8::Gemm g{ACT, (const bf16*)(ws + WS_WFFOUT) + (size_t)1024 * DFF, T_TOK, 1024, DFF}; pg8::StaticOrder S; S.init(T_TOK, 1024, G, bid);
        pg8::EpiResidT<false> E{R, R, ss + 4 * T_TOK}; pg8::gemm_phase<pg8::EpiResidT<false>, pg8::StaticOrder, true, true>(lds, g, S, E); }
    SYNC(14);
    PB(15); if (IN(15)) final_phase(A.out, R, ss + 4 * T_TOK, A.final_norm, G, bid);
    PE(15);
    if (PROBE_MASK != 0u && bid == 0 && threadIdx.x == 0) { const unsigned long long te = __builtin_amdgcn_s_memrealtime(); while (__builtin_amdgcn_s_memrealtime() - te < PROBE_K * pr_sum) __builtin_amdgcn_s_sleep(8); }
#undef IN
#undef SYNC
}

extern "C" void kernel_launch(void* const* d_in, const int* in_sizes, int n_in, void* d_out, int out_size, void* d_ws, size_t ws_size, hipStream_t stream) {
    static int grid = 0;
    if (grid == 0) {
        if (n_in != 17 || in_sizes[0] != T_TOK * DM || out_size != T_TOK * DM || ws_size < WS_END) { fprintf(stderr, "kernel_launch: unexpected shapes (n_in %d, in0 %d, out %d, ws %zu); nothing launched\n", n_in, n_in > 0 ? in_sizes[0] : -1, out_size, ws_size); grid = -1; return; }
        int dev = 0, cus = 0, per_cu = 0;
        if (hipGetDevice(&dev) != hipSuccess || hipDeviceGetAttribute(&cus, hipDeviceAttributeMultiprocessorCount, dev) != hipSuccess) { grid = -1; return; }
        if (hipFuncSetAttribute((const void*)mega_fwd, hipFuncAttributeMaxDynamicSharedMemorySize, LDS_BYTES) != hipSuccess) { fprintf(stderr, "kernel_launch: hipFuncSetAttribute failed\n"); grid = -1; return; }
        if (hipOccupancyMaxActiveBlocksPerMultiprocessor(&per_cu, (const void*)mega_fwd, NWAVES * 64, LDS_BYTES) != hipSuccess || per_cu < 1) { fprintf(stderr, "kernel_launch: occupancy query says %d\n", per_cu); per_cu = 1; }
        (void)hipGetLastError();
        grid = cus;
    }
    if (grid < 0) return;
    Args a{};
    a.x = (const float*)d_in[0]; a.pos = (const int*)d_in[1]; a.attn_norm = (const float*)d_in[2]; a.attn_w_in = (const float*)d_in[3]; a.attn_w_out = (const float*)d_in[4];
    a.mlstm_norm = (const float*)d_in[5]; a.mlstm_w_in = (const float*)d_in[6]; a.conv_w = (const float*)d_in[7]; a.conv_b = (const float*)d_in[8]; a.ig_bias = (const float*)d_in[9];
    a.fg_bias = (const float*)d_in[10]; a.head_gain = (const float*)d_in[11]; a.mlstm_w_out = (const float*)d_in[12]; a.ffn_norm = (const float*)d_in[13]; a.ffn_w_in = (const float*)d_in[14];
    a.ffn_w_out = (const float*)d_in[15]; a.final_norm = (const float*)d_in[16];
    a.out = (float*)d_out; a.ws = (unsigned char*)d_ws; a.ph_lo = 0; a.ph_hi = 16;
    if (hipMemsetAsync((char*)d_ws + WS_BAR, 0, 16384, stream) != hipSuccess) { fprintf(stderr, "kernel_launch: hipMemsetAsync failed\n"); return; }
    void* args[] = {&a};
    const hipError_t e = hipLaunchCooperativeKernel((const void*)mega_fwd, dim3(grid), dim3(NWAVES * 64), args, LDS_BYTES, stream);
    if (e != hipSuccess) fprintf(stderr, "kernel_launch: cooperative launch failed: %s (grid %d)\n", hipGetErrorString(e), grid);
}
```

```cpp
#include <hip/hip_runtime.h>
#include <hip/hip_cooperative_groups.h>
#include <cstdio>
#include <cstdint>
namespace cg = cooperative_groups;

constexpr float RMS_EPS = 1e-6f;
__device__ __forceinline__ float rs_from_ss(float ss) { return __builtin_amdgcn_rsqf(ss * (1.0f / 1024.0f) + RMS_EPS); }
__device__ __forceinline__ float silu_f(float x) { return x * __builtin_amdgcn_rcpf(1.0f + __builtin_amdgcn_exp2f(x * -1.4426950408889634f)); }
__device__ __forceinline__ float sigmoid_f(float x) { return __builtin_amdgcn_rcpf(1.0f + __builtin_amdgcn_exp2f(x * -1.4426950408889634f)); }

namespace pg8 {
#define PG8_LAS __attribute__((address_space(3)))
typedef unsigned short bf16_t;
typedef short bf16x8 __attribute__((ext_vector_type(8)));
typedef float f32x4 __attribute__((ext_vector_type(4)));
typedef unsigned u32x4 __attribute__((ext_vector_type(4)));
constexpr int BM = 256, BK = 64, HALF = 128, HTB = HALF * BK * 2  , STAGE_BYTES = 8 * HTB, NXCD = 8, WGM = 8;

__host__ __device__ __forceinline__ int lds_byte(int r, int c) { const int st = (r >> 4) * 2 + (c >> 5), rr = r & 15, cc = c & 31, ob = rr * 64 + cc * 2; return st * 1024 + (ob ^ (((ob >> 9) & 1) << 5)); }
__host__ __device__ __forceinline__ void stage_rc(int b, int& R, int& C) { const int st = b / 1024, sb = b % 1024, swz = sb ^ (((sb >> 9) & 1) << 5); R = (st >> 1) * 16 + swz / 64; C = (st & 1) * 32 + (swz % 64) / 2; }
__host__ __device__ __forceinline__ int perm32(int rho) { const int n = rho >> 4, i = rho & 15; return 8 * (i >> 2) + 4 * n + (i & 3); }

typedef unsigned u32x2 __attribute__((ext_vector_type(2)));
struct Unit { int pm, pn; };
struct Gemm { const bf16_t* A; const bf16_t* Bt; int M, N, K; };

struct StaticOrder {
    int nM, nN, nwg, G, c;
    __host__ __device__ void init(int M, int N, int G_, int c_) { nM = M / BM; nN = N / BM; nwg = nM * nN; G = G_; c = c_; }
    __host__ __device__ bool next(int i, Unit& u) const {
        const long L = (long)i * G + c; if (L >= nwg) return false;
        int wgid = (int)L; { const int q = nwg / NXCD, r = nwg % NXCD, xcd = wgid % NXCD, off = wgid / NXCD; wgid = (xcd < r ? xcd * (q + 1) : r * (q + 1) + (xcd - r) * q) + off; }
        const int nig = WGM * nN, gid = wgid / nig, fm = gid * WGM, gsz = (nM - fm) < WGM ? (nM - fm) : WGM;
        u.pm = fm + ((wgid % nig) % gsz); u.pn = (wgid % nig) / gsz; return true;
    }
    __device__ __forceinline__ void a_ready(const Unit&) const {}
    __device__ __forceinline__ void done(const Unit&) const {}
};
__device__ __forceinline__ unsigned cvt_pk_bf16(float lo, float hi) { unsigned r; asm volatile("v_cvt_pk_bf16_f32 %0, %1, %2" : "=v"(r) : "v"(lo), "v"(hi)); return r; }

#define EPI_FENCE() asm volatile("" ::: "memory")
struct EpiQKV {
    static constexpr bool PERM = true, AFTER_DRAIN = false;
    bf16_t* O; const float* ss; const float* cs;
    __device__ __forceinline__ void operator()(const f32x4 (&acc)[2][2][4][2], const Unit& u, int wr, int wc, int fr, int fq) const {
        const int row0 = u.pm * BM + wr * 64 + fr; const int colt = u.pn * BM;
        const int tsel = (colt % 3072) / 1024;
        const bool rope = (tsel < 2) && (wc == 0);
        const int gsel = colt / 3072, lg = 2 * gsel, dil = 1 << lg;
        const int hb0 = (gsel * 3 + tsel) * 8 + (colt % 1024) / 128;
        float rsv[8];
#pragma unroll
        for (int k = 0; k < 8; ++k) rsv[k] = ss[row0 + (k >> 2) * HALF + (k & 3) * 16];
        f32x4 cA = {0.f, 0.f, 0.f, 0.f}, sA = cA;
        if (rope) { const float* p = cs + (size_t)row0 * 32 + 4 * fq; cA = *(const f32x4*)p; sA = *(const f32x4*)(p + 16); }
#pragma unroll
        for (int k = 0; k < 8; ++k) {
            const int ai = k >> 2, m = k & 3;
            const int row = row0 + ai * HALF + m * 16;
            f32x4 cN = cA, sN = sA;
            if (rope && k + 1 < 8) { const int rown = row0 + ((k + 1) >> 2) * HALF + ((k + 1) & 3) * 16; const float* p = cs + (size_t)rown * 32 + 4 * fq; cN = *(const f32x4*)p; sN = *(const f32x4*)(p + 16); }
            EPI_FENCE();
            const float rs = rs_from_ss(rsv[k]);
            const int sq = row & 2047, perm = ((sq & (dil - 1)) << (11 - lg)) + (sq >> lg);
            bf16_t* rowp = O + ((size_t)hb0 * 17408 + (row >> 11) * 2176 + perm) * 128;
            if (rope) {
                const f32x4 cr = cA * rs, sr = sA * rs;
#pragma unroll
                for (int bj = 0; bj < 2; ++bj) {
                    const f32x4 v0 = acc[ai][bj][m][0], v1 = acc[ai][bj][m][1];
                    const f32x4 o0 = v0 * cr - v1 * sr, o1 = v1 * cr + v0 * sr;
                    u32x2 w0, w1; w0.x = cvt_pk_bf16(o0[0], o0[1]); w0.y = cvt_pk_bf16(o0[2], o0[3]); w1.x = cvt_pk_bf16(o1[0], o1[1]); w1.y = cvt_pk_bf16(o1[2], o1[3]);
                    bf16_t* hp = rowp + (size_t)bj * 17408 * 128 + 4 * fq;
                    *(u32x2*)hp = w0; *(u32x2*)(hp + 16) = w1;
                }
            } else {
#pragma unroll
                for (int bj = 0; bj < 2; ++bj) {
                    const f32x4 v0 = acc[ai][bj][m][0] * rs, v1 = acc[ai][bj][m][1] * rs;
                    u32x4 wv; wv.x = cvt_pk_bf16(v0[0], v0[1]); wv.y = cvt_pk_bf16(v0[2], v0[3]); wv.z = cvt_pk_bf16(v1[0], v1[1]); wv.w = cvt_pk_bf16(v1[2], v1[3]);
                    *(u32x4*)(rowp + (size_t)bj * 17408 * 128 + wc * 32 + 8 * fq) = wv;
                }
            }
            cA = cN; sA = sN;
        }
    }
};
template <bool F32B> struct EpiResidT {
    static constexpr bool PERM = true, AFTER_DRAIN = false;
    const void* base; bf16_t* outb; float* ssn;
    __device__ __forceinline__ void operator()(const f32x4 (&acc)[2][2][4][2], const Unit& u, int wr, int wc, int fr, int fq) const {
        const int row0 = u.pm * BM + wr * 64 + fr; const int col0 = u.pn * BM + wc * 32 + 8 * fq;
        f32x4 fA[4]; u32x4 hA[2];
#pragma unroll
        for (int q = 0; q < 4; ++q) fA[q] = (f32x4){0.f, 0.f, 0.f, 0.f};
        hA[0] = (u32x4){0u, 0u, 0u, 0u}; hA[1] = hA[0];
        if constexpr (F32B) { const float* p = (const float*)base + (size_t)row0 * 1024 + col0; fA[0] = __builtin_nontemporal_load((const f32x4*)p); fA[1] = __builtin_nontemporal_load((const f32x4*)(p + 4)); fA[2] = __builtin_nontemporal_load((const f32x4*)(p + HALF)); fA[3] = __builtin_nontemporal_load((const f32x4*)(p + HALF + 4)); }
        else { const bf16_t* p = (const bf16_t*)base + (size_t)row0 * 1024 + col0; hA[0] = *(const u32x4*)p; hA[1] = *(const u32x4*)(p + HALF); }
#pragma unroll
        for (int k = 0; k < 8; ++k) {
            const int ai = k >> 2, m = k & 3;
            const int row = row0 + ai * HALF + m * 16;
            f32x4 fN[4]; u32x4 hN[2];
#pragma unroll
            for (int q = 0; q < 4; ++q) fN[q] = fA[q];
            hN[0] = hA[0]; hN[1] = hA[1];
            if (k + 1 < 8) { const int rown = row0 + ((k + 1) >> 2) * HALF + ((k + 1) & 3) * 16;
                if constexpr (F32B) { const float* p = (const float*)base + (size_t)rown * 1024 + col0; fN[0] = __builtin_nontemporal_load((const f32x4*)p); fN[1] = __builtin_nontemporal_load((const f32x4*)(p + 4)); fN[2] = __builtin_nontemporal_load((const f32x4*)(p + HALF)); fN[3] = __builtin_nontemporal_load((const f32x4*)(p + HALF + 4)); }
                else { const bf16_t* p = (const bf16_t*)base + (size_t)rown * 1024 + col0; hN[0] = *(const u32x4*)p; hN[1] = *(const u32x4*)(p + HALF); } }
            EPI_FENCE();
            float sq = 0.f;
#pragma unroll
            for (int bj = 0; bj < 2; ++bj) {
                const size_t off = (size_t)row * 1024 + col0 + bj * HALF;
                f32x4 b0, b1;
                if constexpr (F32B) { b0 = fA[2 * bj]; b1 = fA[2 * bj + 1]; }
                else { const u32x4 hv = hA[bj]; b0[0] = __uint_as_float(hv[0] << 16); b0[1] = __uint_as_float(hv[0] & 0xffff0000u); b0[2] = __uint_as_float(hv[1] << 16); b0[3] = __uint_as_float(hv[1] & 0xffff0000u);
                    b1[0] = __uint_as_float(hv[2] << 16); b1[1] = __uint_as_float(hv[2] & 0xffff0000u); b1[2] = __uint_as_float(hv[3] << 16); b1[3] = __uint_as_float(hv[3] & 0xffff0000u); }
                const f32x4 v0 = acc[ai][bj][m][0] + b0, v1 = acc[ai][bj][m][1] + b1;
                u32x4 wv; wv.x = cvt_pk_bf16(v0[0], v0[1]); wv.y = cvt_pk_bf16(v0[2], v0[3]); wv.z = cvt_pk_bf16(v1[0], v1[1]); wv.w = cvt_pk_bf16(v1[2], v1[3]); *(u32x4*)(outb + off) = wv;
                sq += (v0[0] * v0[0] + v0[1] * v0[1]) + (v0[2] * v0[2] + v0[3] * v0[3]) + (v1[0] * v1[0] + v1[1] * v1[1]) + (v1[2] * v1[2] + v1[3] * v1[3]);
            }
            sq += __shfl_xor(sq, 16); sq += __shfl_xor(sq, 32);
            if (fq == 0) atomicAdd(ssn + row, sq);
#pragma unroll
            for (int q = 0; q < 4; ++q) fA[q] = fN[q];
            hA[0] = hN[0]; hA[1] = hN[1];
        }
    }
};
struct EpiSwiGLU {
    static constexpr bool PERM = true, AFTER_DRAIN = false;
    bf16_t* O; const float* ss;
    __device__ __forceinline__ void operator()(const f32x4 (&acc)[2][2][4][2], const Unit& u, int wr, int wc, int fr, int fq) const {
        const int row0 = u.pm * BM + wr * 64 + fr; const int col0 = u.pn * HALF + wc * 32 + 8 * fq;
        float rsv[8];
#pragma unroll
        for (int k = 0; k < 8; ++k) rsv[k] = ss[row0 + (k >> 2) * HALF + (k & 3) * 16];
        EPI_FENCE();
#pragma unroll
        for (int ai = 0; ai < 2; ++ai)
#pragma unroll
            for (int m = 0; m < 4; ++m) {
                const int row = row0 + ai * HALF + m * 16;
                const float rs = rs_from_ss(rsv[ai * 4 + m]); const float rs2 = rs * rs, nrs = rs * -1.4426950408889634f;
                float o[8];
#pragma unroll
                for (int n = 0; n < 2; ++n)
#pragma unroll
                    for (int e = 0; e < 4; ++e) { const float g = acc[ai][0][m][n][e], uu = acc[ai][1][m][n][e] * rs2;
                        o[4 * n + e] = (g * uu) * __builtin_amdgcn_rcpf(1.0f + __builtin_amdgcn_exp2f(g * nrs)); }
                u32x4 wv; wv.x = cvt_pk_bf16(o[0], o[1]); wv.y = cvt_pk_bf16(o[2], o[3]); wv.z = cvt_pk_bf16(o[4], o[5]); wv.w = cvt_pk_bf16(o[6], o[7]);
                *(u32x4*)(O + (size_t)row * 2816 + col0) = wv;
            }
    }
};
struct EpiMlstmIn {
    static constexpr bool PERM = true, AFTER_DRAIN = false;
    bf16_t* P2; bf16_t* OP; float* gates; const float* ss;
    __device__ __forceinline__ void operator()(const f32x4 (&acc)[2][2][4][2], const Unit& u, int wr, int wc, int fr, int fq) const {
        const int row0 = u.pm * BM + wr * 64 + fr;
        float rsv[8];
#pragma unroll
        for (int k = 0; k < 8; ++k) rsv[k] = ss[row0 + (k >> 2) * HALF + (k & 3) * 16];
        EPI_FENCE();
#pragma unroll
        for (int ai = 0; ai < 2; ++ai)
#pragma unroll
            for (int m = 0; m < 4; ++m) {
                const int row = row0 + ai * HALF + m * 16;
                const float rs = rs_from_ss(rsv[ai * 4 + m]);
#pragma unroll
                for (int bj = 0; bj < 2; ++bj) {
                    const int cb = u.pn * BM + bj * HALF;
                    const f32x4 v0 = acc[ai][bj][m][0] * rs, v1 = acc[ai][bj][m][1] * rs;
                    const int cc = wc * 32 + 8 * fq;
                    if (cb < 3072) {
                        u32x4 wv; wv.x = cvt_pk_bf16(v0[0], v0[1]); wv.y = cvt_pk_bf16(v0[2], v0[3]); wv.z = cvt_pk_bf16(v1[0], v1[1]); wv.w = cvt_pk_bf16(v1[2], v1[3]);
                        bf16_t* dst = (cb < 2048) ? (P2 + (size_t)row * 2048 + cb + cc) : (OP + (size_t)row * 1024 + (cb - 2048) + cc);
                        *(u32x4*)dst = wv;
                    } else if (cb == 3072 && cc < 16) {
                        float* dst = gates + (size_t)row * 16 + cc;
                        *(f32x4*)dst = v0; *(f32x4*)(dst + 4) = v1;
                    }
                }
            }
    }
};

template <class Epi, class Sched, bool ALIGN_EPI = false, bool SP2 = false>
__device__ __forceinline__ void gemm_phase(PG8_LAS unsigned char* lds, const Gemm g, const Sched& S, const Epi& E) {
    const int tid = threadIdx.x, wid = __builtin_amdgcn_readfirstlane(tid >> 6), lane = tid & 63, wr = wid >> 2, wc = wid & 3, fr = lane & 15, fq = lane >> 4;
    const int K = g.K, nt = K / BK;
    unsigned voffA[2], voffB[2];
#pragma unroll
    for (int i = 0; i < 2; ++i) { int R, C; stage_rc(tid * 16 + i * 8192, R, C); const int Rb = Epi::PERM ? ((R & ~31) + perm32(R & 31)) : R;
        voffA[i] = (unsigned)(R * K + C) * 2u; voffB[i] = (unsigned)(Rb * K + C) * 2u; }
    const size_t kstep = (size_t)(BK * 2);
    const size_t hstep = (size_t)HALF * K * 2;
    const size_t tstep = 2 * hstep;
    const unsigned ldsw = (unsigned)wid * 1024u;
    const int aoff = lds_byte(wr * 64 + fr, fq * 8), boff = lds_byte(wc * 32 + fr, fq * 8);
#define PG8_SA(b, h) (((b) * 2 + (h)) * HTB)
#define PG8_SB(b, h) ((4 + (b) * 2 + (h)) * HTB)
#define PG8_STAGE(bufoff, gbase, voff) do { _Pragma("unroll") for (int _i = 0; _i < 2; ++_i) \
        __builtin_amdgcn_global_load_lds((const unsigned*)((const char*)(gbase) + (voff)[_i]), (PG8_LAS unsigned*)(lds + (bufoff) + ldsw + _i * 8192), 16, 0, 0); } while (0)
#define PG8_LDA(dst, b, h) do { _Pragma("unroll") for (int m = 0; m < 4; ++m) _Pragma("unroll") for (int k = 0; k < 2; ++k) dst[m][k] = *(const PG8_LAS bf16x8*)(lds + PG8_SA(b, h) + aoff + m * 2048 + k * 1024); } while (0)
#define PG8_LDB(dst, b, h) do { _Pragma("unroll") for (int n = 0; n < 2; ++n) _Pragma("unroll") for (int k = 0; k < 2; ++k) dst[n][k] = *(const PG8_LAS bf16x8*)(lds + PG8_SB(b, h) + boff + n * 2048 + k * 1024); } while (0)
#define PG8_MMA(ai, bj, At, Bt) do { __builtin_amdgcn_s_setprio(1); _Pragma("unroll") for (int m = 0; m < 4; ++m) _Pragma("unroll") for (int n = 0; n < 2; ++n) _Pragma("unroll") for (int k = 0; k < 2; ++k) \
        acc[ai][bj][m][n] = __builtin_amdgcn_mfma_f32_16x16x32_bf16(Bt[n][k], At[m][k], acc[ai][bj][m][n], 0, 0, 0); __builtin_amdgcn_s_setprio(0); } while (0)
#define PG8_WAIT_V(n) asm volatile("s_waitcnt vmcnt(" #n ")" ::: "memory")
#define PG8_WAIT_L(n) asm volatile("s_waitcnt lgkmcnt(" #n ")" ::: "memory")
#define PG8_BAR __builtin_amdgcn_s_barrier()
#define PG8_SCHED __builtin_amdgcn_sched_barrier(0)
    Unit cur, nxt; int ui = 0;
    if (!S.next(0, cur)) return;
    f32x4 acc[2][2][4][2];
#pragma unroll
    for (int a = 0; a < 2; ++a)
#pragma unroll
        for (int b = 0; b < 2; ++b)
#pragma unroll
            for (int m = 0; m < 4; ++m)
#pragma unroll
                for (int n = 0; n < 2; ++n) acc[a][b][m][n] = (f32x4){0.f, 0.f, 0.f, 0.f};
    bf16x8 At[4][2], B0[2][2], B1[2][2];
    const char* cA = (const char*)g.A + (size_t)cur.pm * tstep; const char* cB = (const char*)g.Bt + (size_t)cur.pn * tstep;
    S.a_ready(cur);
    if constexpr (SP2) {
        PG8_STAGE(PG8_SB(0, 0), cB, voffB); PG8_STAGE(PG8_SB(0, 1), cB + hstep, voffB); PG8_STAGE(PG8_SA(0, 0), cA, voffA); PG8_STAGE(PG8_SA(0, 1), cA + hstep, voffA);
        if (wr == 1) PG8_BAR;
        PG8_WAIT_V(2); PG8_BAR;
        PG8_STAGE(PG8_SB(1, 0), cB + kstep, voffB); PG8_STAGE(PG8_SA(1, 0), cA + kstep, voffA); PG8_STAGE(PG8_SB(1, 1), cB + hstep + kstep, voffB);
        PG8_WAIT_V(6); PG8_BAR;
    } else {
        PG8_STAGE(PG8_SB(0, 0), cB, voffB); PG8_STAGE(PG8_SA(0, 0), cA, voffA); PG8_STAGE(PG8_SB(0, 1), cB + hstep, voffB); PG8_STAGE(PG8_SA(0, 1), cA + hstep, voffA);
        if (wr == 1) PG8_BAR;
        PG8_WAIT_V(4); PG8_BAR;
        PG8_STAGE(PG8_SB(1, 0), cB + kstep, voffB); PG8_STAGE(PG8_SA(1, 0), cA + kstep, voffA); PG8_STAGE(PG8_SB(1, 1), cB + hstep + kstep, voffB);
        PG8_WAIT_V(6); PG8_BAR;
    }
    for (;;) {
        const bool has_next = S.next(ui + 1, nxt);
        const char* nA = has_next ? (const char*)g.A + (size_t)nxt.pm * tstep : cA; const char* nB = has_next ? (const char*)g.Bt + (size_t)nxt.pn * tstep : cB;
        for (int t = 0; t < nt; t += 2) {
            const bool last = (t == nt - 2);
            const char* a1 = cA + (size_t)(t + 1) * kstep;
            const char* a2 = last ? nA : cA + (size_t)(t + 2) * kstep; const char* b2 = last ? nB : cB + (size_t)(t + 2) * kstep;
            const char* a3 = a2 + kstep; const char* b3 = b2 + kstep;
            if (last && has_next) S.a_ready(nxt);
            if constexpr (SP2) {
            PG8_LDB(B0, 0, 0); PG8_LDB(B1, 0, 1); PG8_SCHED; PG8_LDA(At, 0, 0); PG8_STAGE(PG8_SA(1, 1), a1 + hstep, voffA);
            PG8_WAIT_V(8); PG8_WAIT_L(0); PG8_BAR; PG8_MMA(0, 0, At, B0); PG8_MMA(0, 1, At, B1); PG8_BAR; PG8_SCHED;
            PG8_LDA(At, 0, 1); PG8_STAGE(PG8_SB(0, 0), b2, voffB); PG8_STAGE(PG8_SB(0, 1), b2 + hstep, voffB); PG8_STAGE(PG8_SA(0, 0), a2, voffA);
            PG8_WAIT_V(8); PG8_WAIT_L(0); PG8_BAR; PG8_MMA(1, 0, At, B0); PG8_MMA(1, 1, At, B1); PG8_BAR; PG8_SCHED;
            PG8_LDB(B0, 1, 0); PG8_LDB(B1, 1, 1); PG8_SCHED; PG8_LDA(At, 1, 0); PG8_STAGE(PG8_SA(0, 1), a2 + hstep, voffA);
            PG8_WAIT_V(8); PG8_WAIT_L(0); PG8_BAR; PG8_MMA(0, 0, At, B0); PG8_MMA(0, 1, At, B1); PG8_BAR; PG8_SCHED;
            PG8_LDA(At, 1, 1); PG8_STAGE(PG8_SB(1, 0), b3, voffB); PG8_STAGE(PG8_SB(1, 1), b3 + hstep, voffB); PG8_STAGE(PG8_SA(1, 0), a3, voffA);
            PG8_WAIT_V(8); PG8_WAIT_L(0); PG8_BAR; PG8_MMA(1, 0, At, B0); PG8_MMA(1, 1, At, B1); PG8_BAR; PG8_SCHED;
            } else {
            PG8_LDB(B0, 0, 0); PG8_SCHED; PG8_LDA(At, 0, 0); PG8_STAGE(PG8_SA(1, 1), a1 + hstep, voffA);
            PG8_WAIT_L(8); PG8_BAR; PG8_WAIT_L(0); PG8_MMA(0, 0, At, B0); PG8_BAR; PG8_SCHED;
            PG8_LDB(B1, 0, 1); PG8_STAGE(PG8_SB(0, 0), b2, voffB);
            PG8_BAR; PG8_WAIT_L(0); PG8_MMA(0, 1, At, B1); PG8_BAR;
            PG8_LDA(At, 0, 1); PG8_STAGE(PG8_SA(0, 0), a2, voffA);
            PG8_BAR; PG8_WAIT_L(0); PG8_MMA(1, 0, At, B0); PG8_BAR; PG8_SCHED;
            PG8_STAGE(PG8_SB(0, 1), b2 + hstep, voffB);
            PG8_WAIT_V(6); PG8_BAR; PG8_MMA(1, 1, At, B1); PG8_BAR;
            PG8_LDB(B0, 1, 0); PG8_SCHED; PG8_LDA(At, 1, 0); PG8_STAGE(PG8_SA(0, 1), a2 + hstep, voffA);
            PG8_WAIT_L(8); PG8_BAR; PG8_WAIT_L(0); PG8_MMA(0, 0, At, B0); PG8_BAR; PG8_SCHED;
            PG8_LDB(B1, 1, 1); PG8_STAGE(PG8_SB(1, 0), b3, voffB);
            PG8_BAR; PG8_WAIT_L(0); PG8_MMA(0, 1, At, B1); PG8_BAR;
            PG8_LDA(At, 1, 1); PG8_STAGE(PG8_SA(1, 0), a3, voffA);
            PG8_BAR; PG8_WAIT_L(0); PG8_MMA(1, 0, At, B0); PG8_BAR; PG8_SCHED;
            PG8_STAGE(PG8_SB(1, 1), b3 + hstep, voffB);
            PG8_WAIT_V(6); PG8_BAR; PG8_MMA(1, 1, At, B1); PG8_BAR;
            }
        }
        if constexpr (ALIGN_EPI) { if (wr == 0) PG8_BAR; }
        if constexpr (!Epi::AFTER_DRAIN) { E(acc, cur, wr, wc, fr, fq); S.done(cur); }
        if (!has_next) break;
#pragma unroll
        for (int a = 0; a < 2; ++a)
#pragma unroll
            for (int b = 0; b < 2; ++b)
#pragma unroll
                for (int m = 0; m < 4; ++m)
#pragma unroll
                    for (int n = 0; n < 2; ++n) acc[a][b][m][n] = (f32x4){0.f, 0.f, 0.f, 0.f};
        cur = nxt; cA = nA; cB = nB; ++ui;
        if constexpr (ALIGN_EPI) { if (wr == 1) PG8_BAR; }
    }
    PG8_WAIT_V(0);
    if constexpr (!ALIGN_EPI) { if (wr == 0) PG8_BAR; }
    PG8_BAR;
    if constexpr (Epi::AFTER_DRAIN) { E.fused(acc, cur, wr, wc, fr, fq, lds, wid, lane); S.done(cur); }
#undef PG8_SA
#undef PG8_SB
#undef PG8_STAGE
#undef PG8_LDA
#undef PG8_LDB
#undef PG8_MMA
#undef PG8_WAIT_V
#undef PG8_WAIT_L
#undef PG8_BAR
#undef PG8_SCHED
}
}

constexpr int T_TOK = 32768, DM = 1024, SEQ = 2048, NB = 16, DFF = 2816, THALF = 16384;
constexpr int NWAVES = 8;
constexpr int RB = 2176, HBR = 8 * RB;
constexpr int LDS_BYTES = 147456;
constexpr size_t MiB = 1u << 20;
constexpr size_t WS_SS = 0;
constexpr size_t WS_MST = 1 * MiB;
constexpr size_t WS_NST = 1 * MiB + 65536;
constexpr size_t WS_BAR = 3 * MiB;
constexpr size_t WS_WQKV = 4 * MiB;
constexpr size_t WS_WAO = 22 * MiB;
constexpr size_t WS_WFFIN = 24 * MiB;
constexpr size_t WS_WFFOUT = 46 * MiB;
constexpr size_t WS_WMIN = 57 * MiB;
constexpr size_t WS_WMOUT = 64 * MiB;
constexpr size_t WS_ROPE = 66 * MiB;
constexpr size_t WS_LSE = 70 * MiB;
constexpr size_t WS_GATES = 73 * MiB;
constexpr size_t WS_HB = 76 * MiB;
constexpr size_t WS_MX = 140 * MiB;
constexpr size_t WS_BIG = 204 * MiB;
constexpr size_t WS_H = WS_BIG;
constexpr size_t WS_ACT = WS_BIG + 128 * MiB;
constexpr size_t WS_END = 512 * MiB;
static_assert(WS_ACT + (size_t)T_TOK * DFF * 2 <= WS_END && WS_BIG + (size_t)72 * 8 * 2176 * 256 <= WS_END, "d_ws map");

#define LAS __attribute__((address_space(3)))
typedef unsigned short bf16;
typedef unsigned u32x4 __attribute__((ext_vector_type(4)));
typedef unsigned u32x2 __attribute__((ext_vector_type(2)));
typedef float f32x4 __attribute__((ext_vector_type(4)));
typedef float f32x16 __attribute__((ext_vector_type(16)));
typedef short bf16x8 __attribute__((ext_vector_type(8)));
typedef short s16x4 __attribute__((ext_vector_type(4)));
typedef float f32x2_t __attribute__((ext_vector_type(2)));
typedef __bf16 bf16x2_t __attribute__((ext_vector_type(2)));
__device__ __forceinline__ unsigned pk2(float lo, float hi) { f32x2_t v = {lo, hi}; bf16x2_t b = __builtin_convertvector(v, bf16x2_t); return __builtin_bit_cast(unsigned, b); }
__device__ __forceinline__ float bf_lo(unsigned w) { return __uint_as_float(w << 16); }
__device__ __forceinline__ float bf_hi(unsigned w) { return __uint_as_float(w & 0xffff0000u); }
__device__ __forceinline__ float wave_sum(float v) {
#pragma unroll
    for (int o = 1; o < 64; o <<= 1) v += __shfl_xor(v, o);
    return v;
}
__device__ __forceinline__ float wave_max(float v) {
#pragma unroll
    for (int o = 1; o < 64; o <<= 1) v = fmaxf(v, __shfl_xor(v, o));
    return v;
}
#define MFMA16(a, b, c) __builtin_amdgcn_mfma_f32_16x16x32_bf16((a), (b), (c), 0, 0, 0)
#define MFMA32(a, b, c) __builtin_amdgcn_mfma_f32_32x32x16_bf16((a), (b), (c), 0, 0, 0)

#define XB_TMO      128
#define XB_XCNT(j)  (256  + 64 * (j))
#define XB_XSUB(j)  (1280 + 64 * (j))
#define XB_XGEN(j)  (2304 + 64 * (j))
#define XB_TOP      3328
#define XB_TOPGEN   3392
#define XCD_BAR_WORDS 3456
#define XB_SPIN_CAP (1u << 18)

__device__ __forceinline__ unsigned xb_ld(unsigned* p)              { return __hip_atomic_load(p, __ATOMIC_RELAXED, __HIP_MEMORY_SCOPE_AGENT); }
__device__ __forceinline__ unsigned xb_add(unsigned* p, unsigned v) { return __hip_atomic_fetch_add(p, v, __ATOMIC_RELAXED, __HIP_MEMORY_SCOPE_AGENT); }
__device__ __forceinline__ unsigned xb_xcc_id() { return (unsigned)__builtin_amdgcn_s_getreg((3 << 11) | 20) & 0xFu; }
#define XB_SPIN(cond, bar) do { unsigned _sp = 0; while (cond) { __builtin_amdgcn_s_sleep(1); \
    if ((++_sp & 255u) == 0u) { if (xb_ld(&(bar)[XB_TMO])) break; if (_sp > XB_SPIN_CAP) { atomicAdd(&(bar)[XB_TMO], 1u); break; } } } } while (0)

struct XcdBarrier {
    unsigned* bar; unsigned x;
    volatile LAS unsigned* st;
};

__device__ __forceinline__ XcdBarrier xcd_barrier_post(unsigned* bar, volatile LAS unsigned* st) {
    XcdBarrier b; b.bar = bar; b.x = xb_xcc_id(); b.st = st;
    if (threadIdx.x == 0) (void)xb_add(&bar[XB_XCNT(b.x)], 1u);
    return b;
}
__device__ __forceinline__ void xcd_barrier_complete(unsigned* bar, unsigned x, unsigned& nloc, unsigned& nx) {
    const unsigned G = gridDim.x * gridDim.y * gridDim.z;
    unsigned sum, cnt, mine, sp = 0u;
    for (;;) {
        sum = 0u; cnt = 0u; mine = 0u;
#pragma unroll
        for (unsigned j = 0; j < 16; ++j) { const unsigned c = xb_ld(&bar[XB_XCNT(j)]); sum += c; cnt += (c > 0u) ? 1u : 0u; mine = (j == x) ? c : mine; }
        if (sum == G) break;
        __builtin_amdgcn_s_sleep(1);
        if ((++sp & 255u) == 0u) { if (xb_ld(&bar[XB_TMO])) break; if (sp > XB_SPIN_CAP) { atomicAdd(&bar[XB_TMO], 1u); break; } }
    }
    nloc = mine > 0u ? mine : 1u; nx = cnt > 0u ? cnt : 1u;
}

__device__ __forceinline__ void xcd_barrier(const XcdBarrier& b) {
    asm volatile("s_waitcnt vmcnt(0)" ::: "memory");
    __syncthreads();
    if (threadIdx.x == 0) {
        unsigned* bar = b.bar;
        __builtin_amdgcn_s_waitcnt(0);
        unsigned nloc = b.st[0], nx = b.st[1];
        if (nloc == 0u) { xcd_barrier_complete(bar, b.x, nloc, nx); b.st[0] = nloc; b.st[1] = nx; }
        const unsigned old = xb_add(&bar[XB_XSUB(b.x)], 1u);
        const unsigned gen = old / nloc;
        if (old + 1u == (gen + 1u) * nloc) {
            __builtin_amdgcn_fence(__ATOMIC_RELEASE, "agent");
            asm volatile("s_waitcnt vmcnt(0)" ::: "memory");
            const unsigned og = xb_add(&bar[XB_TOP], 1u);
            const unsigned tg = og / nx;
            if (og + 1u == (tg + 1u) * nx) xb_add(&bar[XB_TOPGEN], 1u);
            else XB_SPIN(xb_ld(&bar[XB_TOPGEN]) == tg, bar);
            __builtin_amdgcn_fence(__ATOMIC_ACQUIRE, "agent");
            xb_add(&bar[XB_XGEN(b.x)], 1u);
            asm volatile("s_waitcnt vmcnt(0)" ::: "memory");
        } else {
            XB_SPIN(xb_ld(&bar[XB_XGEN(b.x)]) == gen, bar);
            __builtin_amdgcn_fence(__ATOMIC_ACQUIRE, "agent");
            asm volatile("s_waitcnt vmcnt(0)" ::: "memory");
        }
    }
    __syncthreads();
}


struct Args {
    const float* x; const int* pos; const float* attn_norm; const float* attn_w_in; const float* attn_w_out; const float* mlstm_norm; const float* mlstm_w_in;
    const float* conv_w; const float* conv_b; const float* ig_bias; const float* fg_bias; const float* head_gain; const float* mlstm_w_out;
    const float* ffn_norm; const float* ffn_w_in; const float* ffn_w_out; const float* final_norm;
    float* out; unsigned char* ws; int ph_lo, ph_hi;
};

__device__ __forceinline__ void tr_item(const float* __restrict__ W, int K, int Nsrc, bf16* WT, int n0_dst, int n0_src, int k0, const float* __restrict__ gain, float scale, LAS float* scr, int lane, bool ropeperm = false) {
    const int n4 = lane & 15, kq = lane >> 4; const int s4 = (ropeperm && n4 < 8) ? (((n4 & 1) << 2) + (n4 >> 1)) : n4; const int col = n0_src + 4 * s4; const bool ok = col < Nsrc;
    f32x4 v[16];
#pragma unroll
    for (int i = 0; i < 16; ++i) { v[i] = (f32x4){0.f, 0.f, 0.f, 0.f}; if (ok) v[i] = __builtin_nontemporal_load((const f32x4*)(W + (size_t)(k0 + 4 * i + kq) * Nsrc + col)); }
#pragma unroll
    for (int i = 0; i < 16; ++i) { const int kk = 4 * i + kq; const float g = gain ? gain[k0 + kk] * scale : scale; LAS float* d = scr + kk * 65 + 4 * n4;
        d[0] = v[i][0] * g; d[1] = v[i][1] * g; d[2] = v[i][2] * g; d[3] = v[i][3] * g; }
    asm volatile("s_waitcnt lgkmcnt(0)" ::: "memory");
    const int c = lane & 7;
#pragma unroll
    for (int j = 0; j < 8; ++j) { const int n = (lane >> 3) + 8 * j; const LAS float* sp = scr + (8 * c) * 65 + n;
        u32x4 o; o.x = pk2(sp[0 * 65], sp[1 * 65]); o.y = pk2(sp[2 * 65], sp[3 * 65]); o.z = pk2(sp[4 * 65], sp[5 * 65]); o.w = pk2(sp[6 * 65], sp[7 * 65]);
        *(u32x4*)(WT + (size_t)(n0_dst + n) * K + k0 + 8 * c) = o; }
    asm volatile("s_waitcnt lgkmcnt(0)" ::: "memory");
}
__device__ __forceinline__ void p0_prologue(const Args& A, LAS unsigned char* lds, int G, int bid) {
    const int tid = threadIdx.x, lane = tid & 63, wave = tid >> 6;
    LAS float* scr = (LAS float*)(lds + wave * 16640);
    const int gw = bid * NWAVES + wave, NGW = G * NWAVES;
    unsigned char* ws = A.ws;
    constexpr int I_QKV = 16 * 144, I_AO = 16 * 16, I_FFIN = 16 * 88, I_FFOUT = 44 * 16, I_MIN = 16 * 52, I_MOUT = 16 * 16;
    constexpr int NITEMS = I_QKV + I_AO + 2 * I_FFIN + 2 * I_FFOUT + I_MIN + I_MOUT;
    constexpr float QSCALE = 0.08838834764831845f * 1.4426950408889634f;
    for (int it = gw; it < NITEMS; it += NGW) {
        int r = it;
        if (r < I_QKV) { const int kb = r / 144, nb = r % 144, n0 = 64 * nb; const int tsel = (n0 % 3072) / 1024;
            tr_item(A.attn_w_in, 1024, 9216, (bf16*)(ws + WS_WQKV), n0, n0, 64 * kb, A.attn_norm, tsel == 0 ? QSCALE : 1.f, scr, lane, tsel < 2 && (n0 & 127) == 0); continue; } r -= I_QKV;
        if (r < I_AO) { const int kb = r / 16, nb = r % 16; tr_item(A.attn_w_out, 1024, 1024, (bf16*)(ws + WS_WAO), 64 * nb, 64 * nb, 64 * kb, nullptr, 1.f, scr, lane); continue; } r -= I_AO;
        if (r < 2 * I_FFIN) { const int l = r / I_FFIN; r -= l * I_FFIN; const int kb = r / 88, nb = r % 88, n0 = 64 * nb;
            const int pn = n0 >> 8, bj = (n0 >> 7) & 1, jj = n0 & 127; const int nsrc = (bj ? DFF : 0) + 128 * pn + jj;
            tr_item(A.ffn_w_in + (size_t)l * 1024 * 5632, 1024, 5632, (bf16*)(ws + WS_WFFIN) + (size_t)l * 5632 * 1024, n0, nsrc, 64 * kb, A.ffn_norm + l * 1024, 1.f, scr, lane); continue; } r -= 2 * I_FFIN;
        if (r < 2 * I_FFOUT) { const int l = r / I_FFOUT; r -= l * I_FFOUT; const int kb = r / 16, nb = r % 16;
            tr_item(A.ffn_w_out + (size_t)l * DFF * 1024, DFF, 1024, (bf16*)(ws + WS_WFFOUT) + (size_t)l * 1024 * DFF, 64 * nb, 64 * nb, 64 * kb, nullptr, 1.f, scr, lane); continue; } r -= 2 * I_FFOUT;
        if (r < I_MIN) { const int kb = r / 52, nb = r % 52; tr_item(A.mlstm_w_in, 1024, 3088, (bf16*)(ws + WS_WMIN), 64 * nb, 64 * nb, 64 * kb, A.mlstm_norm, 1.f, scr, lane); continue; } r -= I_MIN;
        { const int kb = r / 16, nb = r % 16; tr_item(A.mlstm_w_out, 1024, 1024, (bf16*)(ws + WS_WMOUT), 64 * nb, 64 * nb, 64 * kb, nullptr, 1.f, scr, lane); }
    }
    float* ss = (float*)(ws + WS_SS); bf16* hb = (bf16*)(ws + WS_HB);
    for (int m4 = gw; m4 < T_TOK / 4; m4 += NGW) {
        f32x4 v[4][4];
#pragma unroll
        for (int q = 0; q < 4; ++q) { const f32x4* xr = (const f32x4*)(A.x + (size_t)(4 * m4 + q) * DM) + lane;
#pragma unroll
            for (int j = 0; j < 4; ++j) v[q][j] = __builtin_nontemporal_load(xr + 64 * j); }
#pragma unroll
        for (int q = 0; q < 4; ++q) { const int m = 4 * m4 + q; float sq = 0.f;
#pragma unroll
            for (int j = 0; j < 4; ++j) sq += (v[q][j].x * v[q][j].x + v[q][j].y * v[q][j].y) + (v[q][j].z * v[q][j].z + v[q][j].w * v[q][j].w);
            sq = wave_sum(sq);
            u32x2* o8 = (u32x2*)(hb + (size_t)m * DM) + lane;
#pragma unroll
            for (int j = 0; j < 4; ++j) { u32x2 o; o.x = pk2(v[q][j].x, v[q][j].y); o.y = pk2(v[q][j].z, v[q][j].w); o8[64 * j] = o; }
            if (lane == 0) ss[m] = sq; }
    }
    const int gt = bid * 512 + tid, NGT = G * 512;
    for (int i = gt; i < 4 * T_TOK; i += NGT) ss[T_TOK + i] = 0.f;
    float* rope = (float*)(ws + WS_ROPE);
    for (int i = gt; i < T_TOK * 16; i += NGT) {
        const int t = i >> 4, f = i & 15;
        const float invf = __builtin_amdgcn_exp2f((float)f * -1.1832230355827609f);
        const float ang = (float)A.pos[t] * invf;
        const double rev = (double)ang * 0.15915494309189535; const float fr = (float)(rev - rint(rev));
        rope[(size_t)t * 32 + f] = __builtin_amdgcn_cosf(fr); rope[(size_t)t * 32 + 16 + f] = __builtin_amdgcn_sinf(fr);
    }
}

struct AStep { const bf16* base; size_t rowstride; int blk, g, h, dil, rr, b; bool valid, compute; };
__device__ __forceinline__ AStep attn_step(int u, int s, const bf16* QKVh) {
    AStep t; t.valid = true; t.compute = true;
    if (s < 5) { t.g = 0; t.dil = 1; t.rr = 0; const int qt = u & 3; t.h = (u >> 2) & 7; t.b = u >> 5; t.blk = 4 * qt + s - 1; if (s == 0) { t.compute = false; t.valid = qt > 0; if (!t.valid) t.blk = 0; } }
    else if (s < 9) { t.g = 1; t.dil = 4; t.h = u & 7; t.rr = (u >> 3) & 3; t.b = u >> 5; t.blk = s - 5; }
    else { t.g = 2; t.dil = 16; const int v = 4 * u + (s - 9); t.h = v & 7; t.rr = (v >> 3) & 15; t.b = v >> 7; t.blk = 0; }
    t.rowstride = 128;
    t.base = QKVh + ((size_t)(t.g * 24 + t.h) * HBR + t.b * RB + t.rr * (SEQ / t.dil)) * 128;
    return t;
}
typedef short v4i16_t __attribute__((ext_vector_type(4)));
__device__ __forceinline__ s16x4 tr_read(const LAS unsigned char* p) { return __builtin_bit_cast(s16x4, __builtin_amdgcn_ds_read_tr16_b64_v4i16((LAS v4i16_t*)p)); }
__device__ __forceinline__ void attn_phase(LAS unsigned char* lds, const bf16* __restrict__ QKVh, bf16* __restrict__ Oh, float* __restrict__ lse, int half, int G, int bid) {
    const int tid = threadIdx.x, lane = tid & 63, w = __builtin_amdgcn_readfirstlane(tid >> 6), r = lane & 15, q4 = lane >> 4;
    constexpr int SLOT = 34816, VSLOT = 36864;
#define ATT_LOAD(st) do { \
        _Pragma("unroll") for (int i = 0; i < 4; ++i) { const int chunk = tid + 512 * i, c = chunk >> 4, ch = chunk & 15; const bf16* gp = (st).base + (size_t)(128 * (st).blk + c) * (st).rowstride + 8 * ch; \
            kr[i] = __builtin_nontemporal_load((const u32x4*)(gp + (size_t)8 * HBR * 128)); vr[i] = __builtin_nontemporal_load((const u32x4*)(gp + (size_t)16 * HBR * 128)); } \
        { const bf16* qrow = (st).base + (size_t)(128 * (st).blk + 16 * w + r) * (st).rowstride; \
            _Pragma("unroll") for (int q = 0; q < 4; ++q) qn[q] = *(const bf16x8*)(qrow + 32 * q + 8 * q4); } } while (0)
    for (int u = bid; u < 256; u += G) {
        AStep nx = attn_step(u, 0, QKVh);
        u32x4 kr[4], vr[4]; bf16x8 qn[4];
#pragma unroll
        for (int i = 0; i < 4; ++i) { kr[i] = (u32x4){0u, 0u, 0u, 0u}; vr[i] = kr[i]; qn[i] = (bf16x8){0, 0, 0, 0, 0, 0, 0, 0}; }
        ATT_LOAD(nx);
        for (int s = 0; s < 13; ++s) {
            const AStep cu = nx; const int cs = s & 1;
            LAS unsigned char* Kc = lds + cs * SLOT; LAS unsigned char* Vc = lds + 2 * SLOT + cs * VSLOT;
#pragma unroll
            for (int i = 0; i < 4; ++i) { const int chunk = tid + 512 * i, c = chunk >> 4, ch = chunk & 15; *(LAS u32x4*)(Kc + c * 272 + ch * 16) = kr[i]; *(LAS u32x4*)(Vc + c * 288 + ch * 16) = vr[i]; }
            bf16x8 qf[4];
#pragma unroll
            for (int q = 0; q < 4; ++q) qf[q] = qn[q];
            __syncthreads();
            { nx = attn_step(u, (s + 1 < 13) ? s + 1 : 12, QKVh); ATT_LOAD(nx); }
            if (cu.compute) {
                const bool first = (cu.blk == 0);
                const LAS unsigned char* Kp = first ? Kc : lds + (cs ^ 1) * SLOT; const LAS unsigned char* Vp = first ? Vc : lds + 2 * SLOT + (cs ^ 1) * VSLOT;
                const int a = 16 * w + r;
                const int jlo = first ? 8 : 0;
                f32x4 S[9]; float mx = -INFINITY;
#pragma unroll
                for (int jj = 0; jj < 9; ++jj) { const int j = w + jj; S[jj] = (f32x4){0.f, 0.f, 0.f, 0.f};
                    if (j >= jlo) { const LAS unsigned char* kp = (j >= 8 ? Kc : Kp) + ((j & 7) * 16 + r) * 272 + 16 * q4;
#pragma unroll
                        for (int st = 0; st < 4; ++st) { const bf16x8 kf = *(const LAS bf16x8*)(kp + 64 * st); S[jj] = MFMA16(kf, qf[st], S[jj]); } }
#pragma unroll
                    for (int i = 0; i < 4; ++i) { bool valid = (j >= jlo);
                        if (jj == 0) valid = valid && (4 * q4 + i >= r);
                        if (jj == 8) valid = valid && (4 * q4 + i <= r);
                        S[jj][i] = valid ? S[jj][i] : -INFINITY; mx = fmaxf(mx, S[jj][i]); } }
                mx = fmaxf(mx, __shfl_xor(mx, 16)); mx = fmaxf(mx, __shfl_xor(mx, 32));
                float den = 0.f;
#pragma unroll
                for (int jj = 0; jj < 9; ++jj)
#pragma unroll
                    for (int i = 0; i < 4; ++i) { const float pe = __builtin_amdgcn_exp2f(S[jj][i] - mx); S[jj][i] = pe; den += pe; }
                den += __shfl_xor(den, 16); den += __shfl_xor(den, 32);
                bf16x8 pf[5];
#pragma unroll
                for (int p = 0; p < 5; ++p) { u32x4 wv; wv.x = pk2(S[2 * p][0], S[2 * p][1]); wv.y = pk2(S[2 * p][2], S[2 * p][3]);
                    if (2 * p + 1 < 9) { wv.z = pk2(S[(2 * p + 1) % 9][0], S[(2 * p + 1) % 9][1]); wv.w = pk2(S[(2 * p + 1) % 9][2], S[(2 * p + 1) % 9][3]); } else { wv.z = 0u; wv.w = 0u; }
                    pf[p] = __builtin_bit_cast(bf16x8, wv); }
                f32x4 o[8];
#pragma unroll
                for (int db = 0; db < 8; ++db) o[db] = (f32x4){0.f, 0.f, 0.f, 0.f};
#pragma unroll
                for (int p = 0; p < 5; ++p) { const int j0 = w + 2 * p, j1 = (j0 + 1 > 15) ? 15 : j0 + 1;
                    if (j0 + 1 >= jlo) {
                        const LAS unsigned char* v0p = (j0 >= 8 ? Vc : Vp) + ((j0 & 7) * 16 + 4 * q4 + (r >> 2)) * 288 + 8 * (r & 3);
                        const LAS unsigned char* v1p = (j1 >= 8 ? Vc : Vp) + ((j1 & 7) * 16 + 4 * q4 + (r >> 2)) * 288 + 8 * (r & 3);
#pragma unroll
                        for (int db = 0; db < 8; ++db) {
                            const s16x4 lo = tr_read(v0p + 32 * db), hi = tr_read(v1p + 32 * db);
                            const bf16x8 af = __builtin_shufflevector(lo, hi, 0, 1, 2, 3, 4, 5, 6, 7);
                            o[db] = MFMA16(af, pf[p], o[db]); } } }
                const float inv = __builtin_amdgcn_rcpf(den);
                const int tl = cu.b * SEQ + (128 * cu.blk + a) * cu.dil + cu.rr;
                bf16* orow = Oh + ((size_t)(cu.g * 8 + cu.h) * HBR + cu.b * RB + cu.rr * (SEQ / cu.dil) + 128 * cu.blk + a) * 128 + 4 * q4;
#pragma unroll
                for (int db = 0; db < 8; ++db) { u32x2 wv; wv.x = pk2(o[db][0] * inv, o[db][1] * inv); wv.y = pk2(o[db][2] * inv, o[db][3] * inv); *(u32x2*)(orow + 16 * db) = wv; }
                if (q4 == 0) lse[((size_t)cu.g * T_TOK + (size_t)half * THALF + tl) * 8 + cu.h] = mx * 0.6931471805599453f + __logf(den);
            }
            __syncthreads();
        }
    }
#undef ATT_LOAD
}
__device__ __forceinline__ void merge_phase(const bf16* __restrict__ Oh, const float* __restrict__ lse, bf16* __restrict__ MX, int half, int G, int bid) {
    const int gt = bid * 512 + threadIdx.x, NGT = G * 512;
    for (int i = gt; i < THALF * 128; i += NGT) {
        const int tl = i >> 7, ch = i & 127, h = ch >> 4; const size_t tg = (size_t)half * THALF + tl;
        const float l0 = lse[((size_t)0 * T_TOK + tg) * 8 + h], l1 = lse[((size_t)1 * T_TOK + tg) * 8 + h], l2 = lse[((size_t)2 * T_TOK + tg) * 8 + h];
        const float mxl = fmaxf(l0, fmaxf(l1, l2)); float w0 = __expf(l0 - mxl), w1 = __expf(l1 - mxl), w2 = __expf(l2 - mxl); const float inv = 1.0f / (w0 + w1 + w2); w0 *= inv; w1 *= inv; w2 *= inv;
        const int sq = tl & 2047, bb = (tl >> 11) * RB, dch = ch & 15;
        const int p1 = ((sq & 3) << 9) + (sq >> 2), p2 = ((sq & 15) << 7) + (sq >> 4);
        const u32x4 a = __builtin_nontemporal_load((const u32x4*)(Oh + ((size_t)(0 + h) * HBR + bb + sq) * 128 + 8 * dch)), b = __builtin_nontemporal_load((const u32x4*)(Oh + ((size_t)(8 + h) * HBR + bb + p1) * 128 + 8 * dch)), c = __builtin_nontemporal_load((const u32x4*)(Oh + ((size_t)(16 + h) * HBR + bb + p2) * 128 + 8 * dch));
        u32x4 o;
#pragma unroll
        for (int e = 0; e < 4; ++e) o[e] = pk2(w0 * bf_lo(a[e]) + w1 * bf_lo(b[e]) + w2 * bf_lo(c[e]), w0 * bf_hi(a[e]) + w1 * bf_hi(b[e]) + w2 * bf_hi(c[e]));
        *(u32x4*)(MX + tg * 1024 + 8 * ch) = o;
    }
}
__device__ __forceinline__ float logsigmoid_f(float x) { return fminf(x, 0.f) - __logf(1.0f + __expf(-fabsf(x))); }
__device__ __forceinline__ void mlstm_pre_phase(const bf16* __restrict__ P2, const float* __restrict__ gates, const float* __restrict__ convw, const float* __restrict__ convb, const float* __restrict__ igb, const float* __restrict__ fgb,
                                                bf16* __restrict__ QKc, float* __restrict__ GA, float* __restrict__ GB, float* __restrict__ GP, float* __restrict__ CH, int G, int bid) {
    const int tid = threadIdx.x, lane = tid & 63, wave = tid >> 6;
    const int gt = bid * 512 + tid, NGT = G * 512;
    {
        const int ch = gt & 255, col = 4 * ch; const int tgs = NGT >> 8;
        float cw[4][4], cb[4];
        { const f32x4 b4 = *(const f32x4*)(convb + col);
#pragma unroll
          for (int e = 0; e < 4; ++e) cb[e] = b4[e];
#pragma unroll
          for (int j = 0; j < 4; ++j) { const f32x4 w4 = *(const f32x4*)(convw + j * 1024 + col);
#pragma unroll
              for (int e = 0; e < 4; ++e) cw[j][e] = w4[e]; } }
        const float ksc = (ch >= 128) ? 0.125f : 1.0f;
        u32x2 rn[11];
#define PRE_LOAD(tg_) do { const int t0_ = 8 * (tg_), sq0_ = t0_ & 2047; \
            _Pragma("unroll") for (int i = 0; i < 11; ++i) { const int dlt_ = (sq0_ + i - 3 >= 0) ? (i - 3) : -sq0_; \
                rn[i] = __builtin_nontemporal_load((const u32x2*)(P2 + (size_t)(t0_ + dlt_) * 2048 + col)); } } while (0)
        int tg = gt >> 8;
        if (tg < T_TOK / 8) PRE_LOAD(tg);
        for (; tg < T_TOK / 8; tg += tgs) {
            const int t0 = 8 * tg, sq0 = t0 & 2047;
            u32x2 rw[11];
#pragma unroll
            for (int i = 0; i < 11; ++i) rw[i] = (sq0 + i - 3 >= 0) ? rn[i] : (u32x2){0u, 0u};
            { const int tgn = (tg + tgs < T_TOK / 8) ? tg + tgs : tg; PRE_LOAD(tgn); }
#pragma unroll
            for (int i = 0; i < 8; ++i) { u32x2 o;
#pragma unroll
                for (int e = 0; e < 2; ++e) { float x0 = cb[2 * e], x1 = cb[2 * e + 1];
#pragma unroll
                    for (int j = 0; j < 4; ++j) { x0 += cw[j][2 * e] * bf_lo(rw[i + j][e]); x1 += cw[j][2 * e + 1] * bf_hi(rw[i + j][e]); }
                    o[e] = pk2(silu_f(x0) * ksc, silu_f(x1) * ksc); }
                *(u32x2*)(QKc + (size_t)(t0 + i) * 1024 + col) = o; }
        }
#undef PRE_LOAD
    }
    const int gw = bid * NWAVES + wave, NGW = G * NWAVES;
    for (int it = gw; it < NB * 32 * 8; it += NGW) {
        const int h = it & 7, c = (it >> 3) & 31, b = it >> 8; const size_t t = (size_t)b * SEQ + 64 * c + lane;
        const float gi = gates[t * 16 + h], gf = gates[t * 16 + 8 + h];
        float bs = logsigmoid_f(gf + fgb[h]);
#pragma unroll
        for (int o = 1; o < 64; o <<= 1) { const float v = __shfl_up(bs, o); if (lane >= o) bs += v; }
        const float av = gi + igb[h] - bs; float pm = av;
#pragma unroll
        for (int o = 1; o < 64; o <<= 1) { const float v = __shfl_up(pm, o); if (lane >= o) pm = fmaxf(pm, v); }
        const size_t o = (size_t)(b * 8 + h) * SEQ + 64 * c + lane; GA[o] = av; GB[o] = bs; GP[o] = pm;
        if (lane == 63) { const size_t cid = (size_t)(b * 8 + h) * 32 + c; CH[2 * cid] = bs; CH[2 * cid + 1] = bs + pm; }
    }
}
__device__ __forceinline__ void mlstm_scan_phase(LAS unsigned char* lds, const bf16* __restrict__ P2, const bf16* __restrict__ QKc, const float* __restrict__ GA, const float* __restrict__ CH,
                                                 bf16* __restrict__ Cst, float* __restrict__ nst, float* __restrict__ mst, int G, int bid) {
    const int tid = threadIdx.x, lane = tid & 63, w = __builtin_amdgcn_readfirstlane(tid >> 6), r = lane & 15, q4 = lane >> 4;
    const int dvb = w & 3, dkh = w >> 2;
    const bf16x8 ones = {0x3F80, 0x3F80, 0x3F80, 0x3F80, 0x3F80, 0x3F80, 0x3F80, 0x3F80};
    for (int item = bid; item < 256; item += G) {
        const int dvh = item & 1, h = (item >> 1) & 7, b = item >> 4;
        const size_t cid0 = (size_t)(b * 8 + h) * 32;
        f32x4 acc[2], accn[2]; acc[0] = (f32x4){0.f, 0.f, 0.f, 0.f}; acc[1] = acc[0]; accn[0] = acc[0]; accn[1] = acc[0];
        float mcar = 0.f;
        u32x4 nk, nv; float na, nbl, nml;
#define MSCAN_LOAD(c) do { const size_t t_ = (size_t)b * SEQ + 64 * (c) + lane; nk = *(const u32x4*)(QKc + t_ * 1024 + 512 + h * 64 + 8 * w); nv = *(const u32x4*)(P2 + t_ * 2048 + 1024 + h * 128 + 64 * dvh + 8 * w); \
            na = GA[(size_t)(b * 8 + h) * SEQ + 64 * (c) + lane]; nbl = CH[2 * (cid0 + (c))]; nml = CH[2 * (cid0 + (c)) + 1]; } while (0)
        MSCAN_LOAD(0);
        for (int c = 0; c < 32; ++c) {
            const u32x4 ck = nk, cv = nv; const float as = na, blast = nbl, mloc = nml;
            if (c + 1 < 32) MSCAN_LOAD(c + 1);
            const float mnew = fmaxf(blast + mcar, mloc);
            const float wsv = __expf(blast + as - mnew), carry = __expf(blast + mcar - mnew);
            const size_t cid = cid0 + c;
#pragma unroll
            for (int nb = 0; nb < 2; ++nb)
#pragma unroll
                for (int i = 0; i < 4; ++i) { const int dv = 64 * dvh + 16 * dvb + 4 * q4 + i, dk = 32 * dkh + 16 * nb + r;
                    Cst[(cid * 128 + dv) * 64 + dk] = (bf16)(pk2(acc[nb][i], 0.f) & 0xffffu); }
            if (dvh == 0 && dvb == 0 && q4 == 0) { nst[cid * 64 + 32 * dkh + r] = accn[0][0]; nst[cid * 64 + 32 * dkh + 16 + r] = accn[1][0]; }
            if (dvh == 0 && tid == 0) mst[cid] = mcar;
            LAS unsigned char* Kw = lds + (c & 1) * 18432; LAS unsigned char* Vs = Kw + 9216;
            u32x4 kw;
#pragma unroll
            for (int e = 0; e < 4; ++e) kw[e] = pk2(bf_lo(ck[e]) * wsv, bf_hi(ck[e]) * wsv);
            *(LAS u32x4*)(Kw + lane * 144 + 16 * w) = kw; *(LAS u32x4*)(Vs + lane * 144 + 16 * w) = cv;
            __syncthreads();
            acc[0] = acc[0] * carry; acc[1] = acc[1] * carry; accn[0] = accn[0] * carry; accn[1] = accn[1] * carry;
#pragma unroll
            for (int st = 0; st < 2; ++st) {
                const int rowb = (32 * st + 8 * q4 + (r >> 2)) * 144 + 8 * (r & 3);
                const s16x4 alo = tr_read(Vs + rowb + 32 * dvb), ahi = tr_read(Vs + rowb + 4 * 144 + 32 * dvb);
                const bf16x8 af = __builtin_shufflevector(alo, ahi, 0, 1, 2, 3, 4, 5, 6, 7);
#pragma unroll
                for (int nb = 0; nb < 2; ++nb) {
                    const s16x4 blo = tr_read(Kw + rowb + 64 * dkh + 32 * nb), bhi = tr_read(Kw + rowb + 4 * 144 + 64 * dkh + 32 * nb);
                    const bf16x8 bfr = __builtin_shufflevector(blo, bhi, 0, 1, 2, 3, 4, 5, 6, 7);
                    acc[nb] = MFMA16(af, bfr, acc[nb]);
                    if (dvb == 0) accn[nb] = MFMA16(ones, bfr, accn[nb]); }
            }
            mcar = mnew;
        }
        __syncthreads();
#undef MSCAN_LOAD
    }
}
__device__ __forceinline__ void mlstm_out_phase(LAS unsigned char* lds, const bf16* __restrict__ P2, const bf16* __restrict__ QKc, const bf16* __restrict__ OP, const float* __restrict__ GA, const float* __restrict__ GB, const float* __restrict__ GP,
                                                const float* __restrict__ hgain, const bf16* __restrict__ Cst, const float* __restrict__ nst, const float* __restrict__ mst, bf16* __restrict__ MX, int G, int bid) {
    const int tid = threadIdx.x, lane = tid & 63, w = __builtin_amdgcn_readfirstlane(tid >> 6), r = lane & 31, h2 = lane >> 5;
    const int dvb = w & 3, tb = w >> 2;
    constexpr int O_Q = 0, O_K = 9216, O_V = 18432, O_C = 38912, O_VEC = 57344, O_GN = 58368, O_PART = 58880, SETB = 59904;
    u32x4 pq, pk, pv0, pv1, pc0, pc1; float pvec = 0.f, pgn = 0.f, pmc = 0.f; u32x2 popv[4];
    pq = (u32x4){0u, 0u, 0u, 0u}; pk = pq; pv0 = pq; pv1 = pq; pc0 = pq; pc1 = pq;
#pragma unroll
    for (int gq = 0; gq < 4; ++gq) popv[gq] = (u32x2){0u, 0u};
#define OUT_LOAD(it) do { const int c_ = (it) & 31, h_ = ((it) >> 5) & 7, b_ = (it) >> 8; const size_t t0_ = (size_t)b_ * SEQ + 64 * c_; const size_t gb_ = (size_t)(b_ * 8 + h_) * SEQ + 64 * c_; \
        { const bf16* p_ = QKc + (t0_ + (tid >> 3)) * 1024 + h_ * 64 + 8 * (tid & 7); pq = *(const u32x4*)p_; pk = *(const u32x4*)(p_ + 512); } \
        { const bf16* p_ = P2 + (t0_ + (tid >> 4)) * 2048 + 1024 + h_ * 128 + 8 * (tid & 15); pv0 = *(const u32x4*)p_; pv1 = *(const u32x4*)(p_ + (size_t)32 * 2048); } \
        { const bf16* p_ = Cst + ((size_t)(it) * 128 + (tid >> 3)) * 64 + 8 * (tid & 7); pc0 = *(const u32x4*)p_; pc1 = *(const u32x4*)(p_ + 64 * 64); } \
        { const int wh_ = tid >> 6, ix_ = tid & 63; const float* src_ = (wh_ == 0) ? (GA + gb_) : (wh_ == 1) ? (GB + gb_) : (wh_ == 2) ? (GP + gb_) : (wh_ == 3) ? (nst + (size_t)(it) * 64) : (hgain + h_ * 128 + ((wh_ & 1) << 6)); pvec = src_[ix_]; } \
        pmc = mst[(it)]; \
        { const size_t orow_ = (t0_ + 32 * tb + r) * 1024 + h_ * 128 + 32 * dvb + 4 * h2; _Pragma("unroll") for (int gq = 0; gq < 4; ++gq) popv[gq] = *(const u32x2*)(OP + orow_ + 8 * gq); } } while (0)
    { const int fit = (bid < 4096) ? bid : 0; OUT_LOAD(fit); }
    int par = 0;
    for (int item = bid; item < 4096; item += G, par ^= 1) {
        const int c = item & 31, h = (item >> 5) & 7, b = item >> 8;
        const size_t t0 = (size_t)b * SEQ + 64 * c;
        LAS unsigned char* L = lds + par * SETB;
        LAS float* vec = (LAS float*)(L + O_VEC); LAS float* gnl = (LAS float*)(L + O_GN); LAS float* part = (LAS float*)(L + O_PART);
        *(LAS u32x4*)(L + O_Q + (tid >> 3) * 144 + (tid & 7) * 16) = pq; *(LAS u32x4*)(L + O_K + (tid >> 3) * 144 + (tid & 7) * 16) = pk;
        *(LAS u32x4*)(L + O_V + (tid >> 4) * 320 + (tid & 15) * 16) = pv0; *(LAS u32x4*)(L + O_V + (32 + (tid >> 4)) * 320 + (tid & 15) * 16) = pv1;
        *(LAS u32x4*)(L + O_C + (tid >> 3) * 144 + (tid & 7) * 16) = pc0; *(LAS u32x4*)(L + O_C + (64 + (tid >> 3)) * 144 + (tid & 7) * 16) = pc1;
        if (tid < 384) vec[tid] = pvec;
        const float mc = pmc; u32x2 opv[4];
#pragma unroll
        for (int gq = 0; gq < 4; ++gq) opv[gq] = popv[gq];
        __syncthreads();
        { const int nit = (item + G < 4096) ? item + G : item; OUT_LOAD(nit); }
        const int t = 32 * tb + r;
        const float Mt = fmaxf(mc, vec[128 + t]), bt = vec[64 + t];
        bf16x8 qf[4];
#pragma unroll
        for (int st = 0; st < 4; ++st) qf[st] = *(const LAS bf16x8*)(L + O_Q + t * 144 + (16 * st + 8 * h2) * 2);
        float qn = 0.f;
#pragma unroll
        for (int st = 0; st < 4; ++st) { const u32x4 qq = __builtin_bit_cast(u32x4, qf[st]); const f32x4 n0 = *(const LAS f32x4*)(vec + 192 + 16 * st + 8 * h2), n1 = *(const LAS f32x4*)(vec + 192 + 16 * st + 8 * h2 + 4);
#pragma unroll
            for (int e = 0; e < 2; ++e) { qn += bf_lo(qq[e]) * n0[2 * e] + bf_hi(qq[e]) * n0[2 * e + 1]; qn += bf_lo(qq[2 + e]) * n1[2 * e] + bf_hi(qq[2 + e]) * n1[2 * e + 1]; } }
        qn += __shfl_xor(qn, 32);
        f32x16 acc1, acc2;
#pragma unroll
        for (int i = 0; i < 16; ++i) { acc1[i] = 0.f; acc2[i] = 0.f; }
        float dsum = 0.f;
#pragma unroll
        for (int sb = 0; sb < 2; ++sb) {
            if (sb <= tb) {
                f32x16 S;
#pragma unroll
                for (int i = 0; i < 16; ++i) S[i] = 0.f;
#pragma unroll
                for (int st = 0; st < 4; ++st) { const bf16x8 kf = *(const LAS bf16x8*)(L + O_K + (32 * sb + r) * 144 + (16 * st + 8 * h2) * 2); S = MFMA32(kf, qf[st], S); }
#pragma unroll
                for (int gq = 0; gq < 4; ++gq) { const f32x4 a4 = *(const LAS f32x4*)(vec + 32 * sb + 8 * gq + 4 * h2);
#pragma unroll
                    for (int k = 0; k < 4; ++k) { const int i = 4 * gq + k, s = 32 * sb + 8 * gq + 4 * h2 + k; const float ev = __builtin_amdgcn_exp2f(fminf(a4[k] - Mt, 0.f) * 1.4426950408889634f);
                        const float wgt = (s <= t) ? ev : 0.f; S[i] = wgt * S[i]; dsum += S[i]; } }
#pragma unroll
                for (int sp = 0; sp < 2; ++sp) {
                    u32x4 wv; wv.x = pk2(S[8 * sp + 0], S[8 * sp + 1]); wv.y = pk2(S[8 * sp + 2], S[8 * sp + 3]); wv.z = pk2(S[8 * sp + 4], S[8 * sp + 5]); wv.w = pk2(S[8 * sp + 6], S[8 * sp + 7]);
                    const bf16x8 pfr = __builtin_bit_cast(bf16x8, wv);
                    const LAS unsigned char* vp = L + O_V + (32 * sb + 16 * sp + 4 * h2 + ((lane & 15) >> 2)) * 320 + (32 * dvb + 16 * ((lane >> 4) & 1) + 4 * (lane & 3)) * 2;
                    const s16x4 lo = tr_read(vp), hi = tr_read(vp + 8 * 320);
                    const bf16x8 af = __builtin_shufflevector(lo, hi, 0, 1, 2, 3, 4, 5, 6, 7);
                    acc1 = MFMA32(af, pfr, acc1);
                }
            }
        }
        dsum += __shfl_xor(dsum, 32);
#pragma unroll
        for (int st = 0; st < 4; ++st) { const bf16x8 cf = *(const LAS bf16x8*)(L + O_C + (32 * dvb + r) * 144 + (16 * st + 8 * h2) * 2); acc2 = MFMA32(cf, qf[st], acc2); }
        const float winter = __expf(mc - Mt);
        const float den = dsum + winter * qn;
        const float dnm = fmaxf(fabsf(den), __expf(-(bt + Mt)));
        const float idn = __builtin_amdgcn_rcpf(dnm);
        float hsq = 0.f;
#pragma unroll
        for (int i = 0; i < 16; ++i) { acc1[i] = (acc1[i] + winter * acc2[i]) * idn; hsq += acc1[i] * acc1[i]; }
        hsq += __shfl_xor(hsq, 32);
        if (h2 == 0) part[dvb * 64 + t] = hsq;
        __syncthreads();
        const float tot = (part[t] + part[64 + t]) + (part[128 + t] + part[192 + t]);
        const float rsn = __builtin_amdgcn_rsqf(tot * (1.0f / 128.0f) + RMS_EPS);
        const size_t orow = (t0 + t) * 1024 + h * 128 + 32 * dvb + 4 * h2;
#pragma unroll
        for (int gq = 0; gq < 4; ++gq) {
            const u32x2 op = opv[gq]; const f32x4 gn = *(const LAS f32x4*)(gnl + 32 * dvb + 4 * h2 + 8 * gq);
            const float y0 = acc1[4 * gq + 0] * rsn * gn[0] * sigmoid_f(bf_lo(op.x)), y1 = acc1[4 * gq + 1] * rsn * gn[1] * sigmoid_f(bf_hi(op.x));
            const float y2 = acc1[4 * gq + 2] * rsn * gn[2] * sigmoid_f(bf_lo(op.y)), y3 = acc1[4 * gq + 3] * rsn * gn[3] * sigmoid_f(bf_hi(op.y));
            u32x2 wv; wv.x = pk2(y0, y1); wv.y = pk2(y2, y3); *(u32x2*)(MX + orow + 8 * gq) = wv;
        }
    }
    __syncthreads();
#undef OUT_LOAD
}
__device__ __forceinline__ void final_phase(float* __restrict__ out, const bf16* __restrict__ hbv, const float* __restrict__ ss, const float* __restrict__ gain, int G, int bid) {
    const int gt = bid * 512 + threadIdx.x, NGT = G * 512;
    for (int i = gt; i < T_TOK * 128; i += NGT) { const int t = i >> 7, c8 = i & 127; const float rs = rs_from_ss(ss[t]);
        const u32x4 hv = __builtin_nontemporal_load((const u32x4*)(hbv + (size_t)t * 1024 + 8 * c8)); const f32x4 g0 = *(const f32x4*)(gain + 8 * c8), g1 = *(const f32x4*)(gain + 8 * c8 + 4);
        f32x4 o0, o1; o0[0] = bf_lo(hv[0]); o0[1] = bf_hi(hv[0]); o0[2] = bf_lo(hv[1]); o0[3] = bf_hi(hv[1]); o1[0] = bf_lo(hv[2]); o1[1] = bf_hi(hv[2]); o1[2] = bf_lo(hv[3]); o1[3] = bf_hi(hv[3]);
        o0 = o0 * rs * g0; o1 = o1 * rs * g1;
        *(f32x4*)(out + (size_t)t * 1024 + 8 * c8) = o0; *(f32x4*)(out + (size_t)t * 1024 + 8 * c8 + 4) = o1; }
}
__global__ void __launch_bounds__(NWAVES * 64, 2) mega_fwd(Args A) {
    extern __shared__ __attribute__((aligned(16))) unsigned char lds_raw[];
    LAS unsigned char* lds = (LAS unsigned char*)lds_raw;
    cg::grid_group grid = cg::this_grid();
    const int G = gridDim.x, bid = blockIdx.x;
    unsigned char* ws = A.ws;
    float* ss = (float*)(ws + WS_SS);
    bf16* hb = (bf16*)(ws + WS_HB); bf16* MX = (bf16*)(ws + WS_MX);
    bf16* QKVh = (bf16*)(ws + WS_BIG); bf16* R = (bf16*)(ws + WS_H);        bf16* ACT = (bf16*)(ws + WS_ACT); bf16* P2 = (bf16*)(ws + WS_ACT);
    bf16* Oh = (bf16*)A.out; bf16* Cst = (bf16*)A.out; bf16* OP = (bf16*)A.out + (size_t)32 * 1024 * 1024;
    float* lse = (float*)(ws + WS_LSE); float* gates = (float*)(ws + WS_GATES); float* rope = (float*)(ws + WS_ROPE);
    float* mst = (float*)(ws + WS_MST); float* nst = (float*)(ws + WS_NST);
    bf16* QKc = hb;
    float* GA = (float*)(ws + 460 * MiB); float* GB = GA + (size_t)T_TOK * 8; float* GP = GB + (size_t)T_TOK * 8; float* CH = GP + (size_t)T_TOK * 8;
    const int lo = A.ph_lo, hi = A.ph_hi;
    volatile LAS unsigned* MISC = (volatile LAS unsigned*)(lds + LDS_BYTES - 256);
    if (threadIdx.x < 16) MISC[threadIdx.x] = 0u;
    __syncthreads();
    const XcdBarrier bar = xcd_barrier_post((unsigned*)(ws + WS_BAR), MISC + 8);
#ifndef PROBE_MASK
#define PROBE_MASK 0u
#endif
#define PROBE_K 4ull
    unsigned long long pr_sum = 0ull, pr_t0 = 0ull, pr_s0 = 0ull;
#define PB(k) do { if (PROBE_MASK & (1u << (k))) pr_t0 = __builtin_amdgcn_s_memrealtime(); } while (0)
#define PE(k) do { if (PROBE_MASK & (1u << (k))) pr_sum += __builtin_amdgcn_s_memrealtime() - pr_t0; } while (0)
#define IN(k) (lo <= (k) && (k) < hi)
#define SYNC(k) do { if (IN(k) && IN((k) + 1)) { if (PROBE_MASK & (1u << 30)) pr_s0 = __builtin_amdgcn_s_memrealtime(); if (hi < 0) { __threadfence(); grid.sync(); __threadfence(); } else xcd_barrier(bar); if (PROBE_MASK & (1u << 30)) pr_sum += __builtin_amdgcn_s_memrealtime() - pr_s0; if (PROBE_MASK & (1u << 29)) { pr_s0 = __builtin_amdgcn_s_memrealtime(); xcd_barrier(bar); pr_sum += __builtin_amdgcn_s_memrealtime() - pr_s0; } } PE(k); } while (0)
    PB(0); if (IN(0)) p0_prologue(A, lds, G, bid);
    SYNC(0);
    PB(1); if (IN(1)) { pg8::Gemm g{hb, (const bf16*)(ws + WS_WQKV), THALF, 9216, 1024}; pg8::StaticOrder S; S.init(THALF, 9216, G, bid);
        pg8::EpiQKV E{QKVh, ss, rope}; pg8::gemm_phase<pg8::EpiQKV, pg8::StaticOrder, true, true>(lds, g, S, E); }
    SYNC(1);
    PB(2); if (IN(2)) attn_phase(lds, QKVh, Oh, lse, 0, G, bid);
    SYNC(2);
    PB(3); if (IN(3)) { merge_phase(Oh, lse, MX, 0, G, bid);
        pg8::Gemm g{hb + (size_t)THALF * 1024, (const bf16*)(ws + WS_WQKV), THALF, 9216, 1024}; pg8::StaticOrder S; S.init(THALF, 9216, G, bid);
        pg8::EpiQKV E{QKVh, ss + THALF, rope + (size_t)THALF * 32}; pg8::gemm_phase<pg8::EpiQKV, pg8::StaticOrder, true, true>(lds, g, S, E); }
    SYNC(3);
    PB(4); if (IN(4)) attn_phase(lds, QKVh, Oh, lse, 1, G, bid);
    SYNC(4);
    PB(5); if (IN(5)) merge_phase(Oh, lse, MX, 1, G, bid);
    SYNC(5);
    PB(6); if (IN(6)) { pg8::Gemm g{MX, (const bf16*)(ws + WS_WAO), T_TOK, 1024, 1024}; pg8::StaticOrder S; S.init(T_TOK, 1024, G, bid);
        pg8::EpiResidT<false> E{hb, R, ss + T_TOK}; pg8::gemm_phase<pg8::EpiResidT<false>, pg8::StaticOrder, true, true>(lds, g, S, E); }
    SYNC(6);
    PB(7); if (IN(7)) { pg8::Gemm g{R, (const bf16*)(ws + WS_WFFIN), T_TOK, 5632, 1024}; pg8::StaticOrder S; S.init(T_TOK, 5632, G, bid);
        pg8::EpiSwiGLU E{ACT, ss + T_TOK}; pg8::gemm_phase<pg8::EpiSwiGLU, pg8::StaticOrder, true, true>(lds, g, S, E); }
    SYNC(7);
    PB(8); if (IN(8)) { pg8::Gemm g{ACT, (const bf16*)(ws + WS_WFFOUT), T_TOK, 1024, DFF}; pg8::StaticOrder S; S.init(T_TOK, 1024, G, bid);
        pg8::EpiResidT<false> E{R, R, ss + 2 * T_TOK}; pg8::gemm_phase<pg8::EpiResidT<false>, pg8::StaticOrder, true, true>(lds, g, S, E); }
    SYNC(8);
    PB(9); if (IN(9)) { pg8::Gemm g{R, (const bf16*)(ws + WS_WMIN), T_TOK, 3328, 1024}; pg8::StaticOrder S; S.init(T_TOK, 3328, G, bid);
        pg8::EpiMlstmIn E{P2, OP, gates, ss + 2 * T_TOK}; pg8::gemm_phase<pg8::EpiMlstmIn, pg8::StaticOrder, true, true>(lds, g, S, E); }
    SYNC(9);
    PB(10); if (IN(10)) { mlstm_pre_phase(P2, gates, A.conv_w, A.conv_b, A.ig_bias, A.fg_bias, QKc, GA, GB, GP, CH, G, bid); xcd_barrier(bar);
        mlstm_scan_phase(lds, P2, QKc, GA, CH, Cst, nst, mst, G, bid); }
    SYNC(10);
    PB(11); if (IN(11)) mlstm_out_phase(lds, P2, QKc, OP, GA, GB, GP, A.head_gain, Cst, nst, mst, MX, G, bid);
    SYNC(11);
    PB(12); if (IN(12)) { pg8::Gemm g{MX, (const bf16*)(ws + WS_WMOUT), T_TOK, 1024, 1024}; pg8::StaticOrder S; S.init(T_TOK, 1024, G, bid);
        pg8::EpiResidT<false> E{R, R, ss + 3 * T_TOK}; pg8::gemm_phase<pg8::EpiResidT<false>, pg8::StaticOrder, true, true>(lds, g, S, E); }
    SYNC(12);
    PB(13); if (IN(13)) { pg8::Gemm g{R, (const bf16*)(ws + WS_WFFIN) + (size_t)5632 * 1024, T_TOK, 5632, 1024}; pg8::StaticOrder S; S.init(T_TOK, 5632, G, bid);
        pg8::EpiSwiGLU E{ACT, ss + 3 * T_TOK}; pg8::gemm_phase<pg8::EpiSwiGLU, pg8::StaticOrder, true, true>(lds, g, S, E); }
    SYNC(13);
    PB(14); if (IN(14)) { pg8::Gemm g{ACT, (const bf16*)(ws + WS_WFFOUT) + (size_t)1024 * DFF, T_TOK, 1024, DFF}; pg8::StaticOrder S; S.init(T_TOK, 1024, G, bid);
        pg8::EpiResidT<false> E{R, R, ss + 4 * T_TOK}; pg8::gemm_phase<pg8::EpiResidT<false>, pg8::StaticOrder, true, true>(lds, g, S, E); }
    SYNC(14);
    PB(15); if (IN(15)) final_phase(A.out, R, ss + 4 * T_TOK, A.final_norm, G, bid);
    PE(15);
    if (PROBE_MASK != 0u && bid == 0 && threadIdx.x == 0) { const unsigned long long te = __builtin_amdgcn_s_memrealtime(); while (__builtin_amdgcn_s_memrealtime() - te < PROBE_K * pr_sum) __builtin_amdgcn_s_sleep(8); }
#undef IN
#undef SYNC
}

extern "C" void kernel_launch(void* const* d_in, const int* in_sizes, int n_in, void* d_out, int out_size, void* d_ws, size_t ws_size, hipStream_t stream) {
    static int grid = 0;
    if (grid == 0) {
        if (n_in != 17 || in_sizes[0] != T_TOK * DM || out_size != T_TOK * DM || ws_size < WS_END) { fprintf(stderr, "kernel_launch: unexpected shapes (n_in %d, in0 %d, out %d, ws %zu); nothing launched\n", n_in, n_in > 0 ? in_sizes[0] : -1, out_size, ws_size); grid = -1; return; }
        int dev = 0, cus = 0, per_cu = 0;
        if (hipGetDevice(&dev) != hipSuccess || hipDeviceGetAttribute(&cus, hipDeviceAttributeMultiprocessorCount, dev) != hipSuccess) { grid = -1; return; }
        if (hipFuncSetAttribute((const void*)mega_fwd, hipFuncAttributeMaxDynamicSharedMemorySize, LDS_BYTES) != hipSuccess) { fprintf(stderr, "kernel_launch: hipFuncSetAttribute failed\n"); grid = -1; return; }
        if (hipOccupancyMaxActiveBlocksPerMultiprocessor(&per_cu, (const void*)mega_fwd, NWAVES * 64, LDS_BYTES) != hipSuccess || per_cu < 1) { fprintf(stderr, "kernel_launch: occupancy query says %d\n", per_cu); per_cu = 1; }
        (void)hipGetLastError();
        grid = cus;
    }
    if (grid < 0) return;
    Args a{};
    a.x = (const float*)d_in[0]; a.pos = (const int*)d_in[1]; a.attn_norm = (const float*)d_in[2]; a.attn_w_in = (const float*)d_in[3]; a.attn_w_out = (const float*)d_in[4];
    a.mlstm_norm = (const float*)d_in[5]; a.mlstm_w_in = (const float*)d_in[6]; a.conv_w = (const float*)d_in[7]; a.conv_b = (const float*)d_in[8]; a.ig_bias = (const float*)d_in[9];
    a.fg_bias = (const float*)d_in[10]; a.head_gain = (const float*)d_in[11]; a.mlstm_w_out = (const float*)d_in[12]; a.ffn_norm = (const float*)d_in[13]; a.ffn_w_in = (const float*)d_in[14];
    a.ffn_w_out = (const float*)d_in[15]; a.final_norm = (const float*)d_in[16];
    a.out = (float*)d_out; a.ws = (unsigned char*)d_ws; a.ph_lo = 0; a.ph_hi = 16;
    if (hipMemsetAsync((char*)d_ws + WS_BAR, 0, 16384, stream) != hipSuccess) { fprintf(stderr, "kernel_launch: hipMemsetAsync failed\n"); return; }
    void* args[] = {&a};
    const hipError_t e = hipLaunchCooperativeKernel((const void*)mega_fwd, dim3(grid), dim3(NWAVES * 64), args, LDS_BYTES, stream);
    if (e != hipSuccess) fprintf(stderr, "kernel_launch: cooperative launch failed: %s (grid %d)\n", hipGetErrorString(e), grid);
}
```

```cpp
#include <hip/hip_runtime.h>
#include <hip/hip_cooperative_groups.h>
#include <cstdio>
#include <cstdint>
namespace cg = cooperative_groups;

constexpr float RMS_EPS = 1e-6f;
__device__ __forceinline__ float rs_from_ss(float ss) { return __builtin_amdgcn_rsqf(ss * (1.0f / 1024.0f) + RMS_EPS); }
__device__ __forceinline__ float silu_f(float x) { return x * __builtin_amdgcn_rcpf(1.0f + __builtin_amdgcn_exp2f(x * -1.4426950408889634f)); }
__device__ __forceinline__ float sigmoid_f(float x) { return __builtin_amdgcn_rcpf(1.0f + __builtin_amdgcn_exp2f(x * -1.4426950408889634f)); }

namespace pg8 {
#define PG8_LAS __attribute__((address_space(3)))
typedef unsigned short bf16_t;
typedef short bf16x8 __attribute__((ext_vector_type(8)));
typedef float f32x4 __attribute__((ext_vector_type(4)));
typedef unsigned u32x4 __attribute__((ext_vector_type(4)));
constexpr int BM = 256, BK = 64, HALF = 128, HTB = HALF * BK * 2  , STAGE_BYTES = 8 * HTB, NXCD = 8, WGM = 8;

__host__ __device__ __forceinline__ int lds_byte(int r, int c) { const int st = (r >> 4) * 2 + (c >> 5), rr = r & 15, cc = c & 31, ob = rr * 64 + cc * 2; return st * 1024 + (ob ^ (((ob >> 9) & 1) << 5)); }
__host__ __device__ __forceinline__ void stage_rc(int b, int& R, int& C) { const int st = b / 1024, sb = b % 1024, swz = sb ^ (((sb >> 9) & 1) << 5); R = (st >> 1) * 16 + swz / 64; C = (st & 1) * 32 + (swz % 64) / 2; }
__host__ __device__ __forceinline__ int perm32(int rho) { const int n = rho >> 4, i = rho & 15; return 8 * (i >> 2) + 4 * n + (i & 3); }

typedef unsigned u32x2 __attribute__((ext_vector_type(2)));
struct Unit { int pm, pn; };
struct Gemm { const bf16_t* A; const bf16_t* Bt; int M, N, K; };

struct StaticOrder {
    int nM, nN, nwg, G, c;
    __host__ __device__ void init(int M, int N, int G_, int c_) { nM = M / BM; nN = N / BM; nwg = nM * nN; G = G_; c = c_; }
    __host__ __device__ bool next(int i, Unit& u) const {
        const long L = (long)i * G + c; if (L >= nwg) return false;
        int wgid = (int)L; { const int q = nwg / NXCD, r = nwg % NXCD, xcd = wgid % NXCD, off = wgid / NXCD; wgid = (xcd < r ? xcd * (q + 1) : r * (q + 1) + (xcd - r) * q) + off; }
        const int nig = WGM * nN, gid = wgid / nig, fm = gid * WGM, gsz = (nM - fm) < WGM ? (nM - fm) : WGM;
        u.pm = fm + ((wgid % nig) % gsz); u.pn = (wgid % nig) / gsz; return true;
    }
    __device__ __forceinline__ void a_ready(const Unit&) const {}
    __device__ __forceinline__ void done(const Unit&) const {}
};
__device__ __forceinline__ unsigned cvt_pk_bf16(float lo, float hi) { unsigned r; asm volatile("v_cvt_pk_bf16_f32 %0, %1, %2" : "=v"(r) : "v"(lo), "v"(hi)); return r; }

#define EPI_FENCE() asm volatile("" ::: "memory")
struct EpiQKV {
    static constexpr bool PERM = true, AFTER_DRAIN = false;
    bf16_t* O; const float* ss; const float* cs;
    __device__ __forceinline__ void operator()(const f32x4 (&acc)[2][2][4][2], const Unit& u, int wr, int wc, int fr, int fq) const {
        const int row0 = u.pm * BM + wr * 64 + fr; const int colt = u.pn * BM;
        const int tsel = (colt % 3072) / 1024;
        const bool rope = (tsel < 2) && (wc == 0);
        const int gsel = colt / 3072, lg = 2 * gsel, dil = 1 << lg;
        const int hb0 = (gsel * 3 + tsel) * 8 + (colt % 1024) / 128;
        float rsv[8];
#pragma unroll
        for (int k = 0; k < 8; ++k) rsv[k] = ss[row0 + (k >> 2) * HALF + (k & 3) * 16];
        f32x4 cA = {0.f, 0.f, 0.f, 0.f}, sA = cA;
        if (rope) { const float* p = cs + (size_t)row0 * 32 + 4 * fq; cA = *(const f32x4*)p; sA = *(const f32x4*)(p + 16); }
#pragma unroll
        for (int k = 0; k < 8; ++k) {
            const int ai = k >> 2, m = k & 3;
            const int row = row0 + ai * HALF + m * 16;
            f32x4 cN = cA, sN = sA;
            if (rope && k + 1 < 8) { const int rown = row0 + ((k + 1) >> 2) * HALF + ((k + 1) & 3) * 16; const float* p = cs + (size_t)rown * 32 + 4 * fq; cN = *(const f32x4*)p; sN = *(const f32x4*)(p + 16); }
            EPI_FENCE();
            const float rs = rs_from_ss(rsv[k]);
            const int sq = row & 2047, perm = ((sq & (dil - 1)) << (11 - lg)) + (sq >> lg);
            bf16_t* rowp = O + ((size_t)hb0 * 17408 + (row >> 11) * 2176 + perm) * 128;
            if (rope) {
                const f32x4 cr = cA * rs, sr = sA * rs;
#pragma unroll
                for (int bj = 0; bj < 2; ++bj) {
                    const f32x4 v0 = acc[ai][bj][m][0], v1 = acc[ai][bj][m][1];
                    const f32x4 o0 = v0 * cr - v1 * sr, o1 = v1 * cr + v0 * sr;
                    u32x2 w0, w1; w0.x = cvt_pk_bf16(o0[0], o0[1]); w0.y = cvt_pk_bf16(o0[2], o0[3]); w1.x = cvt_pk_bf16(o1[0], o1[1]); w1.y = cvt_pk_bf16(o1[2], o1[3]);
                    bf16_t* hp = rowp + (size_t)bj * 17408 * 128 + 4 * fq;
                    *(u32x2*)hp = w0; *(u32x2*)(hp + 16) = w1;
                }
            } else {
#pragma unroll
                for (int bj = 0; bj < 2; ++bj) {
                    const f32x4 v0 = acc[ai][bj][m][0] * rs, v1 = acc[ai][bj][m][1] * rs;
                    u32x4 wv; wv.x = cvt_pk_bf16(v0[0], v0[1]); wv.y = cvt_pk_bf16(v0[2], v0[3]); wv.z = cvt_pk_bf16(v1[0], v1[1]); wv.w = cvt_pk_bf16(v1[2], v1[3]);
                    *(u32x4*)(rowp + (size_t)bj * 17408 * 128 + wc * 32 + 8 * fq) = wv;
                }
            }
            cA = cN; sA = sN;
        }
    }
};
template <bool F32B> struct EpiResidT {
    static constexpr bool PERM = true, AFTER_DRAIN = false;
    const void* base; bf16_t* outb; float* ssn;
    __device__ __forceinline__ void operator()(const f32x4 (&acc)[2][2][4][2], const Unit& u, int wr, int wc, int fr, int fq) const {
        const int row0 = u.pm * BM + wr * 64 + fr; const int col0 = u.pn * BM + wc * 32 + 8 * fq;
        f32x4 fA[4]; u32x4 hA[2];
#pragma unroll
        for (int q = 0; q < 4; ++q) fA[q] = (f32x4){0.f, 0.f, 0.f, 0.f};
        hA[0] = (u32x4){0u, 0u, 0u, 0u}; hA[1] = hA[0];
        if constexpr (F32B) { const float* p = (const float*)base + (size_t)row0 * 1024 + col0; fA[0] = __builtin_nontemporal_load((const f32x4*)p); fA[1] = __builtin_nontemporal_load((const f32x4*)(p + 4)); fA[2] = __builtin_nontemporal_load((const f32x4*)(p + HALF)); fA[3] = __builtin_nontemporal_load((const f32x4*)(p + HALF + 4)); }
        else { const bf16_t* p = (const bf16_t*)base + (size_t)row0 * 1024 + col0; hA[0] = *(const u32x4*)p; hA[1] = *(const u32x4*)(p + HALF); }
#pragma unroll
        for (int k = 0; k < 8; ++k) {
            const int ai = k >> 2, m = k & 3;
            const int row = row0 + ai * HALF + m * 16;
            f32x4 fN[4]; u32x4 hN[2];
#pragma unroll
            for (int q = 0; q < 4; ++q) fN[q] = fA[q];
            hN[0] = hA[0]; hN[1] = hA[1];
            if (k + 1 < 8) { const int rown = row0 + ((k + 1) >> 2) * HALF + ((k + 1) & 3) * 16;
                if constexpr (F32B) { const float* p = (const float*)base + (size_t)rown * 1024 + col0; fN[0] = __builtin_nontemporal_load((const f32x4*)p); fN[1] = __builtin_nontemporal_load((const f32x4*)(p + 4)); fN[2] = __builtin_nontemporal_load((const f32x4*)(p + HALF)); fN[3] = __builtin_nontemporal_load((const f32x4*)(p + HALF + 4)); }
                else { const bf16_t* p = (const bf16_t*)base + (size_t)rown * 1024 + col0; hN[0] = *(const u32x4*)p; hN[1] = *(const u32x4*)(p + HALF); } }
            EPI_FENCE();
            float sq = 0.f;
#pragma unroll
            for (int bj = 0; bj < 2; ++bj) {
                const size_t off = (size_t)row * 1024 + col0 + bj * HALF;
                f32x4 b0, b1;
                if constexpr (F32B) { b0 = fA[2 * bj]; b1 = fA[2 * bj + 1]; }
                else { const u32x4 hv = hA[bj]; b0[0] = __uint_as_float(hv[0] << 16); b0[1] = __uint_as_float(hv[0] & 0xffff0000u); b0[2] = __uint_as_float(hv[1] << 16); b0[3] = __uint_as_float(hv[1] & 0xffff0000u);
                    b1[0] = __uint_as_float(hv[2] << 16); b1[1] = __uint_as_float(hv[2] & 0xffff0000u); b1[2] = __uint_as_float(hv[3] << 16); b1[3] = __uint_as_float(hv[3] & 0xffff0000u); }
                const f32x4 v0 = acc[ai][bj][m][0] + b0, v1 = acc[ai][bj][m][1] + b1;
                u32x4 wv; wv.x = cvt_pk_bf16(v0[0], v0[1]); wv.y = cvt_pk_bf16(v0[2], v0[3]); wv.z = cvt_pk_bf16(v1[0], v1[1]); wv.w = cvt_pk_bf16(v1[2], v1[3]); *(u32x4*)(outb + off) = wv;
                sq += (v0[0] * v0[0] + v0[1] * v0[1]) + (v0[2] * v0[2] + v0[3] * v0[3]) + (v1[0] * v1[0] + v1[1] * v1[1]) + (v1[2] * v1[2] + v1[3] * v1[3]);
            }
            sq += __shfl_xor(sq, 16); sq += __shfl_xor(sq, 32);
            if (fq == 0) atomicAdd(ssn + row, sq);
#pragma unroll
            for (int q = 0; q < 4; ++q) fA[q] = fN[q];
            hA[0] = hN[0]; hA[1] = hN[1];
        }
    }
};
struct EpiFinal {
    static constexpr bool PERM = true, AFTER_DRAIN = false;
    const bf16_t* base; float* out; float* ssn; const float* gain; unsigned* cnt;
    __device__ __forceinline__ void unpack(const u32x4 hv, f32x4& b0, f32x4& b1) const {
        b0[0] = __uint_as_float(hv[0] << 16); b0[1] = __uint_as_float(hv[0] & 0xffff0000u); b0[2] = __uint_as_float(hv[1] << 16); b0[3] = __uint_as_float(hv[1] & 0xffff0000u);
        b1[0] = __uint_as_float(hv[2] << 16); b1[1] = __uint_as_float(hv[2] & 0xffff0000u); b1[2] = __uint_as_float(hv[3] << 16); b1[3] = __uint_as_float(hv[3] & 0xffff0000u); }
    __device__ __forceinline__ void operator()(const f32x4 (&acc)[2][2][4][2], const Unit& u, int wr, int wc, int fr, int fq) const {
        const int row0 = u.pm * BM + wr * 64 + fr; const int col0 = u.pn * BM + wc * 32 + 8 * fq;
        float sqv[8];
#pragma unroll
        for (int k = 0; k < 8; ++k) { const int ai = k >> 2, m = k & 3; const int row = row0 + ai * HALF + m * 16; float sq = 0.f;
#pragma unroll
            for (int bj = 0; bj < 2; ++bj) { f32x4 b0, b1; unpack(*(const u32x4*)(base + (size_t)row * 1024 + col0 + bj * HALF), b0, b1);
                const f32x4 v0 = acc[ai][bj][m][0] + b0, v1 = acc[ai][bj][m][1] + b1;
                sq += (v0[0] * v0[0] + v0[1] * v0[1]) + (v0[2] * v0[2] + v0[3] * v0[3]) + (v1[0] * v1[0] + v1[1] * v1[1]) + (v1[2] * v1[2] + v1[3] * v1[3]); }
            sqv[k] = sq; }
#pragma unroll
        for (int k = 0; k < 8; ++k) sqv[k] += __shfl_xor(sqv[k], 16);
#pragma unroll
        for (int k = 0; k < 8; ++k) sqv[k] += __shfl_xor(sqv[k], 32);
        if (fq == 0) {
#pragma unroll
            for (int k = 0; k < 8; ++k) atomicAdd(ssn + row0 + (k >> 2) * HALF + (k & 3) * 16, sqv[k]); }
        asm volatile("s_waitcnt vmcnt(0)" ::: "memory");
        __builtin_amdgcn_s_barrier();
        if (threadIdx.x == 0) {
            __builtin_amdgcn_fence(__ATOMIC_RELEASE, "agent");
            __hip_atomic_fetch_add(cnt + 64 * u.pm, 1u, __ATOMIC_RELAXED, __HIP_MEMORY_SCOPE_AGENT);
            unsigned sp = 0u;
            while (__hip_atomic_load(cnt + 64 * u.pm, __ATOMIC_RELAXED, __HIP_MEMORY_SCOPE_AGENT) < 4u) { __builtin_amdgcn_s_sleep(1); if (++sp > (1u << 22)) break; }
            __builtin_amdgcn_fence(__ATOMIC_ACQUIRE, "agent");
        }
        asm volatile("s_waitcnt vmcnt(0) lgkmcnt(0)" ::: "memory");
        __builtin_amdgcn_s_barrier();
        asm volatile("" ::: "memory");
        f32x4 gn[2][2];
#pragma unroll
        for (int bj = 0; bj < 2; ++bj) { gn[bj][0] = *(const f32x4*)(gain + col0 + bj * HALF); gn[bj][1] = *(const f32x4*)(gain + col0 + bj * HALF + 4); }
#pragma unroll
        for (int k = 0; k < 8; ++k) { const int ai = k >> 2, m = k & 3; const int row = row0 + ai * HALF + m * 16;
            const float rs = rs_from_ss(__hip_atomic_load(ssn + row, __ATOMIC_RELAXED, __HIP_MEMORY_SCOPE_AGENT));
#pragma unroll
            for (int bj = 0; bj < 2; ++bj) { f32x4 b0, b1; unpack(*(const u32x4*)(base + (size_t)row * 1024 + col0 + bj * HALF), b0, b1);
                const f32x4 v0 = (acc[ai][bj][m][0] + b0) * rs * gn[bj][0], v1 = (acc[ai][bj][m][1] + b1) * rs * gn[bj][1];
                float* op = out + (size_t)row * 1024 + col0 + bj * HALF; *(f32x4*)op = v0; *(f32x4*)(op + 4) = v1; } }
    }
};
struct EpiSwiGLU {
    static constexpr bool PERM = true, AFTER_DRAIN = false;
    bf16_t* O; const float* ss;
    __device__ __forceinline__ void operator()(const f32x4 (&acc)[2][2][4][2], const Unit& u, int wr, int wc, int fr, int fq) const {
        const int row0 = u.pm * BM + wr * 64 + fr; const int col0 = u.pn * HALF + wc * 32 + 8 * fq;
        float rsv[8];
#pragma unroll
        for (int k = 0; k < 8; ++k) rsv[k] = ss[row0 + (k >> 2) * HALF + (k & 3) * 16];
        EPI_FENCE();
#pragma unroll
        for (int ai = 0; ai < 2; ++ai)
#pragma unroll
            for (int m = 0; m < 4; ++m) {
                const int row = row0 + ai * HALF + m * 16;
                const float rs = rs_from_ss(rsv[ai * 4 + m]); const float rs2 = rs * rs, nrs = rs * -1.4426950408889634f;
                float o[8];
#pragma unroll
                for (int n = 0; n < 2; ++n)
#pragma unroll
                    for (int e = 0; e < 4; ++e) { const float g = acc[ai][0][m][n][e], uu = acc[ai][1][m][n][e] * rs2;
                        o[4 * n + e] = (g * uu) * __builtin_amdgcn_rcpf(1.0f + __builtin_amdgcn_exp2f(g * nrs)); }
                u32x4 wv; wv.x = cvt_pk_bf16(o[0], o[1]); wv.y = cvt_pk_bf16(o[2], o[3]); wv.z = cvt_pk_bf16(o[4], o[5]); wv.w = cvt_pk_bf16(o[6], o[7]);
                *(u32x4*)(O + (size_t)row * 2816 + col0) = wv;
            }
    }
};
struct EpiMlstmIn {
    static constexpr bool PERM = true, AFTER_DRAIN = false;
    bf16_t* P2; bf16_t* OP; float* gates; const float* ss;
    __device__ __forceinline__ void operator()(const f32x4 (&acc)[2][2][4][2], const Unit& u, int wr, int wc, int fr, int fq) const {
        const int row0 = u.pm * BM + wr * 64 + fr;
        float rsv[8];
#pragma unroll
        for (int k = 0; k < 8; ++k) rsv[k] = ss[row0 + (k >> 2) * HALF + (k & 3) * 16];
        EPI_FENCE();
#pragma unroll
        for (int ai = 0; ai < 2; ++ai)
#pragma unroll
            for (int m = 0; m < 4; ++m) {
                const int row = row0 + ai * HALF + m * 16;
                const float rs = rs_from_ss(rsv[ai * 4 + m]);
#pragma unroll
                for (int bj = 0; bj < 2; ++bj) {
                    const int cb = u.pn * BM + bj * HALF;
                    const f32x4 v0 = acc[ai][bj][m][0] * rs, v1 = acc[ai][bj][m][1] * rs;
                    const int cc = wc * 32 + 8 * fq;
                    if (cb < 3072) {
                        u32x4 wv; wv.x = cvt_pk_bf16(v0[0], v0[1]); wv.y = cvt_pk_bf16(v0[2], v0[3]); wv.z = cvt_pk_bf16(v1[0], v1[1]); wv.w = cvt_pk_bf16(v1[2], v1[3]);
                        bf16_t* dst = (cb < 2048) ? (P2 + (size_t)row * 2048 + cb + cc) : (OP + (size_t)row * 1024 + (cb - 2048) + cc);
                        *(u32x4*)dst = wv;
                    } else if (cb == 3072 && cc < 16) {
                        float* dst = gates + (size_t)row * 16 + cc;
                        *(f32x4*)dst = v0; *(f32x4*)(dst + 4) = v1;
                    }
                }
            }
    }
};

template <class Epi, class Sched, bool ALIGN_EPI = false, bool SP2 = false>
__device__ __forceinline__ void gemm_phase(PG8_LAS unsigned char* lds, const Gemm g, const Sched& S, const Epi& E) {
    const int tid = threadIdx.x, wid = __builtin_amdgcn_readfirstlane(tid >> 6), lane = tid & 63, wr = wid >> 2, wc = wid & 3, fr = lane & 15, fq = lane >> 4;
    const int K = g.K, nt = K / BK;
    unsigned voffA[2], voffB[2];
#pragma unroll
    for (int i = 0; i < 2; ++i) { int R, C; stage_rc(tid * 16 + i * 8192, R, C); const int Rb = Epi::PERM ? ((R & ~31) + perm32(R & 31)) : R;
        voffA[i] = (unsigned)(R * K + C) * 2u; voffB[i] = (unsigned)(Rb * K + C) * 2u; }
    const size_t kstep = (size_t)(BK * 2);
    const size_t hstep = (size_t)HALF * K * 2;
    const size_t tstep = 2 * hstep;
    const unsigned ldsw = (unsigned)wid * 1024u;
    const int aoff = lds_byte(wr * 64 + fr, fq * 8), boff = lds_byte(wc * 32 + fr, fq * 8);
#define PG8_SA(b, h) (((b) * 2 + (h)) * HTB)
#define PG8_SB(b, h) ((4 + (b) * 2 + (h)) * HTB)
#define PG8_STAGE(bufoff, gbase, voff) do { _Pragma("unroll") for (int _i = 0; _i < 2; ++_i) \
        __builtin_amdgcn_global_load_lds((const unsigned*)((const char*)(gbase) + (voff)[_i]), (PG8_LAS unsigned*)(lds + (bufoff) + ldsw + _i * 8192), 16, 0, 0); } while (0)
#define PG8_LDA(dst, b, h) do { _Pragma("unroll") for (int m = 0; m < 4; ++m) _Pragma("unroll") for (int k = 0; k < 2; ++k) dst[m][k] = *(const PG8_LAS bf16x8*)(lds + PG8_SA(b, h) + aoff + m * 2048 + k * 1024); } while (0)
#define PG8_LDB(dst, b, h) do { _Pragma("unroll") for (int n = 0; n < 2; ++n) _Pragma("unroll") for (int k = 0; k < 2; ++k) dst[n][k] = *(const PG8_LAS bf16x8*)(lds + PG8_SB(b, h) + boff + n * 2048 + k * 1024); } while (0)
#define PG8_MMA(ai, bj, At, Bt) do { __builtin_amdgcn_s_setprio(1); _Pragma("unroll") for (int m = 0; m < 4; ++m) _Pragma("unroll") for (int n = 0; n < 2; ++n) _Pragma("unroll") for (int k = 0; k < 2; ++k) \
        acc[ai][bj][m][n] = __builtin_amdgcn_mfma_f32_16x16x32_bf16(Bt[n][k], At[m][k], acc[ai][bj][m][n], 0, 0, 0); __builtin_amdgcn_s_setprio(0); } while (0)
#define PG8_WAIT_V(n) asm volatile("s_waitcnt vmcnt(" #n ")" ::: "memory")
#define PG8_WAIT_L(n) asm volatile("s_waitcnt lgkmcnt(" #n ")" ::: "memory")
#define PG8_BAR __builtin_amdgcn_s_barrier()
#define PG8_SCHED __builtin_amdgcn_sched_barrier(0)
    Unit cur, nxt; int ui = 0;
    if (!S.next(0, cur)) return;
    f32x4 acc[2][2][4][2];
#pragma unroll
    for (int a = 0; a < 2; ++a)
#pragma unroll
        for (int b = 0; b < 2; ++b)
#pragma unroll
            for (int m = 0; m < 4; ++m)
#pragma unroll
                for (int n = 0; n < 2; ++n) acc[a][b][m][n] = (f32x4){0.f, 0.f, 0.f, 0.f};
    bf16x8 At[4][2], B0[2][2], B1[2][2];
    const char* cA = (const char*)g.A + (size_t)cur.pm * tstep; const char* cB = (const char*)g.Bt + (size_t)cur.pn * tstep;
    S.a_ready(cur);
    if constexpr (SP2) {
        PG8_STAGE(PG8_SB(0, 0), cB, voffB); PG8_STAGE(PG8_SB(0, 1), cB + hstep, voffB); PG8_STAGE(PG8_SA(0, 0), cA, voffA); PG8_STAGE(PG8_SA(0, 1), cA + hstep, voffA);
        if (wr == 1) PG8_BAR;
        PG8_WAIT_V(2); PG8_BAR;
        PG8_STAGE(PG8_SB(1, 0), cB + kstep, voffB); PG8_STAGE(PG8_SA(1, 0), cA + kstep, voffA); PG8_STAGE(PG8_SB(1, 1), cB + hstep + kstep, voffB);
        PG8_WAIT_V(6); PG8_BAR;
    } else {
        PG8_STAGE(PG8_SB(0, 0), cB, voffB); PG8_STAGE(PG8_SA(0, 0), cA, voffA); PG8_STAGE(PG8_SB(0, 1), cB + hstep, voffB); PG8_STAGE(PG8_SA(0, 1), cA + hstep, voffA);
        if (wr == 1) PG8_BAR;
        PG8_WAIT_V(4); PG8_BAR;
        PG8_STAGE(PG8_SB(1, 0), cB + kstep, voffB); PG8_STAGE(PG8_SA(1, 0), cA + kstep, voffA); PG8_STAGE(PG8_SB(1, 1), cB + hstep + kstep, voffB);
        PG8_WAIT_V(6); PG8_BAR;
    }
    for (;;) {
        const bool has_next = S.next(ui + 1, nxt);
        const char* nA = has_next ? (const char*)g.A + (size_t)nxt.pm * tstep : cA; const char* nB = has_next ? (const char*)g.Bt + (size_t)nxt.pn * tstep : cB;
        for (int t = 0; t < nt; t += 2) {
            const bool last = (t == nt - 2);
            const char* a1 = cA + (size_t)(t + 1) * kstep;
            const char* a2 = last ? nA : cA + (size_t)(t + 2) * kstep; const char* b2 = last ? nB : cB + (size_t)(t + 2) * kstep;
            const char* a3 = a2 + kstep; const char* b3 = b2 + kstep;
            if (last && has_next) S.a_ready(nxt);
            if constexpr (SP2) {
            PG8_LDB(B0, 0, 0); PG8_LDB(B1, 0, 1); PG8_SCHED; PG8_LDA(At, 0, 0); PG8_STAGE(PG8_SA(1, 1), a1 + hstep, voffA);
            PG8_WAIT_V(8); PG8_WAIT_L(0); PG8_BAR; PG8_MMA(0, 0, At, B0); PG8_MMA(0, 1, At, B1); PG8_BAR; PG8_SCHED;
            PG8_LDA(At, 0, 1); PG8_STAGE(PG8_SB(0, 0), b2, voffB); PG8_STAGE(PG8_SB(0, 1), b2 + hstep, voffB); PG8_STAGE(PG8_SA(0, 0), a2, voffA);
            PG8_WAIT_V(8); PG8_WAIT_L(0); PG8_BAR; PG8_MMA(1, 0, At, B0); PG8_MMA(1, 1, At, B1); PG8_BAR; PG8_SCHED;
            PG8_LDB(B0, 1, 0); PG8_LDB(B1, 1, 1); PG8_SCHED; PG8_LDA(At, 1, 0); PG8_STAGE(PG8_SA(0, 1), a2 + hstep, voffA);
            PG8_WAIT_V(8); PG8_WAIT_L(0); PG8_BAR; PG8_MMA(0, 0, At, B0); PG8_MMA(0, 1, At, B1); PG8_BAR; PG8_SCHED;
            PG8_LDA(At, 1, 1); PG8_STAGE(PG8_SB(1, 0), b3, voffB); PG8_STAGE(PG8_SB(1, 1), b3 + hstep, voffB); PG8_STAGE(PG8_SA(1, 0), a3, voffA);
            PG8_WAIT_V(8); PG8_WAIT_L(0); PG8_BAR; PG8_MMA(1, 0, At, B0); PG8_MMA(1, 1, At, B1); PG8_BAR; PG8_SCHED;
            } else {
            PG8_LDB(B0, 0, 0); PG8_SCHED; PG8_LDA(At, 0, 0); PG8_STAGE(PG8_SA(1, 1), a1 + hstep, voffA);
            PG8_WAIT_L(8); PG8_BAR; PG8_WAIT_L(0); PG8_MMA(0, 0, At, B0); PG8_BAR; PG8_SCHED;
            PG8_LDB(B1, 0, 1); PG8_STAGE(PG8_SB(0, 0), b2, voffB);
            PG8_BAR; PG8_WAIT_L(0); PG8_MMA(0, 1, At, B1); PG8_BAR;
            PG8_LDA(At, 0, 1); PG8_STAGE(PG8_SA(0, 0), a2, voffA);
            PG8_BAR; PG8_WAIT_L(0); PG8_MMA(1, 0, At, B0); PG8_BAR; PG8_SCHED;
            PG8_STAGE(PG8_SB(0, 1), b2 + hstep, voffB);
            PG8_WAIT_V(6); PG8_BAR; PG8_MMA(1, 1, At, B1); PG8_BAR;
            PG8_LDB(B0, 1, 0); PG8_SCHED; PG8_LDA(At, 1, 0); PG8_STAGE(PG8_SA(0, 1), a2 + hstep, voffA);
            PG8_WAIT_L(8); PG8_BAR; PG8_WAIT_L(0); PG8_MMA(0, 0, At, B0); PG8_BAR; PG8_SCHED;
            PG8_LDB(B1, 1, 1); PG8_STAGE(PG8_SB(1, 0), b3, voffB);
            PG8_BAR; PG8_WAIT_L(0); PG8_MMA(0, 1, At, B1); PG8_BAR;
            PG8_LDA(At, 1, 1); PG8_STAGE(PG8_SA(1, 0), a3, voffA);
            PG8_BAR; PG8_WAIT_L(0); PG8_MMA(1, 0, At, B0); PG8_BAR; PG8_SCHED;
            PG8_STAGE(PG8_SB(1, 1), b3 + hstep, voffB);
            PG8_WAIT_V(6); PG8_BAR; PG8_MMA(1, 1, At, B1); PG8_BAR;
            }
        }
        if constexpr (ALIGN_EPI) { if (wr == 0) PG8_BAR; }
        if constexpr (!Epi::AFTER_DRAIN) { E(acc, cur, wr, wc, fr, fq); S.done(cur); }
        if (!has_next) break;
#pragma unroll
        for (int a = 0; a < 2; ++a)
#pragma unroll
            for (int b = 0; b < 2; ++b)
#pragma unroll
                for (int m = 0; m < 4; ++m)
#pragma unroll
                    for (int n = 0; n < 2; ++n) acc[a][b][m][n] = (f32x4){0.f, 0.f, 0.f, 0.f};
        cur = nxt; cA = nA; cB = nB; ++ui;
        if constexpr (ALIGN_EPI) { if (wr == 1) PG8_BAR; }
    }
    PG8_WAIT_V(0);
    if constexpr (!ALIGN_EPI) { if (wr == 0) PG8_BAR; }
    PG8_BAR;
    if constexpr (Epi::AFTER_DRAIN) { E.fused(acc, cur, wr, wc, fr, fq, lds, wid, lane); S.done(cur); }
#undef PG8_SA
#undef PG8_SB
#undef PG8_STAGE
#undef PG8_LDA
#undef PG8_LDB
#undef PG8_MMA
#undef PG8_WAIT_V
#undef PG8_WAIT_L
#undef PG8_BAR
#undef PG8_SCHED
}
}

constexpr int T_TOK = 32768, DM = 1024, SEQ = 2048, NB = 16, DFF = 2816, THALF = 16384;
constexpr int NWAVES = 8;
constexpr int RB = 2176, HBR = 8 * RB;
constexpr int LDS_BYTES = 147456;
constexpr size_t MiB = 1u << 20;
constexpr size_t WS_SS = 0;
constexpr size_t WS_MST = 1 * MiB;
constexpr size_t WS_NST = 1 * MiB + 65536;
constexpr size_t WS_BAR = 3 * MiB;
constexpr size_t WS_WQKV = 4 * MiB;
constexpr size_t WS_WAO = 22 * MiB;
constexpr size_t WS_WFFIN = 24 * MiB;
constexpr size_t WS_WFFOUT = 46 * MiB;
constexpr size_t WS_WMIN = 57 * MiB;
constexpr size_t WS_WMOUT = 64 * MiB;
constexpr size_t WS_ROPE = 66 * MiB;
constexpr size_t WS_LSE = 70 * MiB;
constexpr size_t WS_GATES = 73 * MiB;
constexpr size_t WS_HB = 76 * MiB;
constexpr size_t WS_MX = 140 * MiB;
constexpr size_t WS_BIG = 204 * MiB;
constexpr size_t WS_H = WS_BIG;
constexpr size_t WS_ACT = WS_BIG + 128 * MiB;
constexpr size_t WS_END = 512 * MiB;
static_assert(WS_ACT + (size_t)T_TOK * DFF * 2 <= WS_END && WS_BIG + (size_t)72 * 8 * 2176 * 256 <= WS_END, "d_ws map");

#define LAS __attribute__((address_space(3)))
typedef unsigned short bf16;
typedef unsigned u32x4 __attribute__((ext_vector_type(4)));
typedef unsigned u32x2 __attribute__((ext_vector_type(2)));
typedef float f32x4 __attribute__((ext_vector_type(4)));
typedef float f32x16 __attribute__((ext_vector_type(16)));
typedef short bf16x8 __attribute__((ext_vector_type(8)));
typedef short s16x4 __attribute__((ext_vector_type(4)));
typedef float f32x2_t __attribute__((ext_vector_type(2)));
typedef __bf16 bf16x2_t __attribute__((ext_vector_type(2)));
__device__ __forceinline__ unsigned pk2(float lo, float hi) { f32x2_t v = {lo, hi}; bf16x2_t b = __builtin_convertvector(v, bf16x2_t); return __builtin_bit_cast(unsigned, b); }
__device__ __forceinline__ float bf_lo(unsigned w) { return __uint_as_float(w << 16); }
__device__ __forceinline__ float bf_hi(unsigned w) { return __uint_as_float(w & 0xffff0000u); }
__device__ __forceinline__ float wave_sum(float v) {
#pragma unroll
    for (int o = 1; o < 64; o <<= 1) v += __shfl_xor(v, o);
    return v;
}
__device__ __forceinline__ float wave_max(float v) {
#pragma unroll
    for (int o = 1; o < 64; o <<= 1) v = fmaxf(v, __shfl_xor(v, o));
    return v;
}
#define MFMA16(a, b, c) __builtin_amdgcn_mfma_f32_16x16x32_bf16((a), (b), (c), 0, 0, 0)
#define MFMA32(a, b, c) __builtin_amdgcn_mfma_f32_32x32x16_bf16((a), (b), (c), 0, 0, 0)

#define XB_TMO      128
#define XB_XCNT(j)  (256  + 64 * (j))
#define XB_XSUB(j)  (1280 + 64 * (j))
#define XB_XGEN(j)  (2304 + 64 * (j))
#define XB_TOP      3328
#define XB_TOPGEN   3392
#define XCD_BAR_WORDS 3456
#define XB_SPIN_CAP (1u << 18)

__device__ __forceinline__ unsigned xb_ld(unsigned* p)              { return __hip_atomic_load(p, __ATOMIC_RELAXED, __HIP_MEMORY_SCOPE_AGENT); }
__device__ __forceinline__ unsigned xb_add(unsigned* p, unsigned v) { return __hip_atomic_fetch_add(p, v, __ATOMIC_RELAXED, __HIP_MEMORY_SCOPE_AGENT); }
__device__ __forceinline__ unsigned xb_xcc_id() { return (unsigned)__builtin_amdgcn_s_getreg((3 << 11) | 20) & 0xFu; }
#define XB_SPIN(cond, bar) do { unsigned _sp = 0; while (cond) { __builtin_amdgcn_s_sleep(1); \
    if ((++_sp & 255u) == 0u) { if (xb_ld(&(bar)[XB_TMO])) break; if (_sp > XB_SPIN_CAP) { atomicAdd(&(bar)[XB_TMO], 1u); break; } } } } while (0)

struct XcdBarrier {
    unsigned* bar; unsigned x;
    volatile LAS unsigned* st;
};

__device__ __forceinline__ XcdBarrier xcd_barrier_post(unsigned* bar, volatile LAS unsigned* st) {
    XcdBarrier b; b.bar = bar; b.x = xb_xcc_id(); b.st = st;
    if (threadIdx.x == 0) (void)xb_add(&bar[XB_XCNT(b.x)], 1u);
    return b;
}
__device__ __forceinline__ void xcd_barrier_complete(unsigned* bar, unsigned x, unsigned& nloc, unsigned& nx) {
    const unsigned G = gridDim.x * gridDim.y * gridDim.z;
    unsigned sum, cnt, mine, sp = 0u;
    for (;;) {
        sum = 0u; cnt = 0u; mine = 0u;
#pragma unroll
        for (unsigned j = 0; j < 16; ++j) { const unsigned c = xb_ld(&bar[XB_XCNT(j)]); sum += c; cnt += (c > 0u) ? 1u : 0u; mine = (j == x) ? c : mine; }
        if (sum == G) break;
        __builtin_amdgcn_s_sleep(1);
        if ((++sp & 255u) == 0u) { if (xb_ld(&bar[XB_TMO])) break; if (sp > XB_SPIN_CAP) { atomicAdd(&bar[XB_TMO], 1u); break; } }
    }
    nloc = mine > 0u ? mine : 1u; nx = cnt > 0u ? cnt : 1u;
}

__device__ __forceinline__ void xcd_barrier(const XcdBarrier& b) {
    asm volatile("s_waitcnt vmcnt(0)" ::: "memory");
    __syncthreads();
    if (threadIdx.x == 0) {
        unsigned* bar = b.bar;
        __builtin_amdgcn_s_waitcnt(0);
        unsigned nloc = b.st[0], nx = b.st[1];
        if (nloc == 0u) { xcd_barrier_complete(bar, b.x, nloc, nx); b.st[0] = nloc; b.st[1] = nx; }
        const unsigned old = xb_add(&bar[XB_XSUB(b.x)], 1u);
        const unsigned gen = old / nloc;
        if (old + 1u == (gen + 1u) * nloc) {
            __builtin_amdgcn_fence(__ATOMIC_RELEASE, "agent");
            asm volatile("s_waitcnt vmcnt(0)" ::: "memory");
            const unsigned og = xb_add(&bar[XB_TOP], 1u);
            const unsigned tg = og / nx;
            if (og + 1u == (tg + 1u) * nx) xb_add(&bar[XB_TOPGEN], 1u);
            else XB_SPIN(xb_ld(&bar[XB_TOPGEN]) == tg, bar);
            __builtin_amdgcn_fence(__ATOMIC_ACQUIRE, "agent");
            xb_add(&bar[XB_XGEN(b.x)], 1u);
            asm volatile("s_waitcnt vmcnt(0)" ::: "memory");
        } else {
            XB_SPIN(xb_ld(&bar[XB_XGEN(b.x)]) == gen, bar);
            __builtin_amdgcn_fence(__ATOMIC_ACQUIRE, "agent");
            asm volatile("s_waitcnt vmcnt(0)" ::: "memory");
        }
    }
    __syncthreads();
}


struct Args {
    const float* x; const int* pos; const float* attn_norm; const float* attn_w_in; const float* attn_w_out; const float* mlstm_norm; const float* mlstm_w_in;
    const float* conv_w; const float* conv_b; const float* ig_bias; const float* fg_bias; const float* head_gain; const float* mlstm_w_out;
    const float* ffn_norm; const float* ffn_w_in; const float* ffn_w_out; const float* final_norm;
    float* out; unsigned char* ws; int ph_lo, ph_hi;
};

__device__ __forceinline__ void tr_item(const float* __restrict__ W, int K, int Nsrc, bf16* WT, int n0_dst, int n0_src, int k0, const float* __restrict__ gain, float scale, LAS float* scr, int lane, bool ropeperm = false) {
    const int n4 = lane & 15, kq = lane >> 4; const int s4 = (ropeperm && n4 < 8) ? (((n4 & 1) << 2) + (n4 >> 1)) : n4; const int col = n0_src + 4 * s4; const bool ok = col < Nsrc;
    f32x4 v[16];
#pragma unroll
    for (int i = 0; i < 16; ++i) { v[i] = (f32x4){0.f, 0.f, 0.f, 0.f}; if (ok) v[i] = __builtin_nontemporal_load((const f32x4*)(W + (size_t)(k0 + 4 * i + kq) * Nsrc + col)); }
#pragma unroll
    for (int i = 0; i < 16; ++i) { const int kk = 4 * i + kq; const float g = gain ? gain[k0 + kk] * scale : scale; LAS float* d = scr + kk * 65 + 4 * n4;
        d[0] = v[i][0] * g; d[1] = v[i][1] * g; d[2] = v[i][2] * g; d[3] = v[i][3] * g; }
    asm volatile("s_waitcnt lgkmcnt(0)" ::: "memory");
    const int c = lane & 7;
#pragma unroll
    for (int j = 0; j < 8; ++j) { const int n = (lane >> 3) + 8 * j; const LAS float* sp = scr + (8 * c) * 65 + n;
        u32x4 o; o.x = pk2(sp[0 * 65], sp[1 * 65]); o.y = pk2(sp[2 * 65], sp[3 * 65]); o.z = pk2(sp[4 * 65], sp[5 * 65]); o.w = pk2(sp[6 * 65], sp[7 * 65]);
        *(u32x4*)(WT + (size_t)(n0_dst + n) * K + k0 + 8 * c) = o; }
    asm volatile("s_waitcnt lgkmcnt(0)" ::: "memory");
}
__device__ __forceinline__ void p0_prologue(const Args& A, LAS unsigned char* lds, int G, int bid) {
    const int tid = threadIdx.x, lane = tid & 63, wave = tid >> 6;
    LAS float* scr = (LAS float*)(lds + wave * 16640);
    const int gw = bid * NWAVES + wave, NGW = G * NWAVES;
    unsigned char* ws = A.ws;
    constexpr int I_QKV = 16 * 144, I_AO = 16 * 16, I_FFIN = 16 * 88, I_FFOUT = 44 * 16, I_MIN = 16 * 52, I_MOUT = 16 * 16;
    constexpr int NITEMS = I_QKV + I_AO + 2 * I_FFIN + 2 * I_FFOUT + I_MIN + I_MOUT;
    constexpr float QSCALE = 0.08838834764831845f * 1.4426950408889634f;
    for (int it = gw; it < NITEMS; it += NGW) {
        int r = it;
        if (r < I_QKV) { const int kb = r / 144, nb = r % 144, n0 = 64 * nb; const int tsel = (n0 % 3072) / 1024;
            tr_item(A.attn_w_in, 1024, 9216, (bf16*)(ws + WS_WQKV), n0, n0, 64 * kb, A.attn_norm, tsel == 0 ? QSCALE : 1.f, scr, lane, tsel < 2 && (n0 & 127) == 0); continue; } r -= I_QKV;
        if (r < I_AO) { const int kb = r / 16, nb = r % 16; tr_item(A.attn_w_out, 1024, 1024, (bf16*)(ws + WS_WAO), 64 * nb, 64 * nb, 64 * kb, nullptr, 1.f, scr, lane); continue; } r -= I_AO;
        if (r < 2 * I_FFIN) { const int l = r / I_FFIN; r -= l * I_FFIN; const int kb = r / 88, nb = r % 88, n0 = 64 * nb;
            const int pn = n0 >> 8, bj = (n0 >> 7) & 1, jj = n0 & 127; const int nsrc = (bj ? DFF : 0) + 128 * pn + jj;
            tr_item(A.ffn_w_in + (size_t)l * 1024 * 5632, 1024, 5632, (bf16*)(ws + WS_WFFIN) + (size_t)l * 5632 * 1024, n0, nsrc, 64 * kb, A.ffn_norm + l * 1024, 1.f, scr, lane); continue; } r -= 2 * I_FFIN;
        if (r < 2 * I_FFOUT) { const int l = r / I_FFOUT; r -= l * I_FFOUT; const int kb = r / 16, nb = r % 16;
            tr_item(A.ffn_w_out + (size_t)l * DFF * 1024, DFF, 1024, (bf16*)(ws + WS_WFFOUT) + (size_t)l * 1024 * DFF, 64 * nb, 64 * nb, 64 * kb, nullptr, 1.f, scr, lane); continue; } r -= 2 * I_FFOUT;
        if (r < I_MIN) { const int kb = r / 52, nb = r % 52; tr_item(A.mlstm_w_in, 1024, 3088, (bf16*)(ws + WS_WMIN), 64 * nb, 64 * nb, 64 * kb, A.mlstm_norm, 1.f, scr, lane); continue; } r -= I_MIN;
        { const int kb = r / 16, nb = r % 16; tr_item(A.mlstm_w_out, 1024, 1024, (bf16*)(ws + WS_WMOUT), 64 * nb, 64 * nb, 64 * kb, nullptr, 1.f, scr, lane); }
    }
    float* ss = (float*)(ws + WS_SS); bf16* hb = (bf16*)(ws + WS_HB);
    for (int m4 = gw; m4 < T_TOK / 4; m4 += NGW) {
        f32x4 v[4][4];
#pragma unroll
        for (int q = 0; q < 4; ++q) { const f32x4* xr = (const f32x4*)(A.x + (size_t)(4 * m4 + q) * DM) + lane;
#pragma unroll
            for (int j = 0; j < 4; ++j) v[q][j] = __builtin_nontemporal_load(xr + 64 * j); }
#pragma unroll
        for (int q = 0; q < 4; ++q) { const int m = 4 * m4 + q; float sq = 0.f;
#pragma unroll
            for (int j = 0; j < 4; ++j) sq += (v[q][j].x * v[q][j].x + v[q][j].y * v[q][j].y) + (v[q][j].z * v[q][j].z + v[q][j].w * v[q][j].w);
            sq = wave_sum(sq);
            u32x2* o8 = (u32x2*)(hb + (size_t)m * DM) + lane;
#pragma unroll
            for (int j = 0; j < 4; ++j) { u32x2 o; o.x = pk2(v[q][j].x, v[q][j].y); o.y = pk2(v[q][j].z, v[q][j].w); o8[64 * j] = o; }
            if (lane == 0) ss[m] = sq; }
    }
    const int gt = bid * 512 + tid, NGT = G * 512;
    for (int i = gt; i < 4 * T_TOK; i += NGT) ss[T_TOK + i] = 0.f;
    float* rope = (float*)(ws + WS_ROPE);
    for (int i = gt; i < T_TOK * 16; i += NGT) {
        const int t = i >> 4, f = i & 15;
        const float invf = __builtin_amdgcn_exp2f((float)f * -1.1832230355827609f);
        const float ang = (float)A.pos[t] * invf;
        const double rev = (double)ang * 0.15915494309189535; const float fr = (float)(rev - rint(rev));
        rope[(size_t)t * 32 + f] = __builtin_amdgcn_cosf(fr); rope[(size_t)t * 32 + 16 + f] = __builtin_amdgcn_sinf(fr);
    }
}

struct AStep { const bf16* base; size_t rowstride; int blk, g, h, dil, rr, b; bool valid, compute; };
__device__ __forceinline__ AStep attn_step(int u, int s, const bf16* QKVh) {
    AStep t; t.valid = true; t.compute = true;
    if (s < 5) { t.g = 0; t.dil = 1; t.rr = 0; const int qt = u & 3; t.h = (u >> 2) & 7; t.b = u >> 5; t.blk = 4 * qt + s - 1; if (s == 0) { t.compute = false; t.valid = qt > 0; if (!t.valid) t.blk = 0; } }
    else if (s < 9) { t.g = 1; t.dil = 4; t.h = u & 7; t.rr = (u >> 3) & 3; t.b = u >> 5; t.blk = s - 5; }
    else { t.g = 2; t.dil = 16; const int v = 4 * u + (s - 9); t.h = v & 7; t.rr = (v >> 3) & 15; t.b = v >> 7; t.blk = 0; }
    t.rowstride = 128;
    t.base = QKVh + ((size_t)(t.g * 24 + t.h) * HBR + t.b * RB + t.rr * (SEQ / t.dil)) * 128;
    return t;
}
typedef short v4i16_t __attribute__((ext_vector_type(4)));
__device__ __forceinline__ s16x4 tr_read(const LAS unsigned char* p) { return __builtin_bit_cast(s16x4, __builtin_amdgcn_ds_read_tr16_b64_v4i16((LAS v4i16_t*)p)); }
__device__ __forceinline__ void attn_phase(LAS unsigned char* lds, const bf16* __restrict__ QKVh, bf16* __restrict__ Oh, float* __restrict__ lse, int half, int G, int bid) {
    const int tid = threadIdx.x, lane = tid & 63, w = __builtin_amdgcn_readfirstlane(tid >> 6), r = lane & 15, q4 = lane >> 4;
    constexpr int SLOT = 34816, VSLOT = 36864;
#define ATT_LOAD(st) do { \
        _Pragma("unroll") for (int i = 0; i < 4; ++i) { const int chunk = tid + 512 * i, c = chunk >> 4, ch = chunk & 15; const bf16* gp = (st).base + (size_t)(128 * (st).blk + c) * (st).rowstride + 8 * ch; \
            kr[i] = __builtin_nontemporal_load((const u32x4*)(gp + (size_t)8 * HBR * 128)); vr[i] = __builtin_nontemporal_load((const u32x4*)(gp + (size_t)16 * HBR * 128)); } \
        { const bf16* qrow = (st).base + (size_t)(128 * (st).blk + 16 * w + r) * (st).rowstride; \
            _Pragma("unroll") for (int q = 0; q < 4; ++q) qn[q] = *(const bf16x8*)(qrow + 32 * q + 8 * q4); } } while (0)
    for (int u = bid; u < 256; u += G) {
        AStep nx = attn_step(u, 0, QKVh);
        u32x4 kr[4], vr[4]; bf16x8 qn[4];
#pragma unroll
        for (int i = 0; i < 4; ++i) { kr[i] = (u32x4){0u, 0u, 0u, 0u}; vr[i] = kr[i]; qn[i] = (bf16x8){0, 0, 0, 0, 0, 0, 0, 0}; }
        ATT_LOAD(nx);
        for (int s = 0; s < 13; ++s) {
            const AStep cu = nx; const int cs = s & 1;
            LAS unsigned char* Kc = lds + cs * SLOT; LAS unsigned char* Vc = lds + 2 * SLOT + cs * VSLOT;
#pragma unroll
            for (int i = 0; i < 4; ++i) { const int chunk = tid + 512 * i, c = chunk >> 4, ch = chunk & 15; *(LAS u32x4*)(Kc + c * 272 + ch * 16) = kr[i]; *(LAS u32x4*)(Vc + c * 288 + ch * 16) = vr[i]; }
            bf16x8 qf[4];
#pragma unroll
            for (int q = 0; q < 4; ++q) qf[q] = qn[q];
            __syncthreads();
            { nx = attn_step(u, (s + 1 < 13) ? s + 1 : 12, QKVh); ATT_LOAD(nx); }
            if (cu.compute) {
                const bool first = (cu.blk == 0);
                const LAS unsigned char* Kp = first ? Kc : lds + (cs ^ 1) * SLOT; const LAS unsigned char* Vp = first ? Vc : lds + 2 * SLOT + (cs ^ 1) * VSLOT;
                const int a = 16 * w + r;
                const int jlo = first ? 8 : 0;
                f32x4 S[9]; float mx = -INFINITY;
#pragma unroll
                for (int jj = 0; jj < 9; ++jj) { const int j = w + jj; S[jj] = (f32x4){0.f, 0.f, 0.f, 0.f};
                    if (j >= jlo) { const LAS unsigned char* kp = (j >= 8 ? Kc : Kp) + ((j & 7) * 16 + r) * 272 + 16 * q4;
#pragma unroll
                        for (int st = 0; st < 4; ++st) { const bf16x8 kf = *(const LAS bf16x8*)(kp + 64 * st); S[jj] = MFMA16(kf, qf[st], S[jj]); } }
#pragma unroll
                    for (int i = 0; i < 4; ++i) { bool valid = (j >= jlo);
                        if (jj == 0) valid = valid && (4 * q4 + i >= r);
                        if (jj == 8) valid = valid && (4 * q4 + i <= r);
                        S[jj][i] = valid ? S[jj][i] : -INFINITY; mx = fmaxf(mx, S[jj][i]); } }
                mx = fmaxf(mx, __shfl_xor(mx, 16)); mx = fmaxf(mx, __shfl_xor(mx, 32));
                float den = 0.f;
#pragma unroll
                for (int jj = 0; jj < 9; ++jj)
#pragma unroll
                    for (int i = 0; i < 4; ++i) { const float pe = __builtin_amdgcn_exp2f(S[jj][i] - mx); S[jj][i] = pe; den += pe; }
                den += __shfl_xor(den, 16); den += __shfl_xor(den, 32);
                bf16x8 pf[5];
#pragma unroll
                for (int p = 0; p < 5; ++p) { u32x4 wv; wv.x = pk2(S[2 * p][0], S[2 * p][1]); wv.y = pk2(S[2 * p][2], S[2 * p][3]);
                    if (2 * p + 1 < 9) { wv.z = pk2(S[(2 * p + 1) % 9][0], S[(2 * p + 1) % 9][1]); wv.w = pk2(S[(2 * p + 1) % 9][2], S[(2 * p + 1) % 9][3]); } else { wv.z = 0u; wv.w = 0u; }
                    pf[p] = __builtin_bit_cast(bf16x8, wv); }
                f32x4 o[8];
#pragma unroll
                for (int db = 0; db < 8; ++db) o[db] = (f32x4){0.f, 0.f, 0.f, 0.f};
#pragma unroll
                for (int p = 0; p < 5; ++p) { const int j0 = w + 2 * p, j1 = (j0 + 1 > 15) ? 15 : j0 + 1;
                    if (j0 + 1 >= jlo) {
                        const LAS unsigned char* v0p = (j0 >= 8 ? Vc : Vp) + ((j0 & 7) * 16 + 4 * q4 + (r >> 2)) * 288 + 8 * (r & 3);
                        const LAS unsigned char* v1p = (j1 >= 8 ? Vc : Vp) + ((j1 & 7) * 16 + 4 * q4 + (r >> 2)) * 288 + 8 * (r & 3);
#pragma unroll
                        for (int db = 0; db < 8; ++db) {
                            const s16x4 lo = tr_read(v0p + 32 * db), hi = tr_read(v1p + 32 * db);
                            const bf16x8 af = __builtin_shufflevector(lo, hi, 0, 1, 2, 3, 4, 5, 6, 7);
                            o[db] = MFMA16(af, pf[p], o[db]); } } }
                const float inv = __builtin_amdgcn_rcpf(den);
                const int tl = cu.b * SEQ + (128 * cu.blk + a) * cu.dil + cu.rr;
                bf16* orow = Oh + ((size_t)(cu.g * 8 + cu.h) * HBR + cu.b * RB + cu.rr * (SEQ / cu.dil) + 128 * cu.blk + a) * 128 + 4 * q4;
#pragma unroll
                for (int db = 0; db < 8; ++db) { u32x2 wv; wv.x = pk2(o[db][0] * inv, o[db][1] * inv); wv.y = pk2(o[db][2] * inv, o[db][3] * inv); *(u32x2*)(orow + 16 * db) = wv; }
                if (q4 == 0) lse[((size_t)cu.g * T_TOK + (size_t)half * THALF + tl) * 8 + cu.h] = mx * 0.6931471805599453f + __logf(den);
            }
            __syncthreads();
        }
    }
#undef ATT_LOAD
}
__device__ __forceinline__ void merge_phase(const bf16* __restrict__ Oh, const float* __restrict__ lse, bf16* __restrict__ MX, int half, int G, int bid) {
    const int gt = bid * 512 + threadIdx.x, NGT = G * 512;
    for (int i = gt; i < THALF * 128; i += NGT) {
        const int tl = i >> 7, ch = i & 127, h = ch >> 4; const size_t tg = (size_t)half * THALF + tl;
        const float l0 = lse[((size_t)0 * T_TOK + tg) * 8 + h], l1 = lse[((size_t)1 * T_TOK + tg) * 8 + h], l2 = lse[((size_t)2 * T_TOK + tg) * 8 + h];
        const float mxl = fmaxf(l0, fmaxf(l1, l2)); float w0 = __expf(l0 - mxl), w1 = __expf(l1 - mxl), w2 = __expf(l2 - mxl); const float inv = 1.0f / (w0 + w1 + w2); w0 *= inv; w1 *= inv; w2 *= inv;
        const int sq = tl & 2047, bb = (tl >> 11) * RB, dch = ch & 15;
        const int p1 = ((sq & 3) << 9) + (sq >> 2), p2 = ((sq & 15) << 7) + (sq >> 4);
        const u32x4 a = __builtin_nontemporal_load((const u32x4*)(Oh + ((size_t)(0 + h) * HBR + bb + sq) * 128 + 8 * dch)), b = __builtin_nontemporal_load((const u32x4*)(Oh + ((size_t)(8 + h) * HBR + bb + p1) * 128 + 8 * dch)), c = __builtin_nontemporal_load((const u32x4*)(Oh + ((size_t)(16 + h) * HBR + bb + p2) * 128 + 8 * dch));
        u32x4 o;
#pragma unroll
        for (int e = 0; e < 4; ++e) o[e] = pk2(w0 * bf_lo(a[e]) + w1 * bf_lo(b[e]) + w2 * bf_lo(c[e]), w0 * bf_hi(a[e]) + w1 * bf_hi(b[e]) + w2 * bf_hi(c[e]));
        *(u32x4*)(MX + tg * 1024 + 8 * ch) = o;
    }
}
__device__ __forceinline__ float logsigmoid_f(float x) { return fminf(x, 0.f) - __logf(1.0f + __expf(-fabsf(x))); }
__device__ __forceinline__ void mlstm_pre_phase(const bf16* __restrict__ P2, const float* __restrict__ gates, const float* __restrict__ convw, const float* __restrict__ convb, const float* __restrict__ igb, const float* __restrict__ fgb,
                                                bf16* __restrict__ QKc, float* __restrict__ GA, float* __restrict__ GB, float* __restrict__ GP, float* __restrict__ CH, int G, int bid) {
    const int tid = threadIdx.x, lane = tid & 63, wave = tid >> 6;
    const int gt = bid * 512 + tid, NGT = G * 512;
    {
        const int ch = gt & 255, col = 4 * ch; const int tgs = NGT >> 8;
        float cw[4][4], cb[4];
        { const f32x4 b4 = *(const f32x4*)(convb + col);
#pragma unroll
          for (int e = 0; e < 4; ++e) cb[e] = b4[e];
#pragma unroll
          for (int j = 0; j < 4; ++j) { const f32x4 w4 = *(const f32x4*)(convw + j * 1024 + col);
#pragma unroll
              for (int e = 0; e < 4; ++e) cw[j][e] = w4[e]; } }
        const float ksc = (ch >= 128) ? 0.125f : 1.0f;
        u32x2 rn[11];
#define PRE_LOAD(tg_) do { const int t0_ = 8 * (tg_), sq0_ = t0_ & 2047; \
            _Pragma("unroll") for (int i = 0; i < 11; ++i) { const int dlt_ = (sq0_ + i - 3 >= 0) ? (i - 3) : -sq0_; \
                rn[i] = __builtin_nontemporal_load((const u32x2*)(P2 + (size_t)(t0_ + dlt_) * 2048 + col)); } } while (0)
        int tg = gt >> 8;
        if (tg < T_TOK / 8) PRE_LOAD(tg);
        for (; tg < T_TOK / 8; tg += tgs) {
            const int t0 = 8 * tg, sq0 = t0 & 2047;
            u32x2 rw[11];
#pragma unroll
            for (int i = 0; i < 11; ++i) rw[i] = (sq0 + i - 3 >= 0) ? rn[i] : (u32x2){0u, 0u};
            { const int tgn = (tg + tgs < T_TOK / 8) ? tg + tgs : tg; PRE_LOAD(tgn); }
#pragma unroll
            for (int i = 0; i < 8; ++i) { u32x2 o;
#pragma unroll
                for (int e = 0; e < 2; ++e) { float x0 = cb[2 * e], x1 = cb[2 * e + 1];
#pragma unroll
                    for (int j = 0; j < 4; ++j) { x0 += cw[j][2 * e] * bf_lo(rw[i + j][e]); x1 += cw[j][2 * e + 1] * bf_hi(rw[i + j][e]); }
                    o[e] = pk2(silu_f(x0) * ksc, silu_f(x1) * ksc); }
                *(u32x2*)(QKc + (size_t)(t0 + i) * 1024 + col) = o; }
        }
#undef PRE_LOAD
    }
    const int gw = bid * NWAVES + wave, NGW = G * NWAVES;
    for (int it = gw; it < NB * 32 * 8; it += NGW) {
        const int h = it & 7, c = (it >> 3) & 31, b = it >> 8; const size_t t = (size_t)b * SEQ + 64 * c + lane;
        const float gi = gates[t * 16 + h], gf = gates[t * 16 + 8 + h];
        float bs = logsigmoid_f(gf + fgb[h]);
#pragma unroll
        for (int o = 1; o < 64; o <<= 1) { const float v = __shfl_up(bs, o); if (lane >= o) bs += v; }
        const float av = gi + igb[h] - bs; float pm = av;
#pragma unroll
        for (int o = 1; o < 64; o <<= 1) { const float v = __shfl_up(pm, o); if (lane >= o) pm = fmaxf(pm, v); }
        const size_t o = (size_t)(b * 8 + h) * SEQ + 64 * c + lane; GA[o] = av; GB[o] = bs; GP[o] = pm;
        if (lane == 63) { const size_t cid = (size_t)(b * 8 + h) * 32 + c; CH[2 * cid] = bs; CH[2 * cid + 1] = bs + pm; }
    }
}
__device__ __forceinline__ void mlstm_scan_phase(LAS unsigned char* lds, const bf16* __restrict__ P2, const bf16* __restrict__ QKc, const float* __restrict__ GA, const float* __restrict__ CH,
                                                 bf16* __restrict__ Cst, float* __restrict__ nst, float* __restrict__ mst, int G, int bid) {
    const int tid = threadIdx.x, lane = tid & 63, w = __builtin_amdgcn_readfirstlane(tid >> 6), r = lane & 15, q4 = lane >> 4;
    const int dvb = w & 3, dkh = w >> 2;
    const bf16x8 ones = {0x3F80, 0x3F80, 0x3F80, 0x3F80, 0x3F80, 0x3F80, 0x3F80, 0x3F80};
    for (int item = bid; item < 256; item += G) {
        const int dvh = item & 1, h = (item >> 1) & 7, b = item >> 4;
        const size_t cid0 = (size_t)(b * 8 + h) * 32;
        f32x4 acc[2], accn[2]; acc[0] = (f32x4){0.f, 0.f, 0.f, 0.f}; acc[1] = acc[0]; accn[0] = acc[0]; accn[1] = acc[0];
        float mcar = 0.f;
        u32x4 nk, nv; float na, nbl, nml;
#define MSCAN_LOAD(c) do { const size_t t_ = (size_t)b * SEQ + 64 * (c) + lane; nk = *(const u32x4*)(QKc + t_ * 1024 + 512 + h * 64 + 8 * w); nv = *(const u32x4*)(P2 + t_ * 2048 + 1024 + h * 128 + 64 * dvh + 8 * w); \
            na = GA[(size_t)(b * 8 + h) * SEQ + 64 * (c) + lane]; nbl = CH[2 * (cid0 + (c))]; nml = CH[2 * (cid0 + (c)) + 1]; } while (0)
        MSCAN_LOAD(0);
        for (int c = 0; c < 32; ++c) {
            const u32x4 ck = nk, cv = nv; const float as = na, blast = nbl, mloc = nml;
            if (c + 1 < 32) MSCAN_LOAD(c + 1);
            const float mnew = fmaxf(blast + mcar, mloc);
            const float wsv = __expf(blast + as - mnew), carry = __expf(blast + mcar - mnew);
            const size_t cid = cid0 + c;
#pragma unroll
            for (int nb = 0; nb < 2; ++nb)
#pragma unroll
                for (int i = 0; i < 4; ++i) { const int dv = 64 * dvh + 16 * dvb + 4 * q4 + i, dk = 32 * dkh + 16 * nb + r;
                    Cst[(cid * 128 + dv) * 64 + dk] = (bf16)(pk2(acc[nb][i], 0.f) & 0xffffu); }
            if (dvh == 0 && dvb == 0 && q4 == 0) { nst[cid * 64 + 32 * dkh + r] = accn[0][0]; nst[cid * 64 + 32 * dkh + 16 + r] = accn[1][0]; }
            if (dvh == 0 && tid == 0) mst[cid] = mcar;
            LAS unsigned char* Kw = lds + (c & 1) * 18432; LAS unsigned char* Vs = Kw + 9216;
            u32x4 kw;
#pragma unroll
            for (int e = 0; e < 4; ++e) kw[e] = pk2(bf_lo(ck[e]) * wsv, bf_hi(ck[e]) * wsv);
            *(LAS u32x4*)(Kw + lane * 144 + 16 * w) = kw; *(LAS u32x4*)(Vs + lane * 144 + 16 * w) = cv;
            __syncthreads();
            acc[0] = acc[0] * carry; acc[1] = acc[1] * carry; accn[0] = accn[0] * carry; accn[1] = accn[1] * carry;
#pragma unroll
            for (int st = 0; st < 2; ++st) {
                const int rowb = (32 * st + 8 * q4 + (r >> 2)) * 144 + 8 * (r & 3);
                const s16x4 alo = tr_read(Vs + rowb + 32 * dvb), ahi = tr_read(Vs + rowb + 4 * 144 + 32 * dvb);
                const bf16x8 af = __builtin_shufflevector(alo, ahi, 0, 1, 2, 3, 4, 5, 6, 7);
#pragma unroll
                for (int nb = 0; nb < 2; ++nb) {
                    const s16x4 blo = tr_read(Kw + rowb + 64 * dkh + 32 * nb), bhi = tr_read(Kw + rowb + 4 * 144 + 64 * dkh + 32 * nb);
                    const bf16x8 bfr = __builtin_shufflevector(blo, bhi, 0, 1, 2, 3, 4, 5, 6, 7);
                    acc[nb] = MFMA16(af, bfr, acc[nb]);
                    if (dvb == 0) accn[nb] = MFMA16(ones, bfr, accn[nb]); }
            }
            mcar = mnew;
        }
        __syncthreads();
#undef MSCAN_LOAD
    }
}
__device__ __forceinline__ void mlstm_out_phase(LAS unsigned char* lds, const bf16* __restrict__ P2, const bf16* __restrict__ QKc, const bf16* __restrict__ OP, const float* __restrict__ GA, const float* __restrict__ GB, const float* __restrict__ GP,
                                                const float* __restrict__ hgain, const bf16* __restrict__ Cst, const float* __restrict__ nst, const float* __restrict__ mst, bf16* __restrict__ MX, int G, int bid) {
    const int tid = threadIdx.x, lane = tid & 63, w = __builtin_amdgcn_readfirstlane(tid >> 6), r = lane & 31, h2 = lane >> 5;
    const int dvb = w & 3, tb = w >> 2;
    constexpr int O_Q = 0, O_K = 9216, O_V = 18432, O_C = 38912, O_VEC = 57344, O_GN = 58368, O_PART = 58880, SETB = 59904;
    u32x4 pq, pk, pv0, pv1, pc0, pc1; float pvec = 0.f, pgn = 0.f, pmc = 0.f; u32x2 popv[4];
    pq = (u32x4){0u, 0u, 0u, 0u}; pk = pq; pv0 = pq; pv1 = pq; pc0 = pq; pc1 = pq;
#pragma unroll
    for (int gq = 0; gq < 4; ++gq) popv[gq] = (u32x2){0u, 0u};
#define OUT_LOAD(it) do { const int c_ = (it) & 31, h_ = ((it) >> 5) & 7, b_ = (it) >> 8; const size_t t0_ = (size_t)b_ * SEQ + 64 * c_; const size_t gb_ = (size_t)(b_ * 8 + h_) * SEQ + 64 * c_; \
        { const bf16* p_ = QKc + (t0_ + (tid >> 3)) * 1024 + h_ * 64 + 8 * (tid & 7); pq = *(const u32x4*)p_; pk = *(const u32x4*)(p_ + 512); } \
        { const bf16* p_ = P2 + (t0_ + (tid >> 4)) * 2048 + 1024 + h_ * 128 + 8 * (tid & 15); pv0 = *(const u32x4*)p_; pv1 = *(const u32x4*)(p_ + (size_t)32 * 2048); } \
        { const bf16* p_ = Cst + ((size_t)(it) * 128 + (tid >> 3)) * 64 + 8 * (tid & 7); pc0 = *(const u32x4*)p_; pc1 = *(const u32x4*)(p_ + 64 * 64); } \
        { const int wh_ = tid >> 6, ix_ = tid & 63; const float* src_ = (wh_ == 0) ? (GA + gb_) : (wh_ == 1) ? (GB + gb_) : (wh_ == 2) ? (GP + gb_) : (wh_ == 3) ? (nst + (size_t)(it) * 64) : (hgain + h_ * 128 + ((wh_ & 1) << 6)); pvec = src_[ix_]; } \
        pmc = mst[(it)]; \
        { const size_t orow_ = (t0_ + 32 * tb + r) * 1024 + h_ * 128 + 32 * dvb + 4 * h2; _Pragma("unroll") for (int gq = 0; gq < 4; ++gq) popv[gq] = *(const u32x2*)(OP + orow_ + 8 * gq); } } while (0)
    { const int fit = (bid < 4096) ? bid : 0; OUT_LOAD(fit); }
    int par = 0;
    for (int item = bid; item < 4096; item += G, par ^= 1) {
        const int c = item & 31, h = (item >> 5) & 7, b = item >> 8;
        const size_t t0 = (size_t)b * SEQ + 64 * c;
        LAS unsigned char* L = lds + par * SETB;
        LAS float* vec = (LAS float*)(L + O_VEC); LAS float* gnl = (LAS float*)(L + O_GN); LAS float* part = (LAS float*)(L + O_PART);
        *(LAS u32x4*)(L + O_Q + (tid >> 3) * 144 + (tid & 7) * 16) = pq; *(LAS u32x4*)(L + O_K + (tid >> 3) * 144 + (tid & 7) * 16) = pk;
        *(LAS u32x4*)(L + O_V + (tid >> 4) * 320 + (tid & 15) * 16) = pv0; *(LAS u32x4*)(L + O_V + (32 + (tid >> 4)) * 320 + (tid & 15) * 16) = pv1;
        *(LAS u32x4*)(L + O_C + (tid >> 3) * 144 + (tid & 7) * 16) = pc0; *(LAS u32x4*)(L + O_C + (64 + (tid >> 3)) * 144 + (tid & 7) * 16) = pc1;
        if (tid < 384) vec[tid] = pvec;
        const float mc = pmc; u32x2 opv[4];
#pragma unroll
        for (int gq = 0; gq < 4; ++gq) opv[gq] = popv[gq];
        __syncthreads();
        { const int nit = (item + G < 4096) ? item + G : item; OUT_LOAD(nit); }
        const int t = 32 * tb + r;
        const float Mt = fmaxf(mc, vec[128 + t]), bt = vec[64 + t];
        bf16x8 qf[4];
#pragma unroll
        for (int st = 0; st < 4; ++st) qf[st] = *(const LAS bf16x8*)(L + O_Q + t * 144 + (16 * st + 8 * h2) * 2);
        float qn = 0.f;
#pragma unroll
        for (int st = 0; st < 4; ++st) { const u32x4 qq = __builtin_bit_cast(u32x4, qf[st]); const f32x4 n0 = *(const LAS f32x4*)(vec + 192 + 16 * st + 8 * h2), n1 = *(const LAS f32x4*)(vec + 192 + 16 * st + 8 * h2 + 4);
#pragma unroll
            for (int e = 0; e < 2; ++e) { qn += bf_lo(qq[e]) * n0[2 * e] + bf_hi(qq[e]) * n0[2 * e + 1]; qn += bf_lo(qq[2 + e]) * n1[2 * e] + bf_hi(qq[2 + e]) * n1[2 * e + 1]; } }
        qn += __shfl_xor(qn, 32);
        f32x16 acc1, acc2;
#pragma unroll
        for (int i = 0; i < 16; ++i) { acc1[i] = 0.f; acc2[i] = 0.f; }
        float dsum = 0.f;
#pragma unroll
        for (int sb = 0; sb < 2; ++sb) {
            if (sb <= tb) {
                f32x16 S;
#pragma unroll
                for (int i = 0; i < 16; ++i) S[i] = 0.f;
#pragma unroll
                for (int st = 0; st < 4; ++st) { const bf16x8 kf = *(const LAS bf16x8*)(L + O_K + (32 * sb + r) * 144 + (16 * st + 8 * h2) * 2); S = MFMA32(kf, qf[st], S); }
#pragma unroll
                for (int gq = 0; gq < 4; ++gq) { const f32x4 a4 = *(const LAS f32x4*)(vec + 32 * sb + 8 * gq + 4 * h2);
#pragma unroll
                    for (int k = 0; k < 4; ++k) { const int i = 4 * gq + k, s = 32 * sb + 8 * gq + 4 * h2 + k; const float ev = __builtin_amdgcn_exp2f(fminf(a4[k] - Mt, 0.f) * 1.4426950408889634f);
                        const float wgt = (s <= t) ? ev : 0.f; S[i] = wgt * S[i]; dsum += S[i]; } }
#pragma unroll
                for (int sp = 0; sp < 2; ++sp) {
                    u32x4 wv; wv.x = pk2(S[8 * sp + 0], S[8 * sp + 1]); wv.y = pk2(S[8 * sp + 2], S[8 * sp + 3]); wv.z = pk2(S[8 * sp + 4], S[8 * sp + 5]); wv.w = pk2(S[8 * sp + 6], S[8 * sp + 7]);
                    const bf16x8 pfr = __builtin_bit_cast(bf16x8, wv);
                    const LAS unsigned char* vp = L + O_V + (32 * sb + 16 * sp + 4 * h2 + ((lane & 15) >> 2)) * 320 + (32 * dvb + 16 * ((lane >> 4) & 1) + 4 * (lane & 3)) * 2;
                    const s16x4 lo = tr_read(vp), hi = tr_read(vp + 8 * 320);
                    const bf16x8 af = __builtin_shufflevector(lo, hi, 0, 1, 2, 3, 4, 5, 6, 7);
                    acc1 = MFMA32(af, pfr, acc1);
                }
            }
        }
        dsum += __shfl_xor(dsum, 32);
#pragma unroll
        for (int st = 0; st < 4; ++st) { const bf16x8 cf = *(const LAS bf16x8*)(L + O_C + (32 * dvb + r) * 144 + (16 * st + 8 * h2) * 2); acc2 = MFMA32(cf, qf[st], acc2); }
        const float winter = __expf(mc - Mt);
        const float den = dsum + winter * qn;
        const float dnm = fmaxf(fabsf(den), __expf(-(bt + Mt)));
        const float idn = __builtin_amdgcn_rcpf(dnm);
        float hsq = 0.f;
#pragma unroll
        for (int i = 0; i < 16; ++i) { acc1[i] = (acc1[i] + winter * acc2[i]) * idn; hsq += acc1[i] * acc1[i]; }
        hsq += __shfl_xor(hsq, 32);
        if (h2 == 0) part[dvb * 64 + t] = hsq;
        __syncthreads();
        const float tot = (part[t] + part[64 + t]) + (part[128 + t] + part[192 + t]);
        const float rsn = __builtin_amdgcn_rsqf(tot * (1.0f / 128.0f) + RMS_EPS);
        const size_t orow = (t0 + t) * 1024 + h * 128 + 32 * dvb + 4 * h2;
#pragma unroll
        for (int gq = 0; gq < 4; ++gq) {
            const u32x2 op = opv[gq]; const f32x4 gn = *(const LAS f32x4*)(gnl + 32 * dvb + 4 * h2 + 8 * gq);
            const float y0 = acc1[4 * gq + 0] * rsn * gn[0] * sigmoid_f(bf_lo(op.x)), y1 = acc1[4 * gq + 1] * rsn * gn[1] * sigmoid_f(bf_hi(op.x));
            const float y2 = acc1[4 * gq + 2] * rsn * gn[2] * sigmoid_f(bf_lo(op.y)), y3 = acc1[4 * gq + 3] * rsn * gn[3] * sigmoid_f(bf_hi(op.y));
            u32x2 wv; wv.x = pk2(y0, y1); wv.y = pk2(y2, y3); *(u32x2*)(MX + orow + 8 * gq) = wv;
        }
    }
    __syncthreads();
#undef OUT_LOAD
}
__device__ __forceinline__ void final_phase(float* __restrict__ out, const bf16* __restrict__ hbv, const float* __restrict__ ss, const float* __restrict__ gain, int G, int bid) {
    const int gt = bid * 512 + threadIdx.x, NGT = G * 512;
    for (int i = gt; i < T_TOK * 128; i += NGT) { const int t = i >> 7, c8 = i & 127; const float rs = rs_from_ss(ss[t]);
        const u32x4 hv = __builtin_nontemporal_load((const u32x4*)(hbv + (size_t)t * 1024 + 8 * c8)); const f32x4 g0 = *(const f32x4*)(gain + 8 * c8), g1 = *(const f32x4*)(gain + 8 * c8 + 4);
        f32x4 o0, o1; o0[0] = bf_lo(hv[0]); o0[1] = bf_hi(hv[0]); o0[2] = bf_lo(hv[1]); o0[3] = bf_hi(hv[1]); o1[0] = bf_lo(hv[2]); o1[1] = bf_hi(hv[2]); o1[2] = bf_lo(hv[3]); o1[3] = bf_hi(hv[3]);
        o0 = o0 * rs * g0; o1 = o1 * rs * g1;
        *(f32x4*)(out + (size_t)t * 1024 + 8 * c8) = o0; *(f32x4*)(out + (size_t)t * 1024 + 8 * c8 + 4) = o1; }
}
__global__ void __launch_bounds__(NWAVES * 64, 2) mega_fwd(Args A) {
    extern __shared__ __attribute__((aligned(16))) unsigned char lds_raw[];
    LAS unsigned char* lds = (LAS unsigned char*)lds_raw;
    cg::grid_group grid = cg::this_grid();
    const int G = gridDim.x, bid = blockIdx.x;
    unsigned char* ws = A.ws;
    float* ss = (float*)(ws + WS_SS);
    bf16* hb = (bf16*)(ws + WS_HB); bf16* MX = (bf16*)(ws + WS_MX);
    bf16* QKVh = (bf16*)(ws + WS_BIG); bf16* R = (bf16*)(ws + WS_H);        bf16* ACT = (bf16*)(ws + WS_ACT); bf16* P2 = (bf16*)(ws + WS_ACT);
    bf16* Oh = (bf16*)A.out; bf16* Cst = (bf16*)A.out; bf16* OP = (bf16*)A.out + (size_t)32 * 1024 * 1024;
    float* lse = (float*)(ws + WS_LSE); float* gates = (float*)(ws + WS_GATES); float* rope = (float*)(ws + WS_ROPE);
    float* mst = (float*)(ws + WS_MST); float* nst = (float*)(ws + WS_NST);
    bf16* QKc = hb;
    float* GA = (float*)(ws + 460 * MiB); float* GB = GA + (size_t)T_TOK * 8; float* GP = GB + (size_t)T_TOK * 8; float* CH = GP + (size_t)T_TOK * 8;
    const int lo = A.ph_lo, hi = A.ph_hi;
    volatile LAS unsigned* MISC = (volatile LAS unsigned*)(lds + LDS_BYTES - 256);
    if (threadIdx.x < 16) MISC[threadIdx.x] = 0u;
    __syncthreads();
    const XcdBarrier bar = xcd_barrier_post((unsigned*)(ws + WS_BAR), MISC + 8);
#ifndef PROBE_MASK
#define PROBE_MASK 0u
#endif
#define PROBE_K 4ull
    unsigned long long pr_sum = 0ull, pr_t0 = 0ull, pr_s0 = 0ull;
#define PB(k) do { if (PROBE_MASK & (1u << (k))) pr_t0 = __builtin_amdgcn_s_memrealtime(); } while (0)
#define PE(k) do { if (PROBE_MASK & (1u << (k))) pr_sum += __builtin_amdgcn_s_memrealtime() - pr_t0; } while (0)
#define IN(k) (lo <= (k) && (k) < hi)
#define SYNC(k) do { if (IN(k) && IN((k) + 1)) { if (PROBE_MASK & (1u << 30)) pr_s0 = __builtin_amdgcn_s_memrealtime(); if (hi < 0) { __threadfence(); grid.sync(); __threadfence(); } else xcd_barrier(bar); if (PROBE_MASK & (1u << 30)) pr_sum += __builtin_amdgcn_s_memrealtime() - pr_s0; if (PROBE_MASK & (1u << 29)) { pr_s0 = __builtin_amdgcn_s_memrealtime(); xcd_barrier(bar); pr_sum += __builtin_amdgcn_s_memrealtime() - pr_s0; } } PE(k); } while (0)
    PB(0); if (IN(0)) p0_prologue(A, lds, G, bid);
    SYNC(0);
    PB(1); if (IN(1)) { pg8::Gemm g{hb, (const bf16*)(ws + WS_WQKV), THALF, 9216, 1024}; pg8::StaticOrder S; S.init(THALF, 9216, G, bid);
        pg8::EpiQKV E{QKVh, ss, rope}; pg8::gemm_phase<pg8::EpiQKV, pg8::StaticOrder, true, true>(lds, g, S, E); }
    SYNC(1);
    PB(2); if (IN(2)) attn_phase(lds, QKVh, Oh, lse, 0, G, bid);
    SYNC(2);
    PB(3); if (IN(3)) { merge_phase(Oh, lse, MX, 0, G, bid);
        pg8::Gemm g{hb + (size_t)THALF * 1024, (const bf16*)(ws + WS_WQKV), THALF, 9216, 1024}; pg8::StaticOrder S; S.init(THALF, 9216, G, bid);
        pg8::EpiQKV E{QKVh, ss + THALF, rope + (size_t)THALF * 32}; pg8::gemm_phase<pg8::EpiQKV, pg8::StaticOrder, true, true>(lds, g, S, E); }
    SYNC(3);
    PB(4); if (IN(4)) attn_phase(lds, QKVh, Oh, lse, 1, G, bid);
    SYNC(4);
    PB(5); if (IN(5)) merge_phase(Oh, lse, MX, 1, G, bid);
    SYNC(5);
    PB(6); if (IN(6)) { pg8::Gemm g{MX, (const bf16*)(ws + WS_WAO), T_TOK, 1024, 1024}; pg8::StaticOrder S; S.init(T_TOK, 1024, G, bid);
        pg8::EpiResidT<false> E{hb, R, ss + T_TOK}; pg8::gemm_phase<pg8::EpiResidT<false>, pg8::StaticOrder, true, true>(lds, g, S, E); }
    SYNC(6);
    PB(7); if (IN(7)) { pg8::Gemm g{R, (const bf16*)(ws + WS_WFFIN), T_TOK, 5632, 1024}; pg8::StaticOrder S; S.init(T_TOK, 5632, G, bid);
        pg8::EpiSwiGLU E{ACT, ss + T_TOK}; pg8::gemm_phase<pg8::EpiSwiGLU, pg8::StaticOrder, true, true>(lds, g, S, E); }
    SYNC(7);
    PB(8); if (IN(8)) { pg8::Gemm g{ACT, (const bf16*)(ws + WS_WFFOUT), T_TOK, 1024, DFF}; pg8::StaticOrder S; S.init(T_TOK, 1024, G, bid);
        pg8::EpiResidT<false> E{R, R, ss + 2 * T_TOK}; pg8::gemm_phase<pg8::EpiResidT<false>, pg8::StaticOrder, true, true>(lds, g, S, E); }
    SYNC(8);
    PB(9); if (IN(9)) { pg8::Gemm g{R, (const bf16*)(ws + WS_WMIN), T_TOK, 3328, 1024}; pg8::StaticOrder S; S.init(T_TOK, 3328, G, bid);
        pg8::EpiMlstmIn E{P2, OP, gates, ss + 2 * T_TOK}; pg8::gemm_phase<pg8::EpiMlstmIn, pg8::StaticOrder, true, true>(lds, g, S, E); }
    SYNC(9);
    PB(10); if (IN(10)) { mlstm_pre_phase(P2, gates, A.conv_w, A.conv_b, A.ig_bias, A.fg_bias, QKc, GA, GB, GP, CH, G, bid); xcd_barrier(bar);
        mlstm_scan_phase(lds, P2, QKc, GA, CH, Cst, nst, mst, G, bid); }
    SYNC(10);
    PB(11); if (IN(11)) mlstm_out_phase(lds, P2, QKc, OP, GA, GB, GP, A.head_gain, Cst, nst, mst, MX, G, bid);
    SYNC(11);
    PB(12); if (IN(12)) { pg8::Gemm g{MX, (const bf16*)(ws + WS_WMOUT), T_TOK, 1024, 1024}; pg8::StaticOrder S; S.init(T_TOK, 1024, G, bid);
        pg8::EpiResidT<false> E{R, R, ss + 3 * T_TOK}; pg8::gemm_phase<pg8::EpiResidT<false>, pg8::StaticOrder, true, true>(lds, g, S, E); }
    SYNC(12);
    PB(13); if (IN(13)) { pg8::Gemm g{R, (const bf16*)(ws + WS_WFFIN) + (size_t)5632 * 1024, T_TOK, 5632, 1024}; pg8::StaticOrder S; S.init(T_TOK, 5632, G, bid);
        pg8::EpiSwiGLU E{ACT, ss + 3 * T_TOK}; pg8::gemm_phase<pg8::EpiSwiGLU, pg8::StaticOrder, true, true>(lds, g, S, E); }
    SYNC(13);
    const bool fuse_fin = (G == 256) && IN(14) && IN(15);
    PB(14); if (IN(14)) { pg8::Gemm g{ACT, (const bf16*)(ws + WS_WFFOUT) + (size_t)1024 * DFF, T_TOK, 1024, DFF}; pg8::StaticOrder S; S.init(T_TOK, 1024, G, bid);
        if (fuse_fin) { pg8::EpiFinal E{R, A.out, ss + 4 * T_TOK, A.final_norm, (unsigned*)(ws + WS_BAR) + 4096}; pg8::gemm_phase<pg8::EpiFinal, pg8::StaticOrder, true, true>(lds, g, S, E); }
        else { pg8::EpiResidT<false> E{R, R, ss + 4 * T_TOK}; pg8::gemm_phase<pg8::EpiResidT<false>, pg8::StaticOrder, true, true>(lds, g, S, E); } }
    if (!fuse_fin) { SYNC(14); }
    PB(15); if (IN(15) && !fuse_fin) final_phase(A.out, R, ss + 4 * T_TOK, A.final_norm, G, bid);
    PE(15);
    if (PROBE_MASK != 0u && bid == 0 && threadIdx.x == 0) { const unsigned long long te = __builtin_amdgcn_s_memrealtime(); while (__builtin_amdgcn_s_memrealtime() - te < PROBE_K * pr_sum) __builtin_amdgcn_s_sleep(8); }
#undef IN
#undef SYNC
}

extern "C" void kernel_launch(void* const* d_in, const int* in_sizes, int n_in, void* d_out, int out_size, void* d_ws, size_t ws_size, hipStream_t stream) {
    static int grid = 0;
    if (grid == 0) {
        if (n_in != 17 || in_sizes[0] != T_TOK * DM || out_size != T_TOK * DM || ws_size < WS_END) { fprintf(stderr, "kernel_launch: unexpected shapes (n_in %d, in0 %d, out %d, ws %zu); nothing launched\n", n_in, n_in > 0 ? in_sizes[0] : -1, out_size, ws_size); grid = -1; return; }
        int dev = 0, cus = 0, per_cu = 0;
        if (hipGetDevice(&dev) != hipSuccess || hipDeviceGetAttribute(&cus, hipDeviceAttributeMultiprocessorCount, dev) != hipSuccess) { grid = -1; return; }
        if (hipFuncSetAttribute((const void*)mega_fwd, hipFuncAttributeMaxDynamicSharedMemorySize, LDS_BYTES) != hipSuccess) { fprintf(stderr, "kernel_launch: hipFuncSetAttribute failed\n"); grid = -1; return; }
        if (hipOccupancyMaxActiveBlocksPerMultiprocessor(&per_cu, (const void*)mega_fwd, NWAVES * 64, LDS_BYTES) != hipSuccess || per_cu < 1) { fprintf(stderr, "kernel_launch: occupancy query says %d\n", per_cu); per_cu = 1; }
        (void)hipGetLastError();
        grid = cus;
    }
    if (grid < 0) return;
    Args a{};
    a.x = (const float*)d_in[0]; a.pos = (const int*)d_in[1]; a.attn_norm = (const float*)d_in[2]; a.attn_w_in = (const float*)d_in[3]; a.attn_w_out = (const float*)d_in[4];
    a.mlstm_norm = (const float*)d_in[5]; a.mlstm_w_in = (const float*)d_in[6]; a.conv_w = (const float*)d_in[7]; a.conv_b = (const float*)d_in[8]; a.ig_bias = (const float*)d_in[9];
    a.fg_bias = (const float*)d_in[10]; a.head_gain = (const float*)d_in[11]; a.mlstm_w_out = (const float*)d_in[12]; a.ffn_norm = (const float*)d_in[13]; a.ffn_w_in = (const float*)d_in[14];
    a.ffn_w_out = (const float*)d_in[15]; a.final_norm = (const float*)d_in[16];
    a.out = (float*)d_out; a.ws = (unsigned char*)d_ws; a.ph_lo = 0; a.ph_hi = 16;
    if (hipMemsetAsync((char*)d_ws + WS_BAR, 0, 65536, stream) != hipSuccess) { fprintf(stderr, "kernel_launch: hipMemsetAsync failed\n"); return; }
    void* args[] = {&a};
    const hipError_t e = hipLaunchCooperativeKernel((const void*)mega_fwd, dim3(grid), dim3(NWAVES * 64), args, LDS_BYTES, stream);
    if (e != hipSuccess) fprintf(stderr, "kernel_launch: cooperative launch failed: %s (grid %d)\n", hipGetErrorString(e), grid);
}
```
